# Optimizing an MI355X kernel written in HIP

```python
import jax, jax.numpy as jnp
from jax import lax
import numpy as np

D_MODEL = 1024
BATCH = 8
SEQ = 2048
DEPTH = 2

GRID_W = 64
CTX_LEN = 256
D_MIX = D_MODEL

A_HEADS = 6
A_HEAD_DIM = 64
A_WIDTH = A_HEADS * A_HEAD_DIM
DECAY_LORA = 64
ICL_LORA = 64
GATE_LORA = 128
LOG_DECAY_SCALE = 0.606531
GN_EPS = A_HEAD_DIM * 1e-5

B_HEADS = 6
QK_NOPE = 64
QK_ROPE = 32
V_HEAD = 64
B_WIDTH = B_HEADS * V_HEAD
Q_LORA = 768
KV_LORA = 256
ROPE_BASE = 10000.0
Q_BLOCK = 128
ATTN_SCALE = (QK_NOPE + QK_ROPE) ** -0.5

C_GROUPS = 4
C_WIDTH = D_MIX - A_WIDTH - B_WIDTH
CONV_W = 3

D_FF = -(-8 * D_MODEL // (3 * 256)) * 256

A_IN = 3 * A_WIDTH + DECAY_LORA + ICL_LORA + GATE_LORA
B_IN = Q_LORA + KV_LORA + QK_ROPE
C_IN = 3 * C_WIDTH
P_IN = A_IN + B_IN + C_IN
EPS = 1e-6

kernel_name = 'hybrid_rwkv7_mla_shortconv_prefix_dit'


def rms_norm(x, g):
    xf = x.astype(jnp.float32)
    y = xf * lax.rsqrt(jnp.mean(xf * xf, axis=-1, keepdims=True) + EPS)
    return (y * g.astype(jnp.float32)).astype(x.dtype)


def shift_prev(u):
    return jnp.pad(u, ((0, 0), (1, 0), (0, 0)))[:, :-1]


def shift_next(u):
    return jnp.pad(u, ((0, 0), (0, 1), (0, 0)))[:, 1:]


def adaln_params(cond, ada_w, ada_b):
    return jnp.split(jax.nn.silu(cond) @ ada_w + ada_b, 6, axis=-1)


def modulated_norm(x, g, shift, scale):
    return rms_norm(x, g) * (1 + scale) + shift


def axial_rope_tables(rows, dtype):
    r_pos, c_pos = jnp.meshgrid(jnp.arange(rows, dtype=jnp.float32),
                                jnp.arange(GRID_W, dtype=jnp.float32), indexing='ij')
    axis_dim = QK_ROPE // 2
    inv_freq = 1.0 / (ROPE_BASE ** (jnp.arange(0, axis_dim, 2, dtype=jnp.float32) / axis_dim))
    ang_r = r_pos.reshape(-1)[:, None] * inv_freq
    ang_c = c_pos.reshape(-1)[:, None] * inv_freq
    return tuple(t.astype(dtype) for t in (jnp.cos(ang_r), jnp.sin(ang_r), jnp.cos(ang_c), jnp.sin(ang_c)))


def rope_axis(x, cos, sin):
    half = x.shape[-1] // 2
    x1, x2 = x[..., :half], x[..., half:]
    return jnp.concatenate([x1 * cos - x2 * sin, x2 * cos + x1 * sin], axis=-1)


def rope_2d(x, tabs):
    cos_r, sin_r, cos_c, sin_c = tabs
    half = QK_ROPE // 2
    return jnp.concatenate([rope_axis(x[..., :half], cos_r, sin_r),
                            rope_axis(x[..., half:], cos_c, sin_c)], axis=-1)


def wkv7_scan(r, w, k, v, a_vec, b_vec, reverse):
    bsz, _, h, n = r.shape
    xs = tuple(jnp.moveaxis(t.astype(jnp.float32), 1, 0) for t in (r, w, k, v, a_vec, b_vec))

    def step(s, inp):
        r_t, w_t, k_t, v_t, a_t, b_t = inp
        sa = jnp.einsum('bhvk,bhk->bhv', s, a_t)
        s = (s * w_t[:, :, None, :] + sa[..., :, None] * b_t[:, :, None, :]
             + v_t[..., :, None] * k_t[:, :, None, :])
        return s, jnp.einsum('bhvk,bhk->bhv', s, r_t)

    s0 = jnp.zeros((bsz, h, n, n), jnp.float32)
    _, y = lax.scan(step, s0, xs, reverse=reverse)
    return jnp.moveaxis(y, 0, 1)


def rwkv7_group(p_ctx, p_lat, tshift_mu, decay_w0, decay_up, icl_a0, icl_up, gate_up,
                k_k, k_a, r_k, lnx_g, lnx_b):
    n_ctx = p_ctx.shape[1]

    def token_shift(p):
        return p + tshift_mu[0] * (shift_prev(p) - p) + tshift_mu[1] * (shift_next(p) - p)

    p = jnp.concatenate([token_shift(p_ctx), token_shift(p_lat)], axis=1)
    bsz, t_all = p.shape[:2]

    def heads(u):
        return u.reshape(bsz, t_all, A_HEADS, A_HEAD_DIM)

    o1, o2, o3 = A_WIDTH, 2 * A_WIDTH, 3 * A_WIDTH
    o4 = o3 + DECAY_LORA
    o5 = o4 + ICL_LORA
    r, k, v = p[..., :o1], p[..., o1:o2], p[..., o2:o3]
    w_lo, a_lo, g_lo = p[..., o3:o4], p[..., o4:o5], p[..., o5:]
    kk = heads(k * k_k).astype(jnp.float32)
    kk = kk * lax.rsqrt(jnp.sum(kk * kk, axis=-1, keepdims=True) + 1e-12)
    rh, vh = heads(r), heads(v)

    def direction(d):
        w = jnp.exp(-LOG_DECAY_SCALE * jax.nn.sigmoid(
            (decay_w0[d] + jnp.tanh(w_lo) @ decay_up[d]).astype(jnp.float32)))
        a = jax.nn.sigmoid((icl_a0[d] + a_lo @ icl_up[d]).astype(jnp.float32))
        k_d = k * (1 + (a.astype(k.dtype) - 1) * k_a)
        return heads(w), heads(k_d), -kk, kk * heads(a)

    w_f, k_f, a_f, b_f = direction(0)
    y_f = wkv7_scan(rh, w_f, k_f, vh, a_f, b_f, reverse=False)

    def to_bwd(u):
        return jnp.concatenate([u[:, n_ctx:], u[:, :n_ctx]], axis=1)

    def from_bwd(u):
        n_lat = t_all - n_ctx
        return jnp.concatenate([u[:, n_lat:], u[:, :n_lat]], axis=1)

    w_b, k_b, a_b, b_b = direction(1)
    y_b = from_bwd(wkv7_scan(*(to_bwd(u) for u in (rh, w_b, k_b, vh, a_b, b_b)), reverse=True))

    y = y_f + y_b
    mu = jnp.mean(y, axis=-1, keepdims=True)
    var = jnp.mean(jnp.square(y - mu), axis=-1, keepdims=True)
    y = ((y - mu) * lax.rsqrt(var + GN_EPS)).reshape(bsz, t_all, A_WIDTH) * lnx_g + lnx_b
    bonus = (jnp.sum(rh * (k_f + k_b) * r_k, axis=-1, keepdims=True) * vh).reshape(bsz, t_all, A_WIDTH)
    gate = jax.nn.sigmoid(g_lo) @ gate_up
    out = (y.astype(p.dtype) + bonus) * gate
    return out[:, :n_ctx], out[:, n_ctx:]


def mla_attend(q_n, q_r, k_n, k_r, v):
    s = jnp.einsum('bqhd,bkhd->bhqk', q_n, k_n) + jnp.einsum('bqhr,bkr->bhqk', q_r, k_r)
    p = jax.nn.softmax(s.astype(jnp.float32) * ATTN_SCALE, axis=-1).astype(v.dtype)
    return jnp.einsum('bhqk,bkhd->bqhd', p, v)


def mla_group(p_lat, p_ctx, q_norm_g, kv_norm_g, w_uq, w_ukv, q_nope_g, k_nope_g, q_rope_g, k_rope_g,
              rope_tabs, need_ctx):
    def queries(p):
        bsz, t = p.shape[:2]
        q = (rms_norm(p[..., :Q_LORA], q_norm_g) @ w_uq).reshape(bsz, t, B_HEADS, QK_NOPE + QK_ROPE)
        return rms_norm(q[..., :QK_NOPE], q_nope_g), rms_norm(q[..., QK_NOPE:], q_rope_g)

    def keys_values(p):
        bsz, t = p.shape[:2]
        kv = (rms_norm(p[..., Q_LORA:Q_LORA + KV_LORA], kv_norm_g) @ w_ukv).reshape(
            bsz, t, B_HEADS, QK_NOPE + V_HEAD)
        k_r = rms_norm(p[..., Q_LORA + KV_LORA:], k_rope_g)
        return rms_norm(kv[..., :QK_NOPE], k_nope_g), k_r, kv[..., QK_NOPE:]

    bsz, n = p_lat.shape[:2]
    n_ctx = p_ctx.shape[1]
    q_n, q_r = queries(p_lat)
    q_r = rope_2d(q_r, tuple(t[:, None, :] for t in rope_tabs))
    k_n, k_r, v = keys_values(p_lat)
    k_r = rope_2d(k_r, rope_tabs)
    kc_n, kc_r, vc = keys_values(p_ctx)
    k_all_n = jnp.concatenate([k_n, kc_n], axis=1)
    k_all_r = jnp.concatenate([k_r, kc_r], axis=1)
    v_all = jnp.concatenate([v, vc], axis=1)

    nb = n // Q_BLOCK

    def blocks(t):
        return jnp.swapaxes(t.reshape((bsz, nb, Q_BLOCK) + t.shape[2:]), 0, 1)

    out = lax.map(lambda qs: mla_attend(qs[0], qs[1], k_all_n, k_all_r, v_all), (blocks(q_n), blocks(q_r)))
    y_lat = jnp.swapaxes(out, 0, 1).reshape(bsz, n, B_WIDTH)
    y_ctx = None
    if need_ctx:
        qc_n, qc_r = queries(p_ctx)
        y_ctx = mla_attend(qc_n, qc_r, kc_n, kc_r, vc).reshape(bsz, n_ctx, B_WIDTH)
    return y_lat, y_ctx


def short_conv_group(p, conv_w):
    b_gate, c_gate, h = p[..., :C_WIDTH], p[..., C_WIDTH:2 * C_WIDTH], p[..., 2 * C_WIDTH:]
    u = c_gate * h
    conv = conv_w[0] * shift_prev(u) + conv_w[1] * u + conv_w[2] * shift_next(u)
    return b_gate * conv


def swiglu(h, w_in, w_out):
    gate, up = jnp.split(h @ w_in, 2, axis=-1)
    return (jax.nn.silu(gate) * up) @ w_out


def setup_inputs(seed: int = 0) -> dict:
    key = jax.random.key(seed)
    ks = iter(jax.random.split(key, 40))
    f32 = jnp.float32

    def nrm(shape, scale):
        return jax.random.normal(next(ks), shape, f32) * scale

    def gain(shape):
        return 1.0 + nrm(shape, 0.02)

    return {
        'x': nrm((BATCH, SEQ, D_MODEL), 1.0),
        'c': nrm((BATCH, D_MODEL), 1.0),
        'ctx': nrm((BATCH, CTX_LEN, D_MODEL), 1.0),
        'c_ctx': nrm((D_MODEL,), 1.0),
        'ada_w': nrm((DEPTH, D_MODEL, 6 * D_MODEL), 0.5 * D_MODEL ** -0.5),
        'ada_b': nrm((DEPTH, 6 * D_MODEL), 0.02),
        'norm1_g': gain((DEPTH, D_MODEL)),
        'norm2_g': gain((DEPTH, D_MODEL)),
        'w_in': nrm((DEPTH, D_MODEL, P_IN), D_MODEL ** -0.5),
        'tshift_mu': jax.random.uniform(next(ks), (DEPTH, 2, A_IN), f32, 0.0, 0.5),
        'decay_w0': nrm((DEPTH, 2, A_WIDTH), 0.5),
        'decay_up': nrm((DEPTH, 2, DECAY_LORA, A_WIDTH), 0.5 * DECAY_LORA ** -0.5),
        'icl_a0': nrm((DEPTH, 2, A_WIDTH), 0.5),
        'icl_up': nrm((DEPTH, 2, ICL_LORA, A_WIDTH), 0.5 * ICL_LORA ** -0.5),
        'gate_up': nrm((DEPTH, GATE_LORA, A_WIDTH), GATE_LORA ** -0.5),
        'k_k': 0.85 + nrm((DEPTH, A_WIDTH), 0.05),
        'k_a': 1.0 + nrm((DEPTH, A_WIDTH), 0.05),
        'r_k': nrm((DEPTH, A_HEADS, A_HEAD_DIM), 0.1),
        'lnx_g': gain((DEPTH, A_WIDTH)),
        'lnx_b': nrm((DEPTH, A_WIDTH), 0.02),
        'q_norm_g': gain((DEPTH, Q_LORA)),
        'kv_norm_g': gain((DEPTH, KV_LORA)),
        'w_uq': nrm((DEPTH, Q_LORA, B_HEADS * (QK_NOPE + QK_ROPE)), Q_LORA ** -0.5),
        'w_ukv': nrm((DEPTH, KV_LORA, B_HEADS * (QK_NOPE + V_HEAD)), KV_LORA ** -0.5),
        'q_nope_g': gain((DEPTH, QK_NOPE)),
        'k_nope_g': gain((DEPTH, QK_NOPE)),
        'q_rope_g': gain((DEPTH, QK_ROPE)),
        'k_rope_g': gain((DEPTH, QK_ROPE)),
        'conv_w': nrm((DEPTH, CONV_W, C_WIDTH), CONV_W ** -0.5),
        'w_out': nrm((DEPTH, D_MIX, D_MODEL), D_MIX ** -0.5),
        'w_ffn_in': nrm((DEPTH, D_MODEL, 2 * D_FF), D_MODEL ** -0.5),
        'w_ffn_out': nrm((DEPTH, D_FF, D_MODEL), D_FF ** -0.5),
    }


def reference(x, c, ctx, c_ctx, ada_w, ada_b, norm1_g, norm2_g, w_in, tshift_mu, decay_w0, decay_up,
              icl_a0, icl_up, gate_up, k_k, k_a, r_k, lnx_g, lnx_b, q_norm_g, kv_norm_g, w_uq, w_ukv,
              q_nope_g, k_nope_g, q_rope_g, k_rope_g, conv_w, w_out, w_ffn_in, w_ffn_out):
    n = x.shape[1]
    ROWS = n // GRID_W
    rope_tabs = axial_rope_tables(ROWS, x.dtype)
    for l in range(DEPTH):
        need_ctx = l < DEPTH - 1
        sh_a, sc_a, g_a, sh_f, sc_f, g_f = adaln_params(c[:, None, :], ada_w[l], ada_b[l])
        csh_a, csc_a, cg_a, csh_f, csc_f, cg_f = adaln_params(c_ctx[None, None, :], ada_w[l], ada_b[l])
        p_lat = modulated_norm(x, norm1_g[l], sh_a, sc_a) @ w_in[l]
        p_ctx = modulated_norm(ctx, norm1_g[l], csh_a, csc_a) @ w_in[l]
        ya_ctx, ya_lat = rwkv7_group(p_ctx[..., :A_IN], p_lat[..., :A_IN], tshift_mu[l], decay_w0[l],
                                     decay_up[l], icl_a0[l], icl_up[l], gate_up[l], k_k[l], k_a[l], r_k[l],
                                     lnx_g[l], lnx_b[l])
        yb_lat, yb_ctx = mla_group(p_lat[..., A_IN:A_IN + B_IN], p_ctx[..., A_IN:A_IN + B_IN], q_norm_g[l],
                                   kv_norm_g[l], w_uq[l], w_ukv[l], q_nope_g[l], k_nope_g[l], q_rope_g[l],
                                   k_rope_g[l], rope_tabs, need_ctx)
        yc_lat = short_conv_group(p_lat[..., A_IN + B_IN:], conv_w[l])
        x = x + g_a * (jnp.concatenate([ya_lat, yb_lat, yc_lat], axis=-1) @ w_out[l])
        x = x + g_f * swiglu(modulated_norm(x, norm2_g[l], sh_f, sc_f), w_ffn_in[l], w_ffn_out[l])
        if need_ctx:
            yc_ctx = short_conv_group(p_ctx[..., A_IN + B_IN:], conv_w[l])
            ctx = ctx + cg_a * (jnp.concatenate([ya_ctx, yb_ctx, yc_ctx], axis=-1) @ w_out[l])
            ctx = ctx + cg_f * swiglu(modulated_norm(ctx, norm2_g[l], csh_f, csc_f), w_ffn_in[l], w_ffn_out[l])
    return x
```

```cpp
#include <hip/hip_runtime.h>
#include <hip/hip_cooperative_groups.h>
#include <cstdio>
namespace cg = cooperative_groups;

#ifndef MULTI_LAUNCH
#define MULTI_LAUNCH 0
#endif

#define DI __device__ __forceinline__
typedef unsigned short bf16_t;
typedef short bf16x8 __attribute__((ext_vector_type(8)));
typedef short s16x4 __attribute__((ext_vector_type(4)));
typedef float f32x4 __attribute__((ext_vector_type(4)));
typedef float f32x2 __attribute__((ext_vector_type(2)));
typedef float f32x16 __attribute__((ext_vector_type(16)));
typedef unsigned u32x4 __attribute__((ext_vector_type(4)));
typedef unsigned u32x2 __attribute__((ext_vector_type(2)));
#define LAS __attribute__((address_space(3)))

constexpr int T_TOK = 18432, TB = 2304, NCTX = 256, NLAT = 2048, DM = 1024;
constexpr int LDPA = 1408, LDPBC = 1920;
constexpr float EPSF = 1e-6f;
constexpr float LOG_DECAY_SCALE = 0.606531f;
constexpr float GN_EPS = 64e-5f;
constexpr float QSCALE = 0.10206207261596577f * 1.4426950408889634f;

struct Params {
  const float *x, *c, *ctx, *c_ctx, *ada_w, *ada_b, *norm1_g, *norm2_g, *w_in, *tshift_mu, *decay_w0, *decay_up,
      *icl_a0, *icl_up, *gate_up, *k_k, *k_a, *r_k, *lnx_g, *lnx_b, *q_norm_g, *kv_norm_g, *w_uq, *w_ukv, *q_nope_g,
      *k_nope_g, *q_rope_g, *k_rope_g, *conv_w, *w_out, *w_ffn_in, *w_ffn_out;
  float* out;
  float *MOD, *RSTD, *BON, *XCTX, *Y;
  bf16_t *Win, *Wuq, *WukvK, *WvT, *Wgate, *Wdecay, *Wicl, *Wout, *Wffi, *Wffo;
  bf16_t *HY, *TW, *TA, *TG, *Q, *Kt, *VT, *PA, *PBC, *ACT;
};

typedef __bf16 bf16v2 __attribute__((ext_vector_type(2)));
DI unsigned pk_bf16(float lo, float hi) { f32x2 v = {lo, hi}; bf16v2 b = __builtin_convertvector(v, bf16v2); return __builtin_bit_cast(unsigned, b); }
DI float bflo(unsigned u) { return __uint_as_float(u << 16); }
DI float bfhi(unsigned u) { return __uint_as_float(u & 0xffff0000u); }
DI int opaque_tid() { int t = threadIdx.x; asm volatile("" : "+v"(t)); return t; }
DI float sigmoidf_(float x) { return 1.f / (1.f + __expf(-x)); }
template <int CTRL> DI float dppf(float x) { return __builtin_bit_cast(float, __builtin_amdgcn_update_dpp(0, __builtin_bit_cast(int, x), CTRL, 0xf, 0xf, true)); }
DI float red8(float x) { x += dppf<0xB1>(x); x += dppf<0x4E>(x); x += dppf<0x141>(x); return x; }
DI float red16(float x) { x = red8(x); x += dppf<0x140>(x); return x; }
DI float red64(float x) { for (int o = 32; o > 0; o >>= 1) x += __shfl_xor(x, o); return x; }

DI void unpack8(u32x4 v, float* f) {
  f[0] = bflo(v[0]); f[1] = bfhi(v[0]); f[2] = bflo(v[1]); f[3] = bfhi(v[1]);
  f[4] = bflo(v[2]); f[5] = bfhi(v[2]); f[6] = bflo(v[3]); f[7] = bfhi(v[3]);
}
DI void unpack4(u32x2 v, float* f) { f[0] = bflo(v[0]); f[1] = bfhi(v[0]); f[2] = bflo(v[1]); f[3] = bfhi(v[1]); }

DI const float* xsrc_row(const Params& p, bool from_inputs, int b, int s) {
  if (from_inputs) return s < NCTX ? p.ctx + (size_t)(b * NCTX + s) * DM : p.x + (size_t)(b * NLAT + s - NCTX) * DM;
  return s < NCTX ? p.XCTX + (size_t)(b * NCTX + s) * DM : p.out + (size_t)(b * NLAT + s - NCTX) * DM;
}
DI float* xdst_row(const Params& p, int b, int s) {
  return s < NCTX ? p.XCTX + (size_t)(b * NCTX + s) * DM : p.out + (size_t)(b * NLAT + s - NCTX) * DM;
}

DI void adaln_task(const Params& p, int task, char* lds) {
  float* s = (float*)lds;
  float* red = s + 9 * 1024;
  const int l = task / 192, cgi = task % 192, tid = opaque_tid();
  for (int i = tid; i < 9 * 1024; i += 256) {
    int r = i >> 10, k = i & 1023;
    float v = r < 8 ? p.c[r * 1024 + k] : p.c_ctx[k];
    s[i] = v / (1.f + __expf(-v));
  }
  __syncthreads();
  const int kg = tid >> 5, cc = tid & 31, col = cgi * 32 + cc;
  float acc[9];
#pragma unroll
  for (int r = 0; r < 9; ++r) acc[r] = 0.f;
  const float* w = p.ada_w + (size_t)l * 1024 * 6144 + col;
  for (int k = kg; k < 1024; k += 8) {
    float wv = w[(size_t)k * 6144];
#pragma unroll
    for (int r = 0; r < 9; ++r) acc[r] += s[r * 1024 + k] * wv;
  }
#pragma unroll
  for (int r = 0; r < 9; ++r) red[(kg * 9 + r) * 32 + cc] = acc[r];
  __syncthreads();
  for (int i = tid; i < 9 * 32; i += 256) {
    int r = i >> 5, c2 = i & 31;
    float sum = 0.f;
    for (int g = 0; g < 8; ++g) sum += red[(g * 9 + r) * 32 + c2];
    p.MOD[(size_t)(l * 9 + r) * 6144 + cgi * 32 + c2] = sum + p.ada_b[l * 6144 + cgi * 32 + c2];
  }
  __syncthreads();
}

DI int colmap(int mode, int n, int nvalid) {
  switch (mode) {
    case 0: return n < nvalid ? n : -1;
    case 1: if (n < 384) return (n >> 6) * 96 + (n & 63); if (n < 576) return ((n - 384) >> 5) * 96 + 64 + ((n - 384) & 31); return -1;
    case 2: return (n >> 6) * 128 + (n & 63);
    case 3: return (n >> 6) * 128 + 64 + (n & 63);
    default: { int t64 = n >> 6, w = n & 63; return w < 32 ? t64 * 32 + w : 2816 + t64 * 32 + (w - 32); }
  }
}
DI void conv_tile(const float* src, int ld, int K, int mode, int nvalid, const float* kscale, bf16_t* dst, int tile, int ntn, char* lds) {
  float(*tl)[65] = (float(*)[65])lds;
  const int tk = tile / ntn, tn = tile % ntn, tid = opaque_tid(), k0 = tk * 64;
  {
    const int nn = tid & 63, kk0 = tid >> 6;
    const int sc = colmap(mode, tn * 64 + nn, nvalid);
#pragma unroll 4
    for (int i = 0; i < 16; ++i) {
      const int kk = kk0 + 4 * i;
      float v = 0.f;
      if (sc >= 0) { v = src[(size_t)(k0 + kk) * ld + sc]; if (kscale) v *= kscale[k0 + kk]; }
      tl[kk][nn] = v;
    }
  }
  __syncthreads();
  {
    const int kk2 = (tid & 31) * 2, nn2 = tid >> 5;
#pragma unroll
    for (int i = 0; i < 8; ++i) {
      const int nn = nn2 + 8 * i;
      *(unsigned*)(dst + (size_t)(tn * 64 + nn) * K + k0 + kk2) = pk_bf16(tl[kk2][nn], tl[kk2 + 1][nn]);
    }
  }
  __syncthreads();
}
constexpr int NCONV_W1 = 1292, NCONV_FF = 2112;
DI void conv_w1_task(const Params& p, int l, int t, char* lds) {
  if (t < 832) { conv_tile(p.w_in + (size_t)l * 1024 * 3232, 3232, 1024, 0, 3232, nullptr, p.Win, t, 52, lds); return; } t -= 832;
  if (t < 120) { conv_tile(p.w_uq + (size_t)l * 768 * 576, 576, 768, 1, 0, p.q_norm_g + l * 768, p.Wuq, t, 10, lds); return; } t -= 120;
  if (t < 24) { conv_tile(p.w_ukv + (size_t)l * 256 * 768, 768, 256, 2, 0, p.kv_norm_g + l * 256, p.WukvK, t, 6, lds); return; } t -= 24;
  if (t < 24) { conv_tile(p.w_ukv + (size_t)l * 256 * 768, 768, 256, 3, 0, p.kv_norm_g + l * 256, p.WvT, t, 6, lds); return; } t -= 24;
  if (t < 12) { conv_tile(p.gate_up + (size_t)l * 128 * 384, 384, 128, 0, 384, nullptr, p.Wgate, t, 6, lds); return; } t -= 12;
  if (t < 12) { int d = t / 6; conv_tile(p.decay_up + (size_t)(l * 2 + d) * 64 * 384, 384, 64, 0, 384, nullptr, p.Wdecay + d * 384 * 64, t % 6, 6, lds); return; } t -= 12;
  if (t < 12) { int d = t / 6; conv_tile(p.icl_up + (size_t)(l * 2 + d) * 64 * 384, 384, 64, 0, 384, nullptr, p.Wicl + d * 384 * 64, t % 6, 6, lds); return; } t -= 12;
  conv_tile(p.w_out + (size_t)l * 1024 * 1024, 1024, 1024, 0, 1024, nullptr, p.Wout, t, 16, lds);
}
DI void conv_ff_task(const Params& p, int l, int t, char* lds) {
  if (t < 1408) { conv_tile(p.w_ffn_in + (size_t)l * 1024 * 5632, 5632, 1024, 4, 0, nullptr, p.Wffi, t, 88, lds); return; } t -= 1408;
  conv_tile(p.w_ffn_out + (size_t)l * 2816 * 1024, 1024, 2816, 0, 1024, nullptr, p.Wffo, t, 16, lds);
}

DI void modnorm_row(const Params& p, int l, int which  , bool from_inputs, int row, int lane) {
  const int b = row / TB, s = row % TB;
  const float* src = xsrc_row(p, from_inputs, b, s);
  const float* g = (which ? p.norm2_g : p.norm1_g) + l * DM;
  const float* mod = p.MOD + (size_t)(l * 9 + (s < NCTX ? 8 : b)) * 6144 + (which ? 3 * 1024 : 0);
  f32x4 v[4];
  float ss = 0.f;
#pragma unroll
  for (int i = 0; i < 4; ++i) { v[i] = *(const f32x4*)(src + i * 256 + lane * 4); ss += v[i][0] * v[i][0] + v[i][1] * v[i][1] + v[i][2] * v[i][2] + v[i][3] * v[i][3]; }
  ss = red64(ss);
  const float rs = rsqrtf(ss * (1.f / 1024.f) + EPSF);
  bf16_t* dst = p.HY + (size_t)row * DM;
#pragma unroll
  for (int i = 0; i < 4; ++i) {
    const int c0 = i * 256 + lane * 4;
    f32x4 gg = *(const f32x4*)(g + c0), sh = *(const f32x4*)(mod + c0), sc = *(const f32x4*)(mod + 1024 + c0);
    float o[4];
#pragma unroll
    for (int j = 0; j < 4; ++j) o[j] = (v[i][j] * rs * gg[j]) * (1.f + sc[j]) + sh[j];
    u32x2 w = {pk_bf16(o[0], o[1]), pk_bf16(o[2], o[3])};
    *(u32x2*)(dst + c0) = w;
  }
}

template <class Epi>
DI void gemm_tile(const bf16_t* __restrict__ A, int lda, const bf16_t* __restrict__ Bt, int ldb, int K, int row0, int col0, char* lds, const Epi& epi) {
  const int tid = opaque_tid(), lane = tid & 63, wid = tid >> 6, wr = wid >> 1, wc = wid & 1, fr = lane & 15, fq = lane >> 4;
  const bf16_t* ag[4];
  const bf16_t* bg[4];
#pragma unroll
  for (int i = 0; i < 4; ++i) {
    const int id = i * 256 + tid, r = id >> 3, cp = id & 7, c = cp ^ ((r >> 1) & 7);
    ag[i] = A + (size_t)(row0 + r) * lda + c * 8;
    bg[i] = Bt + (size_t)(col0 + r) * ldb + c * 8;
  }
  f32x4 acc[4][4];
#pragma unroll
  for (int m = 0; m < 4; ++m)
#pragma unroll
    for (int n = 0; n < 4; ++n) acc[m][n] = (f32x4){0.f, 0.f, 0.f, 0.f};
  const int KT = K >> 6;
  auto stage = [&](int kt, int buf) {
    char* sa = lds + buf * 32768;
    char* sb = sa + 16384;
#pragma unroll
    for (int i = 0; i < 4; ++i) {
      __builtin_amdgcn_global_load_lds((const void __attribute__((address_space(1)))*)(ag[i] + kt * 64), (void LAS*)(sa + (i * 256 + tid) * 16), 16, 0, 0);
      __builtin_amdgcn_global_load_lds((const void __attribute__((address_space(1)))*)(bg[i] + kt * 64), (void LAS*)(sb + (i * 256 + tid) * 16), 16, 0, 0);
    }
  };
  __syncthreads();
  stage(0, 0);
  const int swz = fr >> 1;
  for (int kt = 0; kt < KT; ++kt) {
    asm volatile("s_waitcnt vmcnt(0)" ::: "memory");
    __syncthreads();
    if (kt + 1 < KT) stage(kt + 1, (kt + 1) & 1);
    const char* sa = lds + (kt & 1) * 32768 + (wr * 64 + fr) * 128;
    const char* sb = lds + (kt & 1) * 32768 + 16384 + (wc * 64 + fr) * 128;
#pragma unroll
    for (int kk = 0; kk < 2; ++kk) {
      bf16x8 a[4], b[4];
      const int co = ((kk * 4 + fq) ^ swz) * 16;
#pragma unroll
      for (int m = 0; m < 4; ++m) a[m] = *(const bf16x8*)(sa + m * 2048 + co);
#pragma unroll
      for (int n = 0; n < 4; ++n) b[n] = *(const bf16x8*)(sb + n * 2048 + co);
#pragma unroll
      for (int m = 0; m < 4; ++m)
#pragma unroll
        for (int n = 0; n < 4; ++n) acc[m][n] = __builtin_amdgcn_mfma_f32_16x16x32_bf16(b[n], a[m], acc[m][n], 0, 0, 0);
    }
  }
  epi(acc, row0 + wr * 64, col0 + wc * 64, fr, fq);
}

struct EpiP {
  bf16_t *PA, *PBC;
  DI void operator()(const f32x4 (&acc)[4][4], int r0, int c0, int fr, int fq) const {
    bf16_t* base; int ld, cb;
    if (c0 < LDPA) { base = PA; ld = LDPA; cb = c0; } else { base = PBC; ld = LDPBC; cb = c0 - LDPA; }
#pragma unroll
    for (int m = 0; m < 4; ++m)
#pragma unroll
      for (int n = 0; n < 4; ++n) {
        u32x2 v = {pk_bf16(acc[m][n][0], acc[m][n][1]), pk_bf16(acc[m][n][2], acc[m][n][3])};
        *(u32x2*)(base + (size_t)(r0 + m * 16 + fr) * ld + cb + n * 16 + fq * 4) = v;
      }
  }
};

DI void rope_angle(int pos, int i, float& cs, float& sn) {
  const float invf = __builtin_amdgcn_exp2f(-(float)i * (13.287712379549449f / 8.f));
  float ang = (float)pos * invf;
  float n = rintf(ang * 0.15915494309189535f);
  float r = fmaf(-n, 6.28125f, ang);
  r = fmaf(-n, 1.9353071795864769e-3f, r);
  cs = __cosf(r); sn = __sinf(r);
}

struct EpiQ {
  const float *rstd, *gn, *gr; bf16_t* Q;
  DI void operator()(const f32x4 (&acc)[4][4], int r0, int c0, int fr, int fq) const {
    if (c0 >= 576) return;
    if (c0 < 384) {
      const int h = c0 >> 6;
#pragma unroll
      for (int m = 0; m < 4; ++m) {
        const int row = r0 + m * 16 + fr; const float rs = rstd[row];
        float ss = 0.f;
#pragma unroll
        for (int n = 0; n < 4; ++n)
#pragma unroll
          for (int j = 0; j < 4; ++j) { float v = acc[m][n][j] * rs; ss += v * v; }
        ss += __shfl_xor(ss, 16); ss += __shfl_xor(ss, 32);
        const float inv = rsqrtf(ss * (1.f / 64.f) + EPSF) * rs * QSCALE;
        const int b = row / TB, s = row % TB;
        bf16_t* dst = Q + ((size_t)(b * 6 + h) * TB + s) * 96;
#pragma unroll
        for (int n = 0; n < 4; ++n) {
          const int d = n * 16 + fq * 4; f32x4 g = *(const f32x4*)(gn + d);
          u32x2 v = {pk_bf16(acc[m][n][0] * inv * g[0], acc[m][n][1] * inv * g[1]), pk_bf16(acc[m][n][2] * inv * g[2], acc[m][n][3] * inv * g[3])};
          *(u32x2*)(dst + d) = v;
        }
      }
    } else {
#pragma unroll
      for (int m = 0; m < 4; ++m) {
        const int row = r0 + m * 16 + fr; const float rs = rstd[row];
        const int b = row / TB, s = row % TB; const bool lat = s >= NCTX; const int sp = s - NCTX;
#pragma unroll
        for (int hh = 0; hh < 2; ++hh) {
          const int h = ((c0 - 384) >> 5) + hh;
          float ss = 0.f;
#pragma unroll
          for (int nn = 0; nn < 2; ++nn)
#pragma unroll
            for (int j = 0; j < 4; ++j) { float v = acc[m][hh * 2 + nn][j] * rs; ss += v * v; }
          ss += __shfl_xor(ss, 16); ss += __shfl_xor(ss, 32);
          const float inv = rsqrtf(ss * (1.f / 32.f) + EPSF) * rs;
          bf16_t* dst = Q + ((size_t)(b * 6 + h) * TB + s) * 96 + 64;
#pragma unroll
          for (int nn = 0; nn < 2; ++nn) {
            const int d = nn * 16 + fq * 4; f32x4 g = *(const f32x4*)(gr + d);
            float o[4];
#pragma unroll
            for (int j = 0; j < 4; ++j) {
              float val = acc[m][hh * 2 + nn][j] * inv * g[j];
              float partner = __shfl_xor(val, 32);
              if (lat) {
                float cs, sn; rope_angle(nn == 0 ? (sp >> 6) : (sp & 63), (fq * 4 + j) & 7, cs, sn);
                val = fq < 2 ? val * cs - partner * sn : val * cs + partner * sn;
              }
              o[j] = val * QSCALE;
            }
            u32x2 v = {pk_bf16(o[0], o[1]), pk_bf16(o[2], o[3])};
            *(u32x2*)(dst + d) = v;
          }
        }
      }
    }
  }
};

struct EpiK {
  const float *rstd, *gk; bf16_t* Kt;
  DI void operator()(const f32x4 (&acc)[4][4], int r0, int c0, int fr, int fq) const {
    const int h = c0 >> 6;
#pragma unroll
    for (int m = 0; m < 4; ++m) {
      const int row = r0 + m * 16 + fr; const float rs = rstd[row];
      float ss = 0.f;
#pragma unroll
      for (int n = 0; n < 4; ++n)
#pragma unroll
        for (int j = 0; j < 4; ++j) { float v = acc[m][n][j] * rs; ss += v * v; }
      ss += __shfl_xor(ss, 16); ss += __shfl_xor(ss, 32);
      const float inv = rsqrtf(ss * (1.f / 64.f) + EPSF) * rs;
      const int b = row / TB, s = row % TB;
      bf16_t* dst = Kt + ((size_t)(b * 6 + h) * TB + s) * 96;
#pragma unroll
      for (int n = 0; n < 4; ++n) {
        const int d = n * 16 + fq * 4; f32x4 g = *(const f32x4*)(gk + d);
        u32x2 v = {pk_bf16(acc[m][n][0] * inv * g[0], acc[m][n][1] * inv * g[1]), pk_bf16(acc[m][n][2] * inv * g[2], acc[m][n][3] * inv * g[3])};
        *(u32x2*)(dst + d) = v;
      }
    }
  }
};

struct EpiV {
  const float* rstd; bf16_t* VT;
  DI void operator()(const f32x4 (&acc)[4][4], int r0, int c0, int fr, int fq) const {
#pragma unroll
    for (int m = 0; m < 4; ++m)
#pragma unroll
      for (int n = 0; n < 4; ++n) {
        const int row = r0 + m * 16 + fr, col = c0 + n * 16 + fq * 4;
        f32x4 rs = *(const f32x4*)(rstd + col);
        u32x2 v = {pk_bf16(acc[m][n][0] * rs[0], acc[m][n][1] * rs[1]), pk_bf16(acc[m][n][2] * rs[2], acc[m][n][3] * rs[3])};
        *(u32x2*)(VT + (size_t)row * T_TOK + col) = v;
      }
  }
};

struct EpiPost {
  const float *Y, *BON, *mu, *lnx_g, *lnx_b; const bf16_t* PA; bf16_t* YC;
  DI void operator()(const f32x4 (&acc)[4][4], int r0, int c0, int fr, int fq) const {
    const int h = c0 >> 6;
#pragma unroll
    for (int m = 0; m < 4; ++m) {
      const int row = r0 + m * 16 + fr; const int s = row % TB;
      const bool hasprev = (s != 0 && s != NCTX), hasnext = (s != NCTX - 1 && s != TB - 1);
      f32x4 y[4];
      float s1 = 0.f;
#pragma unroll
      for (int n = 0; n < 4; ++n) {
        const size_t o = (size_t)row * 384 + c0 + n * 16 + fq * 4;
        y[n] = *(const f32x4*)(Y + o) + *(const f32x4*)(Y + (size_t)T_TOK * 384 + o);
        s1 += y[n][0] + y[n][1] + y[n][2] + y[n][3];
      }
      s1 += __shfl_xor(s1, 16); s1 += __shfl_xor(s1, 32);
      const float mean = s1 * (1.f / 64.f);
      float s2 = 0.f;
#pragma unroll
      for (int n = 0; n < 4; ++n)
#pragma unroll
        for (int j = 0; j < 4; ++j) { float d = y[n][j] - mean; s2 += d * d; }
      s2 += __shfl_xor(s2, 16); s2 += __shfl_xor(s2, 32);
      const float rstdv = rsqrtf(s2 * (1.f / 64.f) + GN_EPS);
      const float bon = BON[(size_t)row * 6 + h] + BON[(size_t)T_TOK * 6 + (size_t)row * 6 + h];
#pragma unroll
      for (int n = 0; n < 4; ++n) {
        const int col = c0 + n * 16 + fq * 4;
        const bf16_t* pv = PA + (size_t)row * LDPA + 768 + col;
        float vc[4], vp[4] = {0.f, 0.f, 0.f, 0.f}, vn[4] = {0.f, 0.f, 0.f, 0.f};
        unpack4(*(const u32x2*)pv, vc);
        if (hasprev) unpack4(*(const u32x2*)(pv - LDPA), vp);
        if (hasnext) unpack4(*(const u32x2*)(pv + LDPA), vn);
        f32x4 m0 = *(const f32x4*)(mu + 768 + col), m1 = *(const f32x4*)(mu + LDPA + 768 + col);
        f32x4 lg = *(const f32x4*)(lnx_g + col), lb = *(const f32x4*)(lnx_b + col);
        float o[4];
#pragma unroll
        for (int j = 0; j < 4; ++j) {
          const float v = vc[j] + m0[j] * (vp[j] - vc[j]) + m1[j] * (vn[j] - vc[j]);
          o[j] = ((y[n][j] - mean) * rstdv * lg[j] + lb[j] + bon * v) * acc[m][n][j];
        }
        u32x2 w = {pk_bf16(o[0], o[1]), pk_bf16(o[2], o[3])};
        *(u32x2*)(YC + (size_t)row * DM + col) = w;
      }
    }
  }
};

struct EpiRes {
  const Params* p; int l; bool from_inputs; int gate_off;
  DI void operator()(const f32x4 (&acc)[4][4], int r0, int c0, int fr, int fq) const {
#pragma unroll
    for (int m = 0; m < 4; ++m) {
      const int row = r0 + m * 16 + fr; const int b = row / TB, s = row % TB;
      const float* src = xsrc_row(*p, from_inputs, b, s);
      float* dst = xdst_row(*p, b, s);
      const float* gate = p->MOD + (size_t)(l * 9 + (s < NCTX ? 8 : b)) * 6144 + gate_off;
#pragma unroll
      for (int n = 0; n < 4; ++n) {
        const int col = c0 + n * 16 + fq * 4;
        f32x4 g = *(const f32x4*)(gate + col), xv = *(const f32x4*)(src + col);
        *(f32x4*)(dst + col) = xv + g * acc[m][n];
      }
    }
  }
};

struct EpiFfnIn {
  bf16_t* ACT;
  DI void operator()(const f32x4 (&acc)[4][4], int r0, int c0, int fr, int fq) const {
    const int cb = (c0 >> 6) * 32;
#pragma unroll
    for (int m = 0; m < 4; ++m)
#pragma unroll
      for (int n = 0; n < 2; ++n) {
        float o[4];
#pragma unroll
        for (int j = 0; j < 4; ++j) { float g = acc[m][n][j]; o[j] = g / (1.f + __expf(-g)) * acc[m][n + 2][j]; }
        u32x2 w = {pk_bf16(o[0], o[1]), pk_bf16(o[2], o[3])};
        *(u32x2*)(ACT + (size_t)(r0 + m * 16 + fr) * 2816 + cb + n * 16 + fq * 4) = w;
      }
  }
};

DI void prep_token(const Params& p, int l, int row, int lane) {
  const int b = row / TB, s = row % TB;
  const bool hasprev = (s != 0 && s != NCTX), hasnext = (s != NCTX - 1 && s != TB - 1);
  const bf16_t* pa = p.PA + (size_t)row * LDPA;
  const bf16_t* pbc = p.PBC + (size_t)row * LDPBC;
  const float* mu = p.tshift_mu + (size_t)l * 2 * LDPA;
  if (lane < 32) {
    const int col = 1152 + lane * 8;
    float c[8], pv[8], nx[8];
    unpack8(*(const u32x4*)(pa + col), c);
#pragma unroll
    for (int j = 0; j < 8; ++j) { pv[j] = 0.f; nx[j] = 0.f; }
    if (hasprev) unpack8(*(const u32x4*)(pa - LDPA + col), pv);
    if (hasnext) unpack8(*(const u32x4*)(pa + LDPA + col), nx);
    float o[8];
#pragma unroll
    for (int j = 0; j < 8; ++j) {
      float t = c[j] + mu[col + j] * (pv[j] - c[j]) + mu[LDPA + col + j] * (nx[j] - c[j]);
      if (lane < 8) { float e = __expf(2.f * t); t = 1.f - 2.f / (1.f + e); }
      else if (lane >= 16) t = sigmoidf_(t);
      o[j] = t;
    }
    u32x4 w = {pk_bf16(o[0], o[1]), pk_bf16(o[2], o[3]), pk_bf16(o[4], o[5]), pk_bf16(o[6], o[7])};
    if (lane < 8) *(u32x4*)(p.TW + (size_t)row * 64 + lane * 8) = w;
    else if (lane < 16) *(u32x4*)(p.TA + (size_t)row * 64 + (lane - 8) * 8) = w;
    else *(u32x4*)(p.TG + (size_t)row * 128 + (lane - 16) * 8) = w;
  }
  {
    float ss = 0.f, f[8];
    unpack8(*(const u32x4*)(pbc + lane * 8), f);
#pragma unroll
    for (int j = 0; j < 8; ++j) ss += f[j] * f[j];
    if (lane < 32) {
      unpack8(*(const u32x4*)(pbc + 512 + lane * 8), f);
#pragma unroll
      for (int j = 0; j < 8; ++j) ss += f[j] * f[j];
    }
    ss = red64(ss);
    float s2 = 0.f;
    if (lane < 32) {
      unpack8(*(const u32x4*)(pbc + 768 + lane * 8), f);
#pragma unroll
      for (int j = 0; j < 8; ++j) s2 += f[j] * f[j];
    }
    s2 = red64(s2);
    if (lane == 0) { p.RSTD[row] = rsqrtf(ss * (1.f / 768.f) + EPSF); p.RSTD[T_TOK + row] = rsqrtf(s2 * (1.f / 256.f) + EPSF); }
  }
  {
    float f[8], s3 = 0.f;
#pragma unroll
    for (int j = 0; j < 8; ++j) f[j] = 0.f;
    if (lane < 4) {
      unpack8(*(const u32x4*)(pbc + 1024 + lane * 8), f);
#pragma unroll
      for (int j = 0; j < 8; ++j) s3 += f[j] * f[j];
    }
    s3 += __shfl_xor(s3, 1); s3 += __shfl_xor(s3, 2);
    const float inv = rsqrtf(s3 * (1.f / 32.f) + EPSF);
    const float* g = p.k_rope_g + l * 32;
    const bool lat = s >= NCTX; const int sp = s - NCTX;
    float o[8];
#pragma unroll
    for (int j = 0; j < 8; ++j) {
      float val = lane < 4 ? f[j] * inv * g[lane * 8 + j] : 0.f;
      float partner = __shfl_xor(val, 1);
      if (lat) {
        float cs, sn; rope_angle(lane < 2 ? (sp >> 6) : (sp & 63), j, cs, sn);
        val = (lane & 1) == 0 ? val * cs - partner * sn : val * cs + partner * sn;
      }
      o[j] = val;
    }
    if (lane < 4) {
      u32x4 w = {pk_bf16(o[0], o[1]), pk_bf16(o[2], o[3]), pk_bf16(o[4], o[5]), pk_bf16(o[6], o[7])};
#pragma unroll
      for (int hh = 0; hh < 6; ++hh) *(u32x4*)(p.Kt + ((size_t)(b * 6 + hh) * TB + s) * 96 + 64 + lane * 8) = w;
    }
  }
  if (lane < 32) {
    const int c8 = lane * 8;
    float bg[8], cc[8], hh[8], cp[8], hp[8], cn[8], hn[8];
    unpack8(*(const u32x4*)(pbc + 1056 + c8), bg);
    unpack8(*(const u32x4*)(pbc + 1312 + c8), cc);
    unpack8(*(const u32x4*)(pbc + 1568 + c8), hh);
#pragma unroll
    for (int j = 0; j < 8; ++j) { cp[j] = hp[j] = cn[j] = hn[j] = 0.f; }
    if (hasprev) { unpack8(*(const u32x4*)(pbc - LDPBC + 1312 + c8), cp); unpack8(*(const u32x4*)(pbc - LDPBC + 1568 + c8), hp); }
    if (hasnext) { unpack8(*(const u32x4*)(pbc + LDPBC + 1312 + c8), cn); unpack8(*(const u32x4*)(pbc + LDPBC + 1568 + c8), hn); }
    const float* cw = p.conv_w + (size_t)l * 3 * 256;
    float o[8];
#pragma unroll
    for (int j = 0; j < 8; ++j) o[j] = bg[j] * (cw[c8 + j] * cp[j] * hp[j] + cw[256 + c8 + j] * cc[j] * hh[j] + cw[512 + c8 + j] * cn[j] * hn[j]);
    u32x4 w = {pk_bf16(o[0], o[1]), pk_bf16(o[2], o[3]), pk_bf16(o[4], o[5]), pk_bf16(o[6], o[7])};
    *(u32x4*)(p.HY + (size_t)row * DM + 768 + c8) = w;
  }
}

#define MFMA32(a, b, c) __builtin_amdgcn_mfma_f32_32x32x16_bf16((a), (b), (c), 0, 0, 0)
DI bf16x8 pack8(const f32x16& x, int s) {
  u32x4 v = {pk_bf16(x[8 * s], x[8 * s + 1]), pk_bf16(x[8 * s + 2], x[8 * s + 3]), pk_bf16(x[8 * s + 4], x[8 * s + 5]), pk_bf16(x[8 * s + 6], x[8 * s + 7])};
  return __builtin_bit_cast(bf16x8, v);
}
constexpr int KROW = 208, VROW = 136, KBUF = 64 * KROW, VBUF = 64 * VROW;
DI void attn_task(const Params& p, int b, int h, int q0, int k0, int nk, char* lds) {
  const int tid = opaque_tid(), lane = tid & 63, wid = tid >> 6, r = lane & 31, hh = lane >> 5;
  const bf16_t* Qp = p.Q + ((size_t)(b * 6 + h) * TB + q0 + wid * 32 + r) * 96;
  const bf16_t* Kp = p.Kt + ((size_t)(b * 6 + h) * TB + k0) * 96;
  const bf16_t* Vp = p.VT + (size_t)(h * 64) * T_TOK + (size_t)b * TB + k0;
  bf16x8 qf[6];
#pragma unroll
  for (int ks = 0; ks < 6; ++ks) qf[ks] = *(const bf16x8*)(Qp + ks * 16 + hh * 8);
  int krow_[3], kch_[3];
#pragma unroll
  for (int i = 0; i < 3; ++i) { int id = tid + i * 256; krow_[i] = id / 12; kch_[i] = id % 12; }
  const int vd0 = tid >> 3, vch = tid & 7;
  u32x4 kreg[3], vreg[2];
  auto load_regs = [&](int kt) {
#pragma unroll
    for (int i = 0; i < 3; ++i) kreg[i] = *(const u32x4*)(Kp + (size_t)(kt * 64 + krow_[i]) * 96 + kch_[i] * 8);
#pragma unroll
    for (int i = 0; i < 2; ++i) vreg[i] = *(const u32x4*)(Vp + (size_t)(vd0 + 32 * i) * T_TOK + kt * 64 + vch * 8);
  };
  auto write_lds = [&](int buf) {
    char* kb = lds + buf * (KBUF + VBUF);
    char* vb = kb + KBUF;
#pragma unroll
    for (int i = 0; i < 3; ++i) *(u32x4*)(kb + krow_[i] * KROW + kch_[i] * 16) = kreg[i];
#pragma unroll
    for (int i = 0; i < 2; ++i) {
      char* d = vb + (vd0 + 32 * i) * VROW + vch * 16;
      *(u32x2*)d = (u32x2){vreg[i][0], vreg[i][1]};
      *(u32x2*)(d + 8) = (u32x2){vreg[i][2], vreg[i][3]};
    }
  };
  f32x16 o[2];
#pragma unroll
  for (int i = 0; i < 16; ++i) { o[0][i] = 0.f; o[1][i] = 0.f; }
  float m_run = -1e30f, l_run = 0.f;
  const int NT = nk >> 6;
  __syncthreads();
  load_regs(0);
  write_lds(0);
  for (int kt = 0; kt < NT; ++kt) {
    if (kt + 1 < NT) load_regs(kt + 1);
    __syncthreads();
    const char* kb = lds + (kt & 1) * (KBUF + VBUF);
    const char* vb = kb + KBUF;
    f32x16 st[2];
#pragma unroll
    for (int kbk = 0; kbk < 2; ++kbk) {
#pragma unroll
      for (int i = 0; i < 16; ++i) st[kbk][i] = 0.f;
#pragma unroll
      for (int ks = 0; ks < 6; ++ks) {
        bf16x8 kf = *(const bf16x8*)(kb + (kbk * 32 + r) * KROW + ks * 32 + hh * 16);
        st[kbk] = MFMA32(kf, qf[ks], st[kbk]);
      }
    }
    float mx = st[0][0];
#pragma unroll
    for (int i = 0; i < 16; ++i) { mx = fmaxf(mx, st[0][i]); mx = fmaxf(mx, st[1][i]); }
    mx = fmaxf(mx, __shfl_xor(mx, 32));
    const float m_new = fmaxf(m_run, mx);
    const float alpha = __builtin_amdgcn_exp2f(m_run - m_new);
    m_run = m_new;
    float psum = 0.f;
#pragma unroll
    for (int kbk = 0; kbk < 2; ++kbk)
#pragma unroll
      for (int i = 0; i < 16; ++i) { float e = __builtin_amdgcn_exp2f(st[kbk][i] - m_new); st[kbk][i] = e; psum += e; }
    psum += __shfl_xor(psum, 32);
    l_run = l_run * alpha + psum;
#pragma unroll
    for (int i = 0; i < 16; ++i) { o[0][i] *= alpha; o[1][i] *= alpha; }
#pragma unroll
    for (int ksv = 0; ksv < 4; ++ksv) {
      const bf16x8 pf = pack8(st[ksv >> 1], ksv & 1);
#pragma unroll
      for (int db = 0; db < 2; ++db) {
        const char* va = vb + (db * 32 + r) * VROW + (ksv * 16 + 4 * hh) * 2;
        s16x4 lo = *(const s16x4*)va, hi = *(const s16x4*)(va + 16);
        bf16x8 vf = __builtin_shufflevector(lo, hi, 0, 1, 2, 3, 4, 5, 6, 7);
        o[db] = MFMA32(vf, pf, o[db]);
      }
    }
    if (kt + 1 < NT) write_lds((kt + 1) & 1);
  }
  const float invl = 1.f / l_run;
  bf16_t* dst = p.HY + (size_t)(b * TB + q0 + wid * 32 + r) * DM + 384 + h * 64;
#pragma unroll
  for (int db = 0; db < 2; ++db)
#pragma unroll
    for (int g = 0; g < 4; ++g) {
      u32x2 w = {pk_bf16(o[db][4 * g] * invl, o[db][4 * g + 1] * invl), pk_bf16(o[db][4 * g + 2] * invl, o[db][4 * g + 3] * invl)};
      *(u32x2*)(dst + db * 32 + 8 * g + 4 * hh) = w;
    }
}

enum { VW = 0, VKK = 1, VB = 2, VKD = 3, VR = 4, VV = 5 };
DI void scan_task(const Params& p, int l, int b, int h, int dir, char* lds) {
  float* cb = (float*)lds;
  float* ybuf = cb + 6 * 1024;
  float* tk = ybuf + 1024;
  const int tid = opaque_tid(), lane = tid & 63, wid = tid >> 6;
  const int st_p = tid >> 4, c4 = tid & 15;
  const int fr = lane & 15, fq = lane >> 4;
  const int rp = lane >> 3, g = lane & 7;
  const int hc = h * 64;
  bf16x8 bw[2], ba[2];
  {
    const bf16_t* wd = p.Wdecay + ((size_t)dir * 384 + hc + wid * 16 + fr) * 64;
    const bf16_t* wi = p.Wicl + ((size_t)dir * 384 + hc + wid * 16 + fr) * 64;
#pragma unroll
    for (int ks = 0; ks < 2; ++ks) { bw[ks] = *(const bf16x8*)(wd + ks * 32 + fq * 8); ba[ks] = *(const bf16x8*)(wi + ks * 32 + fq * 8); }
  }
  f32x4 mu0[3], mu1[3];
  const float* mu = p.tshift_mu + (size_t)l * 2 * LDPA;
#pragma unroll
  for (int sec = 0; sec < 3; ++sec) { mu0[sec] = *(const f32x4*)(mu + sec * 384 + hc + c4 * 4); mu1[sec] = *(const f32x4*)(mu + LDPA + sec * 384 + hc + c4 * 4); }
  const f32x4 kkg = *(const f32x4*)(p.k_k + l * 384 + hc + c4 * 4);
  const f32x4 rkg = *(const f32x4*)(p.r_k + l * 384 + hc + c4 * 4);
  const int colB = wid * 16 + fq * 4;
  const f32x4 w0 = *(const f32x4*)(p.decay_w0 + (size_t)(l * 2 + dir) * 384 + hc + colB);
  const f32x4 a0 = *(const f32x4*)(p.icl_a0 + (size_t)(l * 2 + dir) * 384 + hc + colB);
  const f32x4 kag = *(const f32x4*)(p.k_a + l * 384 + hc + colB);

  u32x2 ld[3][3];
  bf16x8 aw[2], aa[2];
  auto chunk_lo = [&](int c) -> int { return dir == 0 ? 16 * c : (c < 16 ? 240 - 16 * c : 2544 - 16 * c); };
  auto issue_loads = [&](int c) {
    const int slo = chunk_lo(c);
    const int s = slo + st_p;
    const bool hasprev = (s != 0 && s != NCTX), hasnext = (s != NCTX - 1 && s != TB - 1);
    const bf16_t* pa = p.PA + (size_t)(b * TB + s) * LDPA + hc + c4 * 4;
#pragma unroll
    for (int sec = 0; sec < 3; ++sec) {
      ld[sec][1] = *(const u32x2*)(pa + sec * 384);
      ld[sec][0] = hasprev ? *(const u32x2*)(pa + sec * 384 - LDPA) : (u32x2){0u, 0u};
      ld[sec][2] = hasnext ? *(const u32x2*)(pa + sec * 384 + LDPA) : (u32x2){0u, 0u};
    }
    const size_t trow = (size_t)(b * TB + slo + fr) * 64;
#pragma unroll
    for (int ks = 0; ks < 2; ++ks) { aw[ks] = *(const bf16x8*)(p.TW + trow + ks * 32 + fq * 8); aa[ks] = *(const bf16x8*)(p.TA + trow + ks * 32 + fq * 8); }
  };
  auto produce = [&](int c) {
    const int slo = chunk_lo(c);
    float ts[3][4];
#pragma unroll
    for (int sec = 0; sec < 3; ++sec) {
      float pc[4], pp[4], pn[4];
      unpack4(ld[sec][1], pc); unpack4(ld[sec][0], pp); unpack4(ld[sec][2], pn);
#pragma unroll
      for (int j = 0; j < 4; ++j) ts[sec][j] = pc[j] + mu0[sec][j] * (pp[j] - pc[j]) + mu1[sec][j] * (pn[j] - pc[j]);
    }
    *(f32x4*)(cb + VR * 1024 + st_p * 64 + c4 * 4) = (f32x4){ts[0][0], ts[0][1], ts[0][2], ts[0][3]};
    *(f32x4*)(cb + VV * 1024 + st_p * 64 + c4 * 4) = (f32x4){ts[2][0], ts[2][1], ts[2][2], ts[2][3]};
    *(f32x4*)(tk + st_p * 64 + c4 * 4) = (f32x4){ts[1][0], ts[1][1], ts[1][2], ts[1][3]};
    float kx[4], ss = 0.f;
#pragma unroll
    for (int j = 0; j < 4; ++j) { kx[j] = ts[1][j] * kkg[j]; ss += kx[j] * kx[j]; }
    ss = red16(ss);
    const float inv = rsqrtf(ss + 1e-12f);
    *(f32x4*)(cb + VKK * 1024 + st_p * 64 + c4 * 4) = (f32x4){kx[0] * inv, kx[1] * inv, kx[2] * inv, kx[3] * inv};
    __syncthreads();
    f32x4 dw = {0.f, 0.f, 0.f, 0.f}, da = {0.f, 0.f, 0.f, 0.f};
#pragma unroll
    for (int ks = 0; ks < 2; ++ks) {
      dw = __builtin_amdgcn_mfma_f32_16x16x32_bf16(bw[ks], aw[ks], dw, 0, 0, 0);
      da = __builtin_amdgcn_mfma_f32_16x16x32_bf16(ba[ks], aa[ks], da, 0, 0, 0);
    }
    {
      const f32x4 kv = *(const f32x4*)(tk + fr * 64 + colB);
      const f32x4 kkv = *(const f32x4*)(cb + VKK * 1024 + fr * 64 + colB);
      f32x4 wv, kdv, bv;
#pragma unroll
      for (int j = 0; j < 4; ++j) {
        wv[j] = __expf(-LOG_DECAY_SCALE * sigmoidf_(w0[j] + dw[j]));
        const float a = sigmoidf_(a0[j] + da[j]);
        kdv[j] = kv[j] * (1.f + (a - 1.f) * kag[j]);
        bv[j] = kkv[j] * a;
      }
      *(f32x4*)(cb + VW * 1024 + fr * 64 + colB) = wv;
      *(f32x4*)(cb + VKD * 1024 + fr * 64 + colB) = kdv;
      *(f32x4*)(cb + VB * 1024 + fr * 64 + colB) = bv;
    }
    __syncthreads();
    {
      const f32x4 rv = *(const f32x4*)(cb + VR * 1024 + st_p * 64 + c4 * 4);
      const f32x4 kdv = *(const f32x4*)(cb + VKD * 1024 + st_p * 64 + c4 * 4);
      float bs = rv[0] * kdv[0] * rkg[0] + rv[1] * kdv[1] * rkg[1] + rv[2] * kdv[2] * rkg[2] + rv[3] * kdv[3] * rkg[3];
      bs = red16(bs);
      if (c4 == 0) p.BON[(size_t)dir * T_TOK * 6 + (size_t)(b * TB + slo + st_p) * 6 + h] = bs;
    }
  };

  f32x2 S0[4], S1[4];
#pragma unroll
  for (int j = 0; j < 4; ++j) { S0[j] = (f32x2){0.f, 0.f}; S1[j] = (f32x2){0.f, 0.f}; }
  __syncthreads();
  issue_loads(0);
  produce(0);
  __syncthreads();
  const int NCH = TB / 16;
  for (int c = 0; c < NCH; ++c) {
    if (c + 1 < NCH) issue_loads(c + 1);
    for (int ii = 0; ii < 16; ++ii) {
      const int st = dir ? 15 - ii : ii;
      const float* base = cb + st * 64 + g * 8;
      f32x2 w[4], kk[4], bb[4], kd[4], rr[4];
#pragma unroll
      for (int hf = 0; hf < 2; ++hf) {
        f32x4 t;
        t = *(const f32x4*)(base + VW * 1024 + hf * 4); w[2 * hf] = (f32x2){t[0], t[1]}; w[2 * hf + 1] = (f32x2){t[2], t[3]};
        t = *(const f32x4*)(base + VKK * 1024 + hf * 4); kk[2 * hf] = (f32x2){t[0], t[1]}; kk[2 * hf + 1] = (f32x2){t[2], t[3]};
        t = *(const f32x4*)(base + VB * 1024 + hf * 4); bb[2 * hf] = (f32x2){t[0], t[1]}; bb[2 * hf + 1] = (f32x2){t[2], t[3]};
        t = *(const f32x4*)(base + VKD * 1024 + hf * 4); kd[2 * hf] = (f32x2){t[0], t[1]}; kd[2 * hf + 1] = (f32x2){t[2], t[3]};
        t = *(const f32x4*)(base + VR * 1024 + hf * 4); rr[2 * hf] = (f32x2){t[0], t[1]}; rr[2 * hf + 1] = (f32x2){t[2], t[3]};
      }
      const f32x2 vv = *(const f32x2*)(cb + VV * 1024 + st * 64 + wid * 16 + rp * 2);
      f32x2 p0 = S0[0] * kk[0], p1 = S1[0] * kk[0];
#pragma unroll
      for (int j = 1; j < 4; ++j) { p0 += S0[j] * kk[j]; p1 += S1[j] * kk[j]; }
      const float sa0 = -red8(p0[0] + p0[1]), sa1 = -red8(p1[0] + p1[1]);
      f32x2 y0 = {0.f, 0.f}, y1 = {0.f, 0.f};
#pragma unroll
      for (int j = 0; j < 4; ++j) {
        S0[j] = S0[j] * w[j] + (bb[j] * sa0 + kd[j] * vv[0]);
        S1[j] = S1[j] * w[j] + (bb[j] * sa1 + kd[j] * vv[1]);
        y0 += S0[j] * rr[j];
        y1 += S1[j] * rr[j];
      }
      const float yy0 = red8(y0[0] + y0[1]), yy1 = red8(y1[0] + y1[1]);
      if (g == 0) *(f32x2*)(ybuf + st * 64 + wid * 16 + rp * 2) = (f32x2){yy0, yy1};
    }
    __syncthreads();
    {
      const int slo = chunk_lo(c);
      *(f32x4*)(p.Y + (size_t)dir * T_TOK * 384 + (size_t)(b * TB + slo + st_p) * 384 + hc + c4 * 4) = *(const f32x4*)(ybuf + st_p * 64 + c4 * 4);
    }
    if (c + 1 < NCH) produce(c + 1);
    __syncthreads();
  }
}

DI int lat_tile(int i) { return (i >> 4) * 18 + 2 + (i & 15); }

template <int KSEL> DI void run_phase(const Params& p, int ph, char* lds) {
  const int bid = blockIdx.x, G = gridDim.x, tid = opaque_tid(), lane = tid & 63, wid = tid >> 6;
  if (ph == 0) {
    if (KSEL >= 0 && KSEL != 10) return;
    for (int t = bid; t < 384 + NCONV_W1; t += G) { if (t < 384) adaln_task(p, t, lds); else conv_w1_task(p, 0, t - 384, lds); }
    return;
  }
  if (KSEL == 10) return;
  const int l = (ph - 1) / 10, k = (ph - 1) % 10;
  const bool last = (l == 1);
  if (KSEL >= 0 && KSEL != 10 && k != (KSEL == 11 ? 4 : KSEL)) return;
  switch (k) {
    case 0:
      for (int t = bid; t < T_TOK / 4; t += G) modnorm_row(p, l, 0, l == 0, t * 4 + wid, lane);
      break;
    case 1: {
      EpiP e{p.PA, p.PBC};
      for (int t = bid; t < 144 * 26; t += G) gemm_tile(p.HY, DM, p.Win, DM, DM, (t / 26) * 128, (t % 26) * 128, lds, e);
    } break;
    case 2:
      for (int t = bid; t < T_TOK / 4; t += G) prep_token(p, l, t * 4 + wid, lane);
      break;
    case 3: {
      const int nq = last ? 128 * 5 : 144 * 5;
      EpiQ eq{p.RSTD, p.q_nope_g + l * 64, p.q_rope_g + l * 32, p.Q};
      EpiK ek{p.RSTD + T_TOK, p.k_nope_g + l * 64, p.Kt};
      EpiV ev{p.RSTD + T_TOK, p.VT};
      for (int t = bid; t < nq + 432 + 432; t += G) {
        if (t < nq) { int i = t / 5; int tm = last ? lat_tile(i) : i; gemm_tile(p.PBC, LDPBC, p.Wuq, 768, 768, tm * 128, (t % 5) * 128, lds, eq); }
        else if (t < nq + 432) { int u = t - nq; gemm_tile(p.PBC + 768, LDPBC, p.WukvK, 256, 256, (u / 3) * 128, (u % 3) * 128, lds, ek); }
        else { int u = t - nq - 432; gemm_tile(p.WvT, 256, p.PBC + 768, LDPBC, 256, (u % 3) * 128, (u / 3) * 128, lds, ev); }
      }
    } break;
    case 4: {
      const int natt = 768 + (last ? 0 : 96);
      if (KSEL != 11) { if (bid < 96) { scan_task(p, l, bid / 12, (bid % 12) >> 1, bid & 1, lds); break; } if (KSEL == 4) break; }
      const int aoff = KSEL == 11 ? 0 : 96;
      for (int t = bid - aoff; t < natt; t += (G - aoff)) {
        if (t < 768) { int bh = t >> 4, qb = t & 15; attn_task(p, bh / 6, bh % 6, NCTX + qb * 128, 0, TB, lds); }
        else { int u = t - 768; int bh = u >> 1, qb = u & 1; attn_task(p, bh / 6, bh % 6, qb * 128, 0, NCTX, lds); }
      }
    } break;
    case 5: {
      EpiPost e{p.Y, p.BON, p.tshift_mu + (size_t)l * 2 * LDPA, p.lnx_g + l * 384, p.lnx_b + l * 384, p.PA, p.HY};
      const int nm = last ? 128 : 144;
      for (int t = bid; t < nm * 3 + NCONV_FF; t += G) {
        if (t < nm * 3) { int i = t / 3; int tm = last ? lat_tile(i) : i; gemm_tile(p.TG, 128, p.Wgate, 128, 128, tm * 128, (t % 3) * 128, lds, e); }
        else conv_ff_task(p, l, t - nm * 3, lds);
      }
    } break;
    case 6: {
      EpiRes e{&p, l, l == 0, 2 * 1024};
      const int nm = last ? 128 : 144;
      for (int t = bid; t < nm * 8; t += G) { int i = t / 8; int tm = last ? lat_tile(i) : i; gemm_tile(p.HY, DM, p.Wout, DM, DM, tm * 128, (t % 8) * 128, lds, e); }
    } break;
    case 7:
      for (int t = bid; t < T_TOK / 4; t += G) { int row = t * 4 + wid; if (!(last && (row % TB) < NCTX)) modnorm_row(p, l, 1, false, row, lane); }
      break;
    case 8: {
      EpiFfnIn e{p.ACT};
      const int nm = last ? 128 : 144;
      const int nconv = last ? 0 : NCONV_W1;
      for (int t = bid; t < nm * 44 + nconv; t += G) {
        if (t < nm * 44) { int i = t / 44; int tm = last ? lat_tile(i) : i; gemm_tile(p.HY, DM, p.Wffi, DM, DM, tm * 128, (t % 44) * 128, lds, e); }
        else conv_w1_task(p, 1, t - nm * 44, lds);
      }
    } break;
    case 9: {
      EpiRes e{&p, l, false, 5 * 1024};
      const int nm = last ? 128 : 144;
      for (int t = bid; t < nm * 8; t += G) { int i = t / 8; int tm = last ? lat_tile(i) : i; gemm_tile(p.ACT, 2816, p.Wffo, 2816, 2816, tm * 128, (t % 8) * 128, lds, e); }
    } break;
  }
}

constexpr int NPHASE = 21;
#if !MULTI_LAUNCH
__global__ void __launch_bounds__(256, 2) mega(Params p, int ph_lo, int ph_hi) {
  __shared__ __attribute__((aligned(16))) char lds[65536];
  cg::grid_group grid = cg::this_grid();
  for (int ph = ph_lo; ph < ph_hi; ++ph) {
    if (ph > ph_lo) grid.sync();
    run_phase<-1>(p, ph, lds);
  }
}
#endif
template <int KSEL> __global__ void __launch_bounds__(256, 2) phase_k(Params p, int ph) {
  __shared__ __attribute__((aligned(16))) char lds[65536];
  run_phase<KSEL>(p, ph, lds);
}

extern "C" void kernel_launch(void* const* d_in, const int* in_sizes, int n_in, void* d_out, int out_size, void* d_ws, size_t ws_size, hipStream_t stream) {
  static int grid_blocks = 0;
  if (!grid_blocks) {
    int dev = 0, cus = 0, per_cu = 0;
    (void)hipGetDevice(&dev);
    (void)hipDeviceGetAttribute(&cus, hipDeviceAttributeMultiprocessorCount, dev);
    #if MULTI_LAUNCH
    per_cu = 2;
#else
    (void)hipOccupancyMaxActiveBlocksPerMultiprocessor(&per_cu, mega, 256, 0);
#endif
    if (per_cu > 2) per_cu = 2;
    if (per_cu < 1) per_cu = 1;
    grid_blocks = cus * per_cu;
  }
  Params p{};
  const float** pin = (const float**)&p.x;
  for (int i = 0; i < 32; ++i) pin[i] = (const float*)d_in[i];
  p.out = (float*)d_out;
  char* w = (char*)d_ws;
  size_t off = 0;
  auto take = [&](size_t bytes) { char* r = w + off; off += (bytes + 255) & ~(size_t)255; return r; };
  p.MOD = (float*)take(2 * 9 * 6144 * 4);
  p.RSTD = (float*)take(2 * (size_t)T_TOK * 4);
  p.BON = (float*)take(2 * (size_t)T_TOK * 6 * 4);
  p.XCTX = (float*)take((size_t)8 * NCTX * DM * 4);
  p.Win = (bf16_t*)take((size_t)3328 * 1024 * 2);
  p.Wuq = (bf16_t*)take((size_t)640 * 768 * 2);
  p.WukvK = (bf16_t*)take((size_t)384 * 256 * 2);
  p.WvT = (bf16_t*)take((size_t)384 * 256 * 2);
  p.Wgate = (bf16_t*)take((size_t)384 * 128 * 2);
  p.Wdecay = (bf16_t*)take((size_t)2 * 384 * 64 * 2);
  p.Wicl = (bf16_t*)take((size_t)2 * 384 * 64 * 2);
  p.Wout = (bf16_t*)take((size_t)1024 * 1024 * 2);
  p.HY = (bf16_t*)take((size_t)T_TOK * DM * 2);
  p.TW = (bf16_t*)take((size_t)T_TOK * 64 * 2);
  p.TA = (bf16_t*)take((size_t)T_TOK * 64 * 2);
  p.TG = (bf16_t*)take((size_t)T_TOK * 128 * 2);
  char* qkv = take((size_t)T_TOK * 576 * 2 * 2 + (size_t)384 * T_TOK * 2);
  p.Q = (bf16_t*)qkv;
  p.Kt = (bf16_t*)(qkv + (size_t)T_TOK * 576 * 2);
  p.VT = (bf16_t*)(qkv + (size_t)T_TOK * 576 * 2 * 2);
  p.Wffi = (bf16_t*)qkv;
  p.Wffo = (bf16_t*)(qkv + (size_t)5632 * 1024 * 2);
  char* pr = take((size_t)T_TOK * (LDPA + LDPBC) * 2);
  p.PA = (bf16_t*)pr;
  p.PBC = (bf16_t*)(pr + (size_t)T_TOK * LDPA * 2);
  p.Y = (float*)p.PBC;
  p.ACT = (bf16_t*)pr;
  if (off > ws_size) { fprintf(stderr, "workspace too small: need %zu have %zu\n", off, ws_size); }
#if MULTI_LAUNCH
  hipLaunchKernelGGL(phase_k<10>, dim3(grid_blocks), dim3(256), 0, stream, p, 0);
  for (int l = 0; l < 2; ++l) {
    const int b0 = 1 + 10 * l;
    hipLaunchKernelGGL(phase_k<0>, dim3(grid_blocks), dim3(256), 0, stream, p, b0 + 0);
    hipLaunchKernelGGL(phase_k<1>, dim3(grid_blocks), dim3(256), 0, stream, p, b0 + 1);
    hipLaunchKernelGGL(phase_k<2>, dim3(grid_blocks), dim3(256), 0, stream, p, b0 + 2);
    hipLaunchKernelGGL(phase_k<3>, dim3(grid_blocks), dim3(256), 0, stream, p, b0 + 3);
    hipLaunchKernelGGL(phase_k<4>, dim3(96), dim3(256), 0, stream, p, b0 + 4);
    hipLaunchKernelGGL(phase_k<11>, dim3(grid_blocks), dim3(256), 0, stream, p, b0 + 4);
    hipLaunchKernelGGL(phase_k<5>, dim3(grid_blocks), dim3(256), 0, stream, p, b0 + 5);
    hipLaunchKernelGGL(phase_k<6>, dim3(grid_blocks), dim3(256), 0, stream, p, b0 + 6);
    hipLaunchKernelGGL(phase_k<7>, dim3(grid_blocks), dim3(256), 0, stream, p, b0 + 7);
    hipLaunchKernelGGL(phase_k<8>, dim3(grid_blocks), dim3(256), 0, stream, p, b0 + 8);
    hipLaunchKernelGGL(phase_k<9>, dim3(grid_blocks), dim3(256), 0, stream, p, b0 + 9);
  }
#else
  int lo = 0, hi = NPHASE;
  void* args[] = {&p, &lo, &hi};
  hipError_t e = hipLaunchCooperativeKernel((void*)mega, dim3(grid_blocks), dim3(256), args, 0, stream);
  if (e != hipSuccess) fprintf(stderr, "cooperative launch failed: %s (grid %d)\n", hipGetErrorString(e), grid_blocks);
#endif
}
```

```cpp
#include <hip/hip_runtime.h>
#include <hip/hip_cooperative_groups.h>
#include <cstdio>
namespace cg = cooperative_groups;

#ifndef MULTI_LAUNCH
#define MULTI_LAUNCH 0
#endif

#define DI __device__ __forceinline__
typedef unsigned short bf16_t;
typedef short bf16x8 __attribute__((ext_vector_type(8)));
typedef short s16x4 __attribute__((ext_vector_type(4)));
typedef float f32x4 __attribute__((ext_vector_type(4)));
typedef float f32x2 __attribute__((ext_vector_type(2)));
typedef float f32x16 __attribute__((ext_vector_type(16)));
typedef unsigned u32x4 __attribute__((ext_vector_type(4)));
typedef unsigned u32x2 __attribute__((ext_vector_type(2)));
#define LAS __attribute__((address_space(3)))

constexpr int T_TOK = 18432, TB = 2304, NCTX = 256, NLAT = 2048, DM = 1024;
constexpr int LDPA = 1408, LDPBC = 1920;
constexpr float EPSF = 1e-6f;
constexpr float LOG_DECAY_SCALE = 0.606531f;
constexpr float GN_EPS = 64e-5f;
constexpr float QSCALE = 0.10206207261596577f * 1.4426950408889634f;

struct Params {
  const float *x, *c, *ctx, *c_ctx, *ada_w, *ada_b, *norm1_g, *norm2_g, *w_in, *tshift_mu, *decay_w0, *decay_up,
      *icl_a0, *icl_up, *gate_up, *k_k, *k_a, *r_k, *lnx_g, *lnx_b, *q_norm_g, *kv_norm_g, *w_uq, *w_ukv, *q_nope_g,
      *k_nope_g, *q_rope_g, *k_rope_g, *conv_w, *w_out, *w_ffn_in, *w_ffn_out;
  float* out;
  float *MOD, *RSTD, *BON, *XCTX, *Y;
  unsigned* BAR;
  bf16_t *Win, *Wuq, *WukvK, *WvT, *Wgate, *Wdecay, *Wicl, *Wout, *Wffi, *Wffo;
  bf16_t *HY, *TW, *TA, *TG, *Q, *Kt, *VT, *PA, *PBC, *ACT;
};

typedef __bf16 bf16v2 __attribute__((ext_vector_type(2)));
DI unsigned pk_bf16(float lo, float hi) { f32x2 v = {lo, hi}; bf16v2 b = __builtin_convertvector(v, bf16v2); return __builtin_bit_cast(unsigned, b); }
DI float bflo(unsigned u) { return __uint_as_float(u << 16); }
DI float bfhi(unsigned u) { return __uint_as_float(u & 0xffff0000u); }
DI int opaque_tid() { int t = threadIdx.x; asm volatile("" : "+v"(t)); return t; }
DI float sigmoidf_(float x) { return 1.f / (1.f + __expf(-x)); }
template <int CTRL> DI float dppf(float x) { return __builtin_bit_cast(float, __builtin_amdgcn_update_dpp(0, __builtin_bit_cast(int, x), CTRL, 0xf, 0xf, true)); }
DI float red8(float x) { x += dppf<0xB1>(x); x += dppf<0x4E>(x); x += dppf<0x141>(x); return x; }
DI float red16(float x) { x = red8(x); x += dppf<0x140>(x); return x; }
DI float red64(float x) { for (int o = 32; o > 0; o >>= 1) x += __shfl_xor(x, o); return x; }

DI void unpack8(u32x4 v, float* f) {
  f[0] = bflo(v[0]); f[1] = bfhi(v[0]); f[2] = bflo(v[1]); f[3] = bfhi(v[1]);
  f[4] = bflo(v[2]); f[5] = bfhi(v[2]); f[6] = bflo(v[3]); f[7] = bfhi(v[3]);
}
DI void unpack4(u32x2 v, float* f) { f[0] = bflo(v[0]); f[1] = bfhi(v[0]); f[2] = bflo(v[1]); f[3] = bfhi(v[1]); }

DI const float* xsrc_row(const Params& p, bool from_inputs, int b, int s) {
  if (from_inputs) return s < NCTX ? p.ctx + (size_t)(b * NCTX + s) * DM : p.x + (size_t)(b * NLAT + s - NCTX) * DM;
  return s < NCTX ? p.XCTX + (size_t)(b * NCTX + s) * DM : p.out + (size_t)(b * NLAT + s - NCTX) * DM;
}
DI float* xdst_row(const Params& p, int b, int s) {
  return s < NCTX ? p.XCTX + (size_t)(b * NCTX + s) * DM : p.out + (size_t)(b * NLAT + s - NCTX) * DM;
}

DI void adaln_task(const Params& p, int task, char* lds) {
  float* s = (float*)lds;
  float* red = s + 9 * 1024;
  const int l = task / 192, cgi = task % 192, tid = opaque_tid();
  for (int i = tid; i < 9 * 1024; i += 256) {
    int r = i >> 10, k = i & 1023;
    float v = r < 8 ? p.c[r * 1024 + k] : p.c_ctx[k];
    s[i] = v / (1.f + __expf(-v));
  }
  __syncthreads();
  const int kg = tid >> 5, cc = tid & 31, col = cgi * 32 + cc;
  float acc[9];
#pragma unroll
  for (int r = 0; r < 9; ++r) acc[r] = 0.f;
  const float* w = p.ada_w + (size_t)l * 1024 * 6144 + col;
  for (int k = kg; k < 1024; k += 8) {
    float wv = w[(size_t)k * 6144];
#pragma unroll
    for (int r = 0; r < 9; ++r) acc[r] += s[r * 1024 + k] * wv;
  }
#pragma unroll
  for (int r = 0; r < 9; ++r) red[(kg * 9 + r) * 32 + cc] = acc[r];
  __syncthreads();
  for (int i = tid; i < 9 * 32; i += 256) {
    int r = i >> 5, c2 = i & 31;
    float sum = 0.f;
    for (int g = 0; g < 8; ++g) sum += red[(g * 9 + r) * 32 + c2];
    p.MOD[(size_t)(l * 9 + r) * 6144 + cgi * 32 + c2] = sum + p.ada_b[l * 6144 + cgi * 32 + c2];
  }
  __syncthreads();
}

DI int colmap(int mode, int n, int nvalid) {
  switch (mode) {
    case 0: return n < nvalid ? n : -1;
    case 1: if (n < 384) return (n >> 6) * 96 + (n & 63); if (n < 576) return ((n - 384) >> 5) * 96 + 64 + ((n - 384) & 31); return -1;
    case 2: return (n >> 6) * 128 + (n & 63);
    case 3: return (n >> 6) * 128 + 64 + (n & 63);
    default: { int t64 = n >> 6, w = n & 63; return w < 32 ? t64 * 32 + w : 2816 + t64 * 32 + (w - 32); }
  }
}
DI void conv_tile(const float* src, int ld, int K, int mode, int nvalid, const float* kscale, bf16_t* dst, int tile, int ntn, char* lds) {
  float(*tl)[65] = (float(*)[65])lds;
  const int tk = tile / ntn, tn = tile % ntn, tid = opaque_tid(), k0 = tk * 64;
  {
    const int nn = tid & 63, kk0 = tid >> 6;
    const int sc = colmap(mode, tn * 64 + nn, nvalid);
#pragma unroll 4
    for (int i = 0; i < 16; ++i) {
      const int kk = kk0 + 4 * i;
      float v = 0.f;
      if (sc >= 0) { v = src[(size_t)(k0 + kk) * ld + sc]; if (kscale) v *= kscale[k0 + kk]; }
      tl[kk][nn] = v;
    }
  }
  __syncthreads();
  {
    const int kk2 = (tid & 31) * 2, nn2 = tid >> 5;
#pragma unroll
    for (int i = 0; i < 8; ++i) {
      const int nn = nn2 + 8 * i;
      *(unsigned*)(dst + (size_t)(tn * 64 + nn) * K + k0 + kk2) = pk_bf16(tl[kk2][nn], tl[kk2 + 1][nn]);
    }
  }
  __syncthreads();
}
constexpr int NCONV_W1 = 1292, NCONV_FF = 2112;
DI void conv_w1_task(const Params& p, int l, int t, char* lds) {
  if (t < 832) { conv_tile(p.w_in + (size_t)l * 1024 * 3232, 3232, 1024, 0, 3232, nullptr, p.Win, t, 52, lds); return; } t -= 832;
  if (t < 120) { conv_tile(p.w_uq + (size_t)l * 768 * 576, 576, 768, 1, 0, p.q_norm_g + l * 768, p.Wuq, t, 10, lds); return; } t -= 120;
  if (t < 24) { conv_tile(p.w_ukv + (size_t)l * 256 * 768, 768, 256, 2, 0, p.kv_norm_g + l * 256, p.WukvK, t, 6, lds); return; } t -= 24;
  if (t < 24) { conv_tile(p.w_ukv + (size_t)l * 256 * 768, 768, 256, 3, 0, p.kv_norm_g + l * 256, p.WvT, t, 6, lds); return; } t -= 24;
  if (t < 12) { conv_tile(p.gate_up + (size_t)l * 128 * 384, 384, 128, 0, 384, nullptr, p.Wgate, t, 6, lds); return; } t -= 12;
  if (t < 12) { int d = t / 6; conv_tile(p.decay_up + (size_t)(l * 2 + d) * 64 * 384, 384, 64, 0, 384, nullptr, p.Wdecay + d * 384 * 64, t % 6, 6, lds); return; } t -= 12;
  if (t < 12) { int d = t / 6; conv_tile(p.icl_up + (size_t)(l * 2 + d) * 64 * 384, 384, 64, 0, 384, nullptr, p.Wicl + d * 384 * 64, t % 6, 6, lds); return; } t -= 12;
  conv_tile(p.w_out + (size_t)l * 1024 * 1024, 1024, 1024, 0, 1024, nullptr, p.Wout, t, 16, lds);
}
DI void conv_ff_task(const Params& p, int l, int t, char* lds) {
  if (t < 1408) { conv_tile(p.w_ffn_in + (size_t)l * 1024 * 5632, 5632, 1024, 4, 0, nullptr, p.Wffi, t, 88, lds); return; } t -= 1408;
  conv_tile(p.w_ffn_out + (size_t)l * 2816 * 1024, 1024, 2816, 0, 1024, nullptr, p.Wffo, t, 16, lds);
}

DI void modnorm_row(const Params& p, int l, int which  , bool from_inputs, int row, int lane) {
  const int b = row / TB, s = row % TB;
  const float* src = xsrc_row(p, from_inputs, b, s);
  const float* g = (which ? p.norm2_g : p.norm1_g) + l * DM;
  const float* mod = p.MOD + (size_t)(l * 9 + (s < NCTX ? 8 : b)) * 6144 + (which ? 3 * 1024 : 0);
  f32x4 v[4];
  float ss = 0.f;
#pragma unroll
  for (int i = 0; i < 4; ++i) { v[i] = *(const f32x4*)(src + i * 256 + lane * 4); ss += v[i][0] * v[i][0] + v[i][1] * v[i][1] + v[i][2] * v[i][2] + v[i][3] * v[i][3]; }
  ss = red64(ss);
  const float rs = rsqrtf(ss * (1.f / 1024.f) + EPSF);
  bf16_t* dst = p.HY + (size_t)row * DM;
#pragma unroll
  for (int i = 0; i < 4; ++i) {
    const int c0 = i * 256 + lane * 4;
    f32x4 gg = *(const f32x4*)(g + c0), sh = *(const f32x4*)(mod + c0), sc = *(const f32x4*)(mod + 1024 + c0);
    float o[4];
#pragma unroll
    for (int j = 0; j < 4; ++j) o[j] = (v[i][j] * rs * gg[j]) * (1.f + sc[j]) + sh[j];
    u32x2 w = {pk_bf16(o[0], o[1]), pk_bf16(o[2], o[3])};
    *(u32x2*)(dst + c0) = w;
  }
}

template <class Epi>
DI void gemm_tile(const bf16_t* __restrict__ A, int lda, const bf16_t* __restrict__ Bt, int ldb, int K, int row0, int col0, char* lds, const Epi& epi) {
  const int tid = opaque_tid(), lane = tid & 63, wid = tid >> 6, wr = wid >> 1, wc = wid & 1, fr = lane & 15, fq = lane >> 4;
  const bf16_t* ag[4];
  const bf16_t* bg[4];
#pragma unroll
  for (int i = 0; i < 4; ++i) {
    const int id = i * 256 + tid, r = id >> 3, cp = id & 7, c = cp ^ ((r >> 1) & 7);
    ag[i] = A + (size_t)(row0 + r) * lda + c * 8;
    bg[i] = Bt + (size_t)(col0 + r) * ldb + c * 8;
  }
  f32x4 acc[4][4];
#pragma unroll
  for (int m = 0; m < 4; ++m)
#pragma unroll
    for (int n = 0; n < 4; ++n) acc[m][n] = (f32x4){0.f, 0.f, 0.f, 0.f};
  const int KT = K >> 6;
  auto stage = [&](int kt, int buf) {
    char* sa = lds + buf * 32768;
    char* sb = sa + 16384;
#pragma unroll
    for (int i = 0; i < 4; ++i) {
      __builtin_amdgcn_global_load_lds((const void __attribute__((address_space(1)))*)(ag[i] + kt * 64), (void LAS*)(sa + (i * 256 + tid) * 16), 16, 0, 0);
      __builtin_amdgcn_global_load_lds((const void __attribute__((address_space(1)))*)(bg[i] + kt * 64), (void LAS*)(sb + (i * 256 + tid) * 16), 16, 0, 0);
    }
  };
  __syncthreads();
  stage(0, 0);
  const int swz = fr >> 1;
  for (int kt = 0; kt < KT; ++kt) {
    asm volatile("s_waitcnt vmcnt(0)" ::: "memory");
    __syncthreads();
    if (kt + 1 < KT) stage(kt + 1, (kt + 1) & 1);
    const char* sa = lds + (kt & 1) * 32768 + (wr * 64 + fr) * 128;
    const char* sb = lds + (kt & 1) * 32768 + 16384 + (wc * 64 + fr) * 128;
#pragma unroll
    for (int kk = 0; kk < 2; ++kk) {
      bf16x8 a[4], b[4];
      const int co = ((kk * 4 + fq) ^ swz) * 16;
#pragma unroll
      for (int m = 0; m < 4; ++m) a[m] = *(const bf16x8*)(sa + m * 2048 + co);
#pragma unroll
      for (int n = 0; n < 4; ++n) b[n] = *(const bf16x8*)(sb + n * 2048 + co);
#pragma unroll
      for (int m = 0; m < 4; ++m)
#pragma unroll
        for (int n = 0; n < 4; ++n) acc[m][n] = __builtin_amdgcn_mfma_f32_16x16x32_bf16(b[n], a[m], acc[m][n], 0, 0, 0);
    }
  }
  epi(acc, row0 + wr * 64, col0 + wc * 64, fr, fq);
}

struct EpiP {
  bf16_t *PA, *PBC;
  DI void operator()(const f32x4 (&acc)[4][4], int r0, int c0, int fr, int fq) const {
    bf16_t* base; int ld, cb;
    if (c0 < LDPA) { base = PA; ld = LDPA; cb = c0; } else { base = PBC; ld = LDPBC; cb = c0 - LDPA; }
#pragma unroll
    for (int m = 0; m < 4; ++m)
#pragma unroll
      for (int n = 0; n < 4; ++n) {
        u32x2 v = {pk_bf16(acc[m][n][0], acc[m][n][1]), pk_bf16(acc[m][n][2], acc[m][n][3])};
        *(u32x2*)(base + (size_t)(r0 + m * 16 + fr) * ld + cb + n * 16 + fq * 4) = v;
      }
  }
};

DI void rope_angle(int pos, int i, float& cs, float& sn) {
  const float invf = __builtin_amdgcn_exp2f(-(float)i * (13.287712379549449f / 8.f));
  float ang = (float)pos * invf;
  float n = rintf(ang * 0.15915494309189535f);
  float r = fmaf(-n, 6.28125f, ang);
  r = fmaf(-n, 1.9353071795864769e-3f, r);
  cs = __cosf(r); sn = __sinf(r);
}

struct EpiQ {
  const float *rstd, *gn, *gr; bf16_t* Q;
  DI void operator()(const f32x4 (&acc)[4][4], int r0, int c0, int fr, int fq) const {
    if (c0 >= 576) return;
    if (c0 < 384) {
      const int h = c0 >> 6;
#pragma unroll
      for (int m = 0; m < 4; ++m) {
        const int row = r0 + m * 16 + fr; const float rs = rstd[row];
        float ss = 0.f;
#pragma unroll
        for (int n = 0; n < 4; ++n)
#pragma unroll
          for (int j = 0; j < 4; ++j) { float v = acc[m][n][j] * rs; ss += v * v; }
        ss += __shfl_xor(ss, 16); ss += __shfl_xor(ss, 32);
        const float inv = rsqrtf(ss * (1.f / 64.f) + EPSF) * rs * QSCALE;
        const int b = row / TB, s = row % TB;
        bf16_t* dst = Q + ((size_t)(b * 6 + h) * TB + s) * 96;
#pragma unroll
        for (int n = 0; n < 4; ++n) {
          const int d = n * 16 + fq * 4; f32x4 g = *(const f32x4*)(gn + d);
          u32x2 v = {pk_bf16(acc[m][n][0] * inv * g[0], acc[m][n][1] * inv * g[1]), pk_bf16(acc[m][n][2] * inv * g[2], acc[m][n][3] * inv * g[3])};
          *(u32x2*)(dst + d) = v;
        }
      }
    } else {
#pragma unroll
      for (int m = 0; m < 4; ++m) {
        const int row = r0 + m * 16 + fr; const float rs = rstd[row];
        const int b = row / TB, s = row % TB; const bool lat = s >= NCTX; const int sp = s - NCTX;
#pragma unroll
        for (int hh = 0; hh < 2; ++hh) {
          const int h = ((c0 - 384) >> 5) + hh;
          float ss = 0.f;
#pragma unroll
          for (int nn = 0; nn < 2; ++nn)
#pragma unroll
            for (int j = 0; j < 4; ++j) { float v = acc[m][hh * 2 + nn][j] * rs; ss += v * v; }
          ss += __shfl_xor(ss, 16); ss += __shfl_xor(ss, 32);
          const float inv = rsqrtf(ss * (1.f / 32.f) + EPSF) * rs;
          bf16_t* dst = Q + ((size_t)(b * 6 + h) * TB + s) * 96 + 64;
#pragma unroll
          for (int nn = 0; nn < 2; ++nn) {
            const int d = nn * 16 + fq * 4; f32x4 g = *(const f32x4*)(gr + d);
            float o[4];
#pragma unroll
            for (int j = 0; j < 4; ++j) {
              float val = acc[m][hh * 2 + nn][j] * inv * g[j];
              float partner = __shfl_xor(val, 32);
              if (lat) {
                float cs, sn; rope_angle(nn == 0 ? (sp >> 6) : (sp & 63), (fq * 4 + j) & 7, cs, sn);
                val = fq < 2 ? val * cs - partner * sn : val * cs + partner * sn;
              }
              o[j] = val * QSCALE;
            }
            u32x2 v = {pk_bf16(o[0], o[1]), pk_bf16(o[2], o[3])};
            *(u32x2*)(dst + d) = v;
          }
        }
      }
    }
  }
};

struct EpiK {
  const float *rstd, *gk; bf16_t* Kt;
  DI void operator()(const f32x4 (&acc)[4][4], int r0, int c0, int fr, int fq) const {
    const int h = c0 >> 6;
#pragma unroll
    for (int m = 0; m < 4; ++m) {
      const int row = r0 + m * 16 + fr; const float rs = rstd[row];
      float ss = 0.f;
#pragma unroll
      for (int n = 0; n < 4; ++n)
#pragma unroll
        for (int j = 0; j < 4; ++j) { float v = acc[m][n][j] * rs; ss += v * v; }
      ss += __shfl_xor(ss, 16); ss += __shfl_xor(ss, 32);
      const float inv = rsqrtf(ss * (1.f / 64.f) + EPSF) * rs;
      const int b = row / TB, s = row % TB;
      bf16_t* dst = Kt + ((size_t)(b * 6 + h) * TB + s) * 96;
#pragma unroll
      for (int n = 0; n < 4; ++n) {
        const int d = n * 16 + fq * 4; f32x4 g = *(const f32x4*)(gk + d);
        u32x2 v = {pk_bf16(acc[m][n][0] * inv * g[0], acc[m][n][1] * inv * g[1]), pk_bf16(acc[m][n][2] * inv * g[2], acc[m][n][3] * inv * g[3])};
        *(u32x2*)(dst + d) = v;
      }
    }
  }
};

struct EpiV {
  const float* rstd; bf16_t* VT;
  DI void operator()(const f32x4 (&acc)[4][4], int r0, int c0, int fr, int fq) const {
#pragma unroll
    for (int m = 0; m < 4; ++m)
#pragma unroll
      for (int n = 0; n < 4; ++n) {
        const int row = r0 + m * 16 + fr, col = c0 + n * 16 + fq * 4;
        f32x4 rs = *(const f32x4*)(rstd + col);
        u32x2 v = {pk_bf16(acc[m][n][0] * rs[0], acc[m][n][1] * rs[1]), pk_bf16(acc[m][n][2] * rs[2], acc[m][n][3] * rs[3])};
        *(u32x2*)(VT + (size_t)row * T_TOK + col) = v;
      }
  }
};

struct EpiPost {
  const float *Y, *BON, *mu, *lnx_g, *lnx_b; const bf16_t* PA; bf16_t* YC;
  DI void operator()(const f32x4 (&acc)[4][4], int r0, int c0, int fr, int fq) const {
    const int h = c0 >> 6;
#pragma unroll
    for (int m = 0; m < 4; ++m) {
      const int row = r0 + m * 16 + fr; const int s = row % TB;
      const bool hasprev = (s != 0 && s != NCTX), hasnext = (s != NCTX - 1 && s != TB - 1);
      f32x4 y[4];
      float s1 = 0.f;
#pragma unroll
      for (int n = 0; n < 4; ++n) {
        const size_t o = (size_t)row * 384 + c0 + n * 16 + fq * 4;
        y[n] = *(const f32x4*)(Y + o) + *(const f32x4*)(Y + (size_t)T_TOK * 384 + o);
        s1 += y[n][0] + y[n][1] + y[n][2] + y[n][3];
      }
      s1 += __shfl_xor(s1, 16); s1 += __shfl_xor(s1, 32);
      const float mean = s1 * (1.f / 64.f);
      float s2 = 0.f;
#pragma unroll
      for (int n = 0; n < 4; ++n)
#pragma unroll
        for (int j = 0; j < 4; ++j) { float d = y[n][j] - mean; s2 += d * d; }
      s2 += __shfl_xor(s2, 16); s2 += __shfl_xor(s2, 32);
      const float rstdv = rsqrtf(s2 * (1.f / 64.f) + GN_EPS);
      const float bon = BON[(size_t)row * 6 + h] + BON[(size_t)T_TOK * 6 + (size_t)row * 6 + h];
#pragma unroll
      for (int n = 0; n < 4; ++n) {
        const int col = c0 + n * 16 + fq * 4;
        const bf16_t* pv = PA + (size_t)row * LDPA + 768 + col;
        float vc[4], vp[4] = {0.f, 0.f, 0.f, 0.f}, vn[4] = {0.f, 0.f, 0.f, 0.f};
        unpack4(*(const u32x2*)pv, vc);
        if (hasprev) unpack4(*(const u32x2*)(pv - LDPA), vp);
        if (hasnext) unpack4(*(const u32x2*)(pv + LDPA), vn);
        f32x4 m0 = *(const f32x4*)(mu + 768 + col), m1 = *(const f32x4*)(mu + LDPA + 768 + col);
        f32x4 lg = *(const f32x4*)(lnx_g + col), lb = *(const f32x4*)(lnx_b + col);
        float o[4];
#pragma unroll
        for (int j = 0; j < 4; ++j) {
          const float v = vc[j] + m0[j] * (vp[j] - vc[j]) + m1[j] * (vn[j] - vc[j]);
          o[j] = ((y[n][j] - mean) * rstdv * lg[j] + lb[j] + bon * v) * acc[m][n][j];
        }
        u32x2 w = {pk_bf16(o[0], o[1]), pk_bf16(o[2], o[3])};
        *(u32x2*)(YC + (size_t)row * DM + col) = w;
      }
    }
  }
};

struct EpiRes {
  const Params* p; int l; bool from_inputs; int gate_off;
  DI void operator()(const f32x4 (&acc)[4][4], int r0, int c0, int fr, int fq) const {
#pragma unroll
    for (int m = 0; m < 4; ++m) {
      const int row = r0 + m * 16 + fr; const int b = row / TB, s = row % TB;
      const float* src = xsrc_row(*p, from_inputs, b, s);
      float* dst = xdst_row(*p, b, s);
      const float* gate = p->MOD + (size_t)(l * 9 + (s < NCTX ? 8 : b)) * 6144 + gate_off;
#pragma unroll
      for (int n = 0; n < 4; ++n) {
        const int col = c0 + n * 16 + fq * 4;
        f32x4 g = *(const f32x4*)(gate + col), xv = *(const f32x4*)(src + col);
        *(f32x4*)(dst + col) = xv + g * acc[m][n];
      }
    }
  }
};

struct EpiFfnIn {
  bf16_t* ACT;
  DI void operator()(const f32x4 (&acc)[4][4], int r0, int c0, int fr, int fq) const {
    const int cb = (c0 >> 6) * 32;
#pragma unroll
    for (int m = 0; m < 4; ++m)
#pragma unroll
      for (int n = 0; n < 2; ++n) {
        float o[4];
#pragma unroll
        for (int j = 0; j < 4; ++j) { float g = acc[m][n][j]; o[j] = g / (1.f + __expf(-g)) * acc[m][n + 2][j]; }
        u32x2 w = {pk_bf16(o[0], o[1]), pk_bf16(o[2], o[3])};
        *(u32x2*)(ACT + (size_t)(r0 + m * 16 + fr) * 2816 + cb + n * 16 + fq * 4) = w;
      }
  }
};

DI void prep_token(const Params& p, int l, int row, int lane) {
  const int b = row / TB, s = row % TB;
  const bool hasprev = (s != 0 && s != NCTX), hasnext = (s != NCTX - 1 && s != TB - 1);
  const bf16_t* pa = p.PA + (size_t)row * LDPA;
  const bf16_t* pbc = p.PBC + (size_t)row * LDPBC;
  const float* mu = p.tshift_mu + (size_t)l * 2 * LDPA;
  if (lane < 32) {
    const int col = 1152 + lane * 8;
    float c[8], pv[8], nx[8];
    unpack8(*(const u32x4*)(pa + col), c);
#pragma unroll
    for (int j = 0; j < 8; ++j) { pv[j] = 0.f; nx[j] = 0.f; }
    if (hasprev) unpack8(*(const u32x4*)(pa - LDPA + col), pv);
    if (hasnext) unpack8(*(const u32x4*)(pa + LDPA + col), nx);
    float o[8];
#pragma unroll
    for (int j = 0; j < 8; ++j) {
      float t = c[j] + mu[col + j] * (pv[j] - c[j]) + mu[LDPA + col + j] * (nx[j] - c[j]);
      if (lane < 8) { float e = __expf(2.f * t); t = 1.f - 2.f / (1.f + e); }
      else if (lane >= 16) t = sigmoidf_(t);
      o[j] = t;
    }
    u32x4 w = {pk_bf16(o[0], o[1]), pk_bf16(o[2], o[3]), pk_bf16(o[4], o[5]), pk_bf16(o[6], o[7])};
    if (lane < 8) *(u32x4*)(p.TW + (size_t)row * 64 + lane * 8) = w;
    else if (lane < 16) *(u32x4*)(p.TA + (size_t)row * 64 + (lane - 8) * 8) = w;
    else *(u32x4*)(p.TG + (size_t)row * 128 + (lane - 16) * 8) = w;
  }
  {
    float ss = 0.f, f[8];
    unpack8(*(const u32x4*)(pbc + lane * 8), f);
#pragma unroll
    for (int j = 0; j < 8; ++j) ss += f[j] * f[j];
    if (lane < 32) {
      unpack8(*(const u32x4*)(pbc + 512 + lane * 8), f);
#pragma unroll
      for (int j = 0; j < 8; ++j) ss += f[j] * f[j];
    }
    ss = red64(ss);
    float s2 = 0.f;
    if (lane < 32) {
      unpack8(*(const u32x4*)(pbc + 768 + lane * 8), f);
#pragma unroll
      for (int j = 0; j < 8; ++j) s2 += f[j] * f[j];
    }
    s2 = red64(s2);
    if (lane == 0) { p.RSTD[row] = rsqrtf(ss * (1.f / 768.f) + EPSF); p.RSTD[T_TOK + row] = rsqrtf(s2 * (1.f / 256.f) + EPSF); }
  }
  {
    float f[8], s3 = 0.f;
#pragma unroll
    for (int j = 0; j < 8; ++j) f[j] = 0.f;
    if (lane < 4) {
      unpack8(*(const u32x4*)(pbc + 1024 + lane * 8), f);
#pragma unroll
      for (int j = 0; j < 8; ++j) s3 += f[j] * f[j];
    }
    s3 += __shfl_xor(s3, 1); s3 += __shfl_xor(s3, 2);
    const float inv = rsqrtf(s3 * (1.f / 32.f) + EPSF);
    const float* g = p.k_rope_g + l * 32;
    const bool lat = s >= NCTX; const int sp = s - NCTX;
    float o[8];
#pragma unroll
    for (int j = 0; j < 8; ++j) {
      float val = lane < 4 ? f[j] * inv * g[lane * 8 + j] : 0.f;
      float partner = __shfl_xor(val, 1);
      if (lat) {
        float cs, sn; rope_angle(lane < 2 ? (sp >> 6) : (sp & 63), j, cs, sn);
        val = (lane & 1) == 0 ? val * cs - partner * sn : val * cs + partner * sn;
      }
      o[j] = val;
    }
    if (lane < 4) {
      u32x4 w = {pk_bf16(o[0], o[1]), pk_bf16(o[2], o[3]), pk_bf16(o[4], o[5]), pk_bf16(o[6], o[7])};
#pragma unroll
      for (int hh = 0; hh < 6; ++hh) *(u32x4*)(p.Kt + ((size_t)(b * 6 + hh) * TB + s) * 96 + 64 + lane * 8) = w;
    }
  }
  if (lane < 32) {
    const int c8 = lane * 8;
    float bg[8], cc[8], hh[8], cp[8], hp[8], cn[8], hn[8];
    unpack8(*(const u32x4*)(pbc + 1056 + c8), bg);
    unpack8(*(const u32x4*)(pbc + 1312 + c8), cc);
    unpack8(*(const u32x4*)(pbc + 1568 + c8), hh);
#pragma unroll
    for (int j = 0; j < 8; ++j) { cp[j] = hp[j] = cn[j] = hn[j] = 0.f; }
    if (hasprev) { unpack8(*(const u32x4*)(pbc - LDPBC + 1312 + c8), cp); unpack8(*(const u32x4*)(pbc - LDPBC + 1568 + c8), hp); }
    if (hasnext) { unpack8(*(const u32x4*)(pbc + LDPBC + 1312 + c8), cn); unpack8(*(const u32x4*)(pbc + LDPBC + 1568 + c8), hn); }
    const float* cw = p.conv_w + (size_t)l * 3 * 256;
    float o[8];
#pragma unroll
    for (int j = 0; j < 8; ++j) o[j] = bg[j] * (cw[c8 + j] * cp[j] * hp[j] + cw[256 + c8 + j] * cc[j] * hh[j] + cw[512 + c8 + j] * cn[j] * hn[j]);
    u32x4 w = {pk_bf16(o[0], o[1]), pk_bf16(o[2], o[3]), pk_bf16(o[4], o[5]), pk_bf16(o[6], o[7])};
    *(u32x4*)(p.HY + (size_t)row * DM + 768 + c8) = w;
  }
}

#define MFMA32(a, b, c) __builtin_amdgcn_mfma_f32_32x32x16_bf16((a), (b), (c), 0, 0, 0)
DI bf16x8 pack8(const f32x16& x, int s) {
  u32x4 v = {pk_bf16(x[8 * s], x[8 * s + 1]), pk_bf16(x[8 * s + 2], x[8 * s + 3]), pk_bf16(x[8 * s + 4], x[8 * s + 5]), pk_bf16(x[8 * s + 6], x[8 * s + 7])};
  return __builtin_bit_cast(bf16x8, v);
}
constexpr int KROW = 208, VROW = 136, KBUF = 64 * KROW, VBUF = 64 * VROW;
DI void attn_task(const Params& p, int b, int h, int q0, int k0, int nk, char* lds) {
  const int tid = opaque_tid(), lane = tid & 63, wid = tid >> 6, r = lane & 31, hh = lane >> 5;
  const bf16_t* Qp = p.Q + ((size_t)(b * 6 + h) * TB + q0 + wid * 32 + r) * 96;
  const bf16_t* Kp = p.Kt + ((size_t)(b * 6 + h) * TB + k0) * 96;
  const bf16_t* Vp = p.VT + (size_t)(h * 64) * T_TOK + (size_t)b * TB + k0;
  bf16x8 qf[6];
#pragma unroll
  for (int ks = 0; ks < 6; ++ks) qf[ks] = *(const bf16x8*)(Qp + ks * 16 + hh * 8);
  int krow_[3], kch_[3];
#pragma unroll
  for (int i = 0; i < 3; ++i) { int id = tid + i * 256; krow_[i] = id / 12; kch_[i] = id % 12; }
  const int vd0 = tid >> 3, vch = tid & 7;
  u32x4 kreg[3], vreg[2];
  auto load_regs = [&](int kt) {
#pragma unroll
    for (int i = 0; i < 3; ++i) kreg[i] = *(const u32x4*)(Kp + (size_t)(kt * 64 + krow_[i]) * 96 + kch_[i] * 8);
#pragma unroll
    for (int i = 0; i < 2; ++i) vreg[i] = *(const u32x4*)(Vp + (size_t)(vd0 + 32 * i) * T_TOK + kt * 64 + vch * 8);
  };
  auto write_lds = [&](int buf) {
    char* kb = lds + buf * (KBUF + VBUF);
    char* vb = kb + KBUF;
#pragma unroll
    for (int i = 0; i < 3; ++i) *(u32x4*)(kb + krow_[i] * KROW + kch_[i] * 16) = kreg[i];
#pragma unroll
    for (int i = 0; i < 2; ++i) {
      char* d = vb + (vd0 + 32 * i) * VROW + vch * 16;
      *(u32x2*)d = (u32x2){vreg[i][0], vreg[i][1]};
      *(u32x2*)(d + 8) = (u32x2){vreg[i][2], vreg[i][3]};
    }
  };
  f32x16 o[2];
#pragma unroll
  for (int i = 0; i < 16; ++i) { o[0][i] = 0.f; o[1][i] = 0.f; }
  float m_run = -1e30f, l_run = 0.f;
  const int NT = nk >> 6;
  __syncthreads();
  load_regs(0);
  write_lds(0);
  for (int kt = 0; kt < NT; ++kt) {
    if (kt + 1 < NT) load_regs(kt + 1);
    __syncthreads();
    const char* kb = lds + (kt & 1) * (KBUF + VBUF);
    const char* vb = kb + KBUF;
    f32x16 st[2];
#pragma unroll
    for (int kbk = 0; kbk < 2; ++kbk) {
#pragma unroll
      for (int i = 0; i < 16; ++i) st[kbk][i] = 0.f;
#pragma unroll
      for (int ks = 0; ks < 6; ++ks) {
        bf16x8 kf = *(const bf16x8*)(kb + (kbk * 32 + r) * KROW + ks * 32 + hh * 16);
        st[kbk] = MFMA32(kf, qf[ks], st[kbk]);
      }
    }
    float mx = st[0][0];
#pragma unroll
    for (int i = 0; i < 16; ++i) { mx = fmaxf(mx, st[0][i]); mx = fmaxf(mx, st[1][i]); }
    mx = fmaxf(mx, __shfl_xor(mx, 32));
    const float m_new = fmaxf(m_run, mx);
    const float alpha = __builtin_amdgcn_exp2f(m_run - m_new);
    m_run = m_new;
    float psum = 0.f;
#pragma unroll
    for (int kbk = 0; kbk < 2; ++kbk)
#pragma unroll
      for (int i = 0; i < 16; ++i) { float e = __builtin_amdgcn_exp2f(st[kbk][i] - m_new); st[kbk][i] = e; psum += e; }
    psum += __shfl_xor(psum, 32);
    l_run = l_run * alpha + psum;
#pragma unroll
    for (int i = 0; i < 16; ++i) { o[0][i] *= alpha; o[1][i] *= alpha; }
#pragma unroll
    for (int ksv = 0; ksv < 4; ++ksv) {
      const bf16x8 pf = pack8(st[ksv >> 1], ksv & 1);
#pragma unroll
      for (int db = 0; db < 2; ++db) {
        const char* va = vb + (db * 32 + r) * VROW + (ksv * 16 + 4 * hh) * 2;
        s16x4 lo = *(const s16x4*)va, hi = *(const s16x4*)(va + 16);
        bf16x8 vf = __builtin_shufflevector(lo, hi, 0, 1, 2, 3, 4, 5, 6, 7);
        o[db] = MFMA32(vf, pf, o[db]);
      }
    }
    if (kt + 1 < NT) write_lds((kt + 1) & 1);
  }
  const float invl = 1.f / l_run;
  bf16_t* dst = p.HY + (size_t)(b * TB + q0 + wid * 32 + r) * DM + 384 + h * 64;
#pragma unroll
  for (int db = 0; db < 2; ++db)
#pragma unroll
    for (int g = 0; g < 4; ++g) {
      u32x2 w = {pk_bf16(o[db][4 * g] * invl, o[db][4 * g + 1] * invl), pk_bf16(o[db][4 * g + 2] * invl, o[db][4 * g + 3] * invl)};
      *(u32x2*)(dst + db * 32 + 8 * g + 4 * hh) = w;
    }
}

enum { VW = 0, VKK = 1, VB = 2, VKD = 3, VR = 4, VV = 5 };
DI void scan_task(const Params& p, int l, int b, int h, int dir, char* lds) {
  float* cb = (float*)lds;
  float* ybuf = cb + 6 * 1024;
  float* tk = ybuf + 1024;
  const int tid = opaque_tid(), lane = tid & 63, wid = tid >> 6;
  const int st_p = tid >> 4, c4 = tid & 15;
  const int fr = lane & 15, fq = lane >> 4;
  const int rp = lane >> 3, g = lane & 7;
  const int hc = h * 64;
  bf16x8 bw[2], ba[2];
  {
    const bf16_t* wd = p.Wdecay + ((size_t)dir * 384 + hc + wid * 16 + fr) * 64;
    const bf16_t* wi = p.Wicl + ((size_t)dir * 384 + hc + wid * 16 + fr) * 64;
#pragma unroll
    for (int ks = 0; ks < 2; ++ks) { bw[ks] = *(const bf16x8*)(wd + ks * 32 + fq * 8); ba[ks] = *(const bf16x8*)(wi + ks * 32 + fq * 8); }
  }
  f32x4 mu0[3], mu1[3];
  const float* mu = p.tshift_mu + (size_t)l * 2 * LDPA;
#pragma unroll
  for (int sec = 0; sec < 3; ++sec) { mu0[sec] = *(const f32x4*)(mu + sec * 384 + hc + c4 * 4); mu1[sec] = *(const f32x4*)(mu + LDPA + sec * 384 + hc + c4 * 4); }
  const f32x4 kkg = *(const f32x4*)(p.k_k + l * 384 + hc + c4 * 4);
  const f32x4 rkg = *(const f32x4*)(p.r_k + l * 384 + hc + c4 * 4);
  const int colB = wid * 16 + fq * 4;
  const f32x4 w0 = *(const f32x4*)(p.decay_w0 + (size_t)(l * 2 + dir) * 384 + hc + colB);
  const f32x4 a0 = *(const f32x4*)(p.icl_a0 + (size_t)(l * 2 + dir) * 384 + hc + colB);
  const f32x4 kag = *(const f32x4*)(p.k_a + l * 384 + hc + colB);

  u32x2 ld[3][3];
  bf16x8 aw[2], aa[2];
  auto chunk_lo = [&](int c) -> int { return dir == 0 ? 16 * c : (c < 16 ? 240 - 16 * c : 2544 - 16 * c); };
  auto issue_loads = [&](int c) {
    const int slo = chunk_lo(c);
    const int s = slo + st_p;
    const bool hasprev = (s != 0 && s != NCTX), hasnext = (s != NCTX - 1 && s != TB - 1);
    const bf16_t* pa = p.PA + (size_t)(b * TB + s) * LDPA + hc + c4 * 4;
#pragma unroll
    for (int sec = 0; sec < 3; ++sec) {
      ld[sec][1] = *(const u32x2*)(pa + sec * 384);
      ld[sec][0] = hasprev ? *(const u32x2*)(pa + sec * 384 - LDPA) : (u32x2){0u, 0u};
      ld[sec][2] = hasnext ? *(const u32x2*)(pa + sec * 384 + LDPA) : (u32x2){0u, 0u};
    }
    const size_t trow = (size_t)(b * TB + slo + fr) * 64;
#pragma unroll
    for (int ks = 0; ks < 2; ++ks) { aw[ks] = *(const bf16x8*)(p.TW + trow + ks * 32 + fq * 8); aa[ks] = *(const bf16x8*)(p.TA + trow + ks * 32 + fq * 8); }
  };
  auto produce = [&](int c) {
    const int slo = chunk_lo(c);
    float ts[3][4];
#pragma unroll
    for (int sec = 0; sec < 3; ++sec) {
      float pc[4], pp[4], pn[4];
      unpack4(ld[sec][1], pc); unpack4(ld[sec][0], pp); unpack4(ld[sec][2], pn);
#pragma unroll
      for (int j = 0; j < 4; ++j) ts[sec][j] = pc[j] + mu0[sec][j] * (pp[j] - pc[j]) + mu1[sec][j] * (pn[j] - pc[j]);
    }
    *(f32x4*)(cb + VR * 1024 + st_p * 64 + c4 * 4) = (f32x4){ts[0][0], ts[0][1], ts[0][2], ts[0][3]};
    *(f32x4*)(cb + VV * 1024 + st_p * 64 + c4 * 4) = (f32x4){ts[2][0], ts[2][1], ts[2][2], ts[2][3]};
    *(f32x4*)(tk + st_p * 64 + c4 * 4) = (f32x4){ts[1][0], ts[1][1], ts[1][2], ts[1][3]};
    float kx[4], ss = 0.f;
#pragma unroll
    for (int j = 0; j < 4; ++j) { kx[j] = ts[1][j] * kkg[j]; ss += kx[j] * kx[j]; }
    ss = red16(ss);
    const float inv = rsqrtf(ss + 1e-12f);
    *(f32x4*)(cb + VKK * 1024 + st_p * 64 + c4 * 4) = (f32x4){kx[0] * inv, kx[1] * inv, kx[2] * inv, kx[3] * inv};
    __syncthreads();
    f32x4 dw = {0.f, 0.f, 0.f, 0.f}, da = {0.f, 0.f, 0.f, 0.f};
#pragma unroll
    for (int ks = 0; ks < 2; ++ks) {
      dw = __builtin_amdgcn_mfma_f32_16x16x32_bf16(bw[ks], aw[ks], dw, 0, 0, 0);
      da = __builtin_amdgcn_mfma_f32_16x16x32_bf16(ba[ks], aa[ks], da, 0, 0, 0);
    }
    {
      const f32x4 kv = *(const f32x4*)(tk + fr * 64 + colB);
      const f32x4 kkv = *(const f32x4*)(cb + VKK * 1024 + fr * 64 + colB);
      f32x4 wv, kdv, bv;
#pragma unroll
      for (int j = 0; j < 4; ++j) {
        wv[j] = __expf(-LOG_DECAY_SCALE * sigmoidf_(w0[j] + dw[j]));
        const float a = sigmoidf_(a0[j] + da[j]);
        kdv[j] = kv[j] * (1.f + (a - 1.f) * kag[j]);
        bv[j] = kkv[j] * a;
      }
      *(f32x4*)(cb + VW * 1024 + fr * 64 + colB) = wv;
      *(f32x4*)(cb + VKD * 1024 + fr * 64 + colB) = kdv;
      *(f32x4*)(cb + VB * 1024 + fr * 64 + colB) = bv;
    }
    __syncthreads();
    {
      const f32x4 rv = *(const f32x4*)(cb + VR * 1024 + st_p * 64 + c4 * 4);
      const f32x4 kdv = *(const f32x4*)(cb + VKD * 1024 + st_p * 64 + c4 * 4);
      float bs = rv[0] * kdv[0] * rkg[0] + rv[1] * kdv[1] * rkg[1] + rv[2] * kdv[2] * rkg[2] + rv[3] * kdv[3] * rkg[3];
      bs = red16(bs);
      if (c4 == 0) p.BON[(size_t)dir * T_TOK * 6 + (size_t)(b * TB + slo + st_p) * 6 + h] = bs;
    }
  };

  f32x2 S0[4], S1[4];
#pragma unroll
  for (int j = 0; j < 4; ++j) { S0[j] = (f32x2){0.f, 0.f}; S1[j] = (f32x2){0.f, 0.f}; }
  __syncthreads();
  issue_loads(0);
  produce(0);
  __syncthreads();
  const int NCH = TB / 16;
  for (int c = 0; c < NCH; ++c) {
    if (c + 1 < NCH) issue_loads(c + 1);
    for (int ii = 0; ii < 16; ++ii) {
      const int st = dir ? 15 - ii : ii;
      const float* base = cb + st * 64 + g * 8;
      f32x2 w[4], kk[4], bb[4], kd[4], rr[4];
#pragma unroll
      for (int hf = 0; hf < 2; ++hf) {
        f32x4 t;
        t = *(const f32x4*)(base + VW * 1024 + hf * 4); w[2 * hf] = (f32x2){t[0], t[1]}; w[2 * hf + 1] = (f32x2){t[2], t[3]};
        t = *(const f32x4*)(base + VKK * 1024 + hf * 4); kk[2 * hf] = (f32x2){t[0], t[1]}; kk[2 * hf + 1] = (f32x2){t[2], t[3]};
        t = *(const f32x4*)(base + VB * 1024 + hf * 4); bb[2 * hf] = (f32x2){t[0], t[1]}; bb[2 * hf + 1] = (f32x2){t[2], t[3]};
        t = *(const f32x4*)(base + VKD * 1024 + hf * 4); kd[2 * hf] = (f32x2){t[0], t[1]}; kd[2 * hf + 1] = (f32x2){t[2], t[3]};
        t = *(const f32x4*)(base + VR * 1024 + hf * 4); rr[2 * hf] = (f32x2){t[0], t[1]}; rr[2 * hf + 1] = (f32x2){t[2], t[3]};
      }
      const f32x2 vv = *(const f32x2*)(cb + VV * 1024 + st * 64 + wid * 16 + rp * 2);
      f32x2 p0 = S0[0] * kk[0], p1 = S1[0] * kk[0];
#pragma unroll
      for (int j = 1; j < 4; ++j) { p0 += S0[j] * kk[j]; p1 += S1[j] * kk[j]; }
      const float sa0 = -red8(p0[0] + p0[1]), sa1 = -red8(p1[0] + p1[1]);
      f32x2 y0 = {0.f, 0.f}, y1 = {0.f, 0.f};
#pragma unroll
      for (int j = 0; j < 4; ++j) {
        S0[j] = S0[j] * w[j] + (bb[j] * sa0 + kd[j] * vv[0]);
        S1[j] = S1[j] * w[j] + (bb[j] * sa1 + kd[j] * vv[1]);
        y0 += S0[j] * rr[j];
        y1 += S1[j] * rr[j];
      }
      const float yy0 = red8(y0[0] + y0[1]), yy1 = red8(y1[0] + y1[1]);
      if (g == 0) *(f32x2*)(ybuf + st * 64 + wid * 16 + rp * 2) = (f32x2){yy0, yy1};
    }
    __syncthreads();
    {
      const int slo = chunk_lo(c);
      *(f32x4*)(p.Y + (size_t)dir * T_TOK * 384 + (size_t)(b * TB + slo + st_p) * 384 + hc + c4 * 4) = *(const f32x4*)(ybuf + st_p * 64 + c4 * 4);
    }
    if (c + 1 < NCH) produce(c + 1);
    __syncthreads();
  }
}

DI int lat_tile(int i) { return (i >> 4) * 18 + 2 + (i & 15); }

template <int KSEL> DI void run_phase(const Params& p, int ph, char* lds) {
  const int bid = blockIdx.x, G = gridDim.x, tid = opaque_tid(), lane = tid & 63, wid = tid >> 6;
  if (ph == 0) {
    if (KSEL >= 0 && KSEL != 10) return;
    for (int t = bid; t < 384 + NCONV_W1; t += G) { if (t < 384) adaln_task(p, t, lds); else conv_w1_task(p, 0, t - 384, lds); }
    return;
  }
  if (KSEL == 10) return;
  const int l = (ph - 1) / 10, k = (ph - 1) % 10;
  const bool last = (l == 1);
  if (KSEL >= 0 && KSEL != 10 && k != (KSEL == 11 ? 4 : KSEL)) return;
  switch (k) {
    case 0:
      for (int t = bid; t < T_TOK / 4; t += G) modnorm_row(p, l, 0, l == 0, t * 4 + wid, lane);
      break;
    case 1: {
      EpiP e{p.PA, p.PBC};
      for (int t = bid; t < 144 * 26; t += G) gemm_tile(p.HY, DM, p.Win, DM, DM, (t / 26) * 128, (t % 26) * 128, lds, e);
    } break;
    case 2:
      for (int t = bid; t < T_TOK / 4; t += G) prep_token(p, l, t * 4 + wid, lane);
      break;
    case 3: {
      const int nq = last ? 128 * 5 : 144 * 5;
      EpiQ eq{p.RSTD, p.q_nope_g + l * 64, p.q_rope_g + l * 32, p.Q};
      EpiK ek{p.RSTD + T_TOK, p.k_nope_g + l * 64, p.Kt};
      EpiV ev{p.RSTD + T_TOK, p.VT};
      for (int t = bid; t < nq + 432 + 432; t += G) {
        if (t < nq) { int i = t / 5; int tm = last ? lat_tile(i) : i; gemm_tile(p.PBC, LDPBC, p.Wuq, 768, 768, tm * 128, (t % 5) * 128, lds, eq); }
        else if (t < nq + 432) { int u = t - nq; gemm_tile(p.PBC + 768, LDPBC, p.WukvK, 256, 256, (u / 3) * 128, (u % 3) * 128, lds, ek); }
        else { int u = t - nq - 432; gemm_tile(p.WvT, 256, p.PBC + 768, LDPBC, 256, (u % 3) * 128, (u / 3) * 128, lds, ev); }
      }
    } break;
    case 4: {
      const int natt = 768 + (last ? 0 : 96);
      if (KSEL != 11) { if (bid < 96) { scan_task(p, l, bid / 12, (bid % 12) >> 1, bid & 1, lds); break; } if (KSEL == 4) break; }
      const int aoff = KSEL == 11 ? 0 : 96;
      for (int t = bid - aoff; t < natt; t += (G - aoff)) {
        if (t < 768) { int bh = t >> 4, qb = t & 15; attn_task(p, bh / 6, bh % 6, NCTX + qb * 128, 0, TB, lds); }
        else { int u = t - 768; int bh = u >> 1, qb = u & 1; attn_task(p, bh / 6, bh % 6, qb * 128, 0, NCTX, lds); }
      }
    } break;
    case 5: {
      EpiPost e{p.Y, p.BON, p.tshift_mu + (size_t)l * 2 * LDPA, p.lnx_g + l * 384, p.lnx_b + l * 384, p.PA, p.HY};
      const int nm = last ? 128 : 144;
      for (int t = bid; t < nm * 3 + NCONV_FF; t += G) {
        if (t < nm * 3) { int i = t / 3; int tm = last ? lat_tile(i) : i; gemm_tile(p.TG, 128, p.Wgate, 128, 128, tm * 128, (t % 3) * 128, lds, e); }
        else conv_ff_task(p, l, t - nm * 3, lds);
      }
    } break;
    case 6: {
      EpiRes e{&p, l, l == 0, 2 * 1024};
      const int nm = last ? 128 : 144;
      for (int t = bid; t < nm * 8; t += G) { int i = t / 8; int tm = last ? lat_tile(i) : i; gemm_tile(p.HY, DM, p.Wout, DM, DM, tm * 128, (t % 8) * 128, lds, e); }
    } break;
    case 7:
      for (int t = bid; t < T_TOK / 4; t += G) { int row = t * 4 + wid; if (!(last && (row % TB) < NCTX)) modnorm_row(p, l, 1, false, row, lane); }
      break;
    case 8: {
      EpiFfnIn e{p.ACT};
      const int nm = last ? 128 : 144;
      const int nconv = last ? 0 : NCONV_W1;
      for (int t = bid; t < nm * 44 + nconv; t += G) {
        if (t < nm * 44) { int i = t / 44; int tm = last ? lat_tile(i) : i; gemm_tile(p.HY, DM, p.Wffi, DM, DM, tm * 128, (t % 44) * 128, lds, e); }
        else conv_w1_task(p, 1, t - nm * 44, lds);
      }
    } break;
    case 9: {
      EpiRes e{&p, l, false, 5 * 1024};
      const int nm = last ? 128 : 144;
      for (int t = bid; t < nm * 8; t += G) { int i = t / 8; int tm = last ? lat_tile(i) : i; gemm_tile(p.ACT, 2816, p.Wffo, 2816, 2816, tm * 128, (t % 8) * 128, lds, e); }
    } break;
  }
}


#define XB_TMO      128
#define XB_XCNT(j)  (256  + 64 * (j))
#define XB_XSUB(j)  (1280 + 64 * (j))
#define XB_XGEN(j)  (2304 + 64 * (j))
#define XB_TOP      3328
#define XB_TOPGEN   3392
#define XCD_BAR_WORDS 3456
#define XB_SPIN_CAP (1u << 20)
DI unsigned xb_ld(unsigned* p) { return __hip_atomic_load(p, __ATOMIC_RELAXED, __HIP_MEMORY_SCOPE_AGENT); }
DI unsigned xb_add(unsigned* p, unsigned v) { return __hip_atomic_fetch_add(p, v, __ATOMIC_RELAXED, __HIP_MEMORY_SCOPE_AGENT); }
DI unsigned xb_xcc_id() { return (unsigned)__builtin_amdgcn_s_getreg((3 << 11) | 20) & 0xFu; }
#define XB_SPIN(cond, bar) do { unsigned _sp = 0; while (cond) { __builtin_amdgcn_s_sleep(1); \
    if ((++_sp & 255u) == 0u) { if (xb_ld(&(bar)[XB_TMO])) break; if (_sp > XB_SPIN_CAP) { atomicAdd(&(bar)[XB_TMO], 1u); break; } } } } while (0)
struct XcdBarrier { unsigned* bar; unsigned x; volatile LAS unsigned* st; };
DI XcdBarrier xcd_barrier_post(unsigned* bar, volatile LAS unsigned* st) {
  XcdBarrier b; b.bar = bar; b.x = xb_xcc_id(); b.st = st;
  if (threadIdx.x == 0) (void)xb_add(&bar[XB_XCNT(b.x)], 1u);
  return b;
}
DI void xcd_barrier_complete(unsigned* bar, unsigned x, unsigned& nloc, unsigned& nx) {
  const unsigned G = gridDim.x * gridDim.y * gridDim.z;
  unsigned sum, cnt, mine, sp = 0u;
  for (;;) {
    sum = 0u; cnt = 0u; mine = 0u;
#pragma unroll
    for (unsigned j = 0; j < 16; ++j) { const unsigned c = xb_ld(&bar[XB_XCNT(j)]); sum += c; cnt += (c > 0u) ? 1u : 0u; mine = (j == x) ? c : mine; }
    if (sum == G) break;
    __builtin_amdgcn_s_sleep(1);
    if ((++sp & 255u) == 0u) { if (xb_ld(&bar[XB_TMO])) break; if (sp > XB_SPIN_CAP) { atomicAdd(&bar[XB_TMO], 1u); break; } }
  }
  nloc = mine > 0u ? mine : 1u; nx = cnt > 0u ? cnt : 1u;
}
DI void xcd_barrier(const XcdBarrier& b) {
  asm volatile("s_waitcnt vmcnt(0)" ::: "memory");
  __syncthreads();
  if (threadIdx.x == 0) {
    unsigned* bar = b.bar;
    __builtin_amdgcn_s_waitcnt(0);
    unsigned nloc = b.st[0], nx = b.st[1];
    if (nloc == 0u) { xcd_barrier_complete(bar, b.x, nloc, nx); b.st[0] = nloc; b.st[1] = nx; }
    const unsigned old = xb_add(&bar[XB_XSUB(b.x)], 1u);
    const unsigned gen = old / nloc;
    if (old + 1u == (gen + 1u) * nloc) {
      __builtin_amdgcn_fence(__ATOMIC_RELEASE, "agent");
      asm volatile("s_waitcnt vmcnt(0)" ::: "memory");
      const unsigned og = xb_add(&bar[XB_TOP], 1u);
      const unsigned tg = og / nx;
      if (og + 1u == (tg + 1u) * nx) xb_add(&bar[XB_TOPGEN], 1u);
      else XB_SPIN(xb_ld(&bar[XB_TOPGEN]) == tg, bar);
      __builtin_amdgcn_fence(__ATOMIC_ACQUIRE, "agent");
      xb_add(&bar[XB_XGEN(b.x)], 1u);
      asm volatile("s_waitcnt vmcnt(0)" ::: "memory");
    } else {
      XB_SPIN(xb_ld(&bar[XB_XGEN(b.x)]) == gen, bar);
      __builtin_amdgcn_fence(__ATOMIC_ACQUIRE, "agent");
      asm volatile("s_waitcnt vmcnt(0)" ::: "memory");
    }
  }
  __syncthreads();
}

constexpr int NPHASE = 21;
#if !MULTI_LAUNCH
__global__ void __launch_bounds__(256, 2) mega(Params p, int ph_lo, int ph_hi) {
  __shared__ __attribute__((aligned(16))) char lds[65536 + 16];
  cg::grid_group grid = cg::this_grid();
  volatile LAS unsigned* st = (volatile LAS unsigned*)(lds + 65536);
  if (threadIdx.x == 0) { st[0] = 0u; st[1] = 0u; }
  if (blockIdx.x == 0) for (int i = threadIdx.x; i < XCD_BAR_WORDS; i += 256) p.BAR[i] = 0u;
  __syncthreads();
  XcdBarrier xb;
  for (int ph = ph_lo; ph < ph_hi; ++ph) {
    if (ph == ph_lo + 1) { grid.sync(); xb = xcd_barrier_post(p.BAR, st); }
    else if (ph > ph_lo + 1) xcd_barrier(xb);
    run_phase<-1>(p, ph, lds);
#ifdef DBL_MASK
    if (ph > 0 && ((DBL_MASK >> ((ph - 1) % 10)) & 1)) { xcd_barrier(xb); run_phase<-1>(p, ph, lds); }
#endif
  }
}
#endif
template <int KSEL> __global__ void __launch_bounds__(256, 2) phase_k(Params p, int ph) {
  __shared__ __attribute__((aligned(16))) char lds[65536];
  run_phase<KSEL>(p, ph, lds);
}

extern "C" void kernel_launch(void* const* d_in, const int* in_sizes, int n_in, void* d_out, int out_size, void* d_ws, size_t ws_size, hipStream_t stream) {
  static int grid_blocks = 0;
  if (!grid_blocks) {
    int dev = 0, cus = 0, per_cu = 0;
    (void)hipGetDevice(&dev);
    (void)hipDeviceGetAttribute(&cus, hipDeviceAttributeMultiprocessorCount, dev);
    #if MULTI_LAUNCH
    per_cu = 2;
#else
    (void)hipOccupancyMaxActiveBlocksPerMultiprocessor(&per_cu, mega, 256, 0);
#endif
    if (per_cu > 2) per_cu = 2;
    if (per_cu < 1) per_cu = 1;
    grid_blocks = cus * per_cu;
  }
  Params p{};
  const float** pin = (const float**)&p.x;
  for (int i = 0; i < 32; ++i) pin[i] = (const float*)d_in[i];
  p.out = (float*)d_out;
  char* w = (char*)d_ws;
  size_t off = 0;
  auto take = [&](size_t bytes) { char* r = w + off; off += (bytes + 255) & ~(size_t)255; return r; };
  p.BAR = (unsigned*)take(XCD_BAR_WORDS * 4);
  p.MOD = (float*)take(2 * 9 * 6144 * 4);
  p.RSTD = (float*)take(2 * (size_t)T_TOK * 4);
  p.BON = (float*)take(2 * (size_t)T_TOK * 6 * 4);
  p.XCTX = (float*)take((size_t)8 * NCTX * DM * 4);
  p.Win = (bf16_t*)take((size_t)3328 * 1024 * 2);
  p.Wuq = (bf16_t*)take((size_t)640 * 768 * 2);
  p.WukvK = (bf16_t*)take((size_t)384 * 256 * 2);
  p.WvT = (bf16_t*)take((size_t)384 * 256 * 2);
  p.Wgate = (bf16_t*)take((size_t)384 * 128 * 2);
  p.Wdecay = (bf16_t*)take((size_t)2 * 384 * 64 * 2);
  p.Wicl = (bf16_t*)take((size_t)2 * 384 * 64 * 2);
  p.Wout = (bf16_t*)take((size_t)1024 * 1024 * 2);
  p.HY = (bf16_t*)take((size_t)T_TOK * DM * 2);
  p.TW = (bf16_t*)take((size_t)T_TOK * 64 * 2);
  p.TA = (bf16_t*)take((size_t)T_TOK * 64 * 2);
  p.TG = (bf16_t*)take((size_t)T_TOK * 128 * 2);
  char* qkv = take((size_t)T_TOK * 576 * 2 * 2 + (size_t)384 * T_TOK * 2);
  p.Q = (bf16_t*)qkv;
  p.Kt = (bf16_t*)(qkv + (size_t)T_TOK * 576 * 2);
  p.VT = (bf16_t*)(qkv + (size_t)T_TOK * 576 * 2 * 2);
  p.Wffi = (bf16_t*)qkv;
  p.Wffo = (bf16_t*)(qkv + (size_t)5632 * 1024 * 2);
  char* pr = take((size_t)T_TOK * (LDPA + LDPBC) * 2);
  p.PA = (bf16_t*)pr;
  p.PBC = (bf16_t*)(pr + (size_t)T_TOK * LDPA * 2);
  p.Y = (float*)p.PBC;
  p.ACT = (bf16_t*)pr;
  if (off > ws_size) { fprintf(stderr, "workspace too small: need %zu have %zu\n", off, ws_size); }
#if MULTI_LAUNCH
  hipLaunchKernelGGL(phase_k<10>, dim3(grid_blocks), dim3(256), 0, stream, p, 0);
  for (int l = 0; l < 2; ++l) {
    const int b0 = 1 + 10 * l;
    hipLaunchKernelGGL(phase_k<0>, dim3(grid_blocks), dim3(256), 0, stream, p, b0 + 0);
    hipLaunchKernelGGL(phase_k<1>, dim3(grid_blocks), dim3(256), 0, stream, p, b0 + 1);
    hipLaunchKernelGGL(phase_k<2>, dim3(grid_blocks), dim3(256), 0, stream, p, b0 + 2);
    hipLaunchKernelGGL(phase_k<3>, dim3(grid_blocks), dim3(256), 0, stream, p, b0 + 3);
    hipLaunchKernelGGL(phase_k<4>, dim3(96), dim3(256), 0, stream, p, b0 + 4);
    hipLaunchKernelGGL(phase_k<11>, dim3(grid_blocks), dim3(256), 0, stream, p, b0 + 4);
    hipLaunchKernelGGL(phase_k<5>, dim3(grid_blocks), dim3(256), 0, stream, p, b0 + 5);
    hipLaunchKernelGGL(phase_k<6>, dim3(grid_blocks), dim3(256), 0, stream, p, b0 + 6);
    hipLaunchKernelGGL(phase_k<7>, dim3(grid_blocks), dim3(256), 0, stream, p, b0 + 7);
    hipLaunchKernelGGL(phase_k<8>, dim3(grid_blocks), dim3(256), 0, stream, p, b0 + 8);
    hipLaunchKernelGGL(phase_k<9>, dim3(grid_blocks), dim3(256), 0, stream, p, b0 + 9);
  }
#else
  int lo = 0, hi = NPHASE;
  void* args[] = {&p, &lo, &hi};
  hipError_t e = hipLaunchCooperativeKernel((void*)mega, dim3(grid_blocks), dim3(256), args, 0, stream);
  if (e != hipSuccess) fprintf(stderr, "cooperative launch failed: %s (grid %d)\n", hipGetErrorString(e), grid_blocks);
#endif
}
```

```cpp
#include <hip/hip_runtime.h>
#include <hip/hip_cooperative_groups.h>
#include <cstdio>
namespace cg = cooperative_groups;

#ifndef MULTI_LAUNCH
#define MULTI_LAUNCH 0
#endif

#define DI __device__ __forceinline__
typedef unsigned short bf16_t;
typedef short bf16x8 __attribute__((ext_vector_type(8)));
typedef short s16x4 __attribute__((ext_vector_type(4)));
typedef float f32x4 __attribute__((ext_vector_type(4)));
typedef float f32x2 __attribute__((ext_vector_type(2)));
typedef float f32x16 __attribute__((ext_vector_type(16)));
typedef unsigned u32x4 __attribute__((ext_vector_type(4)));
typedef unsigned u32x2 __attribute__((ext_vector_type(2)));
#define LAS __attribute__((address_space(3)))

constexpr int T_TOK = 18432, TB = 2304, NCTX = 256, NLAT = 2048, DM = 1024;
constexpr int LDPA = 1408, LDPBC = 1920;
constexpr float EPSF = 1e-6f;
constexpr float LOG_DECAY_SCALE = 0.606531f;
constexpr float GN_EPS = 64e-5f;
constexpr float QSCALE = 0.10206207261596577f * 1.4426950408889634f;

struct Params {
  const float *x, *c, *ctx, *c_ctx, *ada_w, *ada_b, *norm1_g, *norm2_g, *w_in, *tshift_mu, *decay_w0, *decay_up,
      *icl_a0, *icl_up, *gate_up, *k_k, *k_a, *r_k, *lnx_g, *lnx_b, *q_norm_g, *kv_norm_g, *w_uq, *w_ukv, *q_nope_g,
      *k_nope_g, *q_rope_g, *k_rope_g, *conv_w, *w_out, *w_ffn_in, *w_ffn_out;
  float* out;
  float *MOD, *RSTD, *BON, *XCTX, *Y, *ROPE;
  unsigned* BAR;
  bf16_t *Win, *Wuq, *WukvK, *WvT, *Wgate, *Wdecay, *Wicl, *Wout, *Wffi, *Wffo;
  bf16_t *HY, *TW, *TA, *TG, *Q, *Kt, *VT, *PA, *PBC, *ACT;
};

typedef __bf16 bf16v2 __attribute__((ext_vector_type(2)));
DI unsigned pk_bf16(float lo, float hi) { f32x2 v = {lo, hi}; bf16v2 b = __builtin_convertvector(v, bf16v2); return __builtin_bit_cast(unsigned, b); }
DI float bflo(unsigned u) { return __uint_as_float(u << 16); }
DI float bfhi(unsigned u) { return __uint_as_float(u & 0xffff0000u); }
DI int opaque_tid() { int t = threadIdx.x; asm volatile("" : "+v"(t)); return t; }
DI float sigmoidf_(float x) { return 1.f / (1.f + __expf(-x)); }
template <int CTRL> DI float dppf(float x) { return __builtin_bit_cast(float, __builtin_amdgcn_update_dpp(0, __builtin_bit_cast(int, x), CTRL, 0xf, 0xf, true)); }
DI float red8(float x) { x += dppf<0xB1>(x); x += dppf<0x4E>(x); x += dppf<0x141>(x); return x; }
DI float red16(float x) { x = red8(x); x += dppf<0x140>(x); return x; }
DI float red64(float x) { for (int o = 32; o > 0; o >>= 1) x += __shfl_xor(x, o); return x; }

DI void unpack8(u32x4 v, float* f) {
  f[0] = bflo(v[0]); f[1] = bfhi(v[0]); f[2] = bflo(v[1]); f[3] = bfhi(v[1]);
  f[4] = bflo(v[2]); f[5] = bfhi(v[2]); f[6] = bflo(v[3]); f[7] = bfhi(v[3]);
}
DI void unpack4(u32x2 v, float* f) { f[0] = bflo(v[0]); f[1] = bfhi(v[0]); f[2] = bflo(v[1]); f[3] = bfhi(v[1]); }

DI const float* xsrc_row(const Params& p, bool from_inputs, int b, int s) {
  if (from_inputs) return s < NCTX ? p.ctx + (size_t)(b * NCTX + s) * DM : p.x + (size_t)(b * NLAT + s - NCTX) * DM;
  return s < NCTX ? p.XCTX + (size_t)(b * NCTX + s) * DM : p.out + (size_t)(b * NLAT + s - NCTX) * DM;
}
DI float* xdst_row(const Params& p, int b, int s) {
  return s < NCTX ? p.XCTX + (size_t)(b * NCTX + s) * DM : p.out + (size_t)(b * NLAT + s - NCTX) * DM;
}

DI void adaln_task(const Params& p, int task, char* lds) {
  float* s = (float*)lds;
  float* red = s + 9 * 1024;
  const int l = task / 192, cgi = task % 192, tid = opaque_tid();
  for (int i = tid; i < 9 * 1024; i += 256) {
    int r = i >> 10, k = i & 1023;
    float v = r < 8 ? p.c[r * 1024 + k] : p.c_ctx[k];
    s[i] = v / (1.f + __expf(-v));
  }
  __syncthreads();
  const int kg = tid >> 5, cc = tid & 31, col = cgi * 32 + cc;
  float acc[9];
#pragma unroll
  for (int r = 0; r < 9; ++r) acc[r] = 0.f;
  const float* w = p.ada_w + (size_t)l * 1024 * 6144 + col;
  for (int k = kg; k < 1024; k += 8) {
    float wv = w[(size_t)k * 6144];
#pragma unroll
    for (int r = 0; r < 9; ++r) acc[r] += s[r * 1024 + k] * wv;
  }
#pragma unroll
  for (int r = 0; r < 9; ++r) red[(kg * 9 + r) * 32 + cc] = acc[r];
  __syncthreads();
  for (int i = tid; i < 9 * 32; i += 256) {
    int r = i >> 5, c2 = i & 31;
    float sum = 0.f;
    for (int g = 0; g < 8; ++g) sum += red[(g * 9 + r) * 32 + c2];
    p.MOD[(size_t)(l * 9 + r) * 6144 + cgi * 32 + c2] = sum + p.ada_b[l * 6144 + cgi * 32 + c2];
  }
  __syncthreads();
}

DI int colmap(int mode, int n, int nvalid) {
  switch (mode) {
    case 0: return n < nvalid ? n : -1;
    case 1: if (n < 384) return (n >> 6) * 96 + (n & 63); if (n < 576) return ((n - 384) >> 5) * 96 + 64 + ((n - 384) & 31); return -1;
    case 2: return (n >> 6) * 128 + (n & 63);
    case 3: return (n >> 6) * 128 + 64 + (n & 63);
    default: { int t64 = n >> 6, w = n & 63; return w < 32 ? t64 * 32 + w : 2816 + t64 * 32 + (w - 32); }
  }
}
DI void conv_tile(const float* src, int ld, int K, int mode, int nvalid, const float* kscale, bf16_t* dst, int tile, int ntn, char* lds) {
  float(*tl)[65] = (float(*)[65])lds;
  const int tk = tile / ntn, tn = tile % ntn, tid = opaque_tid(), k0 = tk * 64;
  {
    const int nn = tid & 63, kk0 = tid >> 6;
    const int sc = colmap(mode, tn * 64 + nn, nvalid);
#pragma unroll 4
    for (int i = 0; i < 16; ++i) {
      const int kk = kk0 + 4 * i;
      float v = 0.f;
      if (sc >= 0) { v = src[(size_t)(k0 + kk) * ld + sc]; if (kscale) v *= kscale[k0 + kk]; }
      tl[kk][nn] = v;
    }
  }
  __syncthreads();
  {
    const int kk2 = (tid & 31) * 2, nn2 = tid >> 5;
#pragma unroll
    for (int i = 0; i < 8; ++i) {
      const int nn = nn2 + 8 * i;
      *(unsigned*)(dst + (size_t)(tn * 64 + nn) * K + k0 + kk2) = pk_bf16(tl[kk2][nn], tl[kk2 + 1][nn]);
    }
  }
  __syncthreads();
}
constexpr int NCONV_W1 = 1292, NCONV_FF = 2112;
DI void conv_w1_task(const Params& p, int l, int t, char* lds) {
  if (t < 832) { conv_tile(p.w_in + (size_t)l * 1024 * 3232, 3232, 1024, 0, 3232, nullptr, p.Win, t, 52, lds); return; } t -= 832;
  if (t < 120) { conv_tile(p.w_uq + (size_t)l * 768 * 576, 576, 768, 1, 0, p.q_norm_g + l * 768, p.Wuq, t, 10, lds); return; } t -= 120;
  if (t < 24) { conv_tile(p.w_ukv + (size_t)l * 256 * 768, 768, 256, 2, 0, p.kv_norm_g + l * 256, p.WukvK, t, 6, lds); return; } t -= 24;
  if (t < 24) { conv_tile(p.w_ukv + (size_t)l * 256 * 768, 768, 256, 3, 0, p.kv_norm_g + l * 256, p.WvT, t, 6, lds); return; } t -= 24;
  if (t < 12) { conv_tile(p.gate_up + (size_t)l * 128 * 384, 384, 128, 0, 384, nullptr, p.Wgate, t, 6, lds); return; } t -= 12;
  if (t < 12) { int d = t / 6; conv_tile(p.decay_up + (size_t)(l * 2 + d) * 64 * 384, 384, 64, 0, 384, nullptr, p.Wdecay + d * 384 * 64, t % 6, 6, lds); return; } t -= 12;
  if (t < 12) { int d = t / 6; conv_tile(p.icl_up + (size_t)(l * 2 + d) * 64 * 384, 384, 64, 0, 384, nullptr, p.Wicl + d * 384 * 64, t % 6, 6, lds); return; } t -= 12;
  conv_tile(p.w_out + (size_t)l * 1024 * 1024, 1024, 1024, 0, 1024, nullptr, p.Wout, t, 16, lds);
}
DI void conv_ff_task(const Params& p, int l, int t, char* lds) {
  if (t < 1408) { conv_tile(p.w_ffn_in + (size_t)l * 1024 * 5632, 5632, 1024, 4, 0, nullptr, p.Wffi, t, 88, lds); return; } t -= 1408;
  conv_tile(p.w_ffn_out + (size_t)l * 2816 * 1024, 1024, 2816, 0, 1024, nullptr, p.Wffo, t, 16, lds);
}

DI void modnorm_rows(const Params& p, int l, int which  , bool from_inputs, bool skip_ctx, int w0, int wstride, int lane) {
  const float* g = (which ? p.norm2_g : p.norm1_g) + l * DM;
  f32x4 gg[4];
#pragma unroll
  for (int i = 0; i < 4; ++i) gg[i] = *(const f32x4*)(g + i * 256 + lane * 4);
  const int nrows = skip_ctx ? 8 * NLAT : T_TOK;
  auto rowof = [&](int i) -> int { return skip_ctx ? (i / NLAT) * TB + NCTX + (i % NLAT) : i; };
  int i = w0;
  if (i >= nrows) return;
  f32x4 vn[4];
  {
    const int row = rowof(i); const float* src = xsrc_row(p, from_inputs, row / TB, row % TB);
#pragma unroll
    for (int q = 0; q < 4; ++q) vn[q] = *(const f32x4*)(src + q * 256 + lane * 4);
  }
  for (; i < nrows; i += wstride) {
    const int row = rowof(i); const int b = row / TB, s = row % TB;
    f32x4 v[4];
#pragma unroll
    for (int q = 0; q < 4; ++q) v[q] = vn[q];
    if (i + wstride < nrows) {
      const int rn = rowof(i + wstride); const float* src = xsrc_row(p, from_inputs, rn / TB, rn % TB);
#pragma unroll
      for (int q = 0; q < 4; ++q) vn[q] = *(const f32x4*)(src + q * 256 + lane * 4);
    }
    const float* mod = p.MOD + (size_t)(l * 9 + (s < NCTX ? 8 : b)) * 6144 + (which ? 3 * 1024 : 0);
    f32x4 sh[4], sc[4];
#pragma unroll
    for (int q = 0; q < 4; ++q) { sh[q] = *(const f32x4*)(mod + q * 256 + lane * 4); sc[q] = *(const f32x4*)(mod + 1024 + q * 256 + lane * 4); }
    float ss = 0.f;
#pragma unroll
    for (int q = 0; q < 4; ++q) ss += v[q][0] * v[q][0] + v[q][1] * v[q][1] + v[q][2] * v[q][2] + v[q][3] * v[q][3];
    ss = red64(ss);
    const float rs = rsqrtf(ss * (1.f / 1024.f) + EPSF);
    bf16_t* dst = p.HY + (size_t)row * DM;
#pragma unroll
    for (int q = 0; q < 4; ++q) {
      float o[4];
#pragma unroll
      for (int j = 0; j < 4; ++j) o[j] = (v[q][j] * rs * gg[q][j]) * (1.f + sc[q][j]) + sh[q][j];
      u32x2 w = {pk_bf16(o[0], o[1]), pk_bf16(o[2], o[3])};
      *(u32x2*)(dst + q * 256 + lane * 4) = w;
    }
  }
}

template <class Epi>
DI void gemm_tile(const bf16_t* __restrict__ A, int lda, const bf16_t* __restrict__ Bt, int ldb, int K, int row0, int col0, char* lds, const Epi& epi) {
  const int tid = opaque_tid(), lane = tid & 63, wid = tid >> 6, wr = wid >> 1, wc = wid & 1, fr = lane & 15, fq = lane >> 4;
  const bf16_t* ag[4];
  const bf16_t* bg[4];
#pragma unroll
  for (int i = 0; i < 4; ++i) {
    const int id = i * 256 + tid, r = id >> 3, cp = id & 7, c = cp ^ ((r >> 1) & 7);
    ag[i] = A + (size_t)(row0 + r) * lda + c * 8;
    bg[i] = Bt + (size_t)(col0 + r) * ldb + c * 8;
  }
  f32x4 acc[4][4];
#pragma unroll
  for (int m = 0; m < 4; ++m)
#pragma unroll
    for (int n = 0; n < 4; ++n) acc[m][n] = (f32x4){0.f, 0.f, 0.f, 0.f};
  const int KT = K >> 6;
  auto stage = [&](int kt, int buf) {
    char* sa = lds + buf * 32768;
    char* sb = sa + 16384;
#pragma unroll
    for (int i = 0; i < 4; ++i) {
      __builtin_amdgcn_global_load_lds((const void __attribute__((address_space(1)))*)(ag[i] + kt * 64), (void LAS*)(sa + (i * 256 + tid) * 16), 16, 0, 0);
      __builtin_amdgcn_global_load_lds((const void __attribute__((address_space(1)))*)(bg[i] + kt * 64), (void LAS*)(sb + (i * 256 + tid) * 16), 16, 0, 0);
    }
  };
  __syncthreads();
  stage(0, 0);
  const int swz = fr >> 1;
  for (int kt = 0; kt < KT; ++kt) {
    asm volatile("s_waitcnt vmcnt(0)" ::: "memory");
    __syncthreads();
    if (kt + 1 < KT) stage(kt + 1, (kt + 1) & 1);
    const char* sa = lds + (kt & 1) * 32768 + (wr * 64 + fr) * 128;
    const char* sb = lds + (kt & 1) * 32768 + 16384 + (wc * 64 + fr) * 128;
#pragma unroll
    for (int kk = 0; kk < 2; ++kk) {
      bf16x8 a[4], b[4];
      const int co = ((kk * 4 + fq) ^ swz) * 16;
#pragma unroll
      for (int m = 0; m < 4; ++m) a[m] = *(const bf16x8*)(sa + m * 2048 + co);
#pragma unroll
      for (int n = 0; n < 4; ++n) b[n] = *(const bf16x8*)(sb + n * 2048 + co);
#pragma unroll
      for (int m = 0; m < 4; ++m)
#pragma unroll
        for (int n = 0; n < 4; ++n) acc[m][n] = __builtin_amdgcn_mfma_f32_16x16x32_bf16(b[n], a[m], acc[m][n], 0, 0, 0);
    }
  }
  epi(acc, row0 + wr * 64, col0 + wc * 64, fr, fq);
}

struct EpiP {
  bf16_t *PA, *PBC;
  DI void operator()(const f32x4 (&acc)[4][4], int r0, int c0, int fr, int fq) const {
    bf16_t* base; int ld, cb;
    if (c0 < LDPA) { base = PA; ld = LDPA; cb = c0; } else { base = PBC; ld = LDPBC; cb = c0 - LDPA; }
#pragma unroll
    for (int m = 0; m < 4; ++m)
#pragma unroll
      for (int n = 0; n < 4; ++n) {
        u32x2 v = {pk_bf16(acc[m][n][0], acc[m][n][1]), pk_bf16(acc[m][n][2], acc[m][n][3])};
        *(u32x2*)(base + (size_t)(r0 + m * 16 + fr) * ld + cb + n * 16 + fq * 4) = v;
      }
  }
};

DI void rope_angle(int pos, int i, float& cs, float& sn) {
  const float invf = __builtin_amdgcn_exp2f(-(float)i * (13.287712379549449f / 8.f));
  float ang = (float)pos * invf;
  float n = rintf(ang * 0.15915494309189535f);
  float r = fmaf(-n, 6.28125f, ang);
  r = fmaf(-n, 1.9353071795864769e-3f, r);
  cs = __cosf(r); sn = __sinf(r);
}

struct EpiQ {
  const float *rstd, *gn, *gr, *rope; bf16_t* Q;
  DI void operator()(const f32x4 (&acc)[4][4], int r0, int c0, int fr, int fq) const {
    if (c0 >= 576) return;
    if (c0 < 384) {
      const int h = c0 >> 6;
#pragma unroll
      for (int m = 0; m < 4; ++m) {
        const int row = r0 + m * 16 + fr; const float rs = rstd[row];
        float ss = 0.f;
#pragma unroll
        for (int n = 0; n < 4; ++n)
#pragma unroll
          for (int j = 0; j < 4; ++j) { float v = acc[m][n][j] * rs; ss += v * v; }
        ss += __shfl_xor(ss, 16); ss += __shfl_xor(ss, 32);
        const float inv = rsqrtf(ss * (1.f / 64.f) + EPSF) * rs * QSCALE;
        const int b = row / TB, s = row % TB;
        bf16_t* dst = Q + ((size_t)(b * 6 + h) * TB + s) * 96;
#pragma unroll
        for (int n = 0; n < 4; ++n) {
          const int d = n * 16 + fq * 4; f32x4 g = *(const f32x4*)(gn + d);
          u32x2 v = {pk_bf16(acc[m][n][0] * inv * g[0], acc[m][n][1] * inv * g[1]), pk_bf16(acc[m][n][2] * inv * g[2], acc[m][n][3] * inv * g[3])};
          *(u32x2*)(dst + d) = v;
        }
      }
    } else {
#pragma unroll
      for (int m = 0; m < 4; ++m) {
        const int row = r0 + m * 16 + fr; const float rs = rstd[row];
        const int b = row / TB, s = row % TB; const bool lat = s >= NCTX; const int sp = s - NCTX;
#pragma unroll
        for (int hh = 0; hh < 2; ++hh) {
          const int h = ((c0 - 384) >> 5) + hh;
          float ss = 0.f;
#pragma unroll
          for (int nn = 0; nn < 2; ++nn)
#pragma unroll
            for (int j = 0; j < 4; ++j) { float v = acc[m][hh * 2 + nn][j] * rs; ss += v * v; }
          ss += __shfl_xor(ss, 16); ss += __shfl_xor(ss, 32);
          const float inv = rsqrtf(ss * (1.f / 32.f) + EPSF) * rs;
          bf16_t* dst = Q + ((size_t)(b * 6 + h) * TB + s) * 96 + 64;
#pragma unroll
          for (int nn = 0; nn < 2; ++nn) {
            const int d = nn * 16 + fq * 4; f32x4 g = *(const f32x4*)(gr + d);
            float o[4];
#pragma unroll
            for (int j = 0; j < 4; ++j) {
              float val = acc[m][hh * 2 + nn][j] * inv * g[j];
              float partner = __shfl_xor(val, 32);
              if (lat) {
                const float* rt = rope + ((nn == 0 ? (sp >> 6) : (sp & 63)) * 8 + ((fq * 4 + j) & 7)) * 2; const float cs = rt[0], sn = rt[1];
                val = fq < 2 ? val * cs - partner * sn : val * cs + partner * sn;
              }
              o[j] = val * QSCALE;
            }
            u32x2 v = {pk_bf16(o[0], o[1]), pk_bf16(o[2], o[3])};
            *(u32x2*)(dst + d) = v;
          }
        }
      }
    }
  }
};

struct EpiK {
  const float *rstd, *gk; bf16_t* Kt;
  DI void operator()(const f32x4 (&acc)[4][4], int r0, int c0, int fr, int fq) const {
    const int h = c0 >> 6;
#pragma unroll
    for (int m = 0; m < 4; ++m) {
      const int row = r0 + m * 16 + fr; const float rs = rstd[row];
      float ss = 0.f;
#pragma unroll
      for (int n = 0; n < 4; ++n)
#pragma unroll
        for (int j = 0; j < 4; ++j) { float v = acc[m][n][j] * rs; ss += v * v; }
      ss += __shfl_xor(ss, 16); ss += __shfl_xor(ss, 32);
      const float inv = rsqrtf(ss * (1.f / 64.f) + EPSF) * rs;
      const int b = row / TB, s = row % TB;
      bf16_t* dst = Kt + ((size_t)(b * 6 + h) * TB + s) * 96;
#pragma unroll
      for (int n = 0; n < 4; ++n) {
        const int d = n * 16 + fq * 4; f32x4 g = *(const f32x4*)(gk + d);
        u32x2 v = {pk_bf16(acc[m][n][0] * inv * g[0], acc[m][n][1] * inv * g[1]), pk_bf16(acc[m][n][2] * inv * g[2], acc[m][n][3] * inv * g[3])};
        *(u32x2*)(dst + d) = v;
      }
    }
  }
};

struct EpiV {
  const float* rstd; bf16_t* VT;
  DI void operator()(const f32x4 (&acc)[4][4], int r0, int c0, int fr, int fq) const {
#pragma unroll
    for (int m = 0; m < 4; ++m)
#pragma unroll
      for (int n = 0; n < 4; ++n) {
        const int row = r0 + m * 16 + fr, col = c0 + n * 16 + fq * 4;
        f32x4 rs = *(const f32x4*)(rstd + col);
        u32x2 v = {pk_bf16(acc[m][n][0] * rs[0], acc[m][n][1] * rs[1]), pk_bf16(acc[m][n][2] * rs[2], acc[m][n][3] * rs[3])};
        *(u32x2*)(VT + (size_t)row * T_TOK + col) = v;
      }
  }
};

struct EpiPost {
  const float *Y, *BON, *mu, *lnx_g, *lnx_b; const bf16_t* PA; bf16_t* YC;
  DI void operator()(const f32x4 (&acc)[4][4], int r0, int c0, int fr, int fq) const {
    const int h = c0 >> 6;
#pragma unroll
    for (int m = 0; m < 4; ++m) {
      const int row = r0 + m * 16 + fr; const int s = row % TB;
      const bool hasprev = (s != 0 && s != NCTX), hasnext = (s != NCTX - 1 && s != TB - 1);
      f32x4 y[4];
      float s1 = 0.f;
#pragma unroll
      for (int n = 0; n < 4; ++n) {
        const size_t o = (size_t)row * 384 + c0 + n * 16 + fq * 4;
        y[n] = *(const f32x4*)(Y + o) + *(const f32x4*)(Y + (size_t)T_TOK * 384 + o);
        s1 += y[n][0] + y[n][1] + y[n][2] + y[n][3];
      }
      s1 += __shfl_xor(s1, 16); s1 += __shfl_xor(s1, 32);
      const float mean = s1 * (1.f / 64.f);
      float s2 = 0.f;
#pragma unroll
      for (int n = 0; n < 4; ++n)
#pragma unroll
        for (int j = 0; j < 4; ++j) { float d = y[n][j] - mean; s2 += d * d; }
      s2 += __shfl_xor(s2, 16); s2 += __shfl_xor(s2, 32);
      const float rstdv = rsqrtf(s2 * (1.f / 64.f) + GN_EPS);
      const float bon = BON[(size_t)row * 6 + h] + BON[(size_t)T_TOK * 6 + (size_t)row * 6 + h];
#pragma unroll
      for (int n = 0; n < 4; ++n) {
        const int col = c0 + n * 16 + fq * 4;
        const bf16_t* pv = PA + (size_t)row * LDPA + 768 + col;
        float vc[4], vp[4] = {0.f, 0.f, 0.f, 0.f}, vn[4] = {0.f, 0.f, 0.f, 0.f};
        unpack4(*(const u32x2*)pv, vc);
        if (hasprev) unpack4(*(const u32x2*)(pv - LDPA), vp);
        if (hasnext) unpack4(*(const u32x2*)(pv + LDPA), vn);
        f32x4 m0 = *(const f32x4*)(mu + 768 + col), m1 = *(const f32x4*)(mu + LDPA + 768 + col);
        f32x4 lg = *(const f32x4*)(lnx_g + col), lb = *(const f32x4*)(lnx_b + col);
        float o[4];
#pragma unroll
        for (int j = 0; j < 4; ++j) {
          const float v = vc[j] + m0[j] * (vp[j] - vc[j]) + m1[j] * (vn[j] - vc[j]);
          o[j] = ((y[n][j] - mean) * rstdv * lg[j] + lb[j] + bon * v) * acc[m][n][j];
        }
        u32x2 w = {pk_bf16(o[0], o[1]), pk_bf16(o[2], o[3])};
        *(u32x2*)(YC + (size_t)row * DM + col) = w;
      }
    }
  }
};

struct EpiRes {
  const Params* p; int l; bool from_inputs; int gate_off;
  DI void operator()(const f32x4 (&acc)[4][4], int r0, int c0, int fr, int fq) const {
#pragma unroll
    for (int m = 0; m < 4; ++m) {
      const int row = r0 + m * 16 + fr; const int b = row / TB, s = row % TB;
      const float* src = xsrc_row(*p, from_inputs, b, s);
      float* dst = xdst_row(*p, b, s);
      const float* gate = p->MOD + (size_t)(l * 9 + (s < NCTX ? 8 : b)) * 6144 + gate_off;
#pragma unroll
      for (int n = 0; n < 4; ++n) {
        const int col = c0 + n * 16 + fq * 4;
        f32x4 g = *(const f32x4*)(gate + col), xv = *(const f32x4*)(src + col);
        *(f32x4*)(dst + col) = xv + g * acc[m][n];
      }
    }
  }
};

struct EpiFfnIn {
  bf16_t* ACT;
  DI void operator()(const f32x4 (&acc)[4][4], int r0, int c0, int fr, int fq) const {
    const int cb = (c0 >> 6) * 32;
#pragma unroll
    for (int m = 0; m < 4; ++m)
#pragma unroll
      for (int n = 0; n < 2; ++n) {
        float o[4];
#pragma unroll
        for (int j = 0; j < 4; ++j) { float g = acc[m][n][j]; o[j] = g / (1.f + __expf(-g)) * acc[m][n + 2][j]; }
        u32x2 w = {pk_bf16(o[0], o[1]), pk_bf16(o[2], o[3])};
        *(u32x2*)(ACT + (size_t)(r0 + m * 16 + fr) * 2816 + cb + n * 16 + fq * 4) = w;
      }
  }
};

DI void prep_token(const Params& p, int l, int row, int lane) {
  const int b = row / TB, s = row % TB;
  const bool hasprev = (s != 0 && s != NCTX), hasnext = (s != NCTX - 1 && s != TB - 1);
  const float mp = hasprev ? 1.f : 0.f, mn = hasnext ? 1.f : 0.f;
  const bf16_t* pa = p.PA + (size_t)row * LDPA;
  const bf16_t* pbc = p.PBC + (size_t)row * LDPBC;
  const int opa = hasprev ? -LDPA : 0, ona = hasnext ? LDPA : 0, opb = hasprev ? -LDPBC : 0, onb = hasnext ? LDPBC : 0;
  const int l32 = lane & 31, c8 = l32 * 8, colA = 1152 + c8;
  const u32x4 la_c = *(const u32x4*)(pa + colA), la_p = *(const u32x4*)(pa + opa + colA), la_n = *(const u32x4*)(pa + ona + colA);
  const u32x4 lq0 = *(const u32x4*)(pbc + lane * 8), lq1 = *(const u32x4*)(pbc + 512 + c8), lkv = *(const u32x4*)(pbc + 768 + c8);
  const u32x4 lrp = *(const u32x4*)(pbc + 1024 + (lane & 3) * 8);
  const u32x4 lbg = *(const u32x4*)(pbc + 1056 + c8), lcc = *(const u32x4*)(pbc + 1312 + c8), lhh = *(const u32x4*)(pbc + 1568 + c8);
  const u32x4 lcp = *(const u32x4*)(pbc + opb + 1312 + c8), lhp = *(const u32x4*)(pbc + opb + 1568 + c8);
  const u32x4 lcn = *(const u32x4*)(pbc + onb + 1312 + c8), lhn = *(const u32x4*)(pbc + onb + 1568 + c8);
  const float* mu = p.tshift_mu + (size_t)l * 2 * LDPA;
  {
    float c[8], pv[8], nx[8], o[8];
    unpack8(la_c, c); unpack8(la_p, pv); unpack8(la_n, nx);
    const f32x4 m0a = *(const f32x4*)(mu + colA), m0b = *(const f32x4*)(mu + colA + 4), m1a = *(const f32x4*)(mu + LDPA + colA), m1b = *(const f32x4*)(mu + LDPA + colA + 4);
#pragma unroll
    for (int j = 0; j < 8; ++j) {
      const float m0 = j < 4 ? m0a[j & 3] : m0b[j & 3], m1 = j < 4 ? m1a[j & 3] : m1b[j & 3];
      float t = c[j] + m0 * (pv[j] * mp - c[j]) + m1 * (nx[j] * mn - c[j]);
      if (l32 < 8) { float e = __expf(2.f * t); t = 1.f - 2.f * __builtin_amdgcn_rcpf(1.f + e); }
      else if (l32 >= 16) t = __builtin_amdgcn_rcpf(1.f + __expf(-t));
      o[j] = t;
    }
    u32x4 w = {pk_bf16(o[0], o[1]), pk_bf16(o[2], o[3]), pk_bf16(o[4], o[5]), pk_bf16(o[6], o[7])};
    if (lane < 8) *(u32x4*)(p.TW + (size_t)row * 64 + lane * 8) = w;
    else if (lane < 16) *(u32x4*)(p.TA + (size_t)row * 64 + (lane - 8) * 8) = w;
    else if (lane < 32) *(u32x4*)(p.TG + (size_t)row * 128 + (lane - 16) * 8) = w;
  }
  float f[8], ss = 0.f, s2 = 0.f, s3 = 0.f, fr_[8];
  unpack8(lq0, f);
#pragma unroll
  for (int j = 0; j < 8; ++j) ss += f[j] * f[j];
  unpack8(lq1, f);
  if (lane < 32) {
#pragma unroll
    for (int j = 0; j < 8; ++j) ss += f[j] * f[j];
  }
  unpack8(lkv, f);
  if (lane < 32) {
#pragma unroll
    for (int j = 0; j < 8; ++j) s2 += f[j] * f[j];
  }
  unpack8(lrp, fr_);
  if (lane < 4) {
#pragma unroll
    for (int j = 0; j < 8; ++j) s3 += fr_[j] * fr_[j];
  }
  ss = red64(ss); s2 = red64(s2);
  s3 += __shfl_xor(s3, 1); s3 += __shfl_xor(s3, 2);
  if (lane == 0) { p.RSTD[row] = rsqrtf(ss * (1.f / 768.f) + EPSF); p.RSTD[T_TOK + row] = rsqrtf(s2 * (1.f / 256.f) + EPSF); }
  {
    const float inv = rsqrtf(s3 * (1.f / 32.f) + EPSF);
    const float* g = p.k_rope_g + l * 32;
    const bool lat = s >= NCTX; const int sp = lat ? s - NCTX : 0;
    const float* rt = p.ROPE + ((lane & 2) ? (sp & 63) : (sp >> 6)) * 16;
    float o[8];
#pragma unroll
    for (int j = 0; j < 8; ++j) {
      float val = fr_[j] * inv * g[(lane & 3) * 8 + j];
      float partner = __shfl_xor(val, 1);
      if (lat) {
        const float cs = rt[2 * j], sn = rt[2 * j + 1];
        val = (lane & 1) == 0 ? val * cs - partner * sn : val * cs + partner * sn;
      }
      o[j] = val;
    }
    if (lane < 4) {
      u32x4 w = {pk_bf16(o[0], o[1]), pk_bf16(o[2], o[3]), pk_bf16(o[4], o[5]), pk_bf16(o[6], o[7])};
#pragma unroll
      for (int hh = 0; hh < 6; ++hh) *(u32x4*)(p.Kt + ((size_t)(b * 6 + hh) * TB + s) * 96 + 64 + lane * 8) = w;
    }
  }
  {
    float bg[8], cc[8], hh[8], cp[8], hp[8], cn[8], hn[8], o[8];
    unpack8(lbg, bg); unpack8(lcc, cc); unpack8(lhh, hh); unpack8(lcp, cp); unpack8(lhp, hp); unpack8(lcn, cn); unpack8(lhn, hn);
    const float* cw = p.conv_w + (size_t)l * 3 * 256;
#pragma unroll
    for (int j = 0; j < 8; ++j) o[j] = bg[j] * (cw[c8 + j] * cp[j] * hp[j] * mp + cw[256 + c8 + j] * cc[j] * hh[j] + cw[512 + c8 + j] * cn[j] * hn[j] * mn);
    u32x4 w = {pk_bf16(o[0], o[1]), pk_bf16(o[2], o[3]), pk_bf16(o[4], o[5]), pk_bf16(o[6], o[7])};
    if (lane < 32) *(u32x4*)(p.HY + (size_t)row * DM + 768 + c8) = w;
  }
}

#define MFMA32(a, b, c) __builtin_amdgcn_mfma_f32_32x32x16_bf16((a), (b), (c), 0, 0, 0)
DI bf16x8 pack8(const f32x16& x, int s) {
  u32x4 v = {pk_bf16(x[8 * s], x[8 * s + 1]), pk_bf16(x[8 * s + 2], x[8 * s + 3]), pk_bf16(x[8 * s + 4], x[8 * s + 5]), pk_bf16(x[8 * s + 6], x[8 * s + 7])};
  return __builtin_bit_cast(bf16x8, v);
}
constexpr int KROW = 208, VROW = 136, KBUF = 64 * KROW, VBUF = 64 * VROW;
DI void attn_task(const Params& p, int b, int h, int q0, int k0, int nk, char* lds) {
  const int tid = opaque_tid(), lane = tid & 63, wid = tid >> 6, r = lane & 31, hh = lane >> 5;
  const bf16_t* Qp = p.Q + ((size_t)(b * 6 + h) * TB + q0 + wid * 32 + r) * 96;
  const bf16_t* Kp = p.Kt + ((size_t)(b * 6 + h) * TB + k0) * 96;
  const bf16_t* Vp = p.VT + (size_t)(h * 64) * T_TOK + (size_t)b * TB + k0;
  bf16x8 qf[6];
#pragma unroll
  for (int ks = 0; ks < 6; ++ks) qf[ks] = *(const bf16x8*)(Qp + ks * 16 + hh * 8);
  int krow_[3], kch_[3];
#pragma unroll
  for (int i = 0; i < 3; ++i) { int id = tid + i * 256; krow_[i] = id / 12; kch_[i] = id % 12; }
  const int vd0 = tid >> 3, vch = tid & 7;
  u32x4 kreg[3], vreg[2];
  auto load_regs = [&](int kt) {
#pragma unroll
    for (int i = 0; i < 3; ++i) kreg[i] = *(const u32x4*)(Kp + (size_t)(kt * 64 + krow_[i]) * 96 + kch_[i] * 8);
#pragma unroll
    for (int i = 0; i < 2; ++i) vreg[i] = *(const u32x4*)(Vp + (size_t)(vd0 + 32 * i) * T_TOK + kt * 64 + vch * 8);
  };
  auto write_lds = [&](int buf) {
    char* kb = lds + buf * (KBUF + VBUF);
    char* vb = kb + KBUF;
#pragma unroll
    for (int i = 0; i < 3; ++i) *(u32x4*)(kb + krow_[i] * KROW + kch_[i] * 16) = kreg[i];
#pragma unroll
    for (int i = 0; i < 2; ++i) {
      char* d = vb + (vd0 + 32 * i) * VROW + vch * 16;
      *(u32x2*)d = (u32x2){vreg[i][0], vreg[i][1]};
      *(u32x2*)(d + 8) = (u32x2){vreg[i][2], vreg[i][3]};
    }
  };
  f32x16 o[2];
#pragma unroll
  for (int i = 0; i < 16; ++i) { o[0][i] = 0.f; o[1][i] = 0.f; }
  float m_run = -1e30f, l_run = 0.f;
  const int NT = nk >> 6;
  __syncthreads();
  load_regs(0);
  write_lds(0);
  for (int kt = 0; kt < NT; ++kt) {
    if (kt + 1 < NT) load_regs(kt + 1);
    __syncthreads();
    const char* kb = lds + (kt & 1) * (KBUF + VBUF);
    const char* vb = kb + KBUF;
    f32x16 st[2];
#pragma unroll
    for (int kbk = 0; kbk < 2; ++kbk) {
#pragma unroll
      for (int i = 0; i < 16; ++i) st[kbk][i] = 0.f;
#pragma unroll
      for (int ks = 0; ks < 6; ++ks) {
        bf16x8 kf = *(const bf16x8*)(kb + (kbk * 32 + r) * KROW + ks * 32 + hh * 16);
        st[kbk] = MFMA32(kf, qf[ks], st[kbk]);
      }
    }
    float mx = st[0][0];
#pragma unroll
    for (int i = 0; i < 16; ++i) { mx = fmaxf(mx, st[0][i]); mx = fmaxf(mx, st[1][i]); }
    mx = fmaxf(mx, __shfl_xor(mx, 32));
    const float m_new = fmaxf(m_run, mx);
    const float alpha = __builtin_amdgcn_exp2f(m_run - m_new);
    m_run = m_new;
    float psum = 0.f;
#pragma unroll
    for (int kbk = 0; kbk < 2; ++kbk)
#pragma unroll
      for (int i = 0; i < 16; ++i) { float e = __builtin_amdgcn_exp2f(st[kbk][i] - m_new); st[kbk][i] = e; psum += e; }
    psum += __shfl_xor(psum, 32);
    l_run = l_run * alpha + psum;
#pragma unroll
    for (int i = 0; i < 16; ++i) { o[0][i] *= alpha; o[1][i] *= alpha; }
#pragma unroll
    for (int ksv = 0; ksv < 4; ++ksv) {
      const bf16x8 pf = pack8(st[ksv >> 1], ksv & 1);
#pragma unroll
      for (int db = 0; db < 2; ++db) {
        const char* va = vb + (db * 32 + r) * VROW + (ksv * 16 + 4 * hh) * 2;
        s16x4 lo = *(const s16x4*)va, hi = *(const s16x4*)(va + 16);
        bf16x8 vf = __builtin_shufflevector(lo, hi, 0, 1, 2, 3, 4, 5, 6, 7);
        o[db] = MFMA32(vf, pf, o[db]);
      }
    }
    if (kt + 1 < NT) write_lds((kt + 1) & 1);
  }
  const float invl = 1.f / l_run;
  bf16_t* dst = p.HY + (size_t)(b * TB + q0 + wid * 32 + r) * DM + 384 + h * 64;
#pragma unroll
  for (int db = 0; db < 2; ++db)
#pragma unroll
    for (int g = 0; g < 4; ++g) {
      u32x2 w = {pk_bf16(o[db][4 * g] * invl, o[db][4 * g + 1] * invl), pk_bf16(o[db][4 * g + 2] * invl, o[db][4 * g + 3] * invl)};
      *(u32x2*)(dst + db * 32 + 8 * g + 4 * hh) = w;
    }
}

enum { VW = 0, VKK = 1, VB = 2, VKD = 3, VR = 4, VV = 5 };
DI void scan_task(const Params& p, int l, int b, int h, int dir, int half, char* lds) {
  float* cb = (float*)lds;
  float* tk = cb + 6 * 1024;
  float* ybuf = tk + 1024;
  const int tid = opaque_tid(), lane = tid & 63, wid = tid >> 6;
  const int st_p = tid >> 4, c4 = tid & 15;
  const int fr = lane & 15, fq = lane >> 4;
  const int rp = lane >> 4, g = lane & 15;
  const int hc = h * 64;
  bf16x8 bw[2], ba[2];
  {
    const bf16_t* wd = p.Wdecay + ((size_t)dir * 384 + hc + wid * 16 + fr) * 64;
    const bf16_t* wi = p.Wicl + ((size_t)dir * 384 + hc + wid * 16 + fr) * 64;
#pragma unroll
    for (int ks = 0; ks < 2; ++ks) { bw[ks] = *(const bf16x8*)(wd + ks * 32 + fq * 8); ba[ks] = *(const bf16x8*)(wi + ks * 32 + fq * 8); }
  }
  f32x4 mu0[3], mu1[3];
  const float* mu = p.tshift_mu + (size_t)l * 2 * LDPA;
#pragma unroll
  for (int sec = 0; sec < 3; ++sec) { mu0[sec] = *(const f32x4*)(mu + sec * 384 + hc + c4 * 4); mu1[sec] = *(const f32x4*)(mu + LDPA + sec * 384 + hc + c4 * 4); }
  const f32x4 kkg = *(const f32x4*)(p.k_k + l * 384 + hc + c4 * 4);
  const f32x4 rkg = *(const f32x4*)(p.r_k + l * 384 + hc + c4 * 4);
  const int colB = wid * 16 + fq * 4;
  const f32x4 w0 = *(const f32x4*)(p.decay_w0 + (size_t)(l * 2 + dir) * 384 + hc + colB);
  const f32x4 a0 = *(const f32x4*)(p.icl_a0 + (size_t)(l * 2 + dir) * 384 + hc + colB);
  const f32x4 kag = *(const f32x4*)(p.k_a + l * 384 + hc + colB);

  u32x2 ld[3][3];
  float mprev = 0.f, mnext = 0.f;
  bf16x8 aw[2], aa[2];
  auto chunk_lo = [&](int c) -> int { return dir == 0 ? 16 * c : (c < 16 ? 240 - 16 * c : 2544 - 16 * c); };
  auto issue_loads = [&](int c) {
    const int slo = chunk_lo(c);
    const int s = slo + st_p;
    const bool hasprev = (s != 0 && s != NCTX), hasnext = (s != NCTX - 1 && s != TB - 1);
    const bf16_t* pa = p.PA + (size_t)(b * TB + s) * LDPA + hc + c4 * 4;
    const int op = hasprev ? -LDPA : 0, on = hasnext ? LDPA : 0;
    mprev = hasprev ? 1.f : 0.f; mnext = hasnext ? 1.f : 0.f;
#pragma unroll
    for (int sec = 0; sec < 3; ++sec) {
      ld[sec][1] = *(const u32x2*)(pa + sec * 384);
      ld[sec][0] = *(const u32x2*)(pa + sec * 384 + op);
      ld[sec][2] = *(const u32x2*)(pa + sec * 384 + on);
    }
    const size_t trow = (size_t)(b * TB + slo + fr) * 64;
#pragma unroll
    for (int ks = 0; ks < 2; ++ks) { aw[ks] = *(const bf16x8*)(p.TW + trow + ks * 32 + fq * 8); aa[ks] = *(const bf16x8*)(p.TA + trow + ks * 32 + fq * 8); }
  };
  auto produce = [&](int c) {
    const int slo = chunk_lo(c);
    float ts[3][4];
#pragma unroll
    for (int sec = 0; sec < 3; ++sec) {
      float pc[4], pp[4], pn[4];
      unpack4(ld[sec][1], pc); unpack4(ld[sec][0], pp); unpack4(ld[sec][2], pn);
#pragma unroll
      for (int j = 0; j < 4; ++j) ts[sec][j] = pc[j] + mu0[sec][j] * (pp[j] * mprev - pc[j]) + mu1[sec][j] * (pn[j] * mnext - pc[j]);
    }
    *(f32x4*)(cb + VR * 1024 + st_p * 64 + c4 * 4) = (f32x4){ts[0][0], ts[0][1], ts[0][2], ts[0][3]};
    *(f32x4*)(cb + VV * 1024 + st_p * 64 + c4 * 4) = (f32x4){ts[2][0], ts[2][1], ts[2][2], ts[2][3]};
    *(f32x4*)(tk + st_p * 64 + c4 * 4) = (f32x4){ts[1][0], ts[1][1], ts[1][2], ts[1][3]};
    float kx[4], ss = 0.f;
#pragma unroll
    for (int j = 0; j < 4; ++j) { kx[j] = ts[1][j] * kkg[j]; ss += kx[j] * kx[j]; }
    ss = red16(ss);
    const float inv = rsqrtf(ss + 1e-12f);
    *(f32x4*)(cb + VKK * 1024 + st_p * 64 + c4 * 4) = (f32x4){kx[0] * inv, kx[1] * inv, kx[2] * inv, kx[3] * inv};
    __syncthreads();
    f32x4 dw = {0.f, 0.f, 0.f, 0.f}, da = {0.f, 0.f, 0.f, 0.f};
#pragma unroll
    for (int ks = 0; ks < 2; ++ks) {
      dw = __builtin_amdgcn_mfma_f32_16x16x32_bf16(bw[ks], aw[ks], dw, 0, 0, 0);
      da = __builtin_amdgcn_mfma_f32_16x16x32_bf16(ba[ks], aa[ks], da, 0, 0, 0);
    }
    {
      const f32x4 kv = *(const f32x4*)(tk + fr * 64 + colB);
      const f32x4 kkv = *(const f32x4*)(cb + VKK * 1024 + fr * 64 + colB);
      f32x4 wv, kdv, bv;
#pragma unroll
      for (int j = 0; j < 4; ++j) {
        wv[j] = __expf(-LOG_DECAY_SCALE * sigmoidf_(w0[j] + dw[j]));
        const float a = sigmoidf_(a0[j] + da[j]);
        kdv[j] = kv[j] * (1.f + (a - 1.f) * kag[j]);
        bv[j] = kkv[j] * a;
      }
      *(f32x4*)(cb + VW * 1024 + fr * 64 + colB) = wv;
      *(f32x4*)(cb + VKD * 1024 + fr * 64 + colB) = kdv;
      *(f32x4*)(cb + VB * 1024 + fr * 64 + colB) = bv;
    }
    __syncthreads();
    {
      const f32x4 rv = *(const f32x4*)(cb + VR * 1024 + st_p * 64 + c4 * 4);
      const f32x4 kdv = *(const f32x4*)(cb + VKD * 1024 + st_p * 64 + c4 * 4);
      float bs = rv[0] * kdv[0] * rkg[0] + rv[1] * kdv[1] * rkg[1] + rv[2] * kdv[2] * rkg[2] + rv[3] * kdv[3] * rkg[3];
      bs = red16(bs);
      if (c4 == 0 && half == 0) p.BON[(size_t)dir * T_TOK * 6 + (size_t)(b * TB + slo + st_p) * 6 + h] = bs;
    }
  };

  f32x2 S0[2], S1[2];
#pragma unroll
  for (int j = 0; j < 2; ++j) { S0[j] = (f32x2){0.f, 0.f}; S1[j] = (f32x2){0.f, 0.f}; }
  __syncthreads();
  issue_loads(0);
  produce(0);
  __syncthreads();
  const int NCH = TB / 16;
  const int rowl = half * 32 + wid * 8 + rp * 2;
  const int inc = dir ? -64 : 64;
  for (int c = 0; c < NCH; ++c) {
    if (c + 1 < NCH) issue_loads(c + 1);
    {
      const float* ps = cb + (dir ? 15 * 64 : 0) + g * 4;
      const float* pv = cb + VV * 1024 + (dir ? 15 * 64 : 0) + rowl;
      float* py = ybuf + (dir ? 15 * 512 : 0) + ((wid * 4 + rp) * 16 + g) * 2;
      f32x4 bw_[3], bkk_[3], bbb_[3], bkd_[3], brr_[3]; f32x2 bvv_[3];
#pragma unroll
      for (int q = 0; q < 2; ++q) {
        bw_[q] = *(const f32x4*)(ps + VW * 1024); bkk_[q] = *(const f32x4*)(ps + VKK * 1024); bbb_[q] = *(const f32x4*)(ps + VB * 1024);
        bkd_[q] = *(const f32x4*)(ps + VKD * 1024); brr_[q] = *(const f32x4*)(ps + VR * 1024); bvv_[q] = *(const f32x2*)pv;
        ps += inc; pv += inc;
      }
#pragma unroll
      for (int ii = 0; ii < 16; ++ii) {
        if (ii + 2 < 16) {
          const int q = (ii + 2) % 3;
          bw_[q] = *(const f32x4*)(ps + VW * 1024); bkk_[q] = *(const f32x4*)(ps + VKK * 1024); bbb_[q] = *(const f32x4*)(ps + VB * 1024);
          bkd_[q] = *(const f32x4*)(ps + VKD * 1024); brr_[q] = *(const f32x4*)(ps + VR * 1024); bvv_[q] = *(const f32x2*)pv;
          ps += inc; pv += inc;
        }
        __builtin_amdgcn_sched_barrier(0x7);
        const int cq = ii % 3;
        const f32x4 cw = bw_[cq], ckk = bkk_[cq], cbb = bbb_[cq], ckd = bkd_[cq], crr = brr_[cq]; const f32x2 cvv = bvv_[cq];
        const f32x2 kk0 = {ckk[0], ckk[1]}, kk1 = {ckk[2], ckk[3]}, w0 = {cw[0], cw[1]}, w1 = {cw[2], cw[3]};
        const f32x2 b0 = {cbb[0], cbb[1]}, b1 = {cbb[2], cbb[3]}, kd0 = {ckd[0], ckd[1]}, kd1 = {ckd[2], ckd[3]};
        const f32x2 r0 = {crr[0], crr[1]}, r1 = {crr[2], crr[3]};
        const f32x2 p0 = S0[0] * kk0 + S0[1] * kk1, p1 = S1[0] * kk0 + S1[1] * kk1;
        const f32x2 u00 = S0[0] * w0 + kd0 * cvv[0], u01 = S0[1] * w1 + kd1 * cvv[0];
        const f32x2 u10 = S1[0] * w0 + kd0 * cvv[1], u11 = S1[1] * w1 + kd1 * cvv[1];
        const float q0 = red16(p0[0] + p0[1]), q1 = red16(p1[0] + p1[1]);
        S0[0] = u00 - b0 * q0; S0[1] = u01 - b1 * q0;
        S1[0] = u10 - b0 * q1; S1[1] = u11 - b1 * q1;
        const f32x2 y0 = S0[0] * r0 + S0[1] * r1, y1 = S1[0] * r0 + S1[1] * r1;
        *(f32x2*)py = (f32x2){y0[0] + y0[1], y1[0] + y1[1]};
        py += dir ? -512 : 512;
      }
    }
    __syncthreads();
    {
      const int slo = chunk_lo(c);
      const float* yp = ybuf + (st_p * 16 + c4) * 32;
      f32x4 a = *(const f32x4*)yp;
#pragma unroll
      for (int i = 1; i < 8; ++i) a += *(const f32x4*)(yp + 4 * i);
      *(f32x2*)(p.Y + (size_t)dir * T_TOK * 384 + (size_t)(b * TB + slo + st_p) * 384 + hc + half * 32 + c4 * 2) = (f32x2){a[0] + a[2], a[1] + a[3]};
    }
    if (c + 1 < NCH) produce(c + 1);
    __syncthreads();
  }
}

DI int lat_tile(int i) { return (i >> 4) * 18 + 2 + (i & 15); }

template <int KSEL> DI void run_phase(const Params& p, int ph, char* lds) {
  const int bid = blockIdx.x, G = gridDim.x, tid = opaque_tid(), lane = tid & 63, wid = tid >> 6;
  if (ph == 0) {
    if (KSEL >= 0 && KSEL != 10) return;
    for (int t = bid; t < 384 + NCONV_W1 + 1; t += G) {
      if (t < 384) adaln_task(p, t, lds);
      else if (t < 384 + NCONV_W1) conv_w1_task(p, 0, t - 384, lds);
      else { for (int e = tid; e < 512; e += 256) { float cs, sn; rope_angle(e >> 3, e & 7, cs, sn); p.ROPE[2 * e] = cs; p.ROPE[2 * e + 1] = sn; } }
    }
    return;
  }
  if (KSEL == 10) return;
  const int l = (ph - 1) / 10, k = (ph - 1) % 10;
  const bool last = (l == 1);
  if (KSEL >= 0 && KSEL != 10 && k != (KSEL == 11 ? 4 : KSEL)) return;
  switch (k) {
    case 0:
      modnorm_rows(p, l, 0, l == 0, false, bid * 4 + wid, G * 4, lane);
      break;
    case 1: {
      EpiP e{p.PA, p.PBC};
      for (int t = bid; t < 144 * 26; t += G) gemm_tile(p.HY, DM, p.Win, DM, DM, (t / 26) * 128, (t % 26) * 128, lds, e);
    } break;
    case 2:
      for (int t = bid; t < T_TOK / 4; t += G) prep_token(p, l, t * 4 + wid, lane);
      break;
    case 3: {
      const int nq = last ? 128 * 5 : 144 * 5;
      EpiQ eq{p.RSTD, p.q_nope_g + l * 64, p.q_rope_g + l * 32, p.ROPE, p.Q};
      EpiK ek{p.RSTD + T_TOK, p.k_nope_g + l * 64, p.Kt};
      EpiV ev{p.RSTD + T_TOK, p.VT};
      for (int t = bid; t < nq + 432 + 432; t += G) {
        if (t < nq) { int i = t / 5; int tm = last ? lat_tile(i) : i; gemm_tile(p.PBC, LDPBC, p.Wuq, 768, 768, tm * 128, (t % 5) * 128, lds, eq); }
        else if (t < nq + 432) { int u = t - nq; gemm_tile(p.PBC + 768, LDPBC, p.WukvK, 256, 256, (u / 3) * 128, (u % 3) * 128, lds, ek); }
        else { int u = t - nq - 432; gemm_tile(p.WvT, 256, p.PBC + 768, LDPBC, 256, (u % 3) * 128, (u / 3) * 128, lds, ev); }
      }
    } break;
    case 4: {
      const int natt = 768 + (last ? 0 : 96);
      if (KSEL != 11) { if (bid < 192) { scan_task(p, l, bid / 24, (bid % 24) >> 2, (bid >> 1) & 1, bid & 1, lds); break; } if (KSEL == 4) break; }
      const int aoff = KSEL == 11 ? 0 : 192;
      for (int t = bid - aoff; t < natt; t += (G - aoff)) {
        if (t < 768) { int bh = t >> 4, qb = t & 15; attn_task(p, bh / 6, bh % 6, NCTX + qb * 128, 0, TB, lds); }
        else { int u = t - 768; int bh = u >> 1, qb = u & 1; attn_task(p, bh / 6, bh % 6, qb * 128, 0, NCTX, lds); }
      }
    } break;
    case 5: {
      EpiPost e{p.Y, p.BON, p.tshift_mu + (size_t)l * 2 * LDPA, p.lnx_g + l * 384, p.lnx_b + l * 384, p.PA, p.HY};
      const int nm = last ? 128 : 144;
      for (int t = bid; t < nm * 3 + NCONV_FF; t += G) {
        if (t < nm * 3) { int i = t / 3; int tm = last ? lat_tile(i) : i; gemm_tile(p.TG, 128, p.Wgate, 128, 128, tm * 128, (t % 3) * 128, lds, e); }
        else conv_ff_task(p, l, t - nm * 3, lds);
      }
    } break;
    case 6: {
      EpiRes e{&p, l, l == 0, 2 * 1024};
      const int nm = last ? 128 : 144;
      for (int t = bid; t < nm * 8; t += G) { int i = t / 8; int tm = last ? lat_tile(i) : i; gemm_tile(p.HY, DM, p.Wout, DM, DM, tm * 128, (t % 8) * 128, lds, e); }
    } break;
    case 7:
      modnorm_rows(p, l, 1, false, last, bid * 4 + wid, G * 4, lane);
      break;
    case 8: {
      EpiFfnIn e{p.ACT};
      const int nm = last ? 128 : 144;
      const int nconv = last ? 0 : NCONV_W1;
      for (int t = bid; t < nm * 44 + nconv; t += G) {
        if (t < nm * 44) { int i = t / 44; int tm = last ? lat_tile(i) : i; gemm_tile(p.HY, DM, p.Wffi, DM, DM, tm * 128, (t % 44) * 128, lds, e); }
        else conv_w1_task(p, 1, t - nm * 44, lds);
      }
    } break;
    case 9: {
      EpiRes e{&p, l, false, 5 * 1024};
      const int nm = last ? 128 : 144;
      for (int t = bid; t < nm * 8; t += G) { int i = t / 8; int tm = last ? lat_tile(i) : i; gemm_tile(p.ACT, 2816, p.Wffo, 2816, 2816, tm * 128, (t % 8) * 128, lds, e); }
    } break;
  }
}


#define XB_TMO      128
#define XB_XCNT(j)  (256  + 64 * (j))
#define XB_XSUB(j)  (1280 + 64 * (j))
#define XB_XGEN(j)  (2304 + 64 * (j))
#define XB_TOP      3328
#define XB_TOPGEN   3392
#define XCD_BAR_WORDS 3456
#define XB_SPIN_CAP (1u << 20)
DI unsigned xb_ld(unsigned* p) { return __hip_atomic_load(p, __ATOMIC_RELAXED, __HIP_MEMORY_SCOPE_AGENT); }
DI unsigned xb_add(unsigned* p, unsigned v) { return __hip_atomic_fetch_add(p, v, __ATOMIC_RELAXED, __HIP_MEMORY_SCOPE_AGENT); }
DI unsigned xb_xcc_id() { return (unsigned)__builtin_amdgcn_s_getreg((3 << 11) | 20) & 0xFu; }
#define XB_SPIN(cond, bar) do { unsigned _sp = 0; while (cond) { __builtin_amdgcn_s_sleep(1); \
    if ((++_sp & 255u) == 0u) { if (xb_ld(&(bar)[XB_TMO])) break; if (_sp > XB_SPIN_CAP) { atomicAdd(&(bar)[XB_TMO], 1u); break; } } } } while (0)
struct XcdBarrier { unsigned* bar; unsigned x; volatile LAS unsigned* st; };
DI XcdBarrier xcd_barrier_post(unsigned* bar, volatile LAS unsigned* st) {
  XcdBarrier b; b.bar = bar; b.x = xb_xcc_id(); b.st = st;
  if (threadIdx.x == 0) (void)xb_add(&bar[XB_XCNT(b.x)], 1u);
  return b;
}
DI void xcd_barrier_complete(unsigned* bar, unsigned x, unsigned& nloc, unsigned& nx) {
  const unsigned G = gridDim.x * gridDim.y * gridDim.z;
  unsigned sum, cnt, mine, sp = 0u;
  for (;;) {
    sum = 0u; cnt = 0u; mine = 0u;
#pragma unroll
    for (unsigned j = 0; j < 16; ++j) { const unsigned c = xb_ld(&bar[XB_XCNT(j)]); sum += c; cnt += (c > 0u) ? 1u : 0u; mine = (j == x) ? c : mine; }
    if (sum == G) break;
    __builtin_amdgcn_s_sleep(1);
    if ((++sp & 255u) == 0u) { if (xb_ld(&bar[XB_TMO])) break; if (sp > XB_SPIN_CAP) { atomicAdd(&bar[XB_TMO], 1u); break; } }
  }
  nloc = mine > 0u ? mine : 1u; nx = cnt > 0u ? cnt : 1u;
}
DI void xcd_barrier(const XcdBarrier& b) {
  asm volatile("s_waitcnt vmcnt(0)" ::: "memory");
  __syncthreads();
  if (threadIdx.x == 0) {
    unsigned* bar = b.bar;
    __builtin_amdgcn_s_waitcnt(0);
    unsigned nloc = b.st[0], nx = b.st[1];
    if (nloc == 0u) { xcd_barrier_complete(bar, b.x, nloc, nx); b.st[0] = nloc; b.st[1] = nx; }
    const unsigned old = xb_add(&bar[XB_XSUB(b.x)], 1u);
    const unsigned gen = old / nloc;
    if (old + 1u == (gen + 1u) * nloc) {
      __builtin_amdgcn_fence(__ATOMIC_RELEASE, "agent");
      asm volatile("s_waitcnt vmcnt(0)" ::: "memory");
      const unsigned og = xb_add(&bar[XB_TOP], 1u);
      const unsigned tg = og / nx;
      if (og + 1u == (tg + 1u) * nx) xb_add(&bar[XB_TOPGEN], 1u);
      else XB_SPIN(xb_ld(&bar[XB_TOPGEN]) == tg, bar);
      __builtin_amdgcn_fence(__ATOMIC_ACQUIRE, "agent");
      xb_add(&bar[XB_XGEN(b.x)], 1u);
      asm volatile("s_waitcnt vmcnt(0)" ::: "memory");
    } else {
      XB_SPIN(xb_ld(&bar[XB_XGEN(b.x)]) == gen, bar);
      __builtin_amdgcn_fence(__ATOMIC_ACQUIRE, "agent");
      asm volatile("s_waitcnt vmcnt(0)" ::: "memory");
    }
  }
  __syncthreads();
}

constexpr int NPHASE = 21;
#if !MULTI_LAUNCH
__global__ void __launch_bounds__(256, 2) mega(Params p, int ph_lo, int ph_hi) {
  __shared__ __attribute__((aligned(16))) char lds[65536 + 16];
  cg::grid_group grid = cg::this_grid();
  volatile LAS unsigned* st = (volatile LAS unsigned*)(lds + 65536);
  if (threadIdx.x == 0) { st[0] = 0u; st[1] = 0u; }
  if (blockIdx.x == 0) for (int i = threadIdx.x; i < XCD_BAR_WORDS; i += 256) p.BAR[i] = 0u;
  __syncthreads();
  XcdBarrier xb;
  for (int ph = ph_lo; ph < ph_hi; ++ph) {
    if (ph == ph_lo + 1) { grid.sync(); xb = xcd_barrier_post(p.BAR, st); }
    else if (ph > ph_lo + 1) xcd_barrier(xb);
    run_phase<-1>(p, ph, lds);
#ifdef DBL_MASK
    if (ph > 0 && ((DBL_MASK >> ((ph - 1) % 10)) & 1)) { xcd_barrier(xb); run_phase<-1>(p, ph, lds); }
#endif
  }
}
#endif
template <int KSEL> __global__ void __launch_bounds__(256, 2) phase_k(Params p, int ph) {
  __shared__ __attribute__((aligned(16))) char lds[65536];
  run_phase<KSEL>(p, ph, lds);
}

extern "C" void kernel_launch(void* const* d_in, const int* in_sizes, int n_in, void* d_out, int out_size, void* d_ws, size_t ws_size, hipStream_t stream) {
  static int grid_blocks = 0;
  if (!grid_blocks) {
    int dev = 0, cus = 0, per_cu = 0;
    (void)hipGetDevice(&dev);
    (void)hipDeviceGetAttribute(&cus, hipDeviceAttributeMultiprocessorCount, dev);
    #if MULTI_LAUNCH
    per_cu = 2;
#else
    (void)hipOccupancyMaxActiveBlocksPerMultiprocessor(&per_cu, mega, 256, 0);
#endif
    if (per_cu > 2) per_cu = 2;
    if (per_cu < 1) per_cu = 1;
    grid_blocks = cus * per_cu;
  }
  Params p{};
  const float** pin = (const float**)&p.x;
  for (int i = 0; i < 32; ++i) pin[i] = (const float*)d_in[i];
  p.out = (float*)d_out;
  char* w = (char*)d_ws;
  size_t off = 0;
  auto take = [&](size_t bytes) { char* r = w + off; off += (bytes + 255) & ~(size_t)255; return r; };
  p.BAR = (unsigned*)take(XCD_BAR_WORDS * 4);
  p.MOD = (float*)take(2 * 9 * 6144 * 4);
  p.ROPE = (float*)take(64 * 8 * 2 * 4);
  p.RSTD = (float*)take(2 * (size_t)T_TOK * 4);
  p.BON = (float*)take(2 * (size_t)T_TOK * 6 * 4);
  p.XCTX = (float*)take((size_t)8 * NCTX * DM * 4);
  p.Win = (bf16_t*)take((size_t)3328 * 1024 * 2);
  p.Wuq = (bf16_t*)take((size_t)640 * 768 * 2);
  p.WukvK = (bf16_t*)take((size_t)384 * 256 * 2);
  p.WvT = (bf16_t*)take((size_t)384 * 256 * 2);
  p.Wgate = (bf16_t*)take((size_t)384 * 128 * 2);
  p.Wdecay = (bf16_t*)take((size_t)2 * 384 * 64 * 2);
  p.Wicl = (bf16_t*)take((size_t)2 * 384 * 64 * 2);
  p.Wout = (bf16_t*)take((size_t)1024 * 1024 * 2);
  p.HY = (bf16_t*)take((size_t)T_TOK * DM * 2);
  p.TW = (bf16_t*)take((size_t)T_TOK * 64 * 2);
  p.TA = (bf16_t*)take((size_t)T_TOK * 64 * 2);
  p.TG = (bf16_t*)take((size_t)T_TOK * 128 * 2);
  char* qkv = take((size_t)T_TOK * 576 * 2 * 2 + (size_t)384 * T_TOK * 2);
  p.Q = (bf16_t*)qkv;
  p.Kt = (bf16_t*)(qkv + (size_t)T_TOK * 576 * 2);
  p.VT = (bf16_t*)(qkv + (size_t)T_TOK * 576 * 2 * 2);
  p.Wffi = (bf16_t*)qkv;
  p.Wffo = (bf16_t*)(qkv + (size_t)5632 * 1024 * 2);
  char* pr = take((size_t)T_TOK * (LDPA + LDPBC) * 2);
  p.PA = (bf16_t*)pr;
  p.PBC = (bf16_t*)(pr + (size_t)T_TOK * LDPA * 2);
  p.Y = (float*)p.PBC;
  p.ACT = (bf16_t*)pr;
  if (off > ws_size) { fprintf(stderr, "workspace too small: need %zu have %zu\n", off, ws_size); }
#if MULTI_LAUNCH
  hipLaunchKernelGGL(phase_k<10>, dim3(grid_blocks), dim3(256), 0, stream, p, 0);
  for (int l = 0; l < 2; ++l) {
    const int b0 = 1 + 10 * l;
    hipLaunchKernelGGL(phase_k<0>, dim3(grid_blocks), dim3(256), 0, stream, p, b0 + 0);
    hipLaunchKernelGGL(phase_k<1>, dim3(grid_blocks), dim3(256), 0, stream, p, b0 + 1);
    hipLaunchKernelGGL(phase_k<2>, dim3(grid_blocks), dim3(256), 0, stream, p, b0 + 2);
    hipLaunchKernelGGL(phase_k<3>, dim3(grid_blocks), dim3(256), 0, stream, p, b0 + 3);
    hipLaunchKernelGGL(phase_k<4>, dim3(192), dim3(256), 0, stream, p, b0 + 4);
    hipLaunchKernelGGL(phase_k<11>, dim3(grid_blocks), dim3(256), 0, stream, p, b0 + 4);
    hipLaunchKernelGGL(phase_k<5>, dim3(grid_blocks), dim3(256), 0, stream, p, b0 + 5);
    hipLaunchKernelGGL(phase_k<6>, dim3(grid_blocks), dim3(256), 0, stream, p, b0 + 6);
    hipLaunchKernelGGL(phase_k<7>, dim3(grid_blocks), dim3(256), 0, stream, p, b0 + 7);
    hipLaunchKernelGGL(phase_k<8>, dim3(grid_blocks), dim3(256), 0, stream, p, b0 + 8);
    hipLaunchKernelGGL(phase_k<9>, dim3(grid_blocks), dim3(256), 0, stream, p, b0 + 9);
  }
#else
  int lo = 0, hi = NPHASE;
  void* args[] = {&p, &lo, &hi};
  hipError_t e = hipLaunchCooperativeKernel((void*)mega, dim3(grid_blocks), dim3(256), args, 0, stream);
  if (e != hipSuccess) fprintf(stderr, "cooperative launch failed: %s (grid %d)\n", hipGetErrorString(e), grid_blocks);
#endif
}
```

```cpp
#include <hip/hip_runtime.h>
#include <hip/hip_cooperative_groups.h>
#include <cstdio>
namespace cg = cooperative_groups;

#ifndef MULTI_LAUNCH
#define MULTI_LAUNCH 0
#endif

#define DI __device__ __forceinline__
typedef unsigned short bf16_t;
typedef short bf16x8 __attribute__((ext_vector_type(8)));
typedef short s16x4 __attribute__((ext_vector_type(4)));
typedef float f32x4 __attribute__((ext_vector_type(4)));
typedef float f32x2 __attribute__((ext_vector_type(2)));
typedef float f32x16 __attribute__((ext_vector_type(16)));
typedef unsigned u32x4 __attribute__((ext_vector_type(4)));
typedef unsigned u32x2 __attribute__((ext_vector_type(2)));
#define LAS __attribute__((address_space(3)))

constexpr int T_TOK = 18432, TB = 2304, NCTX = 256, NLAT = 2048, DM = 1024;
constexpr int LDPA = 1408, LDPBC = 1920;
constexpr float EPSF = 1e-6f;
constexpr float LOG_DECAY_SCALE = 0.606531f;
constexpr float GN_EPS = 64e-5f;
constexpr float QSCALE = 0.10206207261596577f * 1.4426950408889634f;

struct Params {
  const float *x, *c, *ctx, *c_ctx, *ada_w, *ada_b, *norm1_g, *norm2_g, *w_in, *tshift_mu, *decay_w0, *decay_up,
      *icl_a0, *icl_up, *gate_up, *k_k, *k_a, *r_k, *lnx_g, *lnx_b, *q_norm_g, *kv_norm_g, *w_uq, *w_ukv, *q_nope_g,
      *k_nope_g, *q_rope_g, *k_rope_g, *conv_w, *w_out, *w_ffn_in, *w_ffn_out;
  float* out;
  float *MOD, *RSTD, *BON, *XCTX, *Y, *ROPE;
  unsigned* BAR;
  bf16_t *Win, *Wuq, *WukvK, *WvT, *Wgate, *Wdecay, *Wicl, *Wout, *Wffi, *Wffo;
  bf16_t *HY, *TW, *TA, *TG, *Q, *Kt, *VT, *PA, *PBC, *ACT;
};

typedef __bf16 bf16v2 __attribute__((ext_vector_type(2)));
DI unsigned pk_bf16(float lo, float hi) { f32x2 v = {lo, hi}; bf16v2 b = __builtin_convertvector(v, bf16v2); return __builtin_bit_cast(unsigned, b); }
DI float bflo(unsigned u) { return __uint_as_float(u << 16); }
DI float bfhi(unsigned u) { return __uint_as_float(u & 0xffff0000u); }
DI int opaque_tid() { int t = threadIdx.x; asm volatile("" : "+v"(t)); return t; }
DI float sigmoidf_(float x) { return 1.f / (1.f + __expf(-x)); }
template <int CTRL> DI float dppf(float x) { return __builtin_bit_cast(float, __builtin_amdgcn_update_dpp(0, __builtin_bit_cast(int, x), CTRL, 0xf, 0xf, true)); }
DI float red8(float x) { x += dppf<0xB1>(x); x += dppf<0x4E>(x); x += dppf<0x141>(x); return x; }
DI float red16(float x) { x = red8(x); x += dppf<0x140>(x); return x; }
DI float red64(float x) { for (int o = 32; o > 0; o >>= 1) x += __shfl_xor(x, o); return x; }

DI void unpack8(u32x4 v, float* f) {
  f[0] = bflo(v[0]); f[1] = bfhi(v[0]); f[2] = bflo(v[1]); f[3] = bfhi(v[1]);
  f[4] = bflo(v[2]); f[5] = bfhi(v[2]); f[6] = bflo(v[3]); f[7] = bfhi(v[3]);
}
DI void unpack4(u32x2 v, float* f) { f[0] = bflo(v[0]); f[1] = bfhi(v[0]); f[2] = bflo(v[1]); f[3] = bfhi(v[1]); }

DI const float* xsrc_row(const Params& p, bool from_inputs, int b, int s) {
  if (from_inputs) return s < NCTX ? p.ctx + (size_t)(b * NCTX + s) * DM : p.x + (size_t)(b * NLAT + s - NCTX) * DM;
  return s < NCTX ? p.XCTX + (size_t)(b * NCTX + s) * DM : p.out + (size_t)(b * NLAT + s - NCTX) * DM;
}
DI float* xdst_row(const Params& p, int b, int s) {
  return s < NCTX ? p.XCTX + (size_t)(b * NCTX + s) * DM : p.out + (size_t)(b * NLAT + s - NCTX) * DM;
}

DI void adaln_task(const Params& p, int task, char* lds) {
  float* s = (float*)lds;
  float* red = s + 9 * 1024;
  const int l = task / 192, cgi = task % 192, tid = opaque_tid();
  for (int i = tid; i < 9 * 1024; i += 256) {
    int r = i >> 10, k = i & 1023;
    float v = r < 8 ? p.c[r * 1024 + k] : p.c_ctx[k];
    s[i] = v / (1.f + __expf(-v));
  }
  __syncthreads();
  const int kg = tid >> 5, cc = tid & 31, col = cgi * 32 + cc;
  float acc[9];
#pragma unroll
  for (int r = 0; r < 9; ++r) acc[r] = 0.f;
  const float* w = p.ada_w + (size_t)l * 1024 * 6144 + col;
  for (int k = kg; k < 1024; k += 8) {
    float wv = w[(size_t)k * 6144];
#pragma unroll
    for (int r = 0; r < 9; ++r) acc[r] += s[r * 1024 + k] * wv;
  }
#pragma unroll
  for (int r = 0; r < 9; ++r) red[(kg * 9 + r) * 32 + cc] = acc[r];
  __syncthreads();
  for (int i = tid; i < 9 * 32; i += 256) {
    int r = i >> 5, c2 = i & 31;
    float sum = 0.f;
    for (int g = 0; g < 8; ++g) sum += red[(g * 9 + r) * 32 + c2];
    p.MOD[(size_t)(l * 9 + r) * 6144 + cgi * 32 + c2] = sum + p.ada_b[l * 6144 + cgi * 32 + c2];
  }
  __syncthreads();
}

DI int colmap(int mode, int n, int nvalid) {
  switch (mode) {
    case 0: return n < nvalid ? n : -1;
    case 1: if (n < 384) return (n >> 6) * 96 + (n & 63); if (n < 576) return ((n - 384) >> 5) * 96 + 64 + ((n - 384) & 31); return -1;
    case 2: return (n >> 6) * 128 + (n & 63);
    case 3: return (n >> 6) * 128 + 64 + (n & 63);
    default: { int t64 = n >> 6, w = n & 63; return w < 32 ? t64 * 32 + w : 2816 + t64 * 32 + (w - 32); }
  }
}
DI void conv_tile(const float* src, int ld, int K, int mode, int nvalid, const float* kscale, bf16_t* dst, int tile, int ntn, char* lds) {
  float(*tl)[65] = (float(*)[65])lds;
  const int tk = tile / ntn, tn = tile % ntn, tid = opaque_tid(), k0 = tk * 64;
  {
    const int nn = tid & 63, kk0 = tid >> 6;
    const int sc = colmap(mode, tn * 64 + nn, nvalid);
#pragma unroll 4
    for (int i = 0; i < 16; ++i) {
      const int kk = kk0 + 4 * i;
      float v = 0.f;
      if (sc >= 0) { v = src[(size_t)(k0 + kk) * ld + sc]; if (kscale) v *= kscale[k0 + kk]; }
      tl[kk][nn] = v;
    }
  }
  __syncthreads();
  {
    const int kk2 = (tid & 31) * 2, nn2 = tid >> 5;
#pragma unroll
    for (int i = 0; i < 8; ++i) {
      const int nn = nn2 + 8 * i;
      *(unsigned*)(dst + (size_t)(tn * 64 + nn) * K + k0 + kk2) = pk_bf16(tl[kk2][nn], tl[kk2 + 1][nn]);
    }
  }
  __syncthreads();
}
constexpr int NCONV_W1 = 1292, NCONV_FF = 2112;
DI void conv_w1_task(const Params& p, int l, int t, char* lds) {
  if (t < 832) { conv_tile(p.w_in + (size_t)l * 1024 * 3232, 3232, 1024, 0, 3232, nullptr, p.Win, t, 52, lds); return; } t -= 832;
  if (t < 120) { conv_tile(p.w_uq + (size_t)l * 768 * 576, 576, 768, 1, 0, p.q_norm_g + l * 768, p.Wuq, t, 10, lds); return; } t -= 120;
  if (t < 24) { conv_tile(p.w_ukv + (size_t)l * 256 * 768, 768, 256, 2, 0, p.kv_norm_g + l * 256, p.WukvK, t, 6, lds); return; } t -= 24;
  if (t < 24) { conv_tile(p.w_ukv + (size_t)l * 256 * 768, 768, 256, 3, 0, p.kv_norm_g + l * 256, p.WvT, t, 6, lds); return; } t -= 24;
  if (t < 12) { conv_tile(p.gate_up + (size_t)l * 128 * 384, 384, 128, 0, 384, nullptr, p.Wgate, t, 6, lds); return; } t -= 12;
  if (t < 12) { int d = t / 6; conv_tile(p.decay_up + (size_t)(l * 2 + d) * 64 * 384, 384, 64, 0, 384, nullptr, p.Wdecay + d * 384 * 64, t % 6, 6, lds); return; } t -= 12;
  if (t < 12) { int d = t / 6; conv_tile(p.icl_up + (size_t)(l * 2 + d) * 64 * 384, 384, 64, 0, 384, nullptr, p.Wicl + d * 384 * 64, t % 6, 6, lds); return; } t -= 12;
  conv_tile(p.w_out + (size_t)l * 1024 * 1024, 1024, 1024, 0, 1024, nullptr, p.Wout, t, 16, lds);
}
DI void conv_ff_task(const Params& p, int l, int t, char* lds) {
  if (t < 1408) { conv_tile(p.w_ffn_in + (size_t)l * 1024 * 5632, 5632, 1024, 4, 0, nullptr, p.Wffi, t, 88, lds); return; } t -= 1408;
  conv_tile(p.w_ffn_out + (size_t)l * 2816 * 1024, 1024, 2816, 0, 1024, nullptr, p.Wffo, t, 16, lds);
}

DI void modnorm_rows(const Params& p, int l, int which  , bool from_inputs, bool skip_ctx, int w0, int wstride, int lane) {
  const float* g = (which ? p.norm2_g : p.norm1_g) + l * DM;
  f32x4 gg[4];
#pragma unroll
  for (int i = 0; i < 4; ++i) gg[i] = *(const f32x4*)(g + i * 256 + lane * 4);
  const int nrows = skip_ctx ? 8 * NLAT : T_TOK;
  auto rowof = [&](int i) -> int { return skip_ctx ? (i / NLAT) * TB + NCTX + (i % NLAT) : i; };
  int i = w0;
  if (i >= nrows) return;
  f32x4 vn[4];
  {
    const int row = rowof(i); const float* src = xsrc_row(p, from_inputs, row / TB, row % TB);
#pragma unroll
    for (int q = 0; q < 4; ++q) vn[q] = *(const f32x4*)(src + q * 256 + lane * 4);
  }
  for (; i < nrows; i += wstride) {
    const int row = rowof(i); const int b = row / TB, s = row % TB;
    f32x4 v[4];
#pragma unroll
    for (int q = 0; q < 4; ++q) v[q] = vn[q];
    if (i + wstride < nrows) {
      const int rn = rowof(i + wstride); const float* src = xsrc_row(p, from_inputs, rn / TB, rn % TB);
#pragma unroll
      for (int q = 0; q < 4; ++q) vn[q] = *(const f32x4*)(src + q * 256 + lane * 4);
    }
    const float* mod = p.MOD + (size_t)(l * 9 + (s < NCTX ? 8 : b)) * 6144 + (which ? 3 * 1024 : 0);
    f32x4 sh[4], sc[4];
#pragma unroll
    for (int q = 0; q < 4; ++q) { sh[q] = *(const f32x4*)(mod + q * 256 + lane * 4); sc[q] = *(const f32x4*)(mod + 1024 + q * 256 + lane * 4); }
    float ss = 0.f;
#pragma unroll
    for (int q = 0; q < 4; ++q) ss += v[q][0] * v[q][0] + v[q][1] * v[q][1] + v[q][2] * v[q][2] + v[q][3] * v[q][3];
    ss = red64(ss);
    const float rs = rsqrtf(ss * (1.f / 1024.f) + EPSF);
    bf16_t* dst = p.HY + (size_t)row * DM;
#pragma unroll
    for (int q = 0; q < 4; ++q) {
      float o[4];
#pragma unroll
      for (int j = 0; j < 4; ++j) o[j] = (v[q][j] * rs * gg[q][j]) * (1.f + sc[q][j]) + sh[q][j];
      u32x2 w = {pk_bf16(o[0], o[1]), pk_bf16(o[2], o[3])};
      *(u32x2*)(dst + q * 256 + lane * 4) = w;
    }
  }
}

template <class Epi>
DI void gemm_tile(const bf16_t* __restrict__ A, int lda, const bf16_t* __restrict__ Bt, int ldb, int K, int row0, int col0, char* lds, const Epi& epi) {
  const int tid = opaque_tid(), lane = tid & 63, wid = tid >> 6, wr = wid >> 1, wc = wid & 1, fr = lane & 15, fq = lane >> 4;
  const bf16_t* ag[4];
  const bf16_t* bg[4];
#pragma unroll
  for (int i = 0; i < 4; ++i) {
    const int id = i * 256 + tid, r = id >> 3, cp = id & 7, c = cp ^ ((r >> 1) & 7);
    ag[i] = A + (size_t)(row0 + r) * lda + c * 8;
    bg[i] = Bt + (size_t)(col0 + r) * ldb + c * 8;
  }
  f32x4 acc[4][4];
#pragma unroll
  for (int m = 0; m < 4; ++m)
#pragma unroll
    for (int n = 0; n < 4; ++n) acc[m][n] = (f32x4){0.f, 0.f, 0.f, 0.f};
  const int KT = K >> 6;
  auto stage = [&](int kt, int buf) {
    char* sa = lds + buf * 32768;
    char* sb = sa + 16384;
#pragma unroll
    for (int i = 0; i < 4; ++i) {
      __builtin_amdgcn_global_load_lds((const void __attribute__((address_space(1)))*)(ag[i] + kt * 64), (void LAS*)(sa + (i * 256 + tid) * 16), 16, 0, 0);
      __builtin_amdgcn_global_load_lds((const void __attribute__((address_space(1)))*)(bg[i] + kt * 64), (void LAS*)(sb + (i * 256 + tid) * 16), 16, 0, 0);
    }
  };
  __syncthreads();
  stage(0, 0);
  const int swz = fr >> 1;
  for (int kt = 0; kt < KT; ++kt) {
    asm volatile("s_waitcnt vmcnt(0)" ::: "memory");
    __syncthreads();
    if (kt + 1 < KT) stage(kt + 1, (kt + 1) & 1);
    const char* sa = lds + (kt & 1) * 32768 + (wr * 64 + fr) * 128;
    const char* sb = lds + (kt & 1) * 32768 + 16384 + (wc * 64 + fr) * 128;
#pragma unroll
    for (int kk = 0; kk < 2; ++kk) {
      bf16x8 a[4], b[4];
      const int co = ((kk * 4 + fq) ^ swz) * 16;
#pragma unroll
      for (int m = 0; m < 4; ++m) a[m] = *(const bf16x8*)(sa + m * 2048 + co);
#pragma unroll
      for (int n = 0; n < 4; ++n) b[n] = *(const bf16x8*)(sb + n * 2048 + co);
#pragma unroll
      for (int m = 0; m < 4; ++m)
#pragma unroll
        for (int n = 0; n < 4; ++n) acc[m][n] = __builtin_amdgcn_mfma_f32_16x16x32_bf16(b[n], a[m], acc[m][n], 0, 0, 0);
    }
  }
  epi(acc, row0 + wr * 64, col0 + wc * 64, fr, fq);
}

struct EpiP {
  bf16_t *PA, *PBC; float* SSQ;
  DI void operator()(const f32x4 (&acc)[4][4], int r0, int c0, int fr, int fq) const {
    bf16_t* base; int ld, cb;
    if (c0 < LDPA) { base = PA; ld = LDPA; cb = c0; } else { base = PBC; ld = LDPBC; cb = c0 - LDPA; }
    if (c0 >= LDPA && cb < 1024) {
      float* dst = SSQ + (cb < 768 ? 0 : T_TOK);
#pragma unroll
      for (int m = 0; m < 4; ++m) {
        float ss = 0.f;
#pragma unroll
        for (int n = 0; n < 4; ++n)
#pragma unroll
          for (int j = 0; j < 4; ++j) ss += acc[m][n][j] * acc[m][n][j];
        ss += __shfl_xor(ss, 16); ss += __shfl_xor(ss, 32);
        if (fq == 0) atomicAdd(dst + r0 + m * 16 + fr, ss);
      }
    }
#pragma unroll
    for (int m = 0; m < 4; ++m)
#pragma unroll
      for (int n = 0; n < 4; ++n) {
        u32x2 v = {pk_bf16(acc[m][n][0], acc[m][n][1]), pk_bf16(acc[m][n][2], acc[m][n][3])};
        *(u32x2*)(base + (size_t)(r0 + m * 16 + fr) * ld + cb + n * 16 + fq * 4) = v;
      }
  }
};

DI void rope_angle(int pos, int i, float& cs, float& sn) {
  const float invf = __builtin_amdgcn_exp2f(-(float)i * (13.287712379549449f / 8.f));
  float ang = (float)pos * invf;
  float n = rintf(ang * 0.15915494309189535f);
  float r = fmaf(-n, 6.28125f, ang);
  r = fmaf(-n, 1.9353071795864769e-3f, r);
  cs = __cosf(r); sn = __sinf(r);
}

struct EpiQ {
  const float *rstd, *gn, *gr, *rope; bf16_t* Q;
  DI void operator()(const f32x4 (&acc)[4][4], int r0, int c0, int fr, int fq) const {
    if (c0 >= 576) return;
    if (c0 < 384) {
      const int h = c0 >> 6;
#pragma unroll
      for (int m = 0; m < 4; ++m) {
        const int row = r0 + m * 16 + fr; const float rs = rsqrtf(rstd[row] * (1.f / 768.f) + EPSF);
        float ss = 0.f;
#pragma unroll
        for (int n = 0; n < 4; ++n)
#pragma unroll
          for (int j = 0; j < 4; ++j) { float v = acc[m][n][j] * rs; ss += v * v; }
        ss += __shfl_xor(ss, 16); ss += __shfl_xor(ss, 32);
        const float inv = rsqrtf(ss * (1.f / 64.f) + EPSF) * rs * QSCALE;
        const int b = row / TB, s = row % TB;
        bf16_t* dst = Q + ((size_t)(b * 6 + h) * TB + s) * 96;
#pragma unroll
        for (int n = 0; n < 4; ++n) {
          const int d = n * 16 + fq * 4; f32x4 g = *(const f32x4*)(gn + d);
          u32x2 v = {pk_bf16(acc[m][n][0] * inv * g[0], acc[m][n][1] * inv * g[1]), pk_bf16(acc[m][n][2] * inv * g[2], acc[m][n][3] * inv * g[3])};
          *(u32x2*)(dst + d) = v;
        }
      }
    } else {
#pragma unroll
      for (int m = 0; m < 4; ++m) {
        const int row = r0 + m * 16 + fr; const float rs = rsqrtf(rstd[row] * (1.f / 768.f) + EPSF);
        const int b = row / TB, s = row % TB; const bool lat = s >= NCTX; const int sp = s - NCTX;
#pragma unroll
        for (int hh = 0; hh < 2; ++hh) {
          const int h = ((c0 - 384) >> 5) + hh;
          float ss = 0.f;
#pragma unroll
          for (int nn = 0; nn < 2; ++nn)
#pragma unroll
            for (int j = 0; j < 4; ++j) { float v = acc[m][hh * 2 + nn][j] * rs; ss += v * v; }
          ss += __shfl_xor(ss, 16); ss += __shfl_xor(ss, 32);
          const float inv = rsqrtf(ss * (1.f / 32.f) + EPSF) * rs;
          bf16_t* dst = Q + ((size_t)(b * 6 + h) * TB + s) * 96 + 64;
#pragma unroll
          for (int nn = 0; nn < 2; ++nn) {
            const int d = nn * 16 + fq * 4; f32x4 g = *(const f32x4*)(gr + d);
            float o[4];
#pragma unroll
            for (int j = 0; j < 4; ++j) {
              float val = acc[m][hh * 2 + nn][j] * inv * g[j];
              float partner = __shfl_xor(val, 32);
              if (lat) {
                const float* rt = rope + ((nn == 0 ? (sp >> 6) : (sp & 63)) * 8 + ((fq * 4 + j) & 7)) * 2; const float cs = rt[0], sn = rt[1];
                val = fq < 2 ? val * cs - partner * sn : val * cs + partner * sn;
              }
              o[j] = val * QSCALE;
            }
            u32x2 v = {pk_bf16(o[0], o[1]), pk_bf16(o[2], o[3])};
            *(u32x2*)(dst + d) = v;
          }
        }
      }
    }
  }
};

struct EpiK {
  const float *rstd, *gk; bf16_t* Kt;
  DI void operator()(const f32x4 (&acc)[4][4], int r0, int c0, int fr, int fq) const {
    const int h = c0 >> 6;
#pragma unroll
    for (int m = 0; m < 4; ++m) {
      const int row = r0 + m * 16 + fr; const float rs = rsqrtf(rstd[row] * (1.f / 256.f) + EPSF);
      float ss = 0.f;
#pragma unroll
      for (int n = 0; n < 4; ++n)
#pragma unroll
        for (int j = 0; j < 4; ++j) { float v = acc[m][n][j] * rs; ss += v * v; }
      ss += __shfl_xor(ss, 16); ss += __shfl_xor(ss, 32);
      const float inv = rsqrtf(ss * (1.f / 64.f) + EPSF) * rs;
      const int b = row / TB, s = row % TB;
      bf16_t* dst = Kt + ((size_t)(b * 6 + h) * TB + s) * 96;
#pragma unroll
      for (int n = 0; n < 4; ++n) {
        const int d = n * 16 + fq * 4; f32x4 g = *(const f32x4*)(gk + d);
        u32x2 v = {pk_bf16(acc[m][n][0] * inv * g[0], acc[m][n][1] * inv * g[1]), pk_bf16(acc[m][n][2] * inv * g[2], acc[m][n][3] * inv * g[3])};
        *(u32x2*)(dst + d) = v;
      }
    }
  }
};

struct EpiV {
  const float* rstd; bf16_t* VT;
  DI void operator()(const f32x4 (&acc)[4][4], int r0, int c0, int fr, int fq) const {
#pragma unroll
    for (int m = 0; m < 4; ++m)
#pragma unroll
      for (int n = 0; n < 4; ++n) {
        const int row = r0 + m * 16 + fr, col = c0 + n * 16 + fq * 4;
        f32x4 rs = *(const f32x4*)(rstd + col);
#pragma unroll
        for (int j = 0; j < 4; ++j) rs[j] = rsqrtf(rs[j] * (1.f / 256.f) + EPSF);
        u32x2 v = {pk_bf16(acc[m][n][0] * rs[0], acc[m][n][1] * rs[1]), pk_bf16(acc[m][n][2] * rs[2], acc[m][n][3] * rs[3])};
        *(u32x2*)(VT + (size_t)row * T_TOK + col) = v;
      }
  }
};

struct EpiPost {
  const float *Y, *BON, *mu, *lnx_g, *lnx_b; const bf16_t* PA; bf16_t* YC;
  DI void operator()(const f32x4 (&acc)[4][4], int r0, int c0, int fr, int fq) const {
    const int h = c0 >> 6;
#pragma unroll
    for (int m = 0; m < 4; ++m) {
      const int row = r0 + m * 16 + fr; const int s = row % TB;
      const bool hasprev = (s != 0 && s != NCTX), hasnext = (s != NCTX - 1 && s != TB - 1);
      f32x4 y[4];
      float s1 = 0.f;
#pragma unroll
      for (int n = 0; n < 4; ++n) {
        const size_t o = (size_t)row * 384 + c0 + n * 16 + fq * 4;
        y[n] = *(const f32x4*)(Y + o) + *(const f32x4*)(Y + (size_t)T_TOK * 384 + o);
        s1 += y[n][0] + y[n][1] + y[n][2] + y[n][3];
      }
      s1 += __shfl_xor(s1, 16); s1 += __shfl_xor(s1, 32);
      const float mean = s1 * (1.f / 64.f);
      float s2 = 0.f;
#pragma unroll
      for (int n = 0; n < 4; ++n)
#pragma unroll
        for (int j = 0; j < 4; ++j) { float d = y[n][j] - mean; s2 += d * d; }
      s2 += __shfl_xor(s2, 16); s2 += __shfl_xor(s2, 32);
      const float rstdv = rsqrtf(s2 * (1.f / 64.f) + GN_EPS);
      const float bon = BON[(size_t)row * 6 + h] + BON[(size_t)T_TOK * 6 + (size_t)row * 6 + h];
#pragma unroll
      for (int n = 0; n < 4; ++n) {
        const int col = c0 + n * 16 + fq * 4;
        const bf16_t* pv = PA + (size_t)row * LDPA + 768 + col;
        float vc[4], vp[4] = {0.f, 0.f, 0.f, 0.f}, vn[4] = {0.f, 0.f, 0.f, 0.f};
        unpack4(*(const u32x2*)pv, vc);
        if (hasprev) unpack4(*(const u32x2*)(pv - LDPA), vp);
        if (hasnext) unpack4(*(const u32x2*)(pv + LDPA), vn);
        f32x4 m0 = *(const f32x4*)(mu + 768 + col), m1 = *(const f32x4*)(mu + LDPA + 768 + col);
        f32x4 lg = *(const f32x4*)(lnx_g + col), lb = *(const f32x4*)(lnx_b + col);
        float o[4];
#pragma unroll
        for (int j = 0; j < 4; ++j) {
          const float v = vc[j] + m0[j] * (vp[j] - vc[j]) + m1[j] * (vn[j] - vc[j]);
          o[j] = ((y[n][j] - mean) * rstdv * lg[j] + lb[j] + bon * v) * acc[m][n][j];
        }
        u32x2 w = {pk_bf16(o[0], o[1]), pk_bf16(o[2], o[3])};
        *(u32x2*)(YC + (size_t)row * DM + col) = w;
      }
    }
  }
};

struct EpiRes {
  const Params* p; int l; bool from_inputs; int gate_off;
  DI void operator()(const f32x4 (&acc)[4][4], int r0, int c0, int fr, int fq) const {
#pragma unroll
    for (int m = 0; m < 4; ++m) {
      const int row = r0 + m * 16 + fr; const int b = row / TB, s = row % TB;
      const float* src = xsrc_row(*p, from_inputs, b, s);
      float* dst = xdst_row(*p, b, s);
      const float* gate = p->MOD + (size_t)(l * 9 + (s < NCTX ? 8 : b)) * 6144 + gate_off;
#pragma unroll
      for (int n = 0; n < 4; ++n) {
        const int col = c0 + n * 16 + fq * 4;
        f32x4 g = *(const f32x4*)(gate + col), xv = *(const f32x4*)(src + col);
        *(f32x4*)(dst + col) = xv + g * acc[m][n];
      }
    }
  }
};

struct EpiFfnIn {
  bf16_t* ACT;
  DI void operator()(const f32x4 (&acc)[4][4], int r0, int c0, int fr, int fq) const {
    const int cb = (c0 >> 6) * 32;
#pragma unroll
    for (int m = 0; m < 4; ++m)
#pragma unroll
      for (int n = 0; n < 2; ++n) {
        float o[4];
#pragma unroll
        for (int j = 0; j < 4; ++j) { float g = acc[m][n][j]; o[j] = g / (1.f + __expf(-g)) * acc[m][n + 2][j]; }
        u32x2 w = {pk_bf16(o[0], o[1]), pk_bf16(o[2], o[3])};
        *(u32x2*)(ACT + (size_t)(r0 + m * 16 + fr) * 2816 + cb + n * 16 + fq * 4) = w;
      }
  }
};

DI void prep_token(const Params& p, int l, int row, int lane) {
  const int b = row / TB, s = row % TB;
  const bool hasprev = (s != 0 && s != NCTX), hasnext = (s != NCTX - 1 && s != TB - 1);
  const float mp = hasprev ? 1.f : 0.f, mn = hasnext ? 1.f : 0.f;
  const bf16_t* pa = p.PA + (size_t)row * LDPA;
  const bf16_t* pbc = p.PBC + (size_t)row * LDPBC;
  const int opa = hasprev ? -LDPA : 0, ona = hasnext ? LDPA : 0, opb = hasprev ? -LDPBC : 0, onb = hasnext ? LDPBC : 0;
  const int l32 = lane & 31, c8 = l32 * 8, colA = 1152 + c8;
  const u32x4 la_c = *(const u32x4*)(pa + colA), la_p = *(const u32x4*)(pa + opa + colA), la_n = *(const u32x4*)(pa + ona + colA);
  const u32x4 lq0 = *(const u32x4*)(pbc + lane * 8), lq1 = *(const u32x4*)(pbc + 512 + c8), lkv = *(const u32x4*)(pbc + 768 + c8);
  const u32x4 lrp = *(const u32x4*)(pbc + 1024 + (lane & 3) * 8);
  const u32x4 lbg = *(const u32x4*)(pbc + 1056 + c8), lcc = *(const u32x4*)(pbc + 1312 + c8), lhh = *(const u32x4*)(pbc + 1568 + c8);
  const u32x4 lcp = *(const u32x4*)(pbc + opb + 1312 + c8), lhp = *(const u32x4*)(pbc + opb + 1568 + c8);
  const u32x4 lcn = *(const u32x4*)(pbc + onb + 1312 + c8), lhn = *(const u32x4*)(pbc + onb + 1568 + c8);
  const float* mu = p.tshift_mu + (size_t)l * 2 * LDPA;
  {
    float c[8], pv[8], nx[8], o[8];
    unpack8(la_c, c); unpack8(la_p, pv); unpack8(la_n, nx);
    const f32x4 m0a = *(const f32x4*)(mu + colA), m0b = *(const f32x4*)(mu + colA + 4), m1a = *(const f32x4*)(mu + LDPA + colA), m1b = *(const f32x4*)(mu + LDPA + colA + 4);
#pragma unroll
    for (int j = 0; j < 8; ++j) {
      const float m0 = j < 4 ? m0a[j & 3] : m0b[j & 3], m1 = j < 4 ? m1a[j & 3] : m1b[j & 3];
      float t = c[j] + m0 * (pv[j] * mp - c[j]) + m1 * (nx[j] * mn - c[j]);
      if (l32 < 8) { float e = __expf(2.f * t); t = 1.f - 2.f * __builtin_amdgcn_rcpf(1.f + e); }
      else if (l32 >= 16) t = __builtin_amdgcn_rcpf(1.f + __expf(-t));
      o[j] = t;
    }
    u32x4 w = {pk_bf16(o[0], o[1]), pk_bf16(o[2], o[3]), pk_bf16(o[4], o[5]), pk_bf16(o[6], o[7])};
    if (lane < 8) *(u32x4*)(p.TW + (size_t)row * 64 + lane * 8) = w;
    else if (lane < 16) *(u32x4*)(p.TA + (size_t)row * 64 + (lane - 8) * 8) = w;
    else if (lane < 32) *(u32x4*)(p.TG + (size_t)row * 128 + (lane - 16) * 8) = w;
  }
  float f[8], ss = 0.f, s2 = 0.f, s3 = 0.f, fr_[8];
  unpack8(lq0, f);
#pragma unroll
  for (int j = 0; j < 8; ++j) ss += f[j] * f[j];
  unpack8(lq1, f);
  if (lane < 32) {
#pragma unroll
    for (int j = 0; j < 8; ++j) ss += f[j] * f[j];
  }
  unpack8(lkv, f);
  if (lane < 32) {
#pragma unroll
    for (int j = 0; j < 8; ++j) s2 += f[j] * f[j];
  }
  unpack8(lrp, fr_);
  if (lane < 4) {
#pragma unroll
    for (int j = 0; j < 8; ++j) s3 += fr_[j] * fr_[j];
  }
  s3 += __shfl_xor(s3, 1); s3 += __shfl_xor(s3, 2);
  {
    const float inv = rsqrtf(s3 * (1.f / 32.f) + EPSF);
    const float* g = p.k_rope_g + l * 32;
    const bool lat = s >= NCTX; const int sp = lat ? s - NCTX : 0;
    const float* rt = p.ROPE + ((lane & 2) ? (sp & 63) : (sp >> 6)) * 16;
    float o[8];
#pragma unroll
    for (int j = 0; j < 8; ++j) {
      float val = fr_[j] * inv * g[(lane & 3) * 8 + j];
      float partner = __shfl_xor(val, 1);
      if (lat) {
        const float cs = rt[2 * j], sn = rt[2 * j + 1];
        val = (lane & 1) == 0 ? val * cs - partner * sn : val * cs + partner * sn;
      }
      o[j] = val;
    }
    if (lane < 4) {
      u32x4 w = {pk_bf16(o[0], o[1]), pk_bf16(o[2], o[3]), pk_bf16(o[4], o[5]), pk_bf16(o[6], o[7])};
#pragma unroll
      for (int hh = 0; hh < 6; ++hh) *(u32x4*)(p.Kt + ((size_t)(b * 6 + hh) * TB + s) * 96 + 64 + lane * 8) = w;
    }
  }
  {
    float bg[8], cc[8], hh[8], cp[8], hp[8], cn[8], hn[8], o[8];
    unpack8(lbg, bg); unpack8(lcc, cc); unpack8(lhh, hh); unpack8(lcp, cp); unpack8(lhp, hp); unpack8(lcn, cn); unpack8(lhn, hn);
    const float* cw = p.conv_w + (size_t)l * 3 * 256;
#pragma unroll
    for (int j = 0; j < 8; ++j) o[j] = bg[j] * (cw[c8 + j] * cp[j] * hp[j] * mp + cw[256 + c8 + j] * cc[j] * hh[j] + cw[512 + c8 + j] * cn[j] * hn[j] * mn);
    u32x4 w = {pk_bf16(o[0], o[1]), pk_bf16(o[2], o[3]), pk_bf16(o[4], o[5]), pk_bf16(o[6], o[7])};
    if (lane < 32) *(u32x4*)(p.HY + (size_t)row * DM + 768 + c8) = w;
  }
}

#define MFMA32(a, b, c) __builtin_amdgcn_mfma_f32_32x32x16_bf16((a), (b), (c), 0, 0, 0)
DI bf16x8 pack8(const f32x16& x, int s) {
  u32x4 v = {pk_bf16(x[8 * s], x[8 * s + 1]), pk_bf16(x[8 * s + 2], x[8 * s + 3]), pk_bf16(x[8 * s + 4], x[8 * s + 5]), pk_bf16(x[8 * s + 6], x[8 * s + 7])};
  return __builtin_bit_cast(bf16x8, v);
}
constexpr int KROW = 208, VROW = 136, KBUF = 64 * KROW, VBUF = 64 * VROW;
DI void attn_task(const Params& p, int b, int h, int q0, int k0, int nk, char* lds) {
  const int tid = opaque_tid(), lane = tid & 63, wid = tid >> 6, r = lane & 31, hh = lane >> 5;
  const bf16_t* Qp = p.Q + ((size_t)(b * 6 + h) * TB + q0 + wid * 32 + r) * 96;
  const bf16_t* Kp = p.Kt + ((size_t)(b * 6 + h) * TB + k0) * 96;
  const bf16_t* Vp = p.VT + (size_t)(h * 64) * T_TOK + (size_t)b * TB + k0;
  bf16x8 qf[6];
#pragma unroll
  for (int ks = 0; ks < 6; ++ks) qf[ks] = *(const bf16x8*)(Qp + ks * 16 + hh * 8);
  int krow_[3], kch_[3];
#pragma unroll
  for (int i = 0; i < 3; ++i) { int id = tid + i * 256; krow_[i] = id / 12; kch_[i] = id % 12; }
  const int vd0 = tid >> 3, vch = tid & 7;
  u32x4 kreg[3], vreg[2];
  auto load_regs = [&](int kt) {
#pragma unroll
    for (int i = 0; i < 3; ++i) kreg[i] = *(const u32x4*)(Kp + (size_t)(kt * 64 + krow_[i]) * 96 + kch_[i] * 8);
#pragma unroll
    for (int i = 0; i < 2; ++i) vreg[i] = *(const u32x4*)(Vp + (size_t)(vd0 + 32 * i) * T_TOK + kt * 64 + vch * 8);
  };
  auto write_lds = [&](int buf) {
    char* kb = lds + buf * (KBUF + VBUF);
    char* vb = kb + KBUF;
#pragma unroll
    for (int i = 0; i < 3; ++i) *(u32x4*)(kb + krow_[i] * KROW + kch_[i] * 16) = kreg[i];
#pragma unroll
    for (int i = 0; i < 2; ++i) {
      char* d = vb + (vd0 + 32 * i) * VROW + vch * 16;
      *(u32x2*)d = (u32x2){vreg[i][0], vreg[i][1]};
      *(u32x2*)(d + 8) = (u32x2){vreg[i][2], vreg[i][3]};
    }
  };
  f32x16 o[2];
#pragma unroll
  for (int i = 0; i < 16; ++i) { o[0][i] = 0.f; o[1][i] = 0.f; }
  float m_run = -1e30f, l_run = 0.f;
  const int NT = nk >> 6;
  __syncthreads();
  load_regs(0);
  write_lds(0);
  for (int kt = 0; kt < NT; ++kt) {
    if (kt + 1 < NT) load_regs(kt + 1);
    __syncthreads();
    const char* kb = lds + (kt & 1) * (KBUF + VBUF);
    const char* vb = kb + KBUF;
    f32x16 st[2];
#pragma unroll
    for (int kbk = 0; kbk < 2; ++kbk) {
#pragma unroll
      for (int i = 0; i < 16; ++i) st[kbk][i] = 0.f;
#pragma unroll
      for (int ks = 0; ks < 6; ++ks) {
        bf16x8 kf = *(const bf16x8*)(kb + (kbk * 32 + r) * KROW + ks * 32 + hh * 16);
        st[kbk] = MFMA32(kf, qf[ks], st[kbk]);
      }
    }
    float mx = st[0][0];
#pragma unroll
    for (int i = 0; i < 16; ++i) { mx = fmaxf(mx, st[0][i]); mx = fmaxf(mx, st[1][i]); }
    mx = fmaxf(mx, __shfl_xor(mx, 32));
    const float m_new = fmaxf(m_run, mx);
    const float alpha = __builtin_amdgcn_exp2f(m_run - m_new);
    m_run = m_new;
    float psum = 0.f;
#pragma unroll
    for (int kbk = 0; kbk < 2; ++kbk)
#pragma unroll
      for (int i = 0; i < 16; ++i) { float e = __builtin_amdgcn_exp2f(st[kbk][i] - m_new); st[kbk][i] = e; psum += e; }
    psum += __shfl_xor(psum, 32);
    l_run = l_run * alpha + psum;
#pragma unroll
    for (int i = 0; i < 16; ++i) { o[0][i] *= alpha; o[1][i] *= alpha; }
#pragma unroll
    for (int ksv = 0; ksv < 4; ++ksv) {
      const bf16x8 pf = pack8(st[ksv >> 1], ksv & 1);
#pragma unroll
      for (int db = 0; db < 2; ++db) {
        const char* va = vb + (db * 32 + r) * VROW + (ksv * 16 + 4 * hh) * 2;
        s16x4 lo = *(const s16x4*)va, hi = *(const s16x4*)(va + 16);
        bf16x8 vf = __builtin_shufflevector(lo, hi, 0, 1, 2, 3, 4, 5, 6, 7);
        o[db] = MFMA32(vf, pf, o[db]);
      }
    }
    if (kt + 1 < NT) write_lds((kt + 1) & 1);
  }
  const float invl = 1.f / l_run;
  bf16_t* dst = p.HY + (size_t)(b * TB + q0 + wid * 32 + r) * DM + 384 + h * 64;
#pragma unroll
  for (int db = 0; db < 2; ++db)
#pragma unroll
    for (int g = 0; g < 4; ++g) {
      u32x2 w = {pk_bf16(o[db][4 * g] * invl, o[db][4 * g + 1] * invl), pk_bf16(o[db][4 * g + 2] * invl, o[db][4 * g + 3] * invl)};
      *(u32x2*)(dst + db * 32 + 8 * g + 4 * hh) = w;
    }
}

enum { VW = 0, VKK = 1, VB = 2, VKD = 3, VR = 4, VV = 5 };
DI void scan_task(const Params& p, int l, int b, int h, int dir, int half, char* lds) {
  float* cb = (float*)lds;
  float* tk = cb + 6 * 1024;
  float* ybuf = tk + 1024;
  const int tid = opaque_tid(), lane = tid & 63, wid = tid >> 6;
  const int st_p = tid >> 4, c4 = tid & 15;
  const int fr = lane & 15, fq = lane >> 4;
  const int rp = lane >> 4, g = lane & 15;
  const int hc = h * 64;
  bf16x8 bw[2], ba[2];
  {
    const bf16_t* wd = p.Wdecay + ((size_t)dir * 384 + hc + wid * 16 + fr) * 64;
    const bf16_t* wi = p.Wicl + ((size_t)dir * 384 + hc + wid * 16 + fr) * 64;
#pragma unroll
    for (int ks = 0; ks < 2; ++ks) { bw[ks] = *(const bf16x8*)(wd + ks * 32 + fq * 8); ba[ks] = *(const bf16x8*)(wi + ks * 32 + fq * 8); }
  }
  f32x4 mu0[3], mu1[3];
  const float* mu = p.tshift_mu + (size_t)l * 2 * LDPA;
#pragma unroll
  for (int sec = 0; sec < 3; ++sec) { mu0[sec] = *(const f32x4*)(mu + sec * 384 + hc + c4 * 4); mu1[sec] = *(const f32x4*)(mu + LDPA + sec * 384 + hc + c4 * 4); }
  const f32x4 kkg = *(const f32x4*)(p.k_k + l * 384 + hc + c4 * 4);
  const f32x4 rkg = *(const f32x4*)(p.r_k + l * 384 + hc + c4 * 4);
  const int colB = wid * 16 + fq * 4;
  const f32x4 w0 = *(const f32x4*)(p.decay_w0 + (size_t)(l * 2 + dir) * 384 + hc + colB);
  const f32x4 a0 = *(const f32x4*)(p.icl_a0 + (size_t)(l * 2 + dir) * 384 + hc + colB);
  const f32x4 kag = *(const f32x4*)(p.k_a + l * 384 + hc + colB);

  u32x2 ld[3][3];
  float mprev = 0.f, mnext = 0.f;
  bf16x8 aw[2], aa[2];
  auto chunk_lo = [&](int c) -> int { return dir == 0 ? 16 * c : (c < 16 ? 240 - 16 * c : 2544 - 16 * c); };
  auto issue_loads = [&](int c) {
    const int slo = chunk_lo(c);
    const int s = slo + st_p;
    const bool hasprev = (s != 0 && s != NCTX), hasnext = (s != NCTX - 1 && s != TB - 1);
    const bf16_t* pa = p.PA + (size_t)(b * TB + s) * LDPA + hc + c4 * 4;
    const int op = hasprev ? -LDPA : 0, on = hasnext ? LDPA : 0;
    mprev = hasprev ? 1.f : 0.f; mnext = hasnext ? 1.f : 0.f;
#pragma unroll
    for (int sec = 0; sec < 3; ++sec) {
      ld[sec][1] = *(const u32x2*)(pa + sec * 384);
      ld[sec][0] = *(const u32x2*)(pa + sec * 384 + op);
      ld[sec][2] = *(const u32x2*)(pa + sec * 384 + on);
    }
    const size_t trow = (size_t)(b * TB + slo + fr) * 64;
#pragma unroll
    for (int ks = 0; ks < 2; ++ks) { aw[ks] = *(const bf16x8*)(p.TW + trow + ks * 32 + fq * 8); aa[ks] = *(const bf16x8*)(p.TA + trow + ks * 32 + fq * 8); }
  };
  auto produce = [&](int c) {
    const int slo = chunk_lo(c);
    float ts[3][4];
#pragma unroll
    for (int sec = 0; sec < 3; ++sec) {
      float pc[4], pp[4], pn[4];
      unpack4(ld[sec][1], pc); unpack4(ld[sec][0], pp); unpack4(ld[sec][2], pn);
#pragma unroll
      for (int j = 0; j < 4; ++j) ts[sec][j] = pc[j] + mu0[sec][j] * (pp[j] * mprev - pc[j]) + mu1[sec][j] * (pn[j] * mnext - pc[j]);
    }
    *(f32x4*)(cb + VR * 1024 + st_p * 64 + c4 * 4) = (f32x4){ts[0][0], ts[0][1], ts[0][2], ts[0][3]};
    *(f32x4*)(cb + VV * 1024 + st_p * 64 + c4 * 4) = (f32x4){ts[2][0], ts[2][1], ts[2][2], ts[2][3]};
    *(f32x4*)(tk + st_p * 64 + c4 * 4) = (f32x4){ts[1][0], ts[1][1], ts[1][2], ts[1][3]};
    float kx[4], ss = 0.f;
#pragma unroll
    for (int j = 0; j < 4; ++j) { kx[j] = ts[1][j] * kkg[j]; ss += kx[j] * kx[j]; }
    ss = red16(ss);
    const float inv = rsqrtf(ss + 1e-12f);
    *(f32x4*)(cb + VKK * 1024 + st_p * 64 + c4 * 4) = (f32x4){kx[0] * inv, kx[1] * inv, kx[2] * inv, kx[3] * inv};
    __syncthreads();
    f32x4 dw = {0.f, 0.f, 0.f, 0.f}, da = {0.f, 0.f, 0.f, 0.f};
#pragma unroll
    for (int ks = 0; ks < 2; ++ks) {
      dw = __builtin_amdgcn_mfma_f32_16x16x32_bf16(bw[ks], aw[ks], dw, 0, 0, 0);
      da = __builtin_amdgcn_mfma_f32_16x16x32_bf16(ba[ks], aa[ks], da, 0, 0, 0);
    }
    {
      const f32x4 kv = *(const f32x4*)(tk + fr * 64 + colB);
      const f32x4 kkv = *(const f32x4*)(cb + VKK * 1024 + fr * 64 + colB);
      f32x4 wv, kdv, bv;
#pragma unroll
      for (int j = 0; j < 4; ++j) {
        wv[j] = __expf(-LOG_DECAY_SCALE * sigmoidf_(w0[j] + dw[j]));
        const float a = sigmoidf_(a0[j] + da[j]);
        kdv[j] = kv[j] * (1.f + (a - 1.f) * kag[j]);
        bv[j] = kkv[j] * a;
      }
      *(f32x4*)(cb + VW * 1024 + fr * 64 + colB) = wv;
      *(f32x4*)(cb + VKD * 1024 + fr * 64 + colB) = kdv;
      *(f32x4*)(cb + VB * 1024 + fr * 64 + colB) = bv;
    }
    __syncthreads();
    {
      const f32x4 rv = *(const f32x4*)(cb + VR * 1024 + st_p * 64 + c4 * 4);
      const f32x4 kdv = *(const f32x4*)(cb + VKD * 1024 + st_p * 64 + c4 * 4);
      float bs = rv[0] * kdv[0] * rkg[0] + rv[1] * kdv[1] * rkg[1] + rv[2] * kdv[2] * rkg[2] + rv[3] * kdv[3] * rkg[3];
      bs = red16(bs);
      if (c4 == 0 && half == 0) p.BON[(size_t)dir * T_TOK * 6 + (size_t)(b * TB + slo + st_p) * 6 + h] = bs;
    }
  };

  f32x2 S0[2], S1[2];
#pragma unroll
  for (int j = 0; j < 2; ++j) { S0[j] = (f32x2){0.f, 0.f}; S1[j] = (f32x2){0.f, 0.f}; }
  __syncthreads();
  issue_loads(0);
  produce(0);
  __syncthreads();
  const int NCH = TB / 16;
  const int rowl = half * 32 + wid * 8 + rp * 2;
  const int inc = dir ? -64 : 64;
  for (int c = 0; c < NCH; ++c) {
    if (c + 1 < NCH) issue_loads(c + 1);
    {
      const float* ps = cb + (dir ? 15 * 64 : 0) + g * 4;
      const float* pv = cb + VV * 1024 + (dir ? 15 * 64 : 0) + rowl;
      float* py = ybuf + (dir ? 15 * 512 : 0) + ((wid * 4 + rp) * 16 + g) * 2;
      f32x4 cw = *(const f32x4*)(ps + VW * 1024), ckk = *(const f32x4*)(ps + VKK * 1024), cbb = *(const f32x4*)(ps + VB * 1024),
            ckd = *(const f32x4*)(ps + VKD * 1024), crr = *(const f32x4*)(ps + VR * 1024);
      f32x2 cvv = *(const f32x2*)pv;
#pragma unroll
      for (int ii = 0; ii < 16; ++ii) {
        f32x4 nw = cw, nkk = ckk, nbb = cbb, nkd = ckd, nrr = crr; f32x2 nvv = cvv;
        if (ii < 15) {
          ps += inc; pv += inc;
          nw = *(const f32x4*)(ps + VW * 1024); nkk = *(const f32x4*)(ps + VKK * 1024); nbb = *(const f32x4*)(ps + VB * 1024);
          nkd = *(const f32x4*)(ps + VKD * 1024); nrr = *(const f32x4*)(ps + VR * 1024); nvv = *(const f32x2*)pv;
        }
        __builtin_amdgcn_sched_barrier(0x7);
        const f32x2 kk0 = {ckk[0], ckk[1]}, kk1 = {ckk[2], ckk[3]}, w0 = {cw[0], cw[1]}, w1 = {cw[2], cw[3]};
        const f32x2 b0 = {cbb[0], cbb[1]}, b1 = {cbb[2], cbb[3]}, kd0 = {ckd[0], ckd[1]}, kd1 = {ckd[2], ckd[3]};
        const f32x2 r0 = {crr[0], crr[1]}, r1 = {crr[2], crr[3]};
        const f32x2 p0 = S0[0] * kk0 + S0[1] * kk1, p1 = S1[0] * kk0 + S1[1] * kk1;
        const f32x2 u00 = S0[0] * w0 + kd0 * cvv[0], u01 = S0[1] * w1 + kd1 * cvv[0];
        const f32x2 u10 = S1[0] * w0 + kd0 * cvv[1], u11 = S1[1] * w1 + kd1 * cvv[1];
        const float q0 = red16(p0[0] + p0[1]), q1 = red16(p1[0] + p1[1]);
        S0[0] = u00 - b0 * q0; S0[1] = u01 - b1 * q0;
        S1[0] = u10 - b0 * q1; S1[1] = u11 - b1 * q1;
        const f32x2 y0 = S0[0] * r0 + S0[1] * r1, y1 = S1[0] * r0 + S1[1] * r1;
        *(f32x2*)py = (f32x2){y0[0] + y0[1], y1[0] + y1[1]};
        py += dir ? -512 : 512;
        cw = nw; ckk = nkk; cbb = nbb; ckd = nkd; crr = nrr; cvv = nvv;
      }
    }
    __syncthreads();
    {
      const int slo = chunk_lo(c);
      const float* yp = ybuf + (st_p * 16 + c4) * 32;
      f32x4 a = *(const f32x4*)yp;
#pragma unroll
      for (int i = 1; i < 8; ++i) a += *(const f32x4*)(yp + 4 * i);
      *(f32x2*)(p.Y + (size_t)dir * T_TOK * 384 + (size_t)(b * TB + slo + st_p) * 384 + hc + half * 32 + c4 * 2) = (f32x2){a[0] + a[2], a[1] + a[3]};
    }
    if (c + 1 < NCH) produce(c + 1);
    __syncthreads();
  }
}

DI int lat_tile(int i) { return (i >> 4) * 18 + 2 + (i & 15); }

template <int KSEL> DI void run_phase(const Params& p, int ph, char* lds) {
  const int bid = blockIdx.x, G = gridDim.x, tid = opaque_tid(), lane = tid & 63, wid = tid >> 6;
  if (ph == 0) {
    if (KSEL >= 0 && KSEL != 10) return;
    for (int t = bid; t < 384 + NCONV_W1 + 1; t += G) {
      if (t < 384) adaln_task(p, t, lds);
      else if (t < 384 + NCONV_W1) conv_w1_task(p, 0, t - 384, lds);
      else { for (int e = tid; e < 512; e += 256) { float cs, sn; rope_angle(e >> 3, e & 7, cs, sn); p.ROPE[2 * e] = cs; p.ROPE[2 * e + 1] = sn; } }
    }
    return;
  }
  if (KSEL == 10) return;
  const int l = (ph - 1) / 9, kq = (ph - 1) % 9, k = kq < 2 ? kq : kq + 1;
  const bool last = (l == 1);
  const int lb = ((G & 7) == 0) ? (bid & 7) * (G >> 3) + (bid >> 3) : bid;
  if (KSEL >= 0 && KSEL != 10 && k != (KSEL == 11 ? 4 : KSEL)) return;
  switch (k) {
    case 0:
      for (int i = bid * 256 + tid; i < 2 * T_TOK; i += G * 256) p.RSTD[i] = 0.f;
      modnorm_rows(p, l, 0, l == 0, false, bid * 4 + wid, G * 4, lane);
      break;
    case 1: {
      EpiP e{p.PA, p.PBC, p.RSTD};
      for (int t = lb; t < 144 * 26; t += G) gemm_tile(p.HY, DM, p.Win, DM, DM, (t / 26) * 128, (t % 26) * 128, lds, e);
    } break;
    case 3: {
      const int nq = last ? 128 * 5 : 144 * 5;
      EpiQ eq{p.RSTD, p.q_nope_g + l * 64, p.q_rope_g + l * 32, p.ROPE, p.Q};
      EpiK ek{p.RSTD + T_TOK, p.k_nope_g + l * 64, p.Kt};
      EpiV ev{p.RSTD + T_TOK, p.VT};
      for (int t = bid; t < nq + 432 + 432 + T_TOK / 4; t += G) {
        if (t >= nq + 864) { prep_token(p, l, (t - nq - 864) * 4 + wid, lane); continue; }
        if (t < nq) { int i = t / 5; int tm = last ? lat_tile(i) : i; gemm_tile(p.PBC, LDPBC, p.Wuq, 768, 768, tm * 128, (t % 5) * 128, lds, eq); }
        else if (t < nq + 432) { int u = t - nq; gemm_tile(p.PBC + 768, LDPBC, p.WukvK, 256, 256, (u / 3) * 128, (u % 3) * 128, lds, ek); }
        else { int u = t - nq - 432; gemm_tile(p.WvT, 256, p.PBC + 768, LDPBC, 256, (u % 3) * 128, (u / 3) * 128, lds, ev); }
      }
    } break;
    case 4: {
      const int natt = 768 + (last ? 0 : 96);
      if (KSEL != 11) { if (bid < 192) { scan_task(p, l, bid / 24, (bid % 24) >> 2, (bid >> 1) & 1, bid & 1, lds); break; } if (KSEL == 4) break; }
      const int aoff = KSEL == 11 ? 0 : 192;
      for (int t = bid - aoff; t < natt + NCONV_FF; t += (G - aoff)) {
        if (t < 768) { int bh = t >> 4, qb = t & 15; attn_task(p, bh / 6, bh % 6, NCTX + qb * 128, 0, TB, lds); }
        else if (t < natt) { int u = t - 768; int bh = u >> 1, qb = u & 1; attn_task(p, bh / 6, bh % 6, qb * 128, 0, NCTX, lds); }
        else conv_ff_task(p, l, t - natt, lds);
      }
    } break;
    case 5: {
      EpiPost e{p.Y, p.BON, p.tshift_mu + (size_t)l * 2 * LDPA, p.lnx_g + l * 384, p.lnx_b + l * 384, p.PA, p.HY};
      const int nm = last ? 128 : 144;
      for (int t = bid; t < nm * 3; t += G) { int i = t / 3; int tm = last ? lat_tile(i) : i; gemm_tile(p.TG, 128, p.Wgate, 128, 128, tm * 128, (t % 3) * 128, lds, e); }
    } break;
    case 6: {
      EpiRes e{&p, l, l == 0, 2 * 1024};
      const int nm = last ? 128 : 144;
      for (int t = lb; t < nm * 8; t += G) { int i = t / 8; int tm = last ? lat_tile(i) : i; gemm_tile(p.HY, DM, p.Wout, DM, DM, tm * 128, (t % 8) * 128, lds, e); }
    } break;
    case 7:
      modnorm_rows(p, l, 1, false, last, bid * 4 + wid, G * 4, lane);
      break;
    case 8: {
      EpiFfnIn e{p.ACT};
      const int nm = last ? 128 : 144;
      const int nconv = last ? 0 : NCONV_W1;
      for (int t = lb; t < nm * 44 + nconv; t += G) {
        if (t < nm * 44) { int i = t / 44; int tm = last ? lat_tile(i) : i; gemm_tile(p.HY, DM, p.Wffi, DM, DM, tm * 128, (t % 44) * 128, lds, e); }
        else conv_w1_task(p, 1, t - nm * 44, lds);
      }
    } break;
    case 9: {
      EpiRes e{&p, l, false, 5 * 1024};
      const int nm = last ? 128 : 144;
      for (int t = lb; t < nm * 8; t += G) { int i = t / 8; int tm = last ? lat_tile(i) : i; gemm_tile(p.ACT, 2816, p.Wffo, 2816, 2816, tm * 128, (t % 8) * 128, lds, e); }
    } break;
  }
}


#define XB_TMO      128
#define XB_XCNT(j)  (256  + 64 * (j))
#define XB_XSUB(j)  (1280 + 64 * (j))
#define XB_XGEN(j)  (2304 + 64 * (j))
#define XB_TOP      3328
#define XB_TOPGEN   3392
#define XCD_BAR_WORDS 3456
#define XB_SPIN_CAP (1u << 20)
DI unsigned xb_ld(unsigned* p) { return __hip_atomic_load(p, __ATOMIC_RELAXED, __HIP_MEMORY_SCOPE_AGENT); }
DI unsigned xb_add(unsigned* p, unsigned v) { return __hip_atomic_fetch_add(p, v, __ATOMIC_RELAXED, __HIP_MEMORY_SCOPE_AGENT); }
DI unsigned xb_xcc_id() { return (unsigned)__builtin_amdgcn_s_getreg((3 << 11) | 20) & 0xFu; }
#define XB_SPIN(cond, bar) do { unsigned _sp = 0; while (cond) { __builtin_amdgcn_s_sleep(1); \
    if ((++_sp & 255u) == 0u) { if (xb_ld(&(bar)[XB_TMO])) break; if (_sp > XB_SPIN_CAP) { atomicAdd(&(bar)[XB_TMO], 1u); break; } } } } while (0)
struct XcdBarrier { unsigned* bar; unsigned x; volatile LAS unsigned* st; };
DI XcdBarrier xcd_barrier_post(unsigned* bar, volatile LAS unsigned* st) {
  XcdBarrier b; b.bar = bar; b.x = xb_xcc_id(); b.st = st;
  if (threadIdx.x == 0) (void)xb_add(&bar[XB_XCNT(b.x)], 1u);
  return b;
}
DI void xcd_barrier_complete(unsigned* bar, unsigned x, unsigned& nloc, unsigned& nx) {
  const unsigned G = gridDim.x * gridDim.y * gridDim.z;
  unsigned sum, cnt, mine, sp = 0u;
  for (;;) {
    sum = 0u; cnt = 0u; mine = 0u;
#pragma unroll
    for (unsigned j = 0; j < 16; ++j) { const unsigned c = xb_ld(&bar[XB_XCNT(j)]); sum += c; cnt += (c > 0u) ? 1u : 0u; mine = (j == x) ? c : mine; }
    if (sum == G) break;
    __builtin_amdgcn_s_sleep(1);
    if ((++sp & 255u) == 0u) { if (xb_ld(&bar[XB_TMO])) break; if (sp > XB_SPIN_CAP) { atomicAdd(&bar[XB_TMO], 1u); break; } }
  }
  nloc = mine > 0u ? mine : 1u; nx = cnt > 0u ? cnt : 1u;
}
DI void xcd_barrier(const XcdBarrier& b) {
  asm volatile("s_waitcnt vmcnt(0)" ::: "memory");
  __syncthreads();
  if (threadIdx.x == 0) {
    unsigned* bar = b.bar;
    __builtin_amdgcn_s_waitcnt(0);
    unsigned nloc = b.st[0], nx = b.st[1];
    if (nloc == 0u) { xcd_barrier_complete(bar, b.x, nloc, nx); b.st[0] = nloc; b.st[1] = nx; }
    const unsigned old = xb_add(&bar[XB_XSUB(b.x)], 1u);
    const unsigned gen = old / nloc;
    if (old + 1u == (gen + 1u) * nloc) {
      __builtin_amdgcn_fence(__ATOMIC_RELEASE, "agent");
      asm volatile("s_waitcnt vmcnt(0)" ::: "memory");
      const unsigned og = xb_add(&bar[XB_TOP], 1u);
      const unsigned tg = og / nx;
      if (og + 1u == (tg + 1u) * nx) xb_add(&bar[XB_TOPGEN], 1u);
      else XB_SPIN(xb_ld(&bar[XB_TOPGEN]) == tg, bar);
      __builtin_amdgcn_fence(__ATOMIC_ACQUIRE, "agent");
      xb_add(&bar[XB_XGEN(b.x)], 1u);
      asm volatile("s_waitcnt vmcnt(0)" ::: "memory");
    } else {
      XB_SPIN(xb_ld(&bar[XB_XGEN(b.x)]) == gen, bar);
      __builtin_amdgcn_fence(__ATOMIC_ACQUIRE, "agent");
      asm volatile("s_waitcnt vmcnt(0)" ::: "memory");
    }
  }
  __syncthreads();
}

constexpr int NPHASE = 19;
#if !MULTI_LAUNCH
__global__ void __launch_bounds__(256, 2) mega(Params p, int ph_lo, int ph_hi) {
  __shared__ __attribute__((aligned(16))) char lds[65536 + 16];
  cg::grid_group grid = cg::this_grid();
  volatile LAS unsigned* st = (volatile LAS unsigned*)(lds + 65536);
  if (threadIdx.x == 0) { st[0] = 0u; st[1] = 0u; }
  if (blockIdx.x == 0) for (int i = threadIdx.x; i < XCD_BAR_WORDS; i += 256) p.BAR[i] = 0u;
  __syncthreads();
  XcdBarrier xb;
  for (int ph = ph_lo; ph < ph_hi; ++ph) {
    if (ph == ph_lo + 1) { grid.sync(); xb = xcd_barrier_post(p.BAR, st); }
    else if (ph > ph_lo + 1) xcd_barrier(xb);
    run_phase<-1>(p, ph, lds);
  }
}
#endif
template <int KSEL> __global__ void __launch_bounds__(256, 2) phase_k(Params p, int ph) {
  __shared__ __attribute__((aligned(16))) char lds[65536];
  run_phase<KSEL>(p, ph, lds);
}

extern "C" void kernel_launch(void* const* d_in, const int* in_sizes, int n_in, void* d_out, int out_size, void* d_ws, size_t ws_size, hipStream_t stream) {
  static int grid_blocks = 0;
  if (!grid_blocks) {
    int dev = 0, cus = 0, per_cu = 0;
    (void)hipGetDevice(&dev);
    (void)hipDeviceGetAttribute(&cus, hipDeviceAttributeMultiprocessorCount, dev);
    #if MULTI_LAUNCH
    per_cu = 2;
#else
    (void)hipOccupancyMaxActiveBlocksPerMultiprocessor(&per_cu, mega, 256, 0);
#endif
    if (per_cu > 2) per_cu = 2;
    if (per_cu < 1) per_cu = 1;
    grid_blocks = cus * per_cu;
  }
  Params p{};
  const float** pin = (const float**)&p.x;
  for (int i = 0; i < 32; ++i) pin[i] = (const float*)d_in[i];
  p.out = (float*)d_out;
  char* w = (char*)d_ws;
  size_t off = 0;
  auto take = [&](size_t bytes) { char* r = w + off; off += (bytes + 255) & ~(size_t)255; return r; };
  p.BAR = (unsigned*)take(XCD_BAR_WORDS * 4);
  p.MOD = (float*)take(2 * 9 * 6144 * 4);
  p.ROPE = (float*)take(64 * 8 * 2 * 4);
  p.RSTD = (float*)take(2 * (size_t)T_TOK * 4);
  p.BON = (float*)take(2 * (size_t)T_TOK * 6 * 4);
  p.XCTX = (float*)take((size_t)8 * NCTX * DM * 4);
  p.Win = (bf16_t*)take((size_t)3328 * 1024 * 2);
  p.Wuq = (bf16_t*)take((size_t)640 * 768 * 2);
  p.WukvK = (bf16_t*)take((size_t)384 * 256 * 2);
  p.WvT = (bf16_t*)take((size_t)384 * 256 * 2);
  p.Wgate = (bf16_t*)take((size_t)384 * 128 * 2);
  p.Wdecay = (bf16_t*)take((size_t)2 * 384 * 64 * 2);
  p.Wicl = (bf16_t*)take((size_t)2 * 384 * 64 * 2);
  p.Wout = (bf16_t*)take((size_t)1024 * 1024 * 2);
  p.HY = (bf16_t*)take((size_t)T_TOK * DM * 2);
  p.TW = (bf16_t*)take((size_t)T_TOK * 64 * 2);
  p.TA = (bf16_t*)take((size_t)T_TOK * 64 * 2);
  p.TG = (bf16_t*)take((size_t)T_TOK * 128 * 2);
  char* qkv = take((size_t)T_TOK * 576 * 2 * 2 + (size_t)384 * T_TOK * 2);
  p.Q = (bf16_t*)qkv;
  p.Kt = (bf16_t*)(qkv + (size_t)T_TOK * 576 * 2);
  p.VT = (bf16_t*)(qkv + (size_t)T_TOK * 576 * 2 * 2);
  p.Wffi = (bf16_t*)take((size_t)5632 * 1024 * 2);
  p.Wffo = (bf16_t*)take((size_t)2816 * 1024 * 2);
  char* pr = take((size_t)T_TOK * (LDPA + LDPBC) * 2);
  p.PA = (bf16_t*)pr;
  p.PBC = (bf16_t*)(pr + (size_t)T_TOK * LDPA * 2);
  p.Y = (float*)p.PBC;
  p.ACT = (bf16_t*)pr;
  if (off > ws_size) { fprintf(stderr, "workspace too small: need %zu have %zu\n", off, ws_size); }
#if MULTI_LAUNCH
  hipLaunchKernelGGL(phase_k<10>, dim3(grid_blocks), dim3(256), 0, stream, p, 0);
  for (int l = 0; l < 2; ++l) {
    const int b0 = 1 + 10 * l;
    hipLaunchKernelGGL(phase_k<0>, dim3(grid_blocks), dim3(256), 0, stream, p, b0 + 0);
    hipLaunchKernelGGL(phase_k<1>, dim3(grid_blocks), dim3(256), 0, stream, p, b0 + 1);
    hipLaunchKernelGGL(phase_k<2>, dim3(grid_blocks), dim3(256), 0, stream, p, b0 + 2);
    hipLaunchKernelGGL(phase_k<3>, dim3(grid_blocks), dim3(256), 0, stream, p, b0 + 3);
    hipLaunchKernelGGL(phase_k<4>, dim3(192), dim3(256), 0, stream, p, b0 + 4);
    hipLaunchKernelGGL(phase_k<11>, dim3(grid_blocks), dim3(256), 0, stream, p, b0 + 4);
    hipLaunchKernelGGL(phase_k<5>, dim3(grid_blocks), dim3(256), 0, stream, p, b0 + 5);
    hipLaunchKernelGGL(phase_k<6>, dim3(grid_blocks), dim3(256), 0, stream, p, b0 + 6);
    hipLaunchKernelGGL(phase_k<7>, dim3(grid_blocks), dim3(256), 0, stream, p, b0 + 7);
    hipLaunchKernelGGL(phase_k<8>, dim3(grid_blocks), dim3(256), 0, stream, p, b0 + 8);
    hipLaunchKernelGGL(phase_k<9>, dim3(grid_blocks), dim3(256), 0, stream, p, b0 + 9);
  }
#else
  int lo = 0, hi = NPHASE;
  void* args[] = {&p, &lo, &hi};
  hipError_t e = hipLaunchCooperativeKernel((void*)mega, dim3(grid_blocks), dim3(256), args, 0, stream);
  if (e != hipSuccess) fprintf(stderr, "cooperative launch failed: %s (grid %d)\n", hipGetErrorString(e), grid_blocks);
#endif
}
```

```cpp
#include <hip/hip_runtime.h>
#include <hip/hip_cooperative_groups.h>
#include <cstdio>
namespace cg = cooperative_groups;

#ifndef MULTI_LAUNCH
#define MULTI_LAUNCH 0
#endif

#define DI __device__ __forceinline__
typedef unsigned short bf16_t;
typedef short bf16x8 __attribute__((ext_vector_type(8)));
typedef short s16x4 __attribute__((ext_vector_type(4)));
typedef float f32x4 __attribute__((ext_vector_type(4)));
typedef float f32x2 __attribute__((ext_vector_type(2)));
typedef float f32x16 __attribute__((ext_vector_type(16)));
typedef unsigned u32x4 __attribute__((ext_vector_type(4)));
typedef unsigned u32x2 __attribute__((ext_vector_type(2)));
#define LAS __attribute__((address_space(3)))

constexpr int T_TOK = 18432, TB = 2304, NCTX = 256, NLAT = 2048, DM = 1024;
constexpr int LDPA = 1408, LDPBC = 1920;
constexpr float EPSF = 1e-6f;
constexpr float LOG_DECAY_SCALE = 0.606531f;
constexpr float GN_EPS = 64e-5f;
constexpr float QSCALE = 0.10206207261596577f * 1.4426950408889634f;

struct Params {
  const float *x, *c, *ctx, *c_ctx, *ada_w, *ada_b, *norm1_g, *norm2_g, *w_in, *tshift_mu, *decay_w0, *decay_up,
      *icl_a0, *icl_up, *gate_up, *k_k, *k_a, *r_k, *lnx_g, *lnx_b, *q_norm_g, *kv_norm_g, *w_uq, *w_ukv, *q_nope_g,
      *k_nope_g, *q_rope_g, *k_rope_g, *conv_w, *w_out, *w_ffn_in, *w_ffn_out;
  float* out;
  float *MOD, *RSTD, *BON, *XCTX, *Y, *ROPE;
  unsigned* BAR;
  bf16_t *Win, *Wuq, *WukvK, *WvT, *Wgate, *Wdecay, *Wicl, *Wout, *Wffi, *Wffo;
  bf16_t *HY, *TW, *TA, *TG, *Q, *Kt, *VT, *PA, *PBC, *ACT;
};

typedef __bf16 bf16v2 __attribute__((ext_vector_type(2)));
DI unsigned pk_bf16(float lo, float hi) { f32x2 v = {lo, hi}; bf16v2 b = __builtin_convertvector(v, bf16v2); return __builtin_bit_cast(unsigned, b); }
DI float bflo(unsigned u) { return __uint_as_float(u << 16); }
DI float bfhi(unsigned u) { return __uint_as_float(u & 0xffff0000u); }
DI int opaque_tid() { int t = threadIdx.x; asm volatile("" : "+v"(t)); return t; }
DI float sigmoidf_(float x) { return 1.f / (1.f + __expf(-x)); }
template <int CTRL> DI float dppf(float x) { return __builtin_bit_cast(float, __builtin_amdgcn_update_dpp(0, __builtin_bit_cast(int, x), CTRL, 0xf, 0xf, true)); }
DI float red8(float x) { x += dppf<0xB1>(x); x += dppf<0x4E>(x); x += dppf<0x141>(x); return x; }
DI float red16(float x) { x = red8(x); x += dppf<0x140>(x); return x; }
DI float red64(float x) { for (int o = 32; o > 0; o >>= 1) x += __shfl_xor(x, o); return x; }

DI void unpack8(u32x4 v, float* f) {
  f[0] = bflo(v[0]); f[1] = bfhi(v[0]); f[2] = bflo(v[1]); f[3] = bfhi(v[1]);
  f[4] = bflo(v[2]); f[5] = bfhi(v[2]); f[6] = bflo(v[3]); f[7] = bfhi(v[3]);
}
DI void unpack4(u32x2 v, float* f) { f[0] = bflo(v[0]); f[1] = bfhi(v[0]); f[2] = bflo(v[1]); f[3] = bfhi(v[1]); }

DI const float* xsrc_row(const Params& p, bool from_inputs, int b, int s) {
  if (from_inputs) return s < NCTX ? p.ctx + (size_t)(b * NCTX + s) * DM : p.x + (size_t)(b * NLAT + s - NCTX) * DM;
  return s < NCTX ? p.XCTX + (size_t)(b * NCTX + s) * DM : p.out + (size_t)(b * NLAT + s - NCTX) * DM;
}
DI float* xdst_row(const Params& p, int b, int s) {
  return s < NCTX ? p.XCTX + (size_t)(b * NCTX + s) * DM : p.out + (size_t)(b * NLAT + s - NCTX) * DM;
}

DI void adaln_task(const Params& p, int task, char* lds) {
  float* s = (float*)lds;
  float* red = s + 9 * 1024;
  const int l = task / 192, cgi = task % 192, tid = opaque_tid();
  for (int i = tid; i < 9 * 1024; i += 256) {
    int r = i >> 10, k = i & 1023;
    float v = r < 8 ? p.c[r * 1024 + k] : p.c_ctx[k];
    s[i] = v / (1.f + __expf(-v));
  }
  __syncthreads();
  const int kg = tid >> 5, cc = tid & 31, col = cgi * 32 + cc;
  float acc[9];
#pragma unroll
  for (int r = 0; r < 9; ++r) acc[r] = 0.f;
  const float* w = p.ada_w + (size_t)l * 1024 * 6144 + col;
  for (int k0 = kg; k0 < 1024; k0 += 128) {
    float wv[16];
#pragma unroll
    for (int u = 0; u < 16; ++u) wv[u] = w[(size_t)(k0 + 8 * u) * 6144];
#pragma unroll
    for (int u = 0; u < 16; ++u)
#pragma unroll
      for (int r = 0; r < 9; ++r) acc[r] += s[r * 1024 + k0 + 8 * u] * wv[u];
  }
#pragma unroll
  for (int r = 0; r < 9; ++r) red[(kg * 9 + r) * 32 + cc] = acc[r];
  __syncthreads();
  for (int i = tid; i < 9 * 32; i += 256) {
    int r = i >> 5, c2 = i & 31;
    float sum = 0.f;
    for (int g = 0; g < 8; ++g) sum += red[(g * 9 + r) * 32 + c2];
    p.MOD[(size_t)(l * 9 + r) * 6144 + cgi * 32 + c2] = sum + p.ada_b[l * 6144 + cgi * 32 + c2];
  }
  __syncthreads();
}

DI int colmap(int mode, int n, int nvalid) {
  switch (mode) {
    case 0: return n < nvalid ? n : -1;
    case 1: if (n < 384) return (n >> 6) * 96 + (n & 63); if (n < 576) return ((n - 384) >> 5) * 96 + 64 + ((n - 384) & 31); return -1;
    case 2: return (n >> 6) * 128 + (n & 63);
    case 3: return (n >> 6) * 128 + 64 + (n & 63);
    default: { int t64 = n >> 6, w = n & 63; return w < 32 ? t64 * 32 + w : 2816 + t64 * 32 + (w - 32); }
  }
}
DI void conv_tile(const float* src, int ld, int K, int mode, int nvalid, const float* kscale, bf16_t* dst, int tile, int ntn, char* lds) {
  float(*tl)[65] = (float(*)[65])lds;
  const int tk = tile / ntn, tn = tile % ntn, tid = opaque_tid(), k0 = tk * 64;
  {
    const int nn = tid & 63, kk0 = tid >> 6;
    const int sc = colmap(mode, tn * 64 + nn, nvalid);
#pragma unroll 4
    for (int i = 0; i < 16; ++i) {
      const int kk = kk0 + 4 * i;
      float v = 0.f;
      if (sc >= 0) { v = src[(size_t)(k0 + kk) * ld + sc]; if (kscale) v *= kscale[k0 + kk]; }
      tl[kk][nn] = v;
    }
  }
  __syncthreads();
  {
    const int kk2 = (tid & 31) * 2, nn2 = tid >> 5;
#pragma unroll
    for (int i = 0; i < 8; ++i) {
      const int nn = nn2 + 8 * i;
      *(unsigned*)(dst + (size_t)(tn * 64 + nn) * K + k0 + kk2) = pk_bf16(tl[kk2][nn], tl[kk2 + 1][nn]);
    }
  }
  __syncthreads();
}
constexpr int NCONV_W1 = 1292, NCONV_FF = 2112;
DI void conv_w1_task(const Params& p, int l, int t, char* lds) {
  if (t < 832) { conv_tile(p.w_in + (size_t)l * 1024 * 3232, 3232, 1024, 0, 3232, nullptr, p.Win, t, 52, lds); return; } t -= 832;
  if (t < 120) { conv_tile(p.w_uq + (size_t)l * 768 * 576, 576, 768, 1, 0, p.q_norm_g + l * 768, p.Wuq, t, 10, lds); return; } t -= 120;
  if (t < 24) { conv_tile(p.w_ukv + (size_t)l * 256 * 768, 768, 256, 2, 0, p.kv_norm_g + l * 256, p.WukvK, t, 6, lds); return; } t -= 24;
  if (t < 24) { conv_tile(p.w_ukv + (size_t)l * 256 * 768, 768, 256, 3, 0, p.kv_norm_g + l * 256, p.WvT, t, 6, lds); return; } t -= 24;
  if (t < 12) { conv_tile(p.gate_up + (size_t)l * 128 * 384, 384, 128, 0, 384, nullptr, p.Wgate, t, 6, lds); return; } t -= 12;
  if (t < 12) { int d = t / 6; conv_tile(p.decay_up + (size_t)(l * 2 + d) * 64 * 384, 384, 64, 0, 384, nullptr, p.Wdecay + d * 384 * 64, t % 6, 6, lds); return; } t -= 12;
  if (t < 12) { int d = t / 6; conv_tile(p.icl_up + (size_t)(l * 2 + d) * 64 * 384, 384, 64, 0, 384, nullptr, p.Wicl + d * 384 * 64, t % 6, 6, lds); return; } t -= 12;
  conv_tile(p.w_out + (size_t)l * 1024 * 1024, 1024, 1024, 0, 1024, nullptr, p.Wout, t, 16, lds);
}
DI void conv_ff_task(const Params& p, int l, int t, char* lds) {
  if (t < 1408) { conv_tile(p.w_ffn_in + (size_t)l * 1024 * 5632, 5632, 1024, 4, 0, nullptr, p.Wffi, t, 88, lds); return; } t -= 1408;
  conv_tile(p.w_ffn_out + (size_t)l * 2816 * 1024, 1024, 2816, 0, 1024, nullptr, p.Wffo, t, 16, lds);
}

DI void modnorm_rows(const Params& p, int l, int which  , bool from_inputs, bool skip_ctx, int w0, int wstride, int lane) {
  const float* g = (which ? p.norm2_g : p.norm1_g) + l * DM;
  f32x4 gg[4];
#pragma unroll
  for (int i = 0; i < 4; ++i) gg[i] = *(const f32x4*)(g + i * 256 + lane * 4);
  const int nrows = skip_ctx ? 8 * NLAT : T_TOK;
  auto rowof = [&](int i) -> int { return skip_ctx ? (i / NLAT) * TB + NCTX + (i % NLAT) : i; };
  int i = w0;
  if (i >= nrows) return;
  f32x4 vn[4];
  {
    const int row = rowof(i); const float* src = xsrc_row(p, from_inputs, row / TB, row % TB);
#pragma unroll
    for (int q = 0; q < 4; ++q) vn[q] = *(const f32x4*)(src + q * 256 + lane * 4);
  }
  for (; i < nrows; i += wstride) {
    const int row = rowof(i); const int b = row / TB, s = row % TB;
    f32x4 v[4];
#pragma unroll
    for (int q = 0; q < 4; ++q) v[q] = vn[q];
    if (i + wstride < nrows) {
      const int rn = rowof(i + wstride); const float* src = xsrc_row(p, from_inputs, rn / TB, rn % TB);
#pragma unroll
      for (int q = 0; q < 4; ++q) vn[q] = *(const f32x4*)(src + q * 256 + lane * 4);
    }
    const float* mod = p.MOD + (size_t)(l * 9 + (s < NCTX ? 8 : b)) * 6144 + (which ? 3 * 1024 : 0);
    f32x4 sh[4], sc[4];
#pragma unroll
    for (int q = 0; q < 4; ++q) { sh[q] = *(const f32x4*)(mod + q * 256 + lane * 4); sc[q] = *(const f32x4*)(mod + 1024 + q * 256 + lane * 4); }
    float ss = 0.f;
#pragma unroll
    for (int q = 0; q < 4; ++q) ss += v[q][0] * v[q][0] + v[q][1] * v[q][1] + v[q][2] * v[q][2] + v[q][3] * v[q][3];
    ss = red64(ss);
    const float rs = rsqrtf(ss * (1.f / 1024.f) + EPSF);
    bf16_t* dst = p.HY + (size_t)row * DM;
#pragma unroll
    for (int q = 0; q < 4; ++q) {
      float o[4];
#pragma unroll
      for (int j = 0; j < 4; ++j) o[j] = (v[q][j] * rs * gg[q][j]) * (1.f + sc[q][j]) + sh[q][j];
      u32x2 w = {pk_bf16(o[0], o[1]), pk_bf16(o[2], o[3])};
      *(u32x2*)(dst + q * 256 + lane * 4) = w;
    }
  }
}

template <class Epi>
DI void gemm_tile(const bf16_t* __restrict__ A, int lda, const bf16_t* __restrict__ Bt, int ldb, int K, int row0, int col0, char* lds, const Epi& epi) {
  const int tid = opaque_tid(), lane = tid & 63, wid = tid >> 6, wr = wid >> 1, wc = wid & 1, fr = lane & 15, fq = lane >> 4;
  const bf16_t* ag[4];
  const bf16_t* bg[4];
#pragma unroll
  for (int i = 0; i < 4; ++i) {
    const int id = i * 256 + tid, r = id >> 3, cp = id & 7, c = cp ^ ((r >> 1) & 7);
    ag[i] = A + (size_t)(row0 + r) * lda + c * 8;
    bg[i] = Bt + (size_t)(col0 + r) * ldb + c * 8;
  }
  f32x4 acc[4][4];
#pragma unroll
  for (int m = 0; m < 4; ++m)
#pragma unroll
    for (int n = 0; n < 4; ++n) acc[m][n] = (f32x4){0.f, 0.f, 0.f, 0.f};
  const int KT = K >> 6;
  auto stage = [&](int kt, int buf) {
    char* sa = lds + buf * 32768;
    char* sb = sa + 16384;
#pragma unroll
    for (int i = 0; i < 4; ++i) {
      __builtin_amdgcn_global_load_lds((const void __attribute__((address_space(1)))*)(ag[i] + kt * 64), (void LAS*)(sa + (i * 256 + tid) * 16), 16, 0, 0);
      __builtin_amdgcn_global_load_lds((const void __attribute__((address_space(1)))*)(bg[i] + kt * 64), (void LAS*)(sb + (i * 256 + tid) * 16), 16, 0, 0);
    }
  };
  __syncthreads();
  stage(0, 0);
  const int swz = fr >> 1;
  for (int kt = 0; kt < KT; ++kt) {
    asm volatile("s_waitcnt vmcnt(0)" ::: "memory");
    __syncthreads();
    if (kt + 1 < KT) stage(kt + 1, (kt + 1) & 1);
    const char* sa = lds + (kt & 1) * 32768 + (wr * 64 + fr) * 128;
    const char* sb = lds + (kt & 1) * 32768 + 16384 + (wc * 64 + fr) * 128;
#pragma unroll
    for (int kk = 0; kk < 2; ++kk) {
      bf16x8 a[4], b[4];
      const int co = ((kk * 4 + fq) ^ swz) * 16;
#pragma unroll
      for (int m = 0; m < 4; ++m) a[m] = *(const bf16x8*)(sa + m * 2048 + co);
#pragma unroll
      for (int n = 0; n < 4; ++n) b[n] = *(const bf16x8*)(sb + n * 2048 + co);
#pragma unroll
      for (int m = 0; m < 4; ++m)
#pragma unroll
        for (int n = 0; n < 4; ++n) acc[m][n] = __builtin_amdgcn_mfma_f32_16x16x32_bf16(b[n], a[m], acc[m][n], 0, 0, 0);
    }
  }
  epi(acc, row0 + wr * 64, col0 + wc * 64, fr, fq);
}

struct EpiP {
  bf16_t *PA, *PBC; float* SSQ;
  DI void operator()(const f32x4 (&acc)[4][4], int r0, int c0, int fr, int fq) const {
    bf16_t* base; int ld, cb;
    if (c0 < LDPA) { base = PA; ld = LDPA; cb = c0; } else { base = PBC; ld = LDPBC; cb = c0 - LDPA; }
    if (c0 >= LDPA && cb < 1024) {
      float* dst = SSQ + (cb < 768 ? 0 : T_TOK);
#pragma unroll
      for (int m = 0; m < 4; ++m) {
        float ss = 0.f;
#pragma unroll
        for (int n = 0; n < 4; ++n)
#pragma unroll
          for (int j = 0; j < 4; ++j) ss += acc[m][n][j] * acc[m][n][j];
        ss += __shfl_xor(ss, 16); ss += __shfl_xor(ss, 32);
        if (fq == 0) atomicAdd(dst + r0 + m * 16 + fr, ss);
      }
    }
#pragma unroll
    for (int m = 0; m < 4; ++m)
#pragma unroll
      for (int n = 0; n < 4; ++n) {
        u32x2 v = {pk_bf16(acc[m][n][0], acc[m][n][1]), pk_bf16(acc[m][n][2], acc[m][n][3])};
        *(u32x2*)(base + (size_t)(r0 + m * 16 + fr) * ld + cb + n * 16 + fq * 4) = v;
      }
  }
};

DI void rope_angle(int pos, int i, float& cs, float& sn) {
  const float invf = __builtin_amdgcn_exp2f(-(float)i * (13.287712379549449f / 8.f));
  float ang = (float)pos * invf;
  float n = rintf(ang * 0.15915494309189535f);
  float r = fmaf(-n, 6.28125f, ang);
  r = fmaf(-n, 1.9353071795864769e-3f, r);
  cs = __cosf(r); sn = __sinf(r);
}

struct EpiQ {
  const float *rstd, *gn, *gr, *rope; bf16_t* Q;
  DI void operator()(const f32x4 (&acc)[4][4], int r0, int c0, int fr, int fq) const {
    if (c0 >= 576) return;
    if (c0 < 384) {
      const int h = c0 >> 6;
#pragma unroll
      for (int m = 0; m < 4; ++m) {
        const int row = r0 + m * 16 + fr; const float rs = rsqrtf(rstd[row] * (1.f / 768.f) + EPSF);
        float ss = 0.f;
#pragma unroll
        for (int n = 0; n < 4; ++n)
#pragma unroll
          for (int j = 0; j < 4; ++j) { float v = acc[m][n][j] * rs; ss += v * v; }
        ss += __shfl_xor(ss, 16); ss += __shfl_xor(ss, 32);
        const float inv = rsqrtf(ss * (1.f / 64.f) + EPSF) * rs * QSCALE;
        const int b = row / TB, s = row % TB;
        bf16_t* dst = Q + ((size_t)(b * 6 + h) * TB + s) * 96;
#pragma unroll
        for (int n = 0; n < 4; ++n) {
          const int d = n * 16 + fq * 4; f32x4 g = *(const f32x4*)(gn + d);
          u32x2 v = {pk_bf16(acc[m][n][0] * inv * g[0], acc[m][n][1] * inv * g[1]), pk_bf16(acc[m][n][2] * inv * g[2], acc[m][n][3] * inv * g[3])};
          *(u32x2*)(dst + d) = v;
        }
      }
    } else {
#pragma unroll
      for (int m = 0; m < 4; ++m) {
        const int row = r0 + m * 16 + fr; const float rs = rsqrtf(rstd[row] * (1.f / 768.f) + EPSF);
        const int b = row / TB, s = row % TB; const bool lat = s >= NCTX; const int sp = s - NCTX;
#pragma unroll
        for (int hh = 0; hh < 2; ++hh) {
          const int h = ((c0 - 384) >> 5) + hh;
          float ss = 0.f;
#pragma unroll
          for (int nn = 0; nn < 2; ++nn)
#pragma unroll
            for (int j = 0; j < 4; ++j) { float v = acc[m][hh * 2 + nn][j] * rs; ss += v * v; }
          ss += __shfl_xor(ss, 16); ss += __shfl_xor(ss, 32);
          const float inv = rsqrtf(ss * (1.f / 32.f) + EPSF) * rs;
          bf16_t* dst = Q + ((size_t)(b * 6 + h) * TB + s) * 96 + 64;
#pragma unroll
          for (int nn = 0; nn < 2; ++nn) {
            const int d = nn * 16 + fq * 4; f32x4 g = *(const f32x4*)(gr + d);
            float o[4];
#pragma unroll
            for (int j = 0; j < 4; ++j) {
              float val = acc[m][hh * 2 + nn][j] * inv * g[j];
              float partner = __shfl_xor(val, 32);
              if (lat) {
                const float* rt = rope + ((nn == 0 ? (sp >> 6) : (sp & 63)) * 8 + ((fq * 4 + j) & 7)) * 2; const float cs = rt[0], sn = rt[1];
                val = fq < 2 ? val * cs - partner * sn : val * cs + partner * sn;
              }
              o[j] = val * QSCALE;
            }
            u32x2 v = {pk_bf16(o[0], o[1]), pk_bf16(o[2], o[3])};
            *(u32x2*)(dst + d) = v;
          }
        }
      }
    }
  }
};

struct EpiK {
  const float *rstd, *gk; bf16_t* Kt;
  DI void operator()(const f32x4 (&acc)[4][4], int r0, int c0, int fr, int fq) const {
    const int h = c0 >> 6;
#pragma unroll
    for (int m = 0; m < 4; ++m) {
      const int row = r0 + m * 16 + fr; const float rs = rsqrtf(rstd[row] * (1.f / 256.f) + EPSF);
      float ss = 0.f;
#pragma unroll
      for (int n = 0; n < 4; ++n)
#pragma unroll
        for (int j = 0; j < 4; ++j) { float v = acc[m][n][j] * rs; ss += v * v; }
      ss += __shfl_xor(ss, 16); ss += __shfl_xor(ss, 32);
      const float inv = rsqrtf(ss * (1.f / 64.f) + EPSF) * rs;
      const int b = row / TB, s = row % TB;
      bf16_t* dst = Kt + ((size_t)(b * 6 + h) * TB + s) * 96;
#pragma unroll
      for (int n = 0; n < 4; ++n) {
        const int d = n * 16 + fq * 4; f32x4 g = *(const f32x4*)(gk + d);
        u32x2 v = {pk_bf16(acc[m][n][0] * inv * g[0], acc[m][n][1] * inv * g[1]), pk_bf16(acc[m][n][2] * inv * g[2], acc[m][n][3] * inv * g[3])};
        *(u32x2*)(dst + d) = v;
      }
    }
  }
};

struct EpiV {
  const float* rstd; bf16_t* VT;
  DI void operator()(const f32x4 (&acc)[4][4], int r0, int c0, int fr, int fq) const {
#pragma unroll
    for (int m = 0; m < 4; ++m)
#pragma unroll
      for (int n = 0; n < 4; ++n) {
        const int row = r0 + m * 16 + fr, col = c0 + n * 16 + fq * 4;
        f32x4 rs = *(const f32x4*)(rstd + col);
#pragma unroll
        for (int j = 0; j < 4; ++j) rs[j] = rsqrtf(rs[j] * (1.f / 256.f) + EPSF);
        u32x2 v = {pk_bf16(acc[m][n][0] * rs[0], acc[m][n][1] * rs[1]), pk_bf16(acc[m][n][2] * rs[2], acc[m][n][3] * rs[3])};
        *(u32x2*)(VT + (size_t)row * T_TOK + col) = v;
      }
  }
};

struct EpiPost {
  const float *Y, *BON, *mu, *lnx_g, *lnx_b; const bf16_t* PA; bf16_t* YC;
  DI void operator()(const f32x4 (&acc)[4][4], int r0, int c0, int fr, int fq) const {
    const int h = c0 >> 6;
#pragma unroll
    for (int m = 0; m < 4; ++m) {
      const int row = r0 + m * 16 + fr; const int s = row % TB;
      const bool hasprev = (s != 0 && s != NCTX), hasnext = (s != NCTX - 1 && s != TB - 1);
      f32x4 y[4];
      float s1 = 0.f;
#pragma unroll
      for (int n = 0; n < 4; ++n) {
        const size_t o = (size_t)row * 384 + c0 + n * 16 + fq * 4;
        y[n] = *(const f32x4*)(Y + o) + *(const f32x4*)(Y + (size_t)T_TOK * 384 + o);
        s1 += y[n][0] + y[n][1] + y[n][2] + y[n][3];
      }
      s1 += __shfl_xor(s1, 16); s1 += __shfl_xor(s1, 32);
      const float mean = s1 * (1.f / 64.f);
      float s2 = 0.f;
#pragma unroll
      for (int n = 0; n < 4; ++n)
#pragma unroll
        for (int j = 0; j < 4; ++j) { float d = y[n][j] - mean; s2 += d * d; }
      s2 += __shfl_xor(s2, 16); s2 += __shfl_xor(s2, 32);
      const float rstdv = rsqrtf(s2 * (1.f / 64.f) + GN_EPS);
      const float bon = BON[(size_t)row * 6 + h] + BON[(size_t)T_TOK * 6 + (size_t)row * 6 + h];
#pragma unroll
      for (int n = 0; n < 4; ++n) {
        const int col = c0 + n * 16 + fq * 4;
        const bf16_t* pv = PA + (size_t)row * LDPA + 768 + col;
        float vc[4], vp[4] = {0.f, 0.f, 0.f, 0.f}, vn[4] = {0.f, 0.f, 0.f, 0.f};
        unpack4(*(const u32x2*)pv, vc);
        if (hasprev) unpack4(*(const u32x2*)(pv - LDPA), vp);
        if (hasnext) unpack4(*(const u32x2*)(pv + LDPA), vn);
        f32x4 m0 = *(const f32x4*)(mu + 768 + col), m1 = *(const f32x4*)(mu + LDPA + 768 + col);
        f32x4 lg = *(const f32x4*)(lnx_g + col), lb = *(const f32x4*)(lnx_b + col);
        float o[4];
#pragma unroll
        for (int j = 0; j < 4; ++j) {
          const float v = vc[j] + m0[j] * (vp[j] - vc[j]) + m1[j] * (vn[j] - vc[j]);
          o[j] = ((y[n][j] - mean) * rstdv * lg[j] + lb[j] + bon * v) * acc[m][n][j];
        }
        u32x2 w = {pk_bf16(o[0], o[1]), pk_bf16(o[2], o[3])};
        *(u32x2*)(YC + (size_t)row * DM + col) = w;
      }
    }
  }
};

struct EpiRes {
  const Params* p; int l; bool from_inputs; int gate_off;
  DI void operator()(const f32x4 (&acc)[4][4], int r0, int c0, int fr, int fq) const {
#pragma unroll
    for (int m = 0; m < 4; ++m) {
      const int row = r0 + m * 16 + fr; const int b = row / TB, s = row % TB;
      const float* src = xsrc_row(*p, from_inputs, b, s);
      float* dst = xdst_row(*p, b, s);
      const float* gate = p->MOD + (size_t)(l * 9 + (s < NCTX ? 8 : b)) * 6144 + gate_off;
#pragma unroll
      for (int n = 0; n < 4; ++n) {
        const int col = c0 + n * 16 + fq * 4;
        f32x4 g = *(const f32x4*)(gate + col), xv = *(const f32x4*)(src + col);
        *(f32x4*)(dst + col) = xv + g * acc[m][n];
      }
    }
  }
};

struct EpiFfnIn {
  bf16_t* ACT;
  DI void operator()(const f32x4 (&acc)[4][4], int r0, int c0, int fr, int fq) const {
    const int cb = (c0 >> 6) * 32;
#pragma unroll
    for (int m = 0; m < 4; ++m)
#pragma unroll
      for (int n = 0; n < 2; ++n) {
        float o[4];
#pragma unroll
        for (int j = 0; j < 4; ++j) { float g = acc[m][n][j]; o[j] = g / (1.f + __expf(-g)) * acc[m][n + 2][j]; }
        u32x2 w = {pk_bf16(o[0], o[1]), pk_bf16(o[2], o[3])};
        *(u32x2*)(ACT + (size_t)(r0 + m * 16 + fr) * 2816 + cb + n * 16 + fq * 4) = w;
      }
  }
};

DI void prep_token(const Params& p, int l, int row, int lane) {
  const int b = row / TB, s = row % TB;
  const bool hasprev = (s != 0 && s != NCTX), hasnext = (s != NCTX - 1 && s != TB - 1);
  const float mp = hasprev ? 1.f : 0.f, mn = hasnext ? 1.f : 0.f;
  const bf16_t* pa = p.PA + (size_t)row * LDPA;
  const bf16_t* pbc = p.PBC + (size_t)row * LDPBC;
  const int opa = hasprev ? -LDPA : 0, ona = hasnext ? LDPA : 0, opb = hasprev ? -LDPBC : 0, onb = hasnext ? LDPBC : 0;
  const int l32 = lane & 31, c8 = l32 * 8, colA = 1152 + c8;
  const u32x4 la_c = *(const u32x4*)(pa + colA), la_p = *(const u32x4*)(pa + opa + colA), la_n = *(const u32x4*)(pa + ona + colA);
  const u32x4 lq0 = *(const u32x4*)(pbc + lane * 8), lq1 = *(const u32x4*)(pbc + 512 + c8), lkv = *(const u32x4*)(pbc + 768 + c8);
  const u32x4 lrp = *(const u32x4*)(pbc + 1024 + (lane & 3) * 8);
  const u32x4 lbg = *(const u32x4*)(pbc + 1056 + c8), lcc = *(const u32x4*)(pbc + 1312 + c8), lhh = *(const u32x4*)(pbc + 1568 + c8);
  const u32x4 lcp = *(const u32x4*)(pbc + opb + 1312 + c8), lhp = *(const u32x4*)(pbc + opb + 1568 + c8);
  const u32x4 lcn = *(const u32x4*)(pbc + onb + 1312 + c8), lhn = *(const u32x4*)(pbc + onb + 1568 + c8);
  const float* mu = p.tshift_mu + (size_t)l * 2 * LDPA;
  {
    float c[8], pv[8], nx[8], o[8];
    unpack8(la_c, c); unpack8(la_p, pv); unpack8(la_n, nx);
    const f32x4 m0a = *(const f32x4*)(mu + colA), m0b = *(const f32x4*)(mu + colA + 4), m1a = *(const f32x4*)(mu + LDPA + colA), m1b = *(const f32x4*)(mu + LDPA + colA + 4);
#pragma unroll
    for (int j = 0; j < 8; ++j) {
      const float m0 = j < 4 ? m0a[j & 3] : m0b[j & 3], m1 = j < 4 ? m1a[j & 3] : m1b[j & 3];
      float t = c[j] + m0 * (pv[j] * mp - c[j]) + m1 * (nx[j] * mn - c[j]);
      if (l32 < 8) { float e = __expf(2.f * t); t = 1.f - 2.f * __builtin_amdgcn_rcpf(1.f + e); }
      else if (l32 >= 16) t = __builtin_amdgcn_rcpf(1.f + __expf(-t));
      o[j] = t;
    }
    u32x4 w = {pk_bf16(o[0], o[1]), pk_bf16(o[2], o[3]), pk_bf16(o[4], o[5]), pk_bf16(o[6], o[7])};
    if (lane < 8) *(u32x4*)(p.TW + (size_t)row * 64 + lane * 8) = w;
    else if (lane < 16) *(u32x4*)(p.TA + (size_t)row * 64 + (lane - 8) * 8) = w;
    else if (lane < 32) *(u32x4*)(p.TG + (size_t)row * 128 + (lane - 16) * 8) = w;
  }
  float f[8], ss = 0.f, s2 = 0.f, s3 = 0.f, fr_[8];
  unpack8(lq0, f);
#pragma unroll
  for (int j = 0; j < 8; ++j) ss += f[j] * f[j];
  unpack8(lq1, f);
  if (lane < 32) {
#pragma unroll
    for (int j = 0; j < 8; ++j) ss += f[j] * f[j];
  }
  unpack8(lkv, f);
  if (lane < 32) {
#pragma unroll
    for (int j = 0; j < 8; ++j) s2 += f[j] * f[j];
  }
  unpack8(lrp, fr_);
  if (lane < 4) {
#pragma unroll
    for (int j = 0; j < 8; ++j) s3 += fr_[j] * fr_[j];
  }
  s3 += __shfl_xor(s3, 1); s3 += __shfl_xor(s3, 2);
  {
    const float inv = rsqrtf(s3 * (1.f / 32.f) + EPSF);
    const float* g = p.k_rope_g + l * 32;
    const bool lat = s >= NCTX; const int sp = lat ? s - NCTX : 0;
    const float* rt = p.ROPE + ((lane & 2) ? (sp & 63) : (sp >> 6)) * 16;
    float o[8];
#pragma unroll
    for (int j = 0; j < 8; ++j) {
      float val = fr_[j] * inv * g[(lane & 3) * 8 + j];
      float partner = __shfl_xor(val, 1);
      if (lat) {
        const float cs = rt[2 * j], sn = rt[2 * j + 1];
        val = (lane & 1) == 0 ? val * cs - partner * sn : val * cs + partner * sn;
      }
      o[j] = val;
    }
    if (lane < 4) {
      u32x4 w = {pk_bf16(o[0], o[1]), pk_bf16(o[2], o[3]), pk_bf16(o[4], o[5]), pk_bf16(o[6], o[7])};
#pragma unroll
      for (int hh = 0; hh < 6; ++hh) *(u32x4*)(p.Kt + ((size_t)(b * 6 + hh) * TB + s) * 96 + 64 + lane * 8) = w;
    }
  }
  {
    float bg[8], cc[8], hh[8], cp[8], hp[8], cn[8], hn[8], o[8];
    unpack8(lbg, bg); unpack8(lcc, cc); unpack8(lhh, hh); unpack8(lcp, cp); unpack8(lhp, hp); unpack8(lcn, cn); unpack8(lhn, hn);
    const float* cw = p.conv_w + (size_t)l * 3 * 256;
#pragma unroll
    for (int j = 0; j < 8; ++j) o[j] = bg[j] * (cw[c8 + j] * cp[j] * hp[j] * mp + cw[256 + c8 + j] * cc[j] * hh[j] + cw[512 + c8 + j] * cn[j] * hn[j] * mn);
    u32x4 w = {pk_bf16(o[0], o[1]), pk_bf16(o[2], o[3]), pk_bf16(o[4], o[5]), pk_bf16(o[6], o[7])};
    if (lane < 32) *(u32x4*)(p.HY + (size_t)row * DM + 768 + c8) = w;
  }
}

#define MFMA32(a, b, c) __builtin_amdgcn_mfma_f32_32x32x16_bf16((a), (b), (c), 0, 0, 0)
DI bf16x8 pack8(const f32x16& x, int s) {
  u32x4 v = {pk_bf16(x[8 * s], x[8 * s + 1]), pk_bf16(x[8 * s + 2], x[8 * s + 3]), pk_bf16(x[8 * s + 4], x[8 * s + 5]), pk_bf16(x[8 * s + 6], x[8 * s + 7])};
  return __builtin_bit_cast(bf16x8, v);
}
constexpr int KROW = 208, VROW = 136, KBUF = 64 * KROW, VBUF = 64 * VROW;
DI void attn_task(const Params& p, int b, int h, int q0, int k0, int nk, char* lds) {
  const int tid = opaque_tid(), lane = tid & 63, wid = tid >> 6, r = lane & 31, hh = lane >> 5;
  const bf16_t* Qp = p.Q + ((size_t)(b * 6 + h) * TB + q0 + wid * 32 + r) * 96;
  const bf16_t* Kp = p.Kt + ((size_t)(b * 6 + h) * TB + k0) * 96;
  const bf16_t* Vp = p.VT + (size_t)(h * 64) * T_TOK + (size_t)b * TB + k0;
  bf16x8 qf[6];
#pragma unroll
  for (int ks = 0; ks < 6; ++ks) qf[ks] = *(const bf16x8*)(Qp + ks * 16 + hh * 8);
  int krow_[3], kch_[3];
#pragma unroll
  for (int i = 0; i < 3; ++i) { int id = tid + i * 256; krow_[i] = id / 12; kch_[i] = id % 12; }
  const int vd0 = tid >> 3, vch = tid & 7;
  u32x4 kreg[3], vreg[2];
  auto load_regs = [&](int kt) {
#pragma unroll
    for (int i = 0; i < 3; ++i) kreg[i] = *(const u32x4*)(Kp + (size_t)(kt * 64 + krow_[i]) * 96 + kch_[i] * 8);
#pragma unroll
    for (int i = 0; i < 2; ++i) vreg[i] = *(const u32x4*)(Vp + (size_t)(vd0 + 32 * i) * T_TOK + kt * 64 + vch * 8);
  };
  auto write_lds = [&](int buf) {
    char* kb = lds + buf * (KBUF + VBUF);
    char* vb = kb + KBUF;
#pragma unroll
    for (int i = 0; i < 3; ++i) *(u32x4*)(kb + krow_[i] * KROW + kch_[i] * 16) = kreg[i];
#pragma unroll
    for (int i = 0; i < 2; ++i) {
      char* d = vb + (vd0 + 32 * i) * VROW + vch * 16;
      *(u32x2*)d = (u32x2){vreg[i][0], vreg[i][1]};
      *(u32x2*)(d + 8) = (u32x2){vreg[i][2], vreg[i][3]};
    }
  };
  f32x16 o[2];
#pragma unroll
  for (int i = 0; i < 16; ++i) { o[0][i] = 0.f; o[1][i] = 0.f; }
  float m_run = -1e30f, l_run = 0.f;
  const int NT = nk >> 6;
  __syncthreads();
  load_regs(0);
  write_lds(0);
  for (int kt = 0; kt < NT; ++kt) {
    if (kt + 1 < NT) load_regs(kt + 1);
    __syncthreads();
    const char* kb = lds + (kt & 1) * (KBUF + VBUF);
    const char* vb = kb + KBUF;
    f32x16 st[2];
#pragma unroll
    for (int kbk = 0; kbk < 2; ++kbk) {
#pragma unroll
      for (int i = 0; i < 16; ++i) st[kbk][i] = 0.f;
#pragma unroll
      for (int ks = 0; ks < 6; ++ks) {
        bf16x8 kf = *(const bf16x8*)(kb + (kbk * 32 + r) * KROW + ks * 32 + hh * 16);
        st[kbk] = MFMA32(kf, qf[ks], st[kbk]);
      }
    }
    float mx = st[0][0];
#pragma unroll
    for (int i = 0; i < 16; ++i) { mx = fmaxf(mx, st[0][i]); mx = fmaxf(mx, st[1][i]); }
    mx = fmaxf(mx, __shfl_xor(mx, 32));
    const float m_new = fmaxf(m_run, mx);
    const float alpha = __builtin_amdgcn_exp2f(m_run - m_new);
    m_run = m_new;
    float psum = 0.f;
#pragma unroll
    for (int kbk = 0; kbk < 2; ++kbk)
#pragma unroll
      for (int i = 0; i < 16; ++i) { float e = __builtin_amdgcn_exp2f(st[kbk][i] - m_new); st[kbk][i] = e; psum += e; }
    psum += __shfl_xor(psum, 32);
    l_run = l_run * alpha + psum;
#pragma unroll
    for (int i = 0; i < 16; ++i) { o[0][i] *= alpha; o[1][i] *= alpha; }
#pragma unroll
    for (int ksv = 0; ksv < 4; ++ksv) {
      const bf16x8 pf = pack8(st[ksv >> 1], ksv & 1);
#pragma unroll
      for (int db = 0; db < 2; ++db) {
        const char* va = vb + (db * 32 + r) * VROW + (ksv * 16 + 4 * hh) * 2;
        s16x4 lo = *(const s16x4*)va, hi = *(const s16x4*)(va + 16);
        bf16x8 vf = __builtin_shufflevector(lo, hi, 0, 1, 2, 3, 4, 5, 6, 7);
        o[db] = MFMA32(vf, pf, o[db]);
      }
    }
    if (kt + 1 < NT) write_lds((kt + 1) & 1);
  }
  const float invl = 1.f / l_run;
  bf16_t* dst = p.HY + (size_t)(b * TB + q0 + wid * 32 + r) * DM + 384 + h * 64;
#pragma unroll
  for (int db = 0; db < 2; ++db)
#pragma unroll
    for (int g = 0; g < 4; ++g) {
      u32x2 w = {pk_bf16(o[db][4 * g] * invl, o[db][4 * g + 1] * invl), pk_bf16(o[db][4 * g + 2] * invl, o[db][4 * g + 3] * invl)};
      *(u32x2*)(dst + db * 32 + 8 * g + 4 * hh) = w;
    }
}

enum { VW = 0, VKK = 1, VB = 2, VKD = 3, VR = 4, VV = 5 };
DI void scan_task(const Params& p, int l, int b, int h, int dir, int half, char* lds) {
  float* cb = (float*)lds;
  float* tk = cb + 6 * 1024;
  float* ybuf = tk + 1024;
  const int tid = opaque_tid(), lane = tid & 63, wid = tid >> 6;
  const int st_p = tid >> 4, c4 = tid & 15;
  const int fr = lane & 15, fq = lane >> 4;
  const int rp = lane >> 4, g = lane & 15;
  const int hc = h * 64;
  bf16x8 bw[2], ba[2];
  {
    const bf16_t* wd = p.Wdecay + ((size_t)dir * 384 + hc + wid * 16 + fr) * 64;
    const bf16_t* wi = p.Wicl + ((size_t)dir * 384 + hc + wid * 16 + fr) * 64;
#pragma unroll
    for (int ks = 0; ks < 2; ++ks) { bw[ks] = *(const bf16x8*)(wd + ks * 32 + fq * 8); ba[ks] = *(const bf16x8*)(wi + ks * 32 + fq * 8); }
  }
  f32x4 mu0[3], mu1[3];
  const float* mu = p.tshift_mu + (size_t)l * 2 * LDPA;
#pragma unroll
  for (int sec = 0; sec < 3; ++sec) { mu0[sec] = *(const f32x4*)(mu + sec * 384 + hc + c4 * 4); mu1[sec] = *(const f32x4*)(mu + LDPA + sec * 384 + hc + c4 * 4); }
  const f32x4 kkg = *(const f32x4*)(p.k_k + l * 384 + hc + c4 * 4);
  const f32x4 rkg = *(const f32x4*)(p.r_k + l * 384 + hc + c4 * 4);
  const int colB = wid * 16 + fq * 4;
  const f32x4 w0 = *(const f32x4*)(p.decay_w0 + (size_t)(l * 2 + dir) * 384 + hc + colB);
  const f32x4 a0 = *(const f32x4*)(p.icl_a0 + (size_t)(l * 2 + dir) * 384 + hc + colB);
  const f32x4 kag = *(const f32x4*)(p.k_a + l * 384 + hc + colB);

  u32x2 ld[3][3];
  float mprev = 0.f, mnext = 0.f;
  bf16x8 aw[2], aa[2];
  auto chunk_lo = [&](int c) -> int { return dir == 0 ? 16 * c : (c < 16 ? 240 - 16 * c : 2544 - 16 * c); };
  auto issue_loads = [&](int c) {
    const int slo = chunk_lo(c);
    const int s = slo + st_p;
    const bool hasprev = (s != 0 && s != NCTX), hasnext = (s != NCTX - 1 && s != TB - 1);
    const bf16_t* pa = p.PA + (size_t)(b * TB + s) * LDPA + hc + c4 * 4;
    const int op = hasprev ? -LDPA : 0, on = hasnext ? LDPA : 0;
    mprev = hasprev ? 1.f : 0.f; mnext = hasnext ? 1.f : 0.f;
#pragma unroll
    for (int sec = 0; sec < 3; ++sec) {
      ld[sec][1] = *(const u32x2*)(pa + sec * 384);
      ld[sec][0] = *(const u32x2*)(pa + sec * 384 + op);
      ld[sec][2] = *(const u32x2*)(pa + sec * 384 + on);
    }
    const size_t trow = (size_t)(b * TB + slo + fr) * 64;
#pragma unroll
    for (int ks = 0; ks < 2; ++ks) { aw[ks] = *(const bf16x8*)(p.TW + trow + ks * 32 + fq * 8); aa[ks] = *(const bf16x8*)(p.TA + trow + ks * 32 + fq * 8); }
  };
  auto produce = [&](int c) {
    const int slo = chunk_lo(c);
    float ts[3][4];
#pragma unroll
    for (int sec = 0; sec < 3; ++sec) {
      float pc[4], pp[4], pn[4];
      unpack4(ld[sec][1], pc); unpack4(ld[sec][0], pp); unpack4(ld[sec][2], pn);
#pragma unroll
      for (int j = 0; j < 4; ++j) ts[sec][j] = pc[j] + mu0[sec][j] * (pp[j] * mprev - pc[j]) + mu1[sec][j] * (pn[j] * mnext - pc[j]);
    }
    *(f32x4*)(cb + VR * 1024 + st_p * 64 + c4 * 4) = (f32x4){ts[0][0], ts[0][1], ts[0][2], ts[0][3]};
    *(f32x4*)(cb + VV * 1024 + st_p * 64 + c4 * 4) = (f32x4){ts[2][0], ts[2][1], ts[2][2], ts[2][3]};
    *(f32x4*)(tk + st_p * 64 + c4 * 4) = (f32x4){ts[1][0], ts[1][1], ts[1][2], ts[1][3]};
    float kx[4], ss = 0.f;
#pragma unroll
    for (int j = 0; j < 4; ++j) { kx[j] = ts[1][j] * kkg[j]; ss += kx[j] * kx[j]; }
    ss = red16(ss);
    const float inv = rsqrtf(ss + 1e-12f);
    *(f32x4*)(cb + VKK * 1024 + st_p * 64 + c4 * 4) = (f32x4){kx[0] * inv, kx[1] * inv, kx[2] * inv, kx[3] * inv};
    __syncthreads();
    f32x4 dw = {0.f, 0.f, 0.f, 0.f}, da = {0.f, 0.f, 0.f, 0.f};
#pragma unroll
    for (int ks = 0; ks < 2; ++ks) {
      dw = __builtin_amdgcn_mfma_f32_16x16x32_bf16(bw[ks], aw[ks], dw, 0, 0, 0);
      da = __builtin_amdgcn_mfma_f32_16x16x32_bf16(ba[ks], aa[ks], da, 0, 0, 0);
    }
    {
      const f32x4 kv = *(const f32x4*)(tk + fr * 64 + colB);
      const f32x4 kkv = *(const f32x4*)(cb + VKK * 1024 + fr * 64 + colB);
      f32x4 wv, kdv, bv;
#pragma unroll
      for (int j = 0; j < 4; ++j) {
        wv[j] = __expf(-LOG_DECAY_SCALE * sigmoidf_(w0[j] + dw[j]));
        const float a = sigmoidf_(a0[j] + da[j]);
        kdv[j] = kv[j] * (1.f + (a - 1.f) * kag[j]);
        bv[j] = kkv[j] * a;
      }
      *(f32x4*)(cb + VW * 1024 + fr * 64 + colB) = wv;
      *(f32x4*)(cb + VKD * 1024 + fr * 64 + colB) = kdv;
      *(f32x4*)(cb + VB * 1024 + fr * 64 + colB) = bv;
    }
    __syncthreads();
    {
      const f32x4 rv = *(const f32x4*)(cb + VR * 1024 + st_p * 64 + c4 * 4);
      const f32x4 kdv = *(const f32x4*)(cb + VKD * 1024 + st_p * 64 + c4 * 4);
      float bs = rv[0] * kdv[0] * rkg[0] + rv[1] * kdv[1] * rkg[1] + rv[2] * kdv[2] * rkg[2] + rv[3] * kdv[3] * rkg[3];
      bs = red16(bs);
      if (c4 == 0 && half == 0) p.BON[(size_t)dir * T_TOK * 6 + (size_t)(b * TB + slo + st_p) * 6 + h] = bs;
    }
  };

  f32x2 S0[2], S1[2];
#pragma unroll
  for (int j = 0; j < 2; ++j) { S0[j] = (f32x2){0.f, 0.f}; S1[j] = (f32x2){0.f, 0.f}; }
  __syncthreads();
  issue_loads(0);
  produce(0);
  __syncthreads();
  const int NCH = TB / 16;
  const int rowl = half * 32 + wid * 8 + rp * 2;
  const int inc = dir ? -64 : 64;
  for (int c = 0; c < NCH; ++c) {
    if (c + 1 < NCH) issue_loads(c + 1);
    {
      const float* ps = cb + (dir ? 15 * 64 : 0) + g * 4;
      const float* pv = cb + VV * 1024 + (dir ? 15 * 64 : 0) + rowl;
      float* py = ybuf + (dir ? 15 * 512 : 0) + ((wid * 4 + rp) * 16 + g) * 2;
      f32x4 cw = *(const f32x4*)(ps + VW * 1024), ckk = *(const f32x4*)(ps + VKK * 1024), cbb = *(const f32x4*)(ps + VB * 1024),
            ckd = *(const f32x4*)(ps + VKD * 1024), crr = *(const f32x4*)(ps + VR * 1024);
      f32x2 cvv = *(const f32x2*)pv;
#pragma unroll
      for (int ii = 0; ii < 16; ++ii) {
        f32x4 nw = cw, nkk = ckk, nbb = cbb, nkd = ckd, nrr = crr; f32x2 nvv = cvv;
        if (ii < 15) {
          ps += inc; pv += inc;
          nw = *(const f32x4*)(ps + VW * 1024); nkk = *(const f32x4*)(ps + VKK * 1024); nbb = *(const f32x4*)(ps + VB * 1024);
          nkd = *(const f32x4*)(ps + VKD * 1024); nrr = *(const f32x4*)(ps + VR * 1024); nvv = *(const f32x2*)pv;
        }
        __builtin_amdgcn_sched_barrier(0x7);
        const f32x2 kk0 = {ckk[0], ckk[1]}, kk1 = {ckk[2], ckk[3]}, w0 = {cw[0], cw[1]}, w1 = {cw[2], cw[3]};
        const f32x2 b0 = {cbb[0], cbb[1]}, b1 = {cbb[2], cbb[3]}, kd0 = {ckd[0], ckd[1]}, kd1 = {ckd[2], ckd[3]};
        const f32x2 r0 = {crr[0], crr[1]}, r1 = {crr[2], crr[3]};
        const f32x2 p0 = S0[0] * kk0 + S0[1] * kk1, p1 = S1[0] * kk0 + S1[1] * kk1;
        const f32x2 u00 = S0[0] * w0 + kd0 * cvv[0], u01 = S0[1] * w1 + kd1 * cvv[0];
        const f32x2 u10 = S1[0] * w0 + kd0 * cvv[1], u11 = S1[1] * w1 + kd1 * cvv[1];
        const float q0 = red16(p0[0] + p0[1]), q1 = red16(p1[0] + p1[1]);
        S0[0] = u00 - b0 * q0; S0[1] = u01 - b1 * q0;
        S1[0] = u10 - b0 * q1; S1[1] = u11 - b1 * q1;
        const f32x2 y0 = S0[0] * r0 + S0[1] * r1, y1 = S1[0] * r0 + S1[1] * r1;
        *(f32x2*)py = (f32x2){y0[0] + y0[1], y1[0] + y1[1]};
        py += dir ? -512 : 512;
        cw = nw; ckk = nkk; cbb = nbb; ckd = nkd; crr = nrr; cvv = nvv;
      }
    }
    __syncthreads();
    {
      const int slo = chunk_lo(c);
      const float* yp = ybuf + (st_p * 16 + c4) * 32;
      f32x4 a = *(const f32x4*)yp;
#pragma unroll
      for (int i = 1; i < 8; ++i) a += *(const f32x4*)(yp + 4 * i);
      *(f32x2*)(p.Y + (size_t)dir * T_TOK * 384 + (size_t)(b * TB + slo + st_p) * 384 + hc + half * 32 + c4 * 2) = (f32x2){a[0] + a[2], a[1] + a[3]};
    }
    if (c + 1 < NCH) produce(c + 1);
    __syncthreads();
  }
}

DI int lat_tile(int i) { return (i >> 4) * 18 + 2 + (i & 15); }

template <int KSEL> DI void run_phase(const Params& p, int ph, char* lds) {
  const int bid = blockIdx.x, G = gridDim.x, tid = opaque_tid(), lane = tid & 63, wid = tid >> 6;
  if (ph == 0) {
    if (KSEL >= 0 && KSEL != 10) return;
    for (int t = bid; t < 384 + NCONV_W1 + 1; t += G) {
      if (t < 384) adaln_task(p, t, lds);
      else if (t < 384 + NCONV_W1) conv_w1_task(p, 0, t - 384, lds);
      else { for (int e = tid; e < 512; e += 256) { float cs, sn; rope_angle(e >> 3, e & 7, cs, sn); p.ROPE[2 * e] = cs; p.ROPE[2 * e + 1] = sn; } }
    }
    return;
  }
  if (KSEL == 10) return;
  const int l = (ph - 1) / 9, kq = (ph - 1) % 9, k = kq < 2 ? kq : kq + 1;
  const bool last = (l == 1);
  const int lb = ((G & 7) == 0) ? (bid & 7) * (G >> 3) + (bid >> 3) : bid;
  if (KSEL >= 0 && KSEL != 10 && k != (KSEL == 11 ? 4 : KSEL)) return;
  switch (k) {
    case 0:
      for (int i = bid * 256 + tid; i < 2 * T_TOK; i += G * 256) p.RSTD[i] = 0.f;
      modnorm_rows(p, l, 0, l == 0, false, bid * 4 + wid, G * 4, lane);
      break;
    case 1: {
      EpiP e{p.PA, p.PBC, p.RSTD};
      for (int t = lb; t < 144 * 26; t += G) gemm_tile(p.HY, DM, p.Win, DM, DM, (t / 26) * 128, (t % 26) * 128, lds, e);
    } break;
    case 3: {
      const int nq = last ? 128 * 5 : 144 * 5;
      EpiQ eq{p.RSTD, p.q_nope_g + l * 64, p.q_rope_g + l * 32, p.ROPE, p.Q};
      EpiK ek{p.RSTD + T_TOK, p.k_nope_g + l * 64, p.Kt};
      EpiV ev{p.RSTD + T_TOK, p.VT};
      for (int t = bid; t < nq + 432 + 432 + T_TOK / 4; t += G) {
        if (t >= nq + 864) { prep_token(p, l, (t - nq - 864) * 4 + wid, lane); continue; }
        if (t < nq) { int i = t / 5; int tm = last ? lat_tile(i) : i; gemm_tile(p.PBC, LDPBC, p.Wuq, 768, 768, tm * 128, (t % 5) * 128, lds, eq); }
        else if (t < nq + 432) { int u = t - nq; gemm_tile(p.PBC + 768, LDPBC, p.WukvK, 256, 256, (u / 3) * 128, (u % 3) * 128, lds, ek); }
        else { int u = t - nq - 432; gemm_tile(p.WvT, 256, p.PBC + 768, LDPBC, 256, (u % 3) * 128, (u / 3) * 128, lds, ev); }
      }
    } break;
    case 4: {
      const int natt = 768 + (last ? 0 : 96);
      if (KSEL != 11) { if (bid < 192) { scan_task(p, l, bid / 24, (bid % 24) >> 2, (bid >> 1) & 1, bid & 1, lds); break; } if (KSEL == 4) break; }
      const int aoff = KSEL == 11 ? 0 : 192;
      for (int t = bid - aoff; t < natt + NCONV_FF; t += (G - aoff)) {
        if (t < 768) { int bh = t >> 4, qb = t & 15; attn_task(p, bh / 6, bh % 6, NCTX + qb * 128, 0, TB, lds); }
        else if (t < natt) { int u = t - 768; int bh = u >> 1, qb = u & 1; attn_task(p, bh / 6, bh % 6, qb * 128, 0, NCTX, lds); }
        else conv_ff_task(p, l, t - natt, lds);
      }
    } break;
    case 5: {
      EpiPost e{p.Y, p.BON, p.tshift_mu + (size_t)l * 2 * LDPA, p.lnx_g + l * 384, p.lnx_b + l * 384, p.PA, p.HY};
      const int nm = last ? 128 : 144;
      for (int t = bid; t < nm * 3; t += G) { int i = t / 3; int tm = last ? lat_tile(i) : i; gemm_tile(p.TG, 128, p.Wgate, 128, 128, tm * 128, (t % 3) * 128, lds, e); }
    } break;
    case 6: {
      EpiRes e{&p, l, l == 0, 2 * 1024};
      const int nm = last ? 128 : 144;
      for (int t = lb; t < nm * 8; t += G) { int i = t / 8; int tm = last ? lat_tile(i) : i; gemm_tile(p.HY, DM, p.Wout, DM, DM, tm * 128, (t % 8) * 128, lds, e); }
    } break;
    case 7:
      modnorm_rows(p, l, 1, false, last, bid * 4 + wid, G * 4, lane);
      break;
    case 8: {
      EpiFfnIn e{p.ACT};
      const int nm = last ? 128 : 144;
      const int nconv = last ? 0 : NCONV_W1;
      for (int t = lb; t < nm * 44 + nconv; t += G) {
        if (t < nm * 44) { int i = t / 44; int tm = last ? lat_tile(i) : i; gemm_tile(p.HY, DM, p.Wffi, DM, DM, tm * 128, (t % 44) * 128, lds, e); }
        else conv_w1_task(p, 1, t - nm * 44, lds);
      }
    } break;
    case 9: {
      EpiRes e{&p, l, false, 5 * 1024};
      const int nm = last ? 128 : 144;
      for (int t = lb; t < nm * 8; t += G) { int i = t / 8; int tm = last ? lat_tile(i) : i; gemm_tile(p.ACT, 2816, p.Wffo, 2816, 2816, tm * 128, (t % 8) * 128, lds, e); }
    } break;
  }
}


#define XB_TMO      128
#define XB_XCNT(j)  (256  + 64 * (j))
#define XB_XSUB(j)  (1280 + 64 * (j))
#define XB_XGEN(j)  (2304 + 64 * (j))
#define XB_TOP      3328
#define XB_TOPGEN   3392
#define XCD_BAR_WORDS 3456
#define XB_SPIN_CAP (1u << 20)
DI unsigned xb_ld(unsigned* p) { return __hip_atomic_load(p, __ATOMIC_RELAXED, __HIP_MEMORY_SCOPE_AGENT); }
DI unsigned xb_add(unsigned* p, unsigned v) { return __hip_atomic_fetch_add(p, v, __ATOMIC_RELAXED, __HIP_MEMORY_SCOPE_AGENT); }
DI unsigned xb_xcc_id() { return (unsigned)__builtin_amdgcn_s_getreg((3 << 11) | 20) & 0xFu; }
#define XB_SPIN(cond, bar) do { unsigned _sp = 0; while (cond) { __builtin_amdgcn_s_sleep(1); \
    if ((++_sp & 255u) == 0u) { if (xb_ld(&(bar)[XB_TMO])) break; if (_sp > XB_SPIN_CAP) { atomicAdd(&(bar)[XB_TMO], 1u); break; } } } } while (0)
struct XcdBarrier { unsigned* bar; unsigned x; volatile LAS unsigned* st; };
DI XcdBarrier xcd_barrier_post(unsigned* bar, volatile LAS unsigned* st) {
  XcdBarrier b; b.bar = bar; b.x = xb_xcc_id(); b.st = st;
  if (threadIdx.x == 0) (void)xb_add(&bar[XB_XCNT(b.x)], 1u);
  return b;
}
DI void xcd_barrier_complete(unsigned* bar, unsigned x, unsigned& nloc, unsigned& nx) {
  const unsigned G = gridDim.x * gridDim.y * gridDim.z;
  unsigned sum, cnt, mine, sp = 0u;
  for (;;) {
    sum = 0u; cnt = 0u; mine = 0u;
#pragma unroll
    for (unsigned j = 0; j < 16; ++j) { const unsigned c = xb_ld(&bar[XB_XCNT(j)]); sum += c; cnt += (c > 0u) ? 1u : 0u; mine = (j == x) ? c : mine; }
    if (sum == G) break;
    __builtin_amdgcn_s_sleep(1);
    if ((++sp & 255u) == 0u) { if (xb_ld(&bar[XB_TMO])) break; if (sp > XB_SPIN_CAP) { atomicAdd(&bar[XB_TMO], 1u); break; } }
  }
  nloc = mine > 0u ? mine : 1u; nx = cnt > 0u ? cnt : 1u;
}
DI void xcd_barrier(const XcdBarrier& b) {
  asm volatile("s_waitcnt vmcnt(0)" ::: "memory");
  __syncthreads();
  if (threadIdx.x == 0) {
    unsigned* bar = b.bar;
    __builtin_amdgcn_s_waitcnt(0);
    unsigned nloc = b.st[0], nx = b.st[1];
    if (nloc == 0u) { xcd_barrier_complete(bar, b.x, nloc, nx); b.st[0] = nloc; b.st[1] = nx; }
    const unsigned old = xb_add(&bar[XB_XSUB(b.x)], 1u);
    const unsigned gen = old / nloc;
    if (old + 1u == (gen + 1u) * nloc) {
      __builtin_amdgcn_fence(__ATOMIC_RELEASE, "agent");
      asm volatile("s_waitcnt vmcnt(0)" ::: "memory");
      const unsigned og = xb_add(&bar[XB_TOP], 1u);
      const unsigned tg = og / nx;
      if (og + 1u == (tg + 1u) * nx) xb_add(&bar[XB_TOPGEN], 1u);
      else XB_SPIN(xb_ld(&bar[XB_TOPGEN]) == tg, bar);
      __builtin_amdgcn_fence(__ATOMIC_ACQUIRE, "agent");
      xb_add(&bar[XB_XGEN(b.x)], 1u);
      asm volatile("s_waitcnt vmcnt(0)" ::: "memory");
    } else {
      XB_SPIN(xb_ld(&bar[XB_XGEN(b.x)]) == gen, bar);
      __builtin_amdgcn_fence(__ATOMIC_ACQUIRE, "agent");
      asm volatile("s_waitcnt vmcnt(0)" ::: "memory");
    }
  }
  __syncthreads();
}

constexpr int NPHASE = 19;
#if !MULTI_LAUNCH
__global__ void __launch_bounds__(256, 2) mega(Params p, int ph_lo, int ph_hi) {
  __shared__ __attribute__((aligned(16))) char lds[65536 + 16];
  cg::grid_group grid = cg::this_grid();
  volatile LAS unsigned* st = (volatile LAS unsigned*)(lds + 65536);
  if (threadIdx.x == 0) { st[0] = 0u; st[1] = 0u; }
  if (blockIdx.x == 0) for (int i = threadIdx.x; i < XCD_BAR_WORDS; i += 256) p.BAR[i] = 0u;
  __syncthreads();
  XcdBarrier xb;
  for (int ph = ph_lo; ph < ph_hi; ++ph) {
    if (ph == ph_lo + 1) { grid.sync(); xb = xcd_barrier_post(p.BAR, st); }
    else if (ph > ph_lo + 1) xcd_barrier(xb);
    run_phase<-1>(p, ph, lds);
  }
}
#endif
template <int KSEL> __global__ void __launch_bounds__(256, 2) phase_k(Params p, int ph) {
  __shared__ __attribute__((aligned(16))) char lds[65536];
  run_phase<KSEL>(p, ph, lds);
}

extern "C" void kernel_launch(void* const* d_in, const int* in_sizes, int n_in, void* d_out, int out_size, void* d_ws, size_t ws_size, hipStream_t stream) {
  static int grid_blocks = 0;
  if (!grid_blocks) {
    int dev = 0, cus = 0, per_cu = 0;
    (void)hipGetDevice(&dev);
    (void)hipDeviceGetAttribute(&cus, hipDeviceAttributeMultiprocessorCount, dev);
    #if MULTI_LAUNCH
    per_cu = 2;
#else
    (void)hipOccupancyMaxActiveBlocksPerMultiprocessor(&per_cu, mega, 256, 0);
#endif
    if (per_cu > 2) per_cu = 2;
    if (per_cu < 1) per_cu = 1;
    grid_blocks = cus * per_cu;
  }
  Params p{};
  const float** pin = (const float**)&p.x;
  for (int i = 0; i < 32; ++i) pin[i] = (const float*)d_in[i];
  p.out = (float*)d_out;
  char* w = (char*)d_ws;
  size_t off = 0;
  auto take = [&](size_t bytes) { char* r = w + off; off += (bytes + 255) & ~(size_t)255; return r; };
  p.BAR = (unsigned*)take(XCD_BAR_WORDS * 4);
  p.MOD = (float*)take(2 * 9 * 6144 * 4);
  p.ROPE = (float*)take(64 * 8 * 2 * 4);
  p.RSTD = (float*)take(2 * (size_t)T_TOK * 4);
  p.BON = (float*)take(2 * (size_t)T_TOK * 6 * 4);
  p.XCTX = (float*)take((size_t)8 * NCTX * DM * 4);
  p.Win = (bf16_t*)take((size_t)3328 * 1024 * 2);
  p.Wuq = (bf16_t*)take((size_t)640 * 768 * 2);
  p.WukvK = (bf16_t*)take((size_t)384 * 256 * 2);
  p.WvT = (bf16_t*)take((size_t)384 * 256 * 2);
  p.Wgate = (bf16_t*)take((size_t)384 * 128 * 2);
  p.Wdecay = (bf16_t*)take((size_t)2 * 384 * 64 * 2);
  p.Wicl = (bf16_t*)take((size_t)2 * 384 * 64 * 2);
  p.Wout = (bf16_t*)take((size_t)1024 * 1024 * 2);
  p.HY = (bf16_t*)take((size_t)T_TOK * DM * 2);
  p.TW = (bf16_t*)take((size_t)T_TOK * 64 * 2);
  p.TA = (bf16_t*)take((size_t)T_TOK * 64 * 2);
  p.TG = (bf16_t*)take((size_t)T_TOK * 128 * 2);
  char* qkv = take((size_t)T_TOK * 576 * 2 * 2 + (size_t)384 * T_TOK * 2);
  p.Q = (bf16_t*)qkv;
  p.Kt = (bf16_t*)(qkv + (size_t)T_TOK * 576 * 2);
  p.VT = (bf16_t*)(qkv + (size_t)T_TOK * 576 * 2 * 2);
  p.Wffi = (bf16_t*)take((size_t)5632 * 1024 * 2);
  p.Wffo = (bf16_t*)take((size_t)2816 * 1024 * 2);
  char* pr = take((size_t)T_TOK * (LDPA + LDPBC) * 2);
  p.PA = (bf16_t*)pr;
  p.PBC = (bf16_t*)(pr + (size_t)T_TOK * LDPA * 2);
  p.Y = (float*)p.PBC;
  p.ACT = (bf16_t*)pr;
  if (off > ws_size) { fprintf(stderr, "workspace too small: need %zu have %zu\n", off, ws_size); }
#if MULTI_LAUNCH
  hipLaunchKernelGGL(phase_k<10>, dim3(grid_blocks), dim3(256), 0, stream, p, 0);
  for (int l = 0; l < 2; ++l) {
    const int b0 = 1 + 10 * l;
    hipLaunchKernelGGL(phase_k<0>, dim3(grid_blocks), dim3(256), 0, stream, p, b0 + 0);
    hipLaunchKernelGGL(phase_k<1>, dim3(grid_blocks), dim3(256), 0, stream, p, b0 + 1);
    hipLaunchKernelGGL(phase_k<2>, dim3(grid_blocks), dim3(256), 0, stream, p, b0 + 2);
    hipLaunchKernelGGL(phase_k<3>, dim3(grid_blocks), dim3(256), 0, stream, p, b0 + 3);
    hipLaunchKernelGGL(phase_k<4>, dim3(192), dim3(256), 0, stream, p, b0 + 4);
    hipLaunchKernelGGL(phase_k<11>, dim3(grid_blocks), dim3(256), 0, stream, p, b0 + 4);
    hipLaunchKernelGGL(phase_k<5>, dim3(grid_blocks), dim3(256), 0, stream, p, b0 + 5);
    hipLaunchKernelGGL(phase_k<6>, dim3(grid_blocks), dim3(256), 0, stream, p, b0 + 6);
    hipLaunchKernelGGL(phase_k<7>, dim3(grid_blocks), dim3(256), 0, stream, p, b0 + 7);
    hipLaunchKernelGGL(phase_k<8>, dim3(grid_blocks), dim3(256), 0, stream, p, b0 + 8);
    hipLaunchKernelGGL(phase_k<9>, dim3(grid_blocks), dim3(256), 0, stream, p, b0 + 9);
  }
#else
  int lo = 0, hi = NPHASE;
  void* args[] = {&p, &lo, &hi};
  hipError_t e = hipLaunchCooperativeKernel((void*)mega, dim3(grid_blocks), dim3(256), args, 0, stream);
  if (e != hipSuccess) fprintf(stderr, "cooperative launch failed: %s (grid %d)\n", hipGetErrorString(e), grid_blocks);
#endif
}
```

```cpp
#include <hip/hip_runtime.h>
#include <hip/hip_cooperative_groups.h>
#include <cstdio>
namespace cg = cooperative_groups;

#ifndef MULTI_LAUNCH
#define MULTI_LAUNCH 0
#endif

#define DI __device__ __forceinline__
typedef unsigned short bf16_t;
typedef short bf16x8 __attribute__((ext_vector_type(8)));
typedef short s16x4 __attribute__((ext_vector_type(4)));
typedef float f32x4 __attribute__((ext_vector_type(4)));
typedef float f32x2 __attribute__((ext_vector_type(2)));
typedef float f32x16 __attribute__((ext_vector_type(16)));
typedef unsigned u32x4 __attribute__((ext_vector_type(4)));
typedef unsigned u32x2 __attribute__((ext_vector_type(2)));
#define LAS __attribute__((address_space(3)))

constexpr int T_TOK = 18432, TB = 2304, NCTX = 256, NLAT = 2048, DM = 1024;
constexpr int LDPA = 1408, LDPBC = 1920;
constexpr float EPSF = 1e-6f;
constexpr float LOG_DECAY_SCALE = 0.606531f;
constexpr float GN_EPS = 64e-5f;
constexpr float QSCALE = 0.10206207261596577f * 1.4426950408889634f;

struct Params {
  const float *x, *c, *ctx, *c_ctx, *ada_w, *ada_b, *norm1_g, *norm2_g, *w_in, *tshift_mu, *decay_w0, *decay_up,
      *icl_a0, *icl_up, *gate_up, *k_k, *k_a, *r_k, *lnx_g, *lnx_b, *q_norm_g, *kv_norm_g, *w_uq, *w_ukv, *q_nope_g,
      *k_nope_g, *q_rope_g, *k_rope_g, *conv_w, *w_out, *w_ffn_in, *w_ffn_out;
  float* out;
  float *MOD, *RSTD, *BON, *XCTX, *Y, *ROPE;
  unsigned* BAR;
  bf16_t *Win, *Wuq, *WukvK, *WvT, *Wgate, *Wdecay, *Wicl, *Wout, *Wffi, *Wffo;
  bf16_t *HY, *TW, *TA, *TG, *Q, *Kt, *VT, *PA, *PBC, *ACT;
};

typedef __bf16 bf16v2 __attribute__((ext_vector_type(2)));
DI unsigned pk_bf16(float lo, float hi) { f32x2 v = {lo, hi}; bf16v2 b = __builtin_convertvector(v, bf16v2); return __builtin_bit_cast(unsigned, b); }
DI float bflo(unsigned u) { return __uint_as_float(u << 16); }
DI float bfhi(unsigned u) { return __uint_as_float(u & 0xffff0000u); }
DI int opaque_tid() { int t = threadIdx.x; asm volatile("" : "+v"(t)); return t; }
DI float sigmoidf_(float x) { return 1.f / (1.f + __expf(-x)); }
template <int CTRL> DI float dppf(float x) { return __builtin_bit_cast(float, __builtin_amdgcn_update_dpp(0, __builtin_bit_cast(int, x), CTRL, 0xf, 0xf, true)); }
DI float red8(float x) { x += dppf<0xB1>(x); x += dppf<0x4E>(x); x += dppf<0x141>(x); return x; }
DI float red16(float x) { x = red8(x); x += dppf<0x140>(x); return x; }
DI float red64(float x) { for (int o = 32; o > 0; o >>= 1) x += __shfl_xor(x, o); return x; }

DI void unpack8(u32x4 v, float* f) {
  f[0] = bflo(v[0]); f[1] = bfhi(v[0]); f[2] = bflo(v[1]); f[3] = bfhi(v[1]);
  f[4] = bflo(v[2]); f[5] = bfhi(v[2]); f[6] = bflo(v[3]); f[7] = bfhi(v[3]);
}
DI void unpack4(u32x2 v, float* f) { f[0] = bflo(v[0]); f[1] = bfhi(v[0]); f[2] = bflo(v[1]); f[3] = bfhi(v[1]); }

DI const float* xsrc_row(const Params& p, bool from_inputs, int b, int s) {
  if (from_inputs) return s < NCTX ? p.ctx + (size_t)(b * NCTX + s) * DM : p.x + (size_t)(b * NLAT + s - NCTX) * DM;
  return s < NCTX ? p.XCTX + (size_t)(b * NCTX + s) * DM : p.out + (size_t)(b * NLAT + s - NCTX) * DM;
}
DI float* xdst_row(const Params& p, int b, int s) {
  return s < NCTX ? p.XCTX + (size_t)(b * NCTX + s) * DM : p.out + (size_t)(b * NLAT + s - NCTX) * DM;
}

DI void adaln_task(const Params& p, int task, char* lds) {
  float* s = (float*)lds;
  float* red = s + 9 * 1024;
  const int l = task / 192, cgi = task % 192, tid = opaque_tid();
  for (int i = tid; i < 9 * 1024; i += 256) {
    int r = i >> 10, k = i & 1023;
    float v = r < 8 ? p.c[r * 1024 + k] : p.c_ctx[k];
    s[i] = v / (1.f + __expf(-v));
  }
  __syncthreads();
  const int kg = tid >> 5, cc = tid & 31, col = cgi * 32 + cc;
  float acc[9];
#pragma unroll
  for (int r = 0; r < 9; ++r) acc[r] = 0.f;
  const float* w = p.ada_w + (size_t)l * 1024 * 6144 + col;
  for (int k0 = kg; k0 < 1024; k0 += 128) {
    float wv[16];
#pragma unroll
    for (int u = 0; u < 16; ++u) wv[u] = w[(size_t)(k0 + 8 * u) * 6144];
#pragma unroll
    for (int u = 0; u < 16; ++u)
#pragma unroll
      for (int r = 0; r < 9; ++r) acc[r] += s[r * 1024 + k0 + 8 * u] * wv[u];
  }
#pragma unroll
  for (int r = 0; r < 9; ++r) red[(kg * 9 + r) * 32 + cc] = acc[r];
  __syncthreads();
  for (int i = tid; i < 9 * 32; i += 256) {
    int r = i >> 5, c2 = i & 31;
    float sum = 0.f;
    for (int g = 0; g < 8; ++g) sum += red[(g * 9 + r) * 32 + c2];
    p.MOD[(size_t)(l * 9 + r) * 6144 + cgi * 32 + c2] = sum + p.ada_b[l * 6144 + cgi * 32 + c2];
  }
  __syncthreads();
}

DI int colmap(int mode, int n, int nvalid) {
  switch (mode) {
    case 0: return n < nvalid ? n : -1;
    case 1: if (n < 384) return (n >> 6) * 96 + (n & 63); if (n < 576) return ((n - 384) >> 5) * 96 + 64 + ((n - 384) & 31); return -1;
    case 2: return (n >> 6) * 128 + (n & 63);
    case 3: return (n >> 6) * 128 + 64 + (n & 63);
    default: { int t64 = n >> 6, w = n & 63; return w < 32 ? t64 * 32 + w : 2816 + t64 * 32 + (w - 32); }
  }
}
DI void conv_tile(const float* src, int ld, int K, int mode, int nvalid, const float* kscale, bf16_t* dst, int tile, int ntn, char* lds) {
  float(*tl)[65] = (float(*)[65])lds;
  const int tk = tile / ntn, tn = tile % ntn, tid = opaque_tid(), k0 = tk * 64;
  {
    const int nn = tid & 63, kk0 = tid >> 6;
    const int sc = colmap(mode, tn * 64 + nn, nvalid);
#pragma unroll 4
    for (int i = 0; i < 16; ++i) {
      const int kk = kk0 + 4 * i;
      float v = 0.f;
      if (sc >= 0) { v = src[(size_t)(k0 + kk) * ld + sc]; if (kscale) v *= kscale[k0 + kk]; }
      tl[kk][nn] = v;
    }
  }
  __syncthreads();
  {
    const int kk2 = (tid & 31) * 2, nn2 = tid >> 5;
#pragma unroll
    for (int i = 0; i < 8; ++i) {
      const int nn = nn2 + 8 * i;
      *(unsigned*)(dst + (size_t)(tn * 64 + nn) * K + k0 + kk2) = pk_bf16(tl[kk2][nn], tl[kk2 + 1][nn]);
    }
  }
  __syncthreads();
}
constexpr int NCONV_W1 = 1292, NCONV_FF = 2112;
DI void conv_w1_task(const Params& p, int l, int t, char* lds) {
  if (t < 832) { conv_tile(p.w_in + (size_t)l * 1024 * 3232, 3232, 1024, 0, 3232, nullptr, p.Win, t, 52, lds); return; } t -= 832;
  if (t < 120) { conv_tile(p.w_uq + (size_t)l * 768 * 576, 576, 768, 1, 0, p.q_norm_g + l * 768, p.Wuq, t, 10, lds); return; } t -= 120;
  if (t < 24) { conv_tile(p.w_ukv + (size_t)l * 256 * 768, 768, 256, 2, 0, p.kv_norm_g + l * 256, p.WukvK, t, 6, lds); return; } t -= 24;
  if (t < 24) { conv_tile(p.w_ukv + (size_t)l * 256 * 768, 768, 256, 3, 0, p.kv_norm_g + l * 256, p.WvT, t, 6, lds); return; } t -= 24;
  if (t < 12) { conv_tile(p.gate_up + (size_t)l * 128 * 384, 384, 128, 0, 384, nullptr, p.Wgate, t, 6, lds); return; } t -= 12;
  if (t < 12) { int d = t / 6; conv_tile(p.decay_up + (size_t)(l * 2 + d) * 64 * 384, 384, 64, 0, 384, nullptr, p.Wdecay + d * 384 * 64, t % 6, 6, lds); return; } t -= 12;
  if (t < 12) { int d = t / 6; conv_tile(p.icl_up + (size_t)(l * 2 + d) * 64 * 384, 384, 64, 0, 384, nullptr, p.Wicl + d * 384 * 64, t % 6, 6, lds); return; } t -= 12;
  conv_tile(p.w_out + (size_t)l * 1024 * 1024, 1024, 1024, 0, 1024, nullptr, p.Wout, t, 16, lds);
}
DI void conv_ff_task(const Params& p, int l, int t, char* lds) {
  if (t < 1408) { conv_tile(p.w_ffn_in + (size_t)l * 1024 * 5632, 5632, 1024, 4, 0, nullptr, p.Wffi, t, 88, lds); return; } t -= 1408;
  conv_tile(p.w_ffn_out + (size_t)l * 2816 * 1024, 1024, 2816, 0, 1024, nullptr, p.Wffo, t, 16, lds);
}

DI void modnorm_rows(const Params& p, int l, int which  , bool from_inputs, bool skip_ctx, int w0, int wstride, int lane) {
  const float* g = (which ? p.norm2_g : p.norm1_g) + l * DM;
  f32x4 gg[4];
#pragma unroll
  for (int i = 0; i < 4; ++i) gg[i] = *(const f32x4*)(g + i * 256 + lane * 4);
  const int nrows = skip_ctx ? 8 * NLAT : T_TOK;
  auto rowof = [&](int i) -> int { return skip_ctx ? (i / NLAT) * TB + NCTX + (i % NLAT) : i; };
  int i = w0;
  if (i >= nrows) return;
  f32x4 vn[4];
  {
    const int row = rowof(i); const float* src = xsrc_row(p, from_inputs, row / TB, row % TB);
#pragma unroll
    for (int q = 0; q < 4; ++q) vn[q] = *(const f32x4*)(src + q * 256 + lane * 4);
  }
  for (; i < nrows; i += wstride) {
    const int row = rowof(i); const int b = row / TB, s = row % TB;
    f32x4 v[4];
#pragma unroll
    for (int q = 0; q < 4; ++q) v[q] = vn[q];
    if (i + wstride < nrows) {
      const int rn = rowof(i + wstride); const float* src = xsrc_row(p, from_inputs, rn / TB, rn % TB);
#pragma unroll
      for (int q = 0; q < 4; ++q) vn[q] = *(const f32x4*)(src + q * 256 + lane * 4);
    }
    const float* mod = p.MOD + (size_t)(l * 9 + (s < NCTX ? 8 : b)) * 6144 + (which ? 3 * 1024 : 0);
    f32x4 sh[4], sc[4];
#pragma unroll
    for (int q = 0; q < 4; ++q) { sh[q] = *(const f32x4*)(mod + q * 256 + lane * 4); sc[q] = *(const f32x4*)(mod + 1024 + q * 256 + lane * 4); }
    float ss = 0.f;
#pragma unroll
    for (int q = 0; q < 4; ++q) ss += v[q][0] * v[q][0] + v[q][1] * v[q][1] + v[q][2] * v[q][2] + v[q][3] * v[q][3];
    ss = red64(ss);
    const float rs = rsqrtf(ss * (1.f / 1024.f) + EPSF);
    bf16_t* dst = p.HY + (size_t)row * DM;
#pragma unroll
    for (int q = 0; q < 4; ++q) {
      float o[4];
#pragma unroll
      for (int j = 0; j < 4; ++j) o[j] = (v[q][j] * rs * gg[q][j]) * (1.f + sc[q][j]) + sh[q][j];
      u32x2 w = {pk_bf16(o[0], o[1]), pk_bf16(o[2], o[3])};
      *(u32x2*)(dst + q * 256 + lane * 4) = w;
    }
  }
}

template <class Epi>
DI void gemm_tile(const bf16_t* __restrict__ A, int lda, const bf16_t* __restrict__ Bt, int ldb, int K, int row0, int col0, char* lds, const Epi& epi) {
  const int tid = opaque_tid(), lane = tid & 63, wid = tid >> 6, wr = wid >> 1, wc = wid & 1, fr = lane & 15, fq = lane >> 4;
  const bf16_t* ag[4];
  const bf16_t* bg[4];
#pragma unroll
  for (int i = 0; i < 4; ++i) {
    const int id = i * 256 + tid, r = id >> 3, cp = id & 7, c = cp ^ ((r >> 1) & 7);
    ag[i] = A + (size_t)(row0 + r) * lda + c * 8;
    bg[i] = Bt + (size_t)(col0 + r) * ldb + c * 8;
  }
  f32x4 acc[4][4];
#pragma unroll
  for (int m = 0; m < 4; ++m)
#pragma unroll
    for (int n = 0; n < 4; ++n) acc[m][n] = (f32x4){0.f, 0.f, 0.f, 0.f};
  const int KT = K >> 6;
  auto stage = [&](int kt, int buf) {
    char* sa = lds + buf * 32768;
    char* sb = sa + 16384;
#pragma unroll
    for (int i = 0; i < 4; ++i) {
      __builtin_amdgcn_global_load_lds((const void __attribute__((address_space(1)))*)(ag[i] + kt * 64), (void LAS*)(sa + (i * 256 + tid) * 16), 16, 0, 0);
      __builtin_amdgcn_global_load_lds((const void __attribute__((address_space(1)))*)(bg[i] + kt * 64), (void LAS*)(sb + (i * 256 + tid) * 16), 16, 0, 0);
    }
  };
  __syncthreads();
  stage(0, 0);
  const int swz = fr >> 1;
  for (int kt = 0; kt < KT; ++kt) {
    asm volatile("s_waitcnt vmcnt(0)" ::: "memory");
    __syncthreads();
    if (kt + 1 < KT) stage(kt + 1, (kt + 1) & 1);
    const char* sa = lds + (kt & 1) * 32768 + (wr * 64 + fr) * 128;
    const char* sb = lds + (kt & 1) * 32768 + 16384 + (wc * 64 + fr) * 128;
#pragma unroll
    for (int kk = 0; kk < 2; ++kk) {
      bf16x8 a[4], b[4];
      const int co = ((kk * 4 + fq) ^ swz) * 16;
#pragma unroll
      for (int m = 0; m < 4; ++m) a[m] = *(const bf16x8*)(sa + m * 2048 + co);
#pragma unroll
      for (int n = 0; n < 4; ++n) b[n] = *(const bf16x8*)(sb + n * 2048 + co);
#pragma unroll
      for (int m = 0; m < 4; ++m)
#pragma unroll
        for (int n = 0; n < 4; ++n) acc[m][n] = __builtin_amdgcn_mfma_f32_16x16x32_bf16(b[n], a[m], acc[m][n], 0, 0, 0);
    }
  }
  epi(acc, row0 + wr * 64, col0 + wc * 64, fr, fq);
}

struct EpiP {
  bf16_t *PA, *PBC; float* SSQ;
  DI void operator()(const f32x4 (&acc)[4][4], int r0, int c0, int fr, int fq) const {
    bf16_t* base; int ld, cb;
    if (c0 < LDPA) { base = PA; ld = LDPA; cb = c0; } else { base = PBC; ld = LDPBC; cb = c0 - LDPA; }
    if (c0 >= LDPA && cb < 1024) {
      float* dst = SSQ + (cb < 768 ? 0 : T_TOK);
#pragma unroll
      for (int m = 0; m < 4; ++m) {
        float ss = 0.f;
#pragma unroll
        for (int n = 0; n < 4; ++n)
#pragma unroll
          for (int j = 0; j < 4; ++j) ss += acc[m][n][j] * acc[m][n][j];
        ss += __shfl_xor(ss, 16); ss += __shfl_xor(ss, 32);
        if (fq == 0) atomicAdd(dst + r0 + m * 16 + fr, ss);
      }
    }
#pragma unroll
    for (int m = 0; m < 4; ++m)
#pragma unroll
      for (int n = 0; n < 4; ++n) {
        u32x2 v = {pk_bf16(acc[m][n][0], acc[m][n][1]), pk_bf16(acc[m][n][2], acc[m][n][3])};
        *(u32x2*)(base + (size_t)(r0 + m * 16 + fr) * ld + cb + n * 16 + fq * 4) = v;
      }
  }
};

DI void rope_angle(int pos, int i, float& cs, float& sn) {
  const float invf = __builtin_amdgcn_exp2f(-(float)i * (13.287712379549449f / 8.f));
  float ang = (float)pos * invf;
  float n = rintf(ang * 0.15915494309189535f);
  float r = fmaf(-n, 6.28125f, ang);
  r = fmaf(-n, 1.9353071795864769e-3f, r);
  cs = __cosf(r); sn = __sinf(r);
}

struct EpiQ {
  const float *rstd, *gn, *gr, *rope; bf16_t* Q;
  DI void operator()(const f32x4 (&acc)[4][4], int r0, int c0, int fr, int fq) const {
    if (c0 >= 576) return;
    if (c0 < 384) {
      const int h = c0 >> 6;
#pragma unroll
      for (int m = 0; m < 4; ++m) {
        const int row = r0 + m * 16 + fr; const float rs = rsqrtf(rstd[row] * (1.f / 768.f) + EPSF);
        float ss = 0.f;
#pragma unroll
        for (int n = 0; n < 4; ++n)
#pragma unroll
          for (int j = 0; j < 4; ++j) { float v = acc[m][n][j] * rs; ss += v * v; }
        ss += __shfl_xor(ss, 16); ss += __shfl_xor(ss, 32);
        const float inv = rsqrtf(ss * (1.f / 64.f) + EPSF) * rs * QSCALE;
        const int b = row / TB, s = row % TB;
        bf16_t* dst = Q + ((size_t)(b * 6 + h) * TB + s) * 96;
#pragma unroll
        for (int n = 0; n < 4; ++n) {
          const int d = n * 16 + fq * 4; f32x4 g = *(const f32x4*)(gn + d);
          u32x2 v = {pk_bf16(acc[m][n][0] * inv * g[0], acc[m][n][1] * inv * g[1]), pk_bf16(acc[m][n][2] * inv * g[2], acc[m][n][3] * inv * g[3])};
          *(u32x2*)(dst + d) = v;
        }
      }
    } else {
#pragma unroll
      for (int m = 0; m < 4; ++m) {
        const int row = r0 + m * 16 + fr; const float rs = rsqrtf(rstd[row] * (1.f / 768.f) + EPSF);
        const int b = row / TB, s = row % TB; const bool lat = s >= NCTX; const int sp = s - NCTX;
#pragma unroll
        for (int hh = 0; hh < 2; ++hh) {
          const int h = ((c0 - 384) >> 5) + hh;
          float ss = 0.f;
#pragma unroll
          for (int nn = 0; nn < 2; ++nn)
#pragma unroll
            for (int j = 0; j < 4; ++j) { float v = acc[m][hh * 2 + nn][j] * rs; ss += v * v; }
          ss += __shfl_xor(ss, 16); ss += __shfl_xor(ss, 32);
          const float inv = rsqrtf(ss * (1.f / 32.f) + EPSF) * rs;
          bf16_t* dst = Q + ((size_t)(b * 6 + h) * TB + s) * 96 + 64;
#pragma unroll
          for (int nn = 0; nn < 2; ++nn) {
            const int d = nn * 16 + fq * 4; f32x4 g = *(const f32x4*)(gr + d);
            float o[4];
#pragma unroll
            for (int j = 0; j < 4; ++j) {
              float val = acc[m][hh * 2 + nn][j] * inv * g[j];
              float partner = __shfl_xor(val, 32);
              if (lat) {
                const float* rt = rope + ((nn == 0 ? (sp >> 6) : (sp & 63)) * 8 + ((fq * 4 + j) & 7)) * 2; const float cs = rt[0], sn = rt[1];
                val = fq < 2 ? val * cs - partner * sn : val * cs + partner * sn;
              }
              o[j] = val * QSCALE;
            }
            u32x2 v = {pk_bf16(o[0], o[1]), pk_bf16(o[2], o[3])};
            *(u32x2*)(dst + d) = v;
          }
        }
      }
    }
  }
};

struct EpiK {
  const float *rstd, *gk; bf16_t* Kt;
  DI void operator()(const f32x4 (&acc)[4][4], int r0, int c0, int fr, int fq) const {
    const int h = c0 >> 6;
#pragma unroll
    for (int m = 0; m < 4; ++m) {
      const int row = r0 + m * 16 + fr; const float rs = rsqrtf(rstd[row] * (1.f / 256.f) + EPSF);
      float ss = 0.f;
#pragma unroll
      for (int n = 0; n < 4; ++n)
#pragma unroll
        for (int j = 0; j < 4; ++j) { float v = acc[m][n][j] * rs; ss += v * v; }
      ss += __shfl_xor(ss, 16); ss += __shfl_xor(ss, 32);
      const float inv = rsqrtf(ss * (1.f / 64.f) + EPSF) * rs;
      const int b = row / TB, s = row % TB;
      bf16_t* dst = Kt + ((size_t)(b * 6 + h) * TB + s) * 96;
#pragma unroll
      for (int n = 0; n < 4; ++n) {
        const int d = n * 16 + fq * 4; f32x4 g = *(const f32x4*)(gk + d);
        u32x2 v = {pk_bf16(acc[m][n][0] * inv * g[0], acc[m][n][1] * inv * g[1]), pk_bf16(acc[m][n][2] * inv * g[2], acc[m][n][3] * inv * g[3])};
        *(u32x2*)(dst + d) = v;
      }
    }
  }
};

struct EpiV {
  const float* rstd; bf16_t* VT;
  DI void operator()(const f32x4 (&acc)[4][4], int r0, int c0, int fr, int fq) const {
#pragma unroll
    for (int m = 0; m < 4; ++m)
#pragma unroll
      for (int n = 0; n < 4; ++n) {
        const int row = r0 + m * 16 + fr, col = c0 + n * 16 + fq * 4;
        f32x4 rs = *(const f32x4*)(rstd + col);
#pragma unroll
        for (int j = 0; j < 4; ++j) rs[j] = rsqrtf(rs[j] * (1.f / 256.f) + EPSF);
        u32x2 v = {pk_bf16(acc[m][n][0] * rs[0], acc[m][n][1] * rs[1]), pk_bf16(acc[m][n][2] * rs[2], acc[m][n][3] * rs[3])};
        *(u32x2*)(VT + (size_t)row * T_TOK + col) = v;
      }
  }
};

struct EpiPost {
  const float *Y, *BON, *mu, *lnx_g, *lnx_b; const bf16_t* PA; bf16_t* YC;
  DI void operator()(const f32x4 (&acc)[4][4], int r0, int c0, int fr, int fq) const {
    const int h = c0 >> 6;
#pragma unroll
    for (int m = 0; m < 4; ++m) {
      const int row = r0 + m * 16 + fr; const int s = row % TB;
      const bool hasprev = (s != 0 && s != NCTX), hasnext = (s != NCTX - 1 && s != TB - 1);
      f32x4 y[4];
      float s1 = 0.f;
#pragma unroll
      for (int n = 0; n < 4; ++n) {
        const size_t o = (size_t)row * 384 + c0 + n * 16 + fq * 4;
        y[n] = *(const f32x4*)(Y + o) + *(const f32x4*)(Y + (size_t)T_TOK * 384 + o);
        s1 += y[n][0] + y[n][1] + y[n][2] + y[n][3];
      }
      s1 += __shfl_xor(s1, 16); s1 += __shfl_xor(s1, 32);
      const float mean = s1 * (1.f / 64.f);
      float s2 = 0.f;
#pragma unroll
      for (int n = 0; n < 4; ++n)
#pragma unroll
        for (int j = 0; j < 4; ++j) { float d = y[n][j] - mean; s2 += d * d; }
      s2 += __shfl_xor(s2, 16); s2 += __shfl_xor(s2, 32);
      const float rstdv = rsqrtf(s2 * (1.f / 64.f) + GN_EPS);
      const float bon = BON[(size_t)row * 6 + h] + BON[(size_t)T_TOK * 6 + (size_t)row * 6 + h];
#pragma unroll
      for (int n = 0; n < 4; ++n) {
        const int col = c0 + n * 16 + fq * 4;
        const bf16_t* pv = PA + (size_t)row * LDPA + 768 + col;
        float vc[4], vp[4] = {0.f, 0.f, 0.f, 0.f}, vn[4] = {0.f, 0.f, 0.f, 0.f};
        unpack4(*(const u32x2*)pv, vc);
        if (hasprev) unpack4(*(const u32x2*)(pv - LDPA), vp);
        if (hasnext) unpack4(*(const u32x2*)(pv + LDPA), vn);
        f32x4 m0 = *(const f32x4*)(mu + 768 + col), m1 = *(const f32x4*)(mu + LDPA + 768 + col);
        f32x4 lg = *(const f32x4*)(lnx_g + col), lb = *(const f32x4*)(lnx_b + col);
        float o[4];
#pragma unroll
        for (int j = 0; j < 4; ++j) {
          const float v = vc[j] + m0[j] * (vp[j] - vc[j]) + m1[j] * (vn[j] - vc[j]);
          o[j] = ((y[n][j] - mean) * rstdv * lg[j] + lb[j] + bon * v) * acc[m][n][j];
        }
        u32x2 w = {pk_bf16(o[0], o[1]), pk_bf16(o[2], o[3])};
        *(u32x2*)(YC + (size_t)row * DM + col) = w;
      }
    }
  }
};

struct EpiRes {
  const Params* p; int l; bool from_inputs; int gate_off;
  DI void operator()(const f32x4 (&acc)[4][4], int r0, int c0, int fr, int fq) const {
#pragma unroll
    for (int m = 0; m < 4; ++m) {
      const int row = r0 + m * 16 + fr; const int b = row / TB, s = row % TB;
      const float* src = xsrc_row(*p, from_inputs, b, s);
      float* dst = xdst_row(*p, b, s);
      const float* gate = p->MOD + (size_t)(l * 9 + (s < NCTX ? 8 : b)) * 6144 + gate_off;
#pragma unroll
      for (int n = 0; n < 4; ++n) {
        const int col = c0 + n * 16 + fq * 4;
        f32x4 g = *(const f32x4*)(gate + col), xv = *(const f32x4*)(src + col);
        *(f32x4*)(dst + col) = xv + g * acc[m][n];
      }
    }
  }
};

struct EpiFfnIn {
  bf16_t* ACT;
  DI void operator()(const f32x4 (&acc)[4][4], int r0, int c0, int fr, int fq) const {
    const int cb = (c0 >> 6) * 32;
#pragma unroll
    for (int m = 0; m < 4; ++m)
#pragma unroll
      for (int n = 0; n < 2; ++n) {
        float o[4];
#pragma unroll
        for (int j = 0; j < 4; ++j) { float g = acc[m][n][j]; o[j] = g / (1.f + __expf(-g)) * acc[m][n + 2][j]; }
        u32x2 w = {pk_bf16(o[0], o[1]), pk_bf16(o[2], o[3])};
        *(u32x2*)(ACT + (size_t)(r0 + m * 16 + fr) * 2816 + cb + n * 16 + fq * 4) = w;
      }
  }
};

DI void prep_token(const Params& p, int l, int row, int lane) {
  const int b = row / TB, s = row % TB;
  const bool hasprev = (s != 0 && s != NCTX), hasnext = (s != NCTX - 1 && s != TB - 1);
  const float mp = hasprev ? 1.f : 0.f, mn = hasnext ? 1.f : 0.f;
  const bf16_t* pa = p.PA + (size_t)row * LDPA;
  const bf16_t* pbc = p.PBC + (size_t)row * LDPBC;
  const int opa = hasprev ? -LDPA : 0, ona = hasnext ? LDPA : 0, opb = hasprev ? -LDPBC : 0, onb = hasnext ? LDPBC : 0;
  const int l32 = lane & 31, c8 = l32 * 8, colA = 1152 + c8;
  const u32x4 la_c = *(const u32x4*)(pa + colA), la_p = *(const u32x4*)(pa + opa + colA), la_n = *(const u32x4*)(pa + ona + colA);
  const u32x4 lq0 = *(const u32x4*)(pbc + lane * 8), lq1 = *(const u32x4*)(pbc + 512 + c8), lkv = *(const u32x4*)(pbc + 768 + c8);
  const u32x4 lrp = *(const u32x4*)(pbc + 1024 + (lane & 3) * 8);
  const u32x4 lbg = *(const u32x4*)(pbc + 1056 + c8), lcc = *(const u32x4*)(pbc + 1312 + c8), lhh = *(const u32x4*)(pbc + 1568 + c8);
  const u32x4 lcp = *(const u32x4*)(pbc + opb + 1312 + c8), lhp = *(const u32x4*)(pbc + opb + 1568 + c8);
  const u32x4 lcn = *(const u32x4*)(pbc + onb + 1312 + c8), lhn = *(const u32x4*)(pbc + onb + 1568 + c8);
  const float* mu = p.tshift_mu + (size_t)l * 2 * LDPA;
  {
    float c[8], pv[8], nx[8], o[8];
    unpack8(la_c, c); unpack8(la_p, pv); unpack8(la_n, nx);
    const f32x4 m0a = *(const f32x4*)(mu + colA), m0b = *(const f32x4*)(mu + colA + 4), m1a = *(const f32x4*)(mu + LDPA + colA), m1b = *(const f32x4*)(mu + LDPA + colA + 4);
#pragma unroll
    for (int j = 0; j < 8; ++j) {
      const float m0 = j < 4 ? m0a[j & 3] : m0b[j & 3], m1 = j < 4 ? m1a[j & 3] : m1b[j & 3];
      float t = c[j] + m0 * (pv[j] * mp - c[j]) + m1 * (nx[j] * mn - c[j]);
      if (l32 < 8) { float e = __expf(2.f * t); t = 1.f - 2.f * __builtin_amdgcn_rcpf(1.f + e); }
      else if (l32 >= 16) t = __builtin_amdgcn_rcpf(1.f + __expf(-t));
      o[j] = t;
    }
    u32x4 w = {pk_bf16(o[0], o[1]), pk_bf16(o[2], o[3]), pk_bf16(o[4], o[5]), pk_bf16(o[6], o[7])};
    if (lane < 8) *(u32x4*)(p.TW + (size_t)row * 64 + lane * 8) = w;
    else if (lane < 16) *(u32x4*)(p.TA + (size_t)row * 64 + (lane - 8) * 8) = w;
    else if (lane < 32) *(u32x4*)(p.TG + (size_t)row * 128 + (lane - 16) * 8) = w;
  }
  float f[8], ss = 0.f, s2 = 0.f, s3 = 0.f, fr_[8];
  unpack8(lq0, f);
#pragma unroll
  for (int j = 0; j < 8; ++j) ss += f[j] * f[j];
  unpack8(lq1, f);
  if (lane < 32) {
#pragma unroll
    for (int j = 0; j < 8; ++j) ss += f[j] * f[j];
  }
  unpack8(lkv, f);
  if (lane < 32) {
#pragma unroll
    for (int j = 0; j < 8; ++j) s2 += f[j] * f[j];
  }
  unpack8(lrp, fr_);
  if (lane < 4) {
#pragma unroll
    for (int j = 0; j < 8; ++j) s3 += fr_[j] * fr_[j];
  }
  s3 += __shfl_xor(s3, 1); s3 += __shfl_xor(s3, 2);
  {
    const float inv = rsqrtf(s3 * (1.f / 32.f) + EPSF);
    const float* g = p.k_rope_g + l * 32;
    const bool lat = s >= NCTX; const int sp = lat ? s - NCTX : 0;
    const float* rt = p.ROPE + ((lane & 2) ? (sp & 63) : (sp >> 6)) * 16;
    float o[8];
#pragma unroll
    for (int j = 0; j < 8; ++j) {
      float val = fr_[j] * inv * g[(lane & 3) * 8 + j];
      float partner = __shfl_xor(val, 1);
      if (lat) {
        const float cs = rt[2 * j], sn = rt[2 * j + 1];
        val = (lane & 1) == 0 ? val * cs - partner * sn : val * cs + partner * sn;
      }
      o[j] = val;
    }
    if (lane < 4) {
      u32x4 w = {pk_bf16(o[0], o[1]), pk_bf16(o[2], o[3]), pk_bf16(o[4], o[5]), pk_bf16(o[6], o[7])};
#pragma unroll
      for (int hh = 0; hh < 6; ++hh) *(u32x4*)(p.Kt + ((size_t)(b * 6 + hh) * TB + s) * 96 + 64 + lane * 8) = w;
    }
  }
  {
    float bg[8], cc[8], hh[8], cp[8], hp[8], cn[8], hn[8], o[8];
    unpack8(lbg, bg); unpack8(lcc, cc); unpack8(lhh, hh); unpack8(lcp, cp); unpack8(lhp, hp); unpack8(lcn, cn); unpack8(lhn, hn);
    const float* cw = p.conv_w + (size_t)l * 3 * 256;
#pragma unroll
    for (int j = 0; j < 8; ++j) o[j] = bg[j] * (cw[c8 + j] * cp[j] * hp[j] * mp + cw[256 + c8 + j] * cc[j] * hh[j] + cw[512 + c8 + j] * cn[j] * hn[j] * mn);
    u32x4 w = {pk_bf16(o[0], o[1]), pk_bf16(o[2], o[3]), pk_bf16(o[4], o[5]), pk_bf16(o[6], o[7])};
    if (lane < 32) *(u32x4*)(p.HY + (size_t)row * DM + 768 + c8) = w;
  }
}

#define MFMA32(a, b, c) __builtin_amdgcn_mfma_f32_32x32x16_bf16((a), (b), (c), 0, 0, 0)
DI bf16x8 pack8(const f32x16& x, int s) {
  u32x4 v = {pk_bf16(x[8 * s], x[8 * s + 1]), pk_bf16(x[8 * s + 2], x[8 * s + 3]), pk_bf16(x[8 * s + 4], x[8 * s + 5]), pk_bf16(x[8 * s + 6], x[8 * s + 7])};
  return __builtin_bit_cast(bf16x8, v);
}
constexpr int KROW = 208, VROW = 136, KBUF = 64 * KROW, VBUF = 64 * VROW;
DI void attn_task(const Params& p, int b, int h, int q0, int k0, int nk, char* lds) {
  const int tid = opaque_tid(), lane = tid & 63, wid = tid >> 6, r = lane & 31, hh = lane >> 5;
  const bf16_t* Qp = p.Q + ((size_t)(b * 6 + h) * TB + q0 + wid * 32 + r) * 96;
  const bf16_t* Kp = p.Kt + ((size_t)(b * 6 + h) * TB + k0) * 96;
  const bf16_t* Vp = p.VT + (size_t)(h * 64) * T_TOK + (size_t)b * TB + k0;
  bf16x8 qf[6];
#pragma unroll
  for (int ks = 0; ks < 6; ++ks) qf[ks] = *(const bf16x8*)(Qp + ks * 16 + hh * 8);
  int krow_[3], kch_[3];
#pragma unroll
  for (int i = 0; i < 3; ++i) { int id = tid + i * 256; krow_[i] = id / 12; kch_[i] = id % 12; }
  const int vd0 = tid >> 3, vch = tid & 7;
  u32x4 kreg[3], vreg[2];
  auto load_regs = [&](int kt) {
#pragma unroll
    for (int i = 0; i < 3; ++i) kreg[i] = *(const u32x4*)(Kp + (size_t)(kt * 64 + krow_[i]) * 96 + kch_[i] * 8);
#pragma unroll
    for (int i = 0; i < 2; ++i) vreg[i] = *(const u32x4*)(Vp + (size_t)(vd0 + 32 * i) * T_TOK + kt * 64 + vch * 8);
  };
  auto write_lds = [&](int buf) {
    char* kb = lds + buf * (KBUF + VBUF);
    char* vb = kb + KBUF;
#pragma unroll
    for (int i = 0; i < 3; ++i) *(u32x4*)(kb + krow_[i] * KROW + kch_[i] * 16) = kreg[i];
#pragma unroll
    for (int i = 0; i < 2; ++i) {
      char* d = vb + (vd0 + 32 * i) * VROW + vch * 16;
      *(u32x2*)d = (u32x2){vreg[i][0], vreg[i][1]};
      *(u32x2*)(d + 8) = (u32x2){vreg[i][2], vreg[i][3]};
    }
  };
  f32x16 o[2];
#pragma unroll
  for (int i = 0; i < 16; ++i) { o[0][i] = 0.f; o[1][i] = 0.f; }
  float m_run = -1e30f, l_run = 0.f;
  const int NT = nk >> 6;
  __syncthreads();
  load_regs(0);
  write_lds(0);
  for (int kt = 0; kt < NT; ++kt) {
    if (kt + 1 < NT) load_regs(kt + 1);
    __syncthreads();
    const char* kb = lds + (kt & 1) * (KBUF + VBUF);
    const char* vb = kb + KBUF;
    f32x16 st[2];
#pragma unroll
    for (int kbk = 0; kbk < 2; ++kbk) {
#pragma unroll
      for (int i = 0; i < 16; ++i) st[kbk][i] = 0.f;
#pragma unroll
      for (int ks = 0; ks < 6; ++ks) {
        bf16x8 kf = *(const bf16x8*)(kb + (kbk * 32 + r) * KROW + ks * 32 + hh * 16);
        st[kbk] = MFMA32(kf, qf[ks], st[kbk]);
      }
    }
    float mx = st[0][0];
#pragma unroll
    for (int i = 0; i < 16; ++i) { mx = fmaxf(mx, st[0][i]); mx = fmaxf(mx, st[1][i]); }
    mx = fmaxf(mx, __shfl_xor(mx, 32));
    const float m_new = fmaxf(m_run, mx);
    const float alpha = __builtin_amdgcn_exp2f(m_run - m_new);
    m_run = m_new;
    float psum = 0.f;
#pragma unroll
    for (int kbk = 0; kbk < 2; ++kbk)
#pragma unroll
      for (int i = 0; i < 16; ++i) { float e = __builtin_amdgcn_exp2f(st[kbk][i] - m_new); st[kbk][i] = e; psum += e; }
    psum += __shfl_xor(psum, 32);
    l_run = l_run * alpha + psum;
#pragma unroll
    for (int i = 0; i < 16; ++i) { o[0][i] *= alpha; o[1][i] *= alpha; }
#pragma unroll
    for (int ksv = 0; ksv < 4; ++ksv) {
      const bf16x8 pf = pack8(st[ksv >> 1], ksv & 1);
#pragma unroll
      for (int db = 0; db < 2; ++db) {
        const char* va = vb + (db * 32 + r) * VROW + (ksv * 16 + 4 * hh) * 2;
        s16x4 lo = *(const s16x4*)va, hi = *(const s16x4*)(va + 16);
        bf16x8 vf = __builtin_shufflevector(lo, hi, 0, 1, 2, 3, 4, 5, 6, 7);
        o[db] = MFMA32(vf, pf, o[db]);
      }
    }
    if (kt + 1 < NT) write_lds((kt + 1) & 1);
  }
  const float invl = 1.f / l_run;
  bf16_t* dst = p.HY + (size_t)(b * TB + q0 + wid * 32 + r) * DM + 384 + h * 64;
#pragma unroll
  for (int db = 0; db < 2; ++db)
#pragma unroll
    for (int g = 0; g < 4; ++g) {
      u32x2 w = {pk_bf16(o[db][4 * g] * invl, o[db][4 * g + 1] * invl), pk_bf16(o[db][4 * g + 2] * invl, o[db][4 * g + 3] * invl)};
      *(u32x2*)(dst + db * 32 + 8 * g + 4 * hh) = w;
    }
}

enum { VW = 0, VKK = 1, VB = 2, VKD = 3, VR = 4, VV = 5 };
DI void scan_task(const Params& p, int l, int b, int h, int dir, int half, char* lds) {
  float* cb = (float*)lds;
  float* tk = cb + 6 * 1024;
  float* ybuf = tk + 1024;
  const int tid = opaque_tid(), lane = tid & 63, wid = tid >> 6;
  const int st_p = tid >> 4, c4 = tid & 15;
  const int fr = lane & 15, fq = lane >> 4;
  const int rp = lane >> 4, g = lane & 15;
  const int hc = h * 64;
  bf16x8 bw[2], ba[2];
  {
    const bf16_t* wd = p.Wdecay + ((size_t)dir * 384 + hc + wid * 16 + fr) * 64;
    const bf16_t* wi = p.Wicl + ((size_t)dir * 384 + hc + wid * 16 + fr) * 64;
#pragma unroll
    for (int ks = 0; ks < 2; ++ks) { bw[ks] = *(const bf16x8*)(wd + ks * 32 + fq * 8); ba[ks] = *(const bf16x8*)(wi + ks * 32 + fq * 8); }
  }
  f32x4 mu0[3], mu1[3];
  const float* mu = p.tshift_mu + (size_t)l * 2 * LDPA;
#pragma unroll
  for (int sec = 0; sec < 3; ++sec) { mu0[sec] = *(const f32x4*)(mu + sec * 384 + hc + c4 * 4); mu1[sec] = *(const f32x4*)(mu + LDPA + sec * 384 + hc + c4 * 4); }
  const f32x4 kkg = *(const f32x4*)(p.k_k + l * 384 + hc + c4 * 4);
  const f32x4 rkg = *(const f32x4*)(p.r_k + l * 384 + hc + c4 * 4);
  const int colB = wid * 16 + fq * 4;
  const f32x4 w0 = *(const f32x4*)(p.decay_w0 + (size_t)(l * 2 + dir) * 384 + hc + colB);
  const f32x4 a0 = *(const f32x4*)(p.icl_a0 + (size_t)(l * 2 + dir) * 384 + hc + colB);
  const f32x4 kag = *(const f32x4*)(p.k_a + l * 384 + hc + colB);

  u32x2 ld[3][3];
  float mprev = 0.f, mnext = 0.f;
  bf16x8 aw[2], aa[2];
  auto chunk_lo = [&](int c) -> int { return dir == 0 ? 16 * c : (c < 16 ? 240 - 16 * c : 2544 - 16 * c); };
  auto issue_loads = [&](int c) {
    const int slo = chunk_lo(c);
    const int s = slo + st_p;
    const bool hasprev = (s != 0 && s != NCTX), hasnext = (s != NCTX - 1 && s != TB - 1);
    const bf16_t* pa = p.PA + (size_t)(b * TB + s) * LDPA + hc + c4 * 4;
    const int op = hasprev ? -LDPA : 0, on = hasnext ? LDPA : 0;
    mprev = hasprev ? 1.f : 0.f; mnext = hasnext ? 1.f : 0.f;
#pragma unroll
    for (int sec = 0; sec < 3; ++sec) {
      ld[sec][1] = *(const u32x2*)(pa + sec * 384);
      ld[sec][0] = *(const u32x2*)(pa + sec * 384 + op);
      ld[sec][2] = *(const u32x2*)(pa + sec * 384 + on);
    }
    const size_t trow = (size_t)(b * TB + slo + fr) * 64;
#pragma unroll
    for (int ks = 0; ks < 2; ++ks) { aw[ks] = *(const bf16x8*)(p.TW + trow + ks * 32 + fq * 8); aa[ks] = *(const bf16x8*)(p.TA + trow + ks * 32 + fq * 8); }
  };
  auto produce = [&](int c) {
    const int slo = chunk_lo(c);
    float ts[3][4];
#pragma unroll
    for (int sec = 0; sec < 3; ++sec) {
      float pc[4], pp[4], pn[4];
      unpack4(ld[sec][1], pc); unpack4(ld[sec][0], pp); unpack4(ld[sec][2], pn);
#pragma unroll
      for (int j = 0; j < 4; ++j) ts[sec][j] = pc[j] + mu0[sec][j] * (pp[j] * mprev - pc[j]) + mu1[sec][j] * (pn[j] * mnext - pc[j]);
    }
    *(f32x4*)(cb + VR * 1024 + st_p * 64 + c4 * 4) = (f32x4){ts[0][0], ts[0][1], ts[0][2], ts[0][3]};
    *(f32x4*)(cb + VV * 1024 + st_p * 64 + c4 * 4) = (f32x4){ts[2][0], ts[2][1], ts[2][2], ts[2][3]};
    *(f32x4*)(tk + st_p * 64 + c4 * 4) = (f32x4){ts[1][0], ts[1][1], ts[1][2], ts[1][3]};
    float kx[4], ss = 0.f;
#pragma unroll
    for (int j = 0; j < 4; ++j) { kx[j] = ts[1][j] * kkg[j]; ss += kx[j] * kx[j]; }
    ss = red16(ss);
    const float inv = rsqrtf(ss + 1e-12f);
    *(f32x4*)(cb + VKK * 1024 + st_p * 64 + c4 * 4) = (f32x4){kx[0] * inv, kx[1] * inv, kx[2] * inv, kx[3] * inv};
    __syncthreads();
    f32x4 dw = {0.f, 0.f, 0.f, 0.f}, da = {0.f, 0.f, 0.f, 0.f};
#pragma unroll
    for (int ks = 0; ks < 2; ++ks) {
      dw = __builtin_amdgcn_mfma_f32_16x16x32_bf16(bw[ks], aw[ks], dw, 0, 0, 0);
      da = __builtin_amdgcn_mfma_f32_16x16x32_bf16(ba[ks], aa[ks], da, 0, 0, 0);
    }
    {
      const f32x4 kv = *(const f32x4*)(tk + fr * 64 + colB);
      const f32x4 kkv = *(const f32x4*)(cb + VKK * 1024 + fr * 64 + colB);
      f32x4 wv, kdv, bv;
#pragma unroll
      for (int j = 0; j < 4; ++j) {
        wv[j] = __expf(-LOG_DECAY_SCALE * sigmoidf_(w0[j] + dw[j]));
        const float a = sigmoidf_(a0[j] + da[j]);
        kdv[j] = kv[j] * (1.f + (a - 1.f) * kag[j]);
        bv[j] = kkv[j] * a;
      }
      *(f32x4*)(cb + VW * 1024 + fr * 64 + colB) = wv;
      *(f32x4*)(cb + VKD * 1024 + fr * 64 + colB) = kdv;
      *(f32x4*)(cb + VB * 1024 + fr * 64 + colB) = bv;
    }
    __syncthreads();
    {
      const f32x4 rv = *(const f32x4*)(cb + VR * 1024 + st_p * 64 + c4 * 4);
      const f32x4 kdv = *(const f32x4*)(cb + VKD * 1024 + st_p * 64 + c4 * 4);
      float bs = rv[0] * kdv[0] * rkg[0] + rv[1] * kdv[1] * rkg[1] + rv[2] * kdv[2] * rkg[2] + rv[3] * kdv[3] * rkg[3];
      bs = red16(bs);
      if (c4 == 0 && half == 0) p.BON[(size_t)dir * T_TOK * 6 + (size_t)(b * TB + slo + st_p) * 6 + h] = bs;
    }
  };

  f32x2 S0[2], S1[2];
#pragma unroll
  for (int j = 0; j < 2; ++j) { S0[j] = (f32x2){0.f, 0.f}; S1[j] = (f32x2){0.f, 0.f}; }
  __syncthreads();
  issue_loads(0);
  produce(0);
  __syncthreads();
  const int NCH = TB / 16;
  const int rowl = half * 32 + wid * 8 + rp * 2;
  const int inc = dir ? -64 : 64;
  for (int c = 0; c < NCH; ++c) {
    if (c + 1 < NCH) issue_loads(c + 1);
    {
      const float* ps = cb + (dir ? 15 * 64 : 0) + g * 4;
      const float* pv = cb + VV * 1024 + (dir ? 15 * 64 : 0) + rowl;
      float* py = ybuf + (dir ? 15 * 512 : 0) + ((wid * 4 + rp) * 16 + g) * 2;
      f32x4 cw = *(const f32x4*)(ps + VW * 1024), ckk = *(const f32x4*)(ps + VKK * 1024), cbb = *(const f32x4*)(ps + VB * 1024),
            ckd = *(const f32x4*)(ps + VKD * 1024), crr = *(const f32x4*)(ps + VR * 1024);
      f32x2 cvv = *(const f32x2*)pv;
#pragma unroll
      for (int ii = 0; ii < 16; ++ii) {
        f32x4 nw = cw, nkk = ckk, nbb = cbb, nkd = ckd, nrr = crr; f32x2 nvv = cvv;
        if (ii < 15) {
          ps += inc; pv += inc;
          nw = *(const f32x4*)(ps + VW * 1024); nkk = *(const f32x4*)(ps + VKK * 1024); nbb = *(const f32x4*)(ps + VB * 1024);
          nkd = *(const f32x4*)(ps + VKD * 1024); nrr = *(const f32x4*)(ps + VR * 1024); nvv = *(const f32x2*)pv;
        }
        __builtin_amdgcn_sched_barrier(0x7);
        const f32x2 kk0 = {ckk[0], ckk[1]}, kk1 = {ckk[2], ckk[3]}, w0 = {cw[0], cw[1]}, w1 = {cw[2], cw[3]};
        const f32x2 b0 = {cbb[0], cbb[1]}, b1 = {cbb[2], cbb[3]}, kd0 = {ckd[0], ckd[1]}, kd1 = {ckd[2], ckd[3]};
        const f32x2 r0 = {crr[0], crr[1]}, r1 = {crr[2], crr[3]};
        const f32x2 p0 = S0[0] * kk0 + S0[1] * kk1, p1 = S1[0] * kk0 + S1[1] * kk1;
        const f32x2 u00 = S0[0] * w0 + kd0 * cvv[0], u01 = S0[1] * w1 + kd1 * cvv[0];
        const f32x2 u10 = S1[0] * w0 + kd0 * cvv[1], u11 = S1[1] * w1 + kd1 * cvv[1];
        const float q0 = red16(p0[0] + p0[1]), q1 = red16(p1[0] + p1[1]);
        S0[0] = u00 - b0 * q0; S0[1] = u01 - b1 * q0;
        S1[0] = u10 - b0 * q1; S1[1] = u11 - b1 * q1;
        const f32x2 y0 = S0[0] * r0 + S0[1] * r1, y1 = S1[0] * r0 + S1[1] * r1;
        *(f32x2*)py = (f32x2){y0[0] + y0[1], y1[0] + y1[1]};
        py += dir ? -512 : 512;
        cw = nw; ckk = nkk; cbb = nbb; ckd = nkd; crr = nrr; cvv = nvv;
      }
    }
    __syncthreads();
    {
      const int slo = chunk_lo(c);
      const float* yp = ybuf + (st_p * 16 + c4) * 32;
      f32x4 a = *(const f32x4*)yp;
#pragma unroll
      for (int i = 1; i < 8; ++i) a += *(const f32x4*)(yp + 4 * i);
      *(f32x2*)(p.Y + (size_t)dir * T_TOK * 384 + (size_t)(b * TB + slo + st_p) * 384 + hc + half * 32 + c4 * 2) = (f32x2){a[0] + a[2], a[1] + a[3]};
    }
    if (c + 1 < NCH) produce(c + 1);
    __syncthreads();
  }
}

DI int lat_tile(int i) { return (i >> 4) * 18 + 2 + (i & 15); }

template <int KSEL> DI void run_phase(const Params& p, int ph, char* lds) {
  const int bid = blockIdx.x, G = gridDim.x, tid = opaque_tid(), lane = tid & 63, wid = tid >> 6;
  if (ph == 0) {
    if (KSEL >= 0 && KSEL != 10) return;
    for (int t = bid; t < 384 + NCONV_W1 + 1; t += G) {
      if (t < 384) adaln_task(p, t, lds);
      else if (t < 384 + NCONV_W1) conv_w1_task(p, 0, t - 384, lds);
      else { for (int e = tid; e < 512; e += 256) { float cs, sn; rope_angle(e >> 3, e & 7, cs, sn); p.ROPE[2 * e] = cs; p.ROPE[2 * e + 1] = sn; } }
    }
    return;
  }
  if (KSEL == 10) return;
  const int l = (ph - 1) / 9, kq = (ph - 1) % 9, k = kq < 2 ? kq : kq + 1;
  const bool last = (l == 1);
  const int lb = ((G & 7) == 0) ? (bid & 7) * (G >> 3) + (bid >> 3) : bid;
  if (KSEL >= 0 && KSEL != 10 && k != (KSEL == 11 ? 4 : KSEL)) return;
  switch (k) {
    case 0:
      for (int i = bid * 256 + tid; i < 2 * T_TOK; i += G * 256) p.RSTD[i] = 0.f;
      modnorm_rows(p, l, 0, l == 0, false, bid * 4 + wid, G * 4, lane);
      break;
    case 1: {
      EpiP e{p.PA, p.PBC, p.RSTD};
      for (int t = lb; t < 144 * 26; t += G) gemm_tile(p.HY, DM, p.Win, DM, DM, (t / 26) * 128, (t % 26) * 128, lds, e);
    } break;
    case 3: {
      const int nq = last ? 128 * 5 : 144 * 5;
      EpiQ eq{p.RSTD, p.q_nope_g + l * 64, p.q_rope_g + l * 32, p.ROPE, p.Q};
      EpiK ek{p.RSTD + T_TOK, p.k_nope_g + l * 64, p.Kt};
      EpiV ev{p.RSTD + T_TOK, p.VT};
      for (int t = bid; t < nq + 432 + 432 + T_TOK / 4; t += G) {
        if (t >= nq + 864) { prep_token(p, l, (t - nq - 864) * 4 + wid, lane); continue; }
        if (t < nq) { int i = t / 5; int tm = last ? lat_tile(i) : i; gemm_tile(p.PBC, LDPBC, p.Wuq, 768, 768, tm * 128, (t % 5) * 128, lds, eq); }
        else if (t < nq + 432) { int u = t - nq; gemm_tile(p.PBC + 768, LDPBC, p.WukvK, 256, 256, (u / 3) * 128, (u % 3) * 128, lds, ek); }
        else { int u = t - nq - 432; gemm_tile(p.WvT, 256, p.PBC + 768, LDPBC, 256, (u % 3) * 128, (u / 3) * 128, lds, ev); }
      }
    } break;
    case 4: {
      const int natt = 768 + (last ? 0 : 96);
      if (KSEL != 11) { if (bid < 192) { scan_task(p, l, bid / 24, (bid % 24) >> 2, (bid >> 1) & 1, bid & 1, lds); break; } if (KSEL == 4) break; }
      const int aoff = KSEL == 11 ? 0 : 192;
      if (KSEL == 11) {
        for (int t = bid; t < natt + NCONV_FF; t += G) {
          if (t < 768) { int bh = t >> 4, qb = t & 15; attn_task(p, bh / 6, bh % 6, NCTX + qb * 128, 0, TB, lds); }
          else if (t < natt) { int u = t - 768; int bh = u >> 1, qb = u & 1; attn_task(p, bh / 6, bh % 6, qb * 128, 0, NCTX, lds); }
          else conv_ff_task(p, l, t - natt, lds);
        }
      } else {
        volatile LAS unsigned* slot = (volatile LAS unsigned*)(lds + 65536 + 8);
        for (;;) {
          __syncthreads();
          if (tid == 0) *slot = __hip_atomic_fetch_add(p.BAR + 3456   + 64 * l, 1u, __ATOMIC_RELAXED, __HIP_MEMORY_SCOPE_AGENT);
          __syncthreads();
          const int t = (int)*slot;
          if (t >= natt + NCONV_FF) break;
          if (t < 768) { int bh = t >> 4, qb = t & 15; attn_task(p, bh / 6, bh % 6, NCTX + qb * 128, 0, TB, lds); }
          else if (t < natt) { int u = t - 768; int bh = u >> 1, qb = u & 1; attn_task(p, bh / 6, bh % 6, qb * 128, 0, NCTX, lds); }
          else conv_ff_task(p, l, t - natt, lds);
        }
      }
    } break;
    case 5: {
      EpiPost e{p.Y, p.BON, p.tshift_mu + (size_t)l * 2 * LDPA, p.lnx_g + l * 384, p.lnx_b + l * 384, p.PA, p.HY};
      const int nm = last ? 128 : 144;
      for (int t = bid; t < nm * 3; t += G) { int i = t / 3; int tm = last ? lat_tile(i) : i; gemm_tile(p.TG, 128, p.Wgate, 128, 128, tm * 128, (t % 3) * 128, lds, e); }
    } break;
    case 6: {
      EpiRes e{&p, l, l == 0, 2 * 1024};
      const int nm = last ? 128 : 144;
      for (int t = lb; t < nm * 8; t += G) { int i = t / 8; int tm = last ? lat_tile(i) : i; gemm_tile(p.HY, DM, p.Wout, DM, DM, tm * 128, (t % 8) * 128, lds, e); }
    } break;
    case 7:
      modnorm_rows(p, l, 1, false, last, bid * 4 + wid, G * 4, lane);
      break;
    case 8: {
      EpiFfnIn e{p.ACT};
      const int nm = last ? 128 : 144;
      const int nconv = last ? 0 : NCONV_W1;
      for (int t = lb; t < nm * 44 + nconv; t += G) {
        if (t < nm * 44) { int i = t / 44; int tm = last ? lat_tile(i) : i; gemm_tile(p.HY, DM, p.Wffi, DM, DM, tm * 128, (t % 44) * 128, lds, e); }
        else conv_w1_task(p, 1, t - nm * 44, lds);
      }
    } break;
    case 9: {
      EpiRes e{&p, l, false, 5 * 1024};
      const int nm = last ? 128 : 144;
      for (int t = lb; t < nm * 8; t += G) { int i = t / 8; int tm = last ? lat_tile(i) : i; gemm_tile(p.ACT, 2816, p.Wffo, 2816, 2816, tm * 128, (t % 8) * 128, lds, e); }
    } break;
  }
}


#define XB_TMO      128
#define XB_XCNT(j)  (256  + 64 * (j))
#define XB_XSUB(j)  (1280 + 64 * (j))
#define XB_XGEN(j)  (2304 + 64 * (j))
#define XB_TOP      3328
#define XB_TOPGEN   3392
#define XCD_BAR_WORDS 3456
#define XB_SPIN_CAP (1u << 20)
DI unsigned xb_ld(unsigned* p) { return __hip_atomic_load(p, __ATOMIC_RELAXED, __HIP_MEMORY_SCOPE_AGENT); }
DI unsigned xb_add(unsigned* p, unsigned v) { return __hip_atomic_fetch_add(p, v, __ATOMIC_RELAXED, __HIP_MEMORY_SCOPE_AGENT); }
DI unsigned xb_xcc_id() { return (unsigned)__builtin_amdgcn_s_getreg((3 << 11) | 20) & 0xFu; }
#define XB_SPIN(cond, bar) do { unsigned _sp = 0; while (cond) { __builtin_amdgcn_s_sleep(1); \
    if ((++_sp & 255u) == 0u) { if (xb_ld(&(bar)[XB_TMO])) break; if (_sp > XB_SPIN_CAP) { atomicAdd(&(bar)[XB_TMO], 1u); break; } } } } while (0)
struct XcdBarrier { unsigned* bar; unsigned x; volatile LAS unsigned* st; };
DI XcdBarrier xcd_barrier_post(unsigned* bar, volatile LAS unsigned* st) {
  XcdBarrier b; b.bar = bar; b.x = xb_xcc_id(); b.st = st;
  if (threadIdx.x == 0) (void)xb_add(&bar[XB_XCNT(b.x)], 1u);
  return b;
}
DI void xcd_barrier_complete(unsigned* bar, unsigned x, unsigned& nloc, unsigned& nx) {
  const unsigned G = gridDim.x * gridDim.y * gridDim.z;
  unsigned sum, cnt, mine, sp = 0u;
  for (;;) {
    sum = 0u; cnt = 0u; mine = 0u;
#pragma unroll
    for (unsigned j = 0; j < 16; ++j) { const unsigned c = xb_ld(&bar[XB_XCNT(j)]); sum += c; cnt += (c > 0u) ? 1u : 0u; mine = (j == x) ? c : mine; }
    if (sum == G) break;
    __builtin_amdgcn_s_sleep(1);
    if ((++sp & 255u) == 0u) { if (xb_ld(&bar[XB_TMO])) break; if (sp > XB_SPIN_CAP) { atomicAdd(&bar[XB_TMO], 1u); break; } }
  }
  nloc = mine > 0u ? mine : 1u; nx = cnt > 0u ? cnt : 1u;
}
DI void xcd_barrier(const XcdBarrier& b) {
  asm volatile("s_waitcnt vmcnt(0)" ::: "memory");
  __syncthreads();
  if (threadIdx.x == 0) {
    unsigned* bar = b.bar;
    __builtin_amdgcn_s_waitcnt(0);
    unsigned nloc = b.st[0], nx = b.st[1];
    if (nloc == 0u) { xcd_barrier_complete(bar, b.x, nloc, nx); b.st[0] = nloc; b.st[1] = nx; }
    const unsigned old = xb_add(&bar[XB_XSUB(b.x)], 1u);
    const unsigned gen = old / nloc;
    if (old + 1u == (gen + 1u) * nloc) {
      __builtin_amdgcn_fence(__ATOMIC_RELEASE, "agent");
      asm volatile("s_waitcnt vmcnt(0)" ::: "memory");
      const unsigned og = xb_add(&bar[XB_TOP], 1u);
      const unsigned tg = og / nx;
      if (og + 1u == (tg + 1u) * nx) xb_add(&bar[XB_TOPGEN], 1u);
      else XB_SPIN(xb_ld(&bar[XB_TOPGEN]) == tg, bar);
      __builtin_amdgcn_fence(__ATOMIC_ACQUIRE, "agent");
      xb_add(&bar[XB_XGEN(b.x)], 1u);
      asm volatile("s_waitcnt vmcnt(0)" ::: "memory");
    } else {
      XB_SPIN(xb_ld(&bar[XB_XGEN(b.x)]) == gen, bar);
      __builtin_amdgcn_fence(__ATOMIC_ACQUIRE, "agent");
      asm volatile("s_waitcnt vmcnt(0)" ::: "memory");
    }
  }
  __syncthreads();
}

constexpr int NPHASE = 19;
#if !MULTI_LAUNCH
__global__ void __launch_bounds__(256, 2) mega(Params p, int ph_lo, int ph_hi) {
  __shared__ __attribute__((aligned(16))) char lds[65536 + 16];
  cg::grid_group grid = cg::this_grid();
  volatile LAS unsigned* st = (volatile LAS unsigned*)(lds + 65536);
  if (threadIdx.x == 0) { st[0] = 0u; st[1] = 0u; }
  if (blockIdx.x == 0) for (int i = threadIdx.x; i < XCD_BAR_WORDS + 128; i += 256) p.BAR[i] = 0u;
  __syncthreads();
  XcdBarrier xb;
  for (int ph = ph_lo; ph < ph_hi; ++ph) {
    if (ph == ph_lo + 1) { grid.sync(); xb = xcd_barrier_post(p.BAR, st); }
    else if (ph > ph_lo + 1) xcd_barrier(xb);
    run_phase<-1>(p, ph, lds);
  }
}
#endif
template <int KSEL> __global__ void __launch_bounds__(256, 2) phase_k(Params p, int ph) {
  __shared__ __attribute__((aligned(16))) char lds[65536];
  run_phase<KSEL>(p, ph, lds);
}

extern "C" void kernel_launch(void* const* d_in, const int* in_sizes, int n_in, void* d_out, int out_size, void* d_ws, size_t ws_size, hipStream_t stream) {
  static int grid_blocks = 0;
  if (!grid_blocks) {
    int dev = 0, cus = 0, per_cu = 0;
    (void)hipGetDevice(&dev);
    (void)hipDeviceGetAttribute(&cus, hipDeviceAttributeMultiprocessorCount, dev);
    #if MULTI_LAUNCH
    per_cu = 2;
#else
    (void)hipOccupancyMaxActiveBlocksPerMultiprocessor(&per_cu, mega, 256, 0);
#endif
    if (per_cu > 2) per_cu = 2;
    if (per_cu < 1) per_cu = 1;
    grid_blocks = cus * per_cu;
  }
  Params p{};
  const float** pin = (const float**)&p.x;
  for (int i = 0; i < 32; ++i) pin[i] = (const float*)d_in[i];
  p.out = (float*)d_out;
  char* w = (char*)d_ws;
  size_t off = 0;
  auto take = [&](size_t bytes) { char* r = w + off; off += (bytes + 255) & ~(size_t)255; return r; };
  p.BAR = (unsigned*)take((XCD_BAR_WORDS + 128) * 4);
  p.MOD = (float*)take(2 * 9 * 6144 * 4);
  p.ROPE = (float*)take(64 * 8 * 2 * 4);
  p.RSTD = (float*)take(2 * (size_t)T_TOK * 4);
  p.BON = (float*)take(2 * (size_t)T_TOK * 6 * 4);
  p.XCTX = (float*)take((size_t)8 * NCTX * DM * 4);
  p.Win = (bf16_t*)take((size_t)3328 * 1024 * 2);
  p.Wuq = (bf16_t*)take((size_t)640 * 768 * 2);
  p.WukvK = (bf16_t*)take((size_t)384 * 256 * 2);
  p.WvT = (bf16_t*)take((size_t)384 * 256 * 2);
  p.Wgate = (bf16_t*)take((size_t)384 * 128 * 2);
  p.Wdecay = (bf16_t*)take((size_t)2 * 384 * 64 * 2);
  p.Wicl = (bf16_t*)take((size_t)2 * 384 * 64 * 2);
  p.Wout = (bf16_t*)take((size_t)1024 * 1024 * 2);
  p.HY = (bf16_t*)take((size_t)T_TOK * DM * 2);
  p.TW = (bf16_t*)take((size_t)T_TOK * 64 * 2);
  p.TA = (bf16_t*)take((size_t)T_TOK * 64 * 2);
  p.TG = (bf16_t*)take((size_t)T_TOK * 128 * 2);
  char* qkv = take((size_t)T_TOK * 576 * 2 * 2 + (size_t)384 * T_TOK * 2);
  p.Q = (bf16_t*)qkv;
  p.Kt = (bf16_t*)(qkv + (size_t)T_TOK * 576 * 2);
  p.VT = (bf16_t*)(qkv + (size_t)T_TOK * 576 * 2 * 2);
  p.Wffi = (bf16_t*)take((size_t)5632 * 1024 * 2);
  p.Wffo = (bf16_t*)take((size_t)2816 * 1024 * 2);
  char* pr = take((size_t)T_TOK * (LDPA + LDPBC) * 2);
  p.PA = (bf16_t*)pr;
  p.PBC = (bf16_t*)(pr + (size_t)T_TOK * LDPA * 2);
  p.Y = (float*)p.PBC;
  p.ACT = (bf16_t*)pr;
  if (off > ws_size) { fprintf(stderr, "workspace too small: need %zu have %zu\n", off, ws_size); }
#if MULTI_LAUNCH
  hipLaunchKernelGGL(phase_k<10>, dim3(grid_blocks), dim3(256), 0, stream, p, 0);
  for (int l = 0; l < 2; ++l) {
    const int b0 = 1 + 10 * l;
    hipLaunchKernelGGL(phase_k<0>, dim3(grid_blocks), dim3(256), 0, stream, p, b0 + 0);
    hipLaunchKernelGGL(phase_k<1>, dim3(grid_blocks), dim3(256), 0, stream, p, b0 + 1);
    hipLaunchKernelGGL(phase_k<2>, dim3(grid_blocks), dim3(256), 0, stream, p, b0 + 2);
    hipLaunchKernelGGL(phase_k<3>, dim3(grid_blocks), dim3(256), 0, stream, p, b0 + 3);
    hipLaunchKernelGGL(phase_k<4>, dim3(192), dim3(256), 0, stream, p, b0 + 4);
    hipLaunchKernelGGL(phase_k<11>, dim3(grid_blocks), dim3(256), 0, stream, p, b0 + 4);
    hipLaunchKernelGGL(phase_k<5>, dim3(grid_blocks), dim3(256), 0, stream, p, b0 + 5);
    hipLaunchKernelGGL(phase_k<6>, dim3(grid_blocks), dim3(256), 0, stream, p, b0 + 6);
    hipLaunchKernelGGL(phase_k<7>, dim3(grid_blocks), dim3(256), 0, stream, p, b0 + 7);
    hipLaunchKernelGGL(phase_k<8>, dim3(grid_blocks), dim3(256), 0, stream, p, b0 + 8);
    hipLaunchKernelGGL(phase_k<9>, dim3(grid_blocks), dim3(256), 0, stream, p, b0 + 9);
  }
#else
  int lo = 0, hi = NPHASE;
  void* args[] = {&p, &lo, &hi};
  hipError_t e = hipLaunchCooperativeKernel((void*)mega, dim3(grid_blocks), dim3(256), args, 0, stream);
  if (e != hipSuccess) fprintf(stderr, "cooperative launch failed: %s (grid %d)\n", hipGetErrorString(e), grid_blocks);
#endif
}
```

```cpp
#include <hip/hip_runtime.h>
#include <hip/hip_cooperative_groups.h>
#include <cstdio>
namespace cg = cooperative_groups;

#ifndef MULTI_LAUNCH
#define MULTI_LAUNCH 0
#endif

#define DI __device__ __forceinline__
typedef unsigned short bf16_t;
typedef short bf16x8 __attribute__((ext_vector_type(8)));
typedef short s16x4 __attribute__((ext_vector_type(4)));
typedef float f32x4 __attribute__((ext_vector_type(4)));
typedef float f32x2 __attribute__((ext_vector_type(2)));
typedef float f32x16 __attribute__((ext_vector_type(16)));
typedef unsigned u32x4 __attribute__((ext_vector_type(4)));
typedef unsigned u32x2 __attribute__((ext_vector_type(2)));
#define LAS __attribute__((address_space(3)))

constexpr int T_TOK = 18432, TB = 2304, NCTX = 256, NLAT = 2048, DM = 1024;
constexpr int LDPA = 1408, LDPBC = 1920;
constexpr float EPSF = 1e-6f;
constexpr float LOG_DECAY_SCALE = 0.606531f;
constexpr float GN_EPS = 64e-5f;
constexpr float QSCALE = 0.10206207261596577f * 1.4426950408889634f;

struct Params {
  const float *x, *c, *ctx, *c_ctx, *ada_w, *ada_b, *norm1_g, *norm2_g, *w_in, *tshift_mu, *decay_w0, *decay_up,
      *icl_a0, *icl_up, *gate_up, *k_k, *k_a, *r_k, *lnx_g, *lnx_b, *q_norm_g, *kv_norm_g, *w_uq, *w_ukv, *q_nope_g,
      *k_nope_g, *q_rope_g, *k_rope_g, *conv_w, *w_out, *w_ffn_in, *w_ffn_out;
  float* out;
  float *MOD, *RSTD, *BON, *XCTX, *Y, *ROPE;
  unsigned* BAR;
  bf16_t *Win, *Wuq, *WukvK, *WvT, *Wgate, *Wdecay, *Wicl, *Wout, *Wffi, *Wffo;
  bf16_t *HY, *TW, *TA, *TG, *Q, *Kt, *VT, *PA, *PBC, *ACT;
};

typedef __bf16 bf16v2 __attribute__((ext_vector_type(2)));
DI unsigned pk_bf16(float lo, float hi) { f32x2 v = {lo, hi}; bf16v2 b = __builtin_convertvector(v, bf16v2); return __builtin_bit_cast(unsigned, b); }
DI float bflo(unsigned u) { return __uint_as_float(u << 16); }
DI float bfhi(unsigned u) { return __uint_as_float(u & 0xffff0000u); }
DI int opaque_tid() { int t = threadIdx.x; asm volatile("" : "+v"(t)); return t; }
DI float sigmoidf_(float x) { return 1.f / (1.f + __expf(-x)); }
template <int CTRL> DI float dppf(float x) { return __builtin_bit_cast(float, __builtin_amdgcn_update_dpp(0, __builtin_bit_cast(int, x), CTRL, 0xf, 0xf, true)); }
DI float red8(float x) { x += dppf<0xB1>(x); x += dppf<0x4E>(x); x += dppf<0x141>(x); return x; }
DI float red16(float x) { x = red8(x); x += dppf<0x140>(x); return x; }
DI float red64(float x) { for (int o = 32; o > 0; o >>= 1) x += __shfl_xor(x, o); return x; }

DI void unpack8(u32x4 v, float* f) {
  f[0] = bflo(v[0]); f[1] = bfhi(v[0]); f[2] = bflo(v[1]); f[3] = bfhi(v[1]);
  f[4] = bflo(v[2]); f[5] = bfhi(v[2]); f[6] = bflo(v[3]); f[7] = bfhi(v[3]);
}
DI void unpack4(u32x2 v, float* f) { f[0] = bflo(v[0]); f[1] = bfhi(v[0]); f[2] = bflo(v[1]); f[3] = bfhi(v[1]); }

DI const float* xsrc_row(const Params& p, bool from_inputs, int b, int s) {
  if (from_inputs) return s < NCTX ? p.ctx + (size_t)(b * NCTX + s) * DM : p.x + (size_t)(b * NLAT + s - NCTX) * DM;
  return s < NCTX ? p.XCTX + (size_t)(b * NCTX + s) * DM : p.out + (size_t)(b * NLAT + s - NCTX) * DM;
}
DI float* xdst_row(const Params& p, int b, int s) {
  return s < NCTX ? p.XCTX + (size_t)(b * NCTX + s) * DM : p.out + (size_t)(b * NLAT + s - NCTX) * DM;
}

DI void adaln_task(const Params& p, int task, char* lds) {
  float* s = (float*)lds;
  float* red = s + 9 * 1024;
  const int l = task / 192, cgi = task % 192, tid = opaque_tid();
  for (int i = tid; i < 9 * 1024; i += 256) {
    int r = i >> 10, k = i & 1023;
    float v = r < 8 ? p.c[r * 1024 + k] : p.c_ctx[k];
    s[i] = v / (1.f + __expf(-v));
  }
  __syncthreads();
  const int kg = tid >> 5, cc = tid & 31, col = cgi * 32 + cc;
  float acc[9];
#pragma unroll
  for (int r = 0; r < 9; ++r) acc[r] = 0.f;
  const float* w = p.ada_w + (size_t)l * 1024 * 6144 + col;
  for (int k0 = kg; k0 < 1024; k0 += 128) {
    float wv[16];
#pragma unroll
    for (int u = 0; u < 16; ++u) wv[u] = w[(size_t)(k0 + 8 * u) * 6144];
#pragma unroll
    for (int u = 0; u < 16; ++u)
#pragma unroll
      for (int r = 0; r < 9; ++r) acc[r] += s[r * 1024 + k0 + 8 * u] * wv[u];
  }
#pragma unroll
  for (int r = 0; r < 9; ++r) red[(kg * 9 + r) * 32 + cc] = acc[r];
  __syncthreads();
  for (int i = tid; i < 9 * 32; i += 256) {
    int r = i >> 5, c2 = i & 31;
    float sum = 0.f;
    for (int g = 0; g < 8; ++g) sum += red[(g * 9 + r) * 32 + c2];
    p.MOD[(size_t)(l * 9 + r) * 6144 + cgi * 32 + c2] = sum + p.ada_b[l * 6144 + cgi * 32 + c2];
  }
  __syncthreads();
}

DI int colmap(int mode, int n, int nvalid) {
  switch (mode) {
    case 0: return n < nvalid ? n : -1;
    case 1: if (n < 384) return (n >> 6) * 96 + (n & 63); if (n < 576) return ((n - 384) >> 5) * 96 + 64 + ((n - 384) & 31); return -1;
    case 2: return (n >> 6) * 128 + (n & 63);
    case 3: return (n >> 6) * 128 + 64 + (n & 63);
    default: { int t64 = n >> 6, w = n & 63; return w < 32 ? t64 * 32 + w : 2816 + t64 * 32 + (w - 32); }
  }
}
DI void conv_tile(const float* src, int ld, int K, int mode, int nvalid, const float* kscale, bf16_t* dst, int tile, int ntn, char* lds) {
  float(*tl)[65] = (float(*)[65])lds;
  const int tk = tile / ntn, tn = tile % ntn, tid = opaque_tid(), k0 = tk * 64;
  {
    const int nn = tid & 63, kk0 = tid >> 6;
    const int sc = colmap(mode, tn * 64 + nn, nvalid);
#pragma unroll 4
    for (int i = 0; i < 16; ++i) {
      const int kk = kk0 + 4 * i;
      float v = 0.f;
      if (sc >= 0) { v = src[(size_t)(k0 + kk) * ld + sc]; if (kscale) v *= kscale[k0 + kk]; }
      tl[kk][nn] = v;
    }
  }
  __syncthreads();
  {
    const int kk2 = (tid & 31) * 2, nn2 = tid >> 5;
#pragma unroll
    for (int i = 0; i < 8; ++i) {
      const int nn = nn2 + 8 * i;
      *(unsigned*)(dst + (size_t)(tn * 64 + nn) * K + k0 + kk2) = pk_bf16(tl[kk2][nn], tl[kk2 + 1][nn]);
    }
  }
  __syncthreads();
}
constexpr int NCONV_W1 = 1292, NCONV_FF = 2112;
DI void conv_w1_task(const Params& p, int l, int t, char* lds) {
  if (t < 832) { conv_tile(p.w_in + (size_t)l * 1024 * 3232, 3232, 1024, 0, 3232, nullptr, p.Win, t, 52, lds); return; } t -= 832;
  if (t < 120) { conv_tile(p.w_uq + (size_t)l * 768 * 576, 576, 768, 1, 0, p.q_norm_g + l * 768, p.Wuq, t, 10, lds); return; } t -= 120;
  if (t < 24) { conv_tile(p.w_ukv + (size_t)l * 256 * 768, 768, 256, 2, 0, p.kv_norm_g + l * 256, p.WukvK, t, 6, lds); return; } t -= 24;
  if (t < 24) { conv_tile(p.w_ukv + (size_t)l * 256 * 768, 768, 256, 3, 0, p.kv_norm_g + l * 256, p.WvT, t, 6, lds); return; } t -= 24;
  if (t < 12) { conv_tile(p.gate_up + (size_t)l * 128 * 384, 384, 128, 0, 384, nullptr, p.Wgate, t, 6, lds); return; } t -= 12;
  if (t < 12) { int d = t / 6; conv_tile(p.decay_up + (size_t)(l * 2 + d) * 64 * 384, 384, 64, 0, 384, nullptr, p.Wdecay + d * 384 * 64, t % 6, 6, lds); return; } t -= 12;
  if (t < 12) { int d = t / 6; conv_tile(p.icl_up + (size_t)(l * 2 + d) * 64 * 384, 384, 64, 0, 384, nullptr, p.Wicl + d * 384 * 64, t % 6, 6, lds); return; } t -= 12;
  conv_tile(p.w_out + (size_t)l * 1024 * 1024, 1024, 1024, 0, 1024, nullptr, p.Wout, t, 16, lds);
}
DI void conv_ff_task(const Params& p, int l, int t, char* lds) {
  if (t < 1408) { conv_tile(p.w_ffn_in + (size_t)l * 1024 * 5632, 5632, 1024, 4, 0, nullptr, p.Wffi, t, 88, lds); return; } t -= 1408;
  conv_tile(p.w_ffn_out + (size_t)l * 2816 * 1024, 1024, 2816, 0, 1024, nullptr, p.Wffo, t, 16, lds);
}

DI void modnorm_rows(const Params& p, int l, int which  , bool from_inputs, bool skip_ctx, int w0, int wstride, int lane) {
  const float* g = (which ? p.norm2_g : p.norm1_g) + l * DM;
  f32x4 gg[4];
#pragma unroll
  for (int i = 0; i < 4; ++i) gg[i] = *(const f32x4*)(g + i * 256 + lane * 4);
  const int nrows = skip_ctx ? 8 * NLAT : T_TOK;
  auto rowof = [&](int i) -> int { return skip_ctx ? (i / NLAT) * TB + NCTX + (i % NLAT) : i; };
  int i = w0;
  if (i >= nrows) return;
  f32x4 vn[4];
  {
    const int row = rowof(i); const float* src = xsrc_row(p, from_inputs, row / TB, row % TB);
#pragma unroll
    for (int q = 0; q < 4; ++q) vn[q] = *(const f32x4*)(src + q * 256 + lane * 4);
  }
  for (; i < nrows; i += wstride) {
    const int row = rowof(i); const int b = row / TB, s = row % TB;
    f32x4 v[4];
#pragma unroll
    for (int q = 0; q < 4; ++q) v[q] = vn[q];
    if (i + wstride < nrows) {
      const int rn = rowof(i + wstride); const float* src = xsrc_row(p, from_inputs, rn / TB, rn % TB);
#pragma unroll
      for (int q = 0; q < 4; ++q) vn[q] = *(const f32x4*)(src + q * 256 + lane * 4);
    }
    const float* mod = p.MOD + (size_t)(l * 9 + (s < NCTX ? 8 : b)) * 6144 + (which ? 3 * 1024 : 0);
    f32x4 sh[4], sc[4];
#pragma unroll
    for (int q = 0; q < 4; ++q) { sh[q] = *(const f32x4*)(mod + q * 256 + lane * 4); sc[q] = *(const f32x4*)(mod + 1024 + q * 256 + lane * 4); }
    float ss = 0.f;
#pragma unroll
    for (int q = 0; q < 4; ++q) ss += v[q][0] * v[q][0] + v[q][1] * v[q][1] + v[q][2] * v[q][2] + v[q][3] * v[q][3];
    ss = red64(ss);
    const float rs = rsqrtf(ss * (1.f / 1024.f) + EPSF);
    bf16_t* dst = p.HY + (size_t)row * DM;
#pragma unroll
    for (int q = 0; q < 4; ++q) {
      float o[4];
#pragma unroll
      for (int j = 0; j < 4; ++j) o[j] = (v[q][j] * rs * gg[q][j]) * (1.f + sc[q][j]) + sh[q][j];
      u32x2 w = {pk_bf16(o[0], o[1]), pk_bf16(o[2], o[3])};
      *(u32x2*)(dst + q * 256 + lane * 4) = w;
    }
  }
}

template <class Epi>
DI void gemm_tile(const bf16_t* __restrict__ A, int lda, const bf16_t* __restrict__ Bt, int ldb, int K, int row0, int col0, char* lds, const Epi& epi) {
  const int tid = opaque_tid(), lane = tid & 63, wid = tid >> 6, wr = wid >> 1, wc = wid & 1, fr = lane & 15, fq = lane >> 4;
  const bf16_t* ag[4];
  const bf16_t* bg[4];
#pragma unroll
  for (int i = 0; i < 4; ++i) {
    const int id = i * 256 + tid, r = id >> 3, cp = id & 7, c = cp ^ ((r >> 1) & 7);
    ag[i] = A + (size_t)(row0 + r) * lda + c * 8;
    bg[i] = Bt + (size_t)(col0 + r) * ldb + c * 8;
  }
  f32x4 acc[4][4];
#pragma unroll
  for (int m = 0; m < 4; ++m)
#pragma unroll
    for (int n = 0; n < 4; ++n) acc[m][n] = (f32x4){0.f, 0.f, 0.f, 0.f};
  const int KT = K >> 6;
  auto stage = [&](int kt, int buf) {
    char* sa = lds + buf * 32768;
    char* sb = sa + 16384;
#pragma unroll
    for (int i = 0; i < 4; ++i) {
      __builtin_amdgcn_global_load_lds((const void __attribute__((address_space(1)))*)(ag[i] + kt * 64), (void LAS*)(sa + (i * 256 + tid) * 16), 16, 0, 0);
      __builtin_amdgcn_global_load_lds((const void __attribute__((address_space(1)))*)(bg[i] + kt * 64), (void LAS*)(sb + (i * 256 + tid) * 16), 16, 0, 0);
    }
  };
  __syncthreads();
  stage(0, 0);
  const int swz = fr >> 1;
  for (int kt = 0; kt < KT; ++kt) {
    asm volatile("s_waitcnt vmcnt(0)" ::: "memory");
    __syncthreads();
    if (kt + 1 < KT) stage(kt + 1, (kt + 1) & 1);
    const char* sa = lds + (kt & 1) * 32768 + (wr * 64 + fr) * 128;
    const char* sb = lds + (kt & 1) * 32768 + 16384 + (wc * 64 + fr) * 128;
#pragma unroll
    for (int kk = 0; kk < 2; ++kk) {
      bf16x8 a[4], b[4];
      const int co = ((kk * 4 + fq) ^ swz) * 16;
#pragma unroll
      for (int m = 0; m < 4; ++m) a[m] = *(const bf16x8*)(sa + m * 2048 + co);
#pragma unroll
      for (int n = 0; n < 4; ++n) b[n] = *(const bf16x8*)(sb + n * 2048 + co);
#pragma unroll
      for (int m = 0; m < 4; ++m)
#pragma unroll
        for (int n = 0; n < 4; ++n) acc[m][n] = __builtin_amdgcn_mfma_f32_16x16x32_bf16(b[n], a[m], acc[m][n], 0, 0, 0);
    }
  }
  epi(acc, row0 + wr * 64, col0 + wc * 64, fr, fq);
}

struct EpiP {
  bf16_t *PA, *PBC; float* SSQ;
  DI void operator()(const f32x4 (&acc)[4][4], int r0, int c0, int fr, int fq) const {
    bf16_t* base; int ld, cb;
    if (c0 < LDPA) { base = PA; ld = LDPA; cb = c0; } else { base = PBC; ld = LDPBC; cb = c0 - LDPA; }
    if (c0 >= LDPA && cb < 1024) {
      float* dst = SSQ + (cb < 768 ? 0 : T_TOK);
#pragma unroll
      for (int m = 0; m < 4; ++m) {
        float ss = 0.f;
#pragma unroll
        for (int n = 0; n < 4; ++n)
#pragma unroll
          for (int j = 0; j < 4; ++j) ss += acc[m][n][j] * acc[m][n][j];
        ss += __shfl_xor(ss, 16); ss += __shfl_xor(ss, 32);
        if (fq == 0) atomicAdd(dst + r0 + m * 16 + fr, ss);
      }
    }
#pragma unroll
    for (int m = 0; m < 4; ++m)
#pragma unroll
      for (int n = 0; n < 4; ++n) {
        u32x2 v = {pk_bf16(acc[m][n][0], acc[m][n][1]), pk_bf16(acc[m][n][2], acc[m][n][3])};
        *(u32x2*)(base + (size_t)(r0 + m * 16 + fr) * ld + cb + n * 16 + fq * 4) = v;
      }
  }
};

DI void rope_angle(int pos, int i, float& cs, float& sn) {
  const float invf = __builtin_amdgcn_exp2f(-(float)i * (13.287712379549449f / 8.f));
  float ang = (float)pos * invf;
  float n = rintf(ang * 0.15915494309189535f);
  float r = fmaf(-n, 6.28125f, ang);
  r = fmaf(-n, 1.9353071795864769e-3f, r);
  cs = __cosf(r); sn = __sinf(r);
}

struct EpiQ {
  const float *rstd, *gn, *gr, *rope; bf16_t* Q;
  DI void operator()(const f32x4 (&acc)[4][4], int r0, int c0, int fr, int fq) const {
    if (c0 >= 576) return;
    if (c0 < 384) {
      const int h = c0 >> 6;
#pragma unroll
      for (int m = 0; m < 4; ++m) {
        const int row = r0 + m * 16 + fr; const float rs = rsqrtf(rstd[row] * (1.f / 768.f) + EPSF);
        float ss = 0.f;
#pragma unroll
        for (int n = 0; n < 4; ++n)
#pragma unroll
          for (int j = 0; j < 4; ++j) { float v = acc[m][n][j] * rs; ss += v * v; }
        ss += __shfl_xor(ss, 16); ss += __shfl_xor(ss, 32);
        const float inv = rsqrtf(ss * (1.f / 64.f) + EPSF) * rs * QSCALE;
        const int b = row / TB, s = row % TB;
        bf16_t* dst = Q + ((size_t)(b * 6 + h) * TB + s) * 96;
#pragma unroll
        for (int n = 0; n < 4; ++n) {
          const int d = n * 16 + fq * 4; f32x4 g = *(const f32x4*)(gn + d);
          u32x2 v = {pk_bf16(acc[m][n][0] * inv * g[0], acc[m][n][1] * inv * g[1]), pk_bf16(acc[m][n][2] * inv * g[2], acc[m][n][3] * inv * g[3])};
          *(u32x2*)(dst + d) = v;
        }
      }
    } else {
#pragma unroll
      for (int m = 0; m < 4; ++m) {
        const int row = r0 + m * 16 + fr; const float rs = rsqrtf(rstd[row] * (1.f / 768.f) + EPSF);
        const int b = row / TB, s = row % TB; const bool lat = s >= NCTX; const int sp = s - NCTX;
#pragma unroll
        for (int hh = 0; hh < 2; ++hh) {
          const int h = ((c0 - 384) >> 5) + hh;
          float ss = 0.f;
#pragma unroll
          for (int nn = 0; nn < 2; ++nn)
#pragma unroll
            for (int j = 0; j < 4; ++j) { float v = acc[m][hh * 2 + nn][j] * rs; ss += v * v; }
          ss += __shfl_xor(ss, 16); ss += __shfl_xor(ss, 32);
          const float inv = rsqrtf(ss * (1.f / 32.f) + EPSF) * rs;
          bf16_t* dst = Q + ((size_t)(b * 6 + h) * TB + s) * 96 + 64;
#pragma unroll
          for (int nn = 0; nn < 2; ++nn) {
            const int d = nn * 16 + fq * 4; f32x4 g = *(const f32x4*)(gr + d);
            float o[4];
#pragma unroll
            for (int j = 0; j < 4; ++j) {
              float val = acc[m][hh * 2 + nn][j] * inv * g[j];
              float partner = __shfl_xor(val, 32);
              if (lat) {
                const float* rt = rope + ((nn == 0 ? (sp >> 6) : (sp & 63)) * 8 + ((fq * 4 + j) & 7)) * 2; const float cs = rt[0], sn = rt[1];
                val = fq < 2 ? val * cs - partner * sn : val * cs + partner * sn;
              }
              o[j] = val * QSCALE;
            }
            u32x2 v = {pk_bf16(o[0], o[1]), pk_bf16(o[2], o[3])};
            *(u32x2*)(dst + d) = v;
          }
        }
      }
    }
  }
};

struct EpiK {
  const float *rstd, *gk; bf16_t* Kt;
  DI void operator()(const f32x4 (&acc)[4][4], int r0, int c0, int fr, int fq) const {
    const int h = c0 >> 6;
#pragma unroll
    for (int m = 0; m < 4; ++m) {
      const int row = r0 + m * 16 + fr; const float rs = rsqrtf(rstd[row] * (1.f / 256.f) + EPSF);
      float ss = 0.f;
#pragma unroll
      for (int n = 0; n < 4; ++n)
#pragma unroll
        for (int j = 0; j < 4; ++j) { float v = acc[m][n][j] * rs; ss += v * v; }
      ss += __shfl_xor(ss, 16); ss += __shfl_xor(ss, 32);
      const float inv = rsqrtf(ss * (1.f / 64.f) + EPSF) * rs;
      const int b = row / TB, s = row % TB;
      bf16_t* dst = Kt + ((size_t)(b * 6 + h) * TB + s) * 96;
#pragma unroll
      for (int n = 0; n < 4; ++n) {
        const int d = n * 16 + fq * 4; f32x4 g = *(const f32x4*)(gk + d);
        u32x2 v = {pk_bf16(acc[m][n][0] * inv * g[0], acc[m][n][1] * inv * g[1]), pk_bf16(acc[m][n][2] * inv * g[2], acc[m][n][3] * inv * g[3])};
        *(u32x2*)(dst + d) = v;
      }
    }
  }
};

struct EpiV {
  const float* rstd; bf16_t* VT;
  DI void operator()(const f32x4 (&acc)[4][4], int r0, int c0, int fr, int fq) const {
#pragma unroll
    for (int m = 0; m < 4; ++m)
#pragma unroll
      for (int n = 0; n < 4; ++n) {
        const int row = r0 + m * 16 + fr, col = c0 + n * 16 + fq * 4;
        f32x4 rs = *(const f32x4*)(rstd + col);
#pragma unroll
        for (int j = 0; j < 4; ++j) rs[j] = rsqrtf(rs[j] * (1.f / 256.f) + EPSF);
        u32x2 v = {pk_bf16(acc[m][n][0] * rs[0], acc[m][n][1] * rs[1]), pk_bf16(acc[m][n][2] * rs[2], acc[m][n][3] * rs[3])};
        *(u32x2*)(VT + (size_t)row * T_TOK + col) = v;
      }
  }
};

struct EpiPost {
  const float *Y, *BON, *mu, *lnx_g, *lnx_b; const bf16_t* PA; bf16_t* YC;
  DI void operator()(const f32x4 (&acc)[4][4], int r0, int c0, int fr, int fq) const {
    const int h = c0 >> 6;
#pragma unroll
    for (int m = 0; m < 4; ++m) {
      const int row = r0 + m * 16 + fr; const int s = row % TB;
      const bool hasprev = (s != 0 && s != NCTX), hasnext = (s != NCTX - 1 && s != TB - 1);
      f32x4 y[4];
      float s1 = 0.f;
#pragma unroll
      for (int n = 0; n < 4; ++n) {
        const size_t o = (size_t)row * 384 + c0 + n * 16 + fq * 4;
        y[n] = *(const f32x4*)(Y + o) + *(const f32x4*)(Y + (size_t)T_TOK * 384 + o);
        s1 += y[n][0] + y[n][1] + y[n][2] + y[n][3];
      }
      s1 += __shfl_xor(s1, 16); s1 += __shfl_xor(s1, 32);
      const float mean = s1 * (1.f / 64.f);
      float s2 = 0.f;
#pragma unroll
      for (int n = 0; n < 4; ++n)
#pragma unroll
        for (int j = 0; j < 4; ++j) { float d = y[n][j] - mean; s2 += d * d; }
      s2 += __shfl_xor(s2, 16); s2 += __shfl_xor(s2, 32);
      const float rstdv = rsqrtf(s2 * (1.f / 64.f) + GN_EPS);
      const float bon = BON[(size_t)row * 6 + h] + BON[(size_t)T_TOK * 6 + (size_t)row * 6 + h];
#pragma unroll
      for (int n = 0; n < 4; ++n) {
        const int col = c0 + n * 16 + fq * 4;
        const bf16_t* pv = PA + (size_t)row * LDPA + 768 + col;
        float vc[4], vp[4] = {0.f, 0.f, 0.f, 0.f}, vn[4] = {0.f, 0.f, 0.f, 0.f};
        unpack4(*(const u32x2*)pv, vc);
        if (hasprev) unpack4(*(const u32x2*)(pv - LDPA), vp);
        if (hasnext) unpack4(*(const u32x2*)(pv + LDPA), vn);
        f32x4 m0 = *(const f32x4*)(mu + 768 + col), m1 = *(const f32x4*)(mu + LDPA + 768 + col);
        f32x4 lg = *(const f32x4*)(lnx_g + col), lb = *(const f32x4*)(lnx_b + col);
        float o[4];
#pragma unroll
        for (int j = 0; j < 4; ++j) {
          const float v = vc[j] + m0[j] * (vp[j] - vc[j]) + m1[j] * (vn[j] - vc[j]);
          o[j] = ((y[n][j] - mean) * rstdv * lg[j] + lb[j] + bon * v) * acc[m][n][j];
        }
        u32x2 w = {pk_bf16(o[0], o[1]), pk_bf16(o[2], o[3])};
        *(u32x2*)(YC + (size_t)row * DM + col) = w;
      }
    }
  }
};

struct EpiRes {
  const Params* p; int l; bool from_inputs; int gate_off;
  DI void operator()(const f32x4 (&acc)[4][4], int r0, int c0, int fr, int fq) const {
#pragma unroll
    for (int m = 0; m < 4; ++m) {
      const int row = r0 + m * 16 + fr; const int b = row / TB, s = row % TB;
      const float* src = xsrc_row(*p, from_inputs, b, s);
      float* dst = xdst_row(*p, b, s);
      const float* gate = p->MOD + (size_t)(l * 9 + (s < NCTX ? 8 : b)) * 6144 + gate_off;
#pragma unroll
      for (int n = 0; n < 4; ++n) {
        const int col = c0 + n * 16 + fq * 4;
        f32x4 g = *(const f32x4*)(gate + col), xv = *(const f32x4*)(src + col);
        *(f32x4*)(dst + col) = xv + g * acc[m][n];
      }
    }
  }
};

struct EpiFfnIn {
  bf16_t* ACT;
  DI void operator()(const f32x4 (&acc)[4][4], int r0, int c0, int fr, int fq) const {
    const int cb = (c0 >> 6) * 32;
#pragma unroll
    for (int m = 0; m < 4; ++m)
#pragma unroll
      for (int n = 0; n < 2; ++n) {
        float o[4];
#pragma unroll
        for (int j = 0; j < 4; ++j) { float g = acc[m][n][j]; o[j] = g / (1.f + __expf(-g)) * acc[m][n + 2][j]; }
        u32x2 w = {pk_bf16(o[0], o[1]), pk_bf16(o[2], o[3])};
        *(u32x2*)(ACT + (size_t)(r0 + m * 16 + fr) * 2816 + cb + n * 16 + fq * 4) = w;
      }
  }
};

DI void prep_token(const Params& p, int l, int row, int lane) {
  const int b = row / TB, s = row % TB;
  const bool hasprev = (s != 0 && s != NCTX), hasnext = (s != NCTX - 1 && s != TB - 1);
  const float mp = hasprev ? 1.f : 0.f, mn = hasnext ? 1.f : 0.f;
  const bf16_t* pa = p.PA + (size_t)row * LDPA;
  const bf16_t* pbc = p.PBC + (size_t)row * LDPBC;
  const int opa = hasprev ? -LDPA : 0, ona = hasnext ? LDPA : 0, opb = hasprev ? -LDPBC : 0, onb = hasnext ? LDPBC : 0;
  const int l32 = lane & 31, c8 = l32 * 8, colA = 1152 + c8;
  const u32x4 la_c = *(const u32x4*)(pa + colA), la_p = *(const u32x4*)(pa + opa + colA), la_n = *(const u32x4*)(pa + ona + colA);
  const u32x4 lq0 = *(const u32x4*)(pbc + lane * 8), lq1 = *(const u32x4*)(pbc + 512 + c8), lkv = *(const u32x4*)(pbc + 768 + c8);
  const u32x4 lrp = *(const u32x4*)(pbc + 1024 + (lane & 3) * 8);
  const u32x4 lbg = *(const u32x4*)(pbc + 1056 + c8), lcc = *(const u32x4*)(pbc + 1312 + c8), lhh = *(const u32x4*)(pbc + 1568 + c8);
  const u32x4 lcp = *(const u32x4*)(pbc + opb + 1312 + c8), lhp = *(const u32x4*)(pbc + opb + 1568 + c8);
  const u32x4 lcn = *(const u32x4*)(pbc + onb + 1312 + c8), lhn = *(const u32x4*)(pbc + onb + 1568 + c8);
  const float* mu = p.tshift_mu + (size_t)l * 2 * LDPA;
  {
    float c[8], pv[8], nx[8], o[8];
    unpack8(la_c, c); unpack8(la_p, pv); unpack8(la_n, nx);
    const f32x4 m0a = *(const f32x4*)(mu + colA), m0b = *(const f32x4*)(mu + colA + 4), m1a = *(const f32x4*)(mu + LDPA + colA), m1b = *(const f32x4*)(mu + LDPA + colA + 4);
#pragma unroll
    for (int j = 0; j < 8; ++j) {
      const float m0 = j < 4 ? m0a[j & 3] : m0b[j & 3], m1 = j < 4 ? m1a[j & 3] : m1b[j & 3];
      float t = c[j] + m0 * (pv[j] * mp - c[j]) + m1 * (nx[j] * mn - c[j]);
      if (l32 < 8) { float e = __expf(2.f * t); t = 1.f - 2.f * __builtin_amdgcn_rcpf(1.f + e); }
      else if (l32 >= 16) t = __builtin_amdgcn_rcpf(1.f + __expf(-t));
      o[j] = t;
    }
    u32x4 w = {pk_bf16(o[0], o[1]), pk_bf16(o[2], o[3]), pk_bf16(o[4], o[5]), pk_bf16(o[6], o[7])};
    if (lane < 8) *(u32x4*)(p.TW + (size_t)row * 64 + lane * 8) = w;
    else if (lane < 16) *(u32x4*)(p.TA + (size_t)row * 64 + (lane - 8) * 8) = w;
    else if (lane < 32) *(u32x4*)(p.TG + (size_t)row * 128 + (lane - 16) * 8) = w;
  }
  float f[8], ss = 0.f, s2 = 0.f, s3 = 0.f, fr_[8];
  unpack8(lq0, f);
#pragma unroll
  for (int j = 0; j < 8; ++j) ss += f[j] * f[j];
  unpack8(lq1, f);
  if (lane < 32) {
#pragma unroll
    for (int j = 0; j < 8; ++j) ss += f[j] * f[j];
  }
  unpack8(lkv, f);
  if (lane < 32) {
#pragma unroll
    for (int j = 0; j < 8; ++j) s2 += f[j] * f[j];
  }
  unpack8(lrp, fr_);
  if (lane < 4) {
#pragma unroll
    for (int j = 0; j < 8; ++j) s3 += fr_[j] * fr_[j];
  }
  s3 += __shfl_xor(s3, 1); s3 += __shfl_xor(s3, 2);
  {
    const float inv = rsqrtf(s3 * (1.f / 32.f) + EPSF);
    const float* g = p.k_rope_g + l * 32;
    const bool lat = s >= NCTX; const int sp = lat ? s - NCTX : 0;
    const float* rt = p.ROPE + ((lane & 2) ? (sp & 63) : (sp >> 6)) * 16;
    float o[8];
#pragma unroll
    for (int j = 0; j < 8; ++j) {
      float val = fr_[j] * inv * g[(lane & 3) * 8 + j];
      float partner = __shfl_xor(val, 1);
      if (lat) {
        const float cs = rt[2 * j], sn = rt[2 * j + 1];
        val = (lane & 1) == 0 ? val * cs - partner * sn : val * cs + partner * sn;
      }
      o[j] = val;
    }
    if (lane < 4) {
      u32x4 w = {pk_bf16(o[0], o[1]), pk_bf16(o[2], o[3]), pk_bf16(o[4], o[5]), pk_bf16(o[6], o[7])};
#pragma unroll
      for (int hh = 0; hh < 6; ++hh) *(u32x4*)(p.Kt + ((size_t)(b * 6 + hh) * TB + s) * 96 + 64 + lane * 8) = w;
    }
  }
  {
    float bg[8], cc[8], hh[8], cp[8], hp[8], cn[8], hn[8], o[8];
    unpack8(lbg, bg); unpack8(lcc, cc); unpack8(lhh, hh); unpack8(lcp, cp); unpack8(lhp, hp); unpack8(lcn, cn); unpack8(lhn, hn);
    const float* cw = p.conv_w + (size_t)l * 3 * 256;
#pragma unroll
    for (int j = 0; j < 8; ++j) o[j] = bg[j] * (cw[c8 + j] * cp[j] * hp[j] * mp + cw[256 + c8 + j] * cc[j] * hh[j] + cw[512 + c8 + j] * cn[j] * hn[j] * mn);
    u32x4 w = {pk_bf16(o[0], o[1]), pk_bf16(o[2], o[3]), pk_bf16(o[4], o[5]), pk_bf16(o[6], o[7])};
    if (lane < 32) *(u32x4*)(p.HY + (size_t)row * DM + 768 + c8) = w;
  }
}

#define MFMA32(a, b, c) __builtin_amdgcn_mfma_f32_32x32x16_bf16((a), (b), (c), 0, 0, 0)
DI bf16x8 pack8(const f32x16& x, int s) {
  u32x4 v = {pk_bf16(x[8 * s], x[8 * s + 1]), pk_bf16(x[8 * s + 2], x[8 * s + 3]), pk_bf16(x[8 * s + 4], x[8 * s + 5]), pk_bf16(x[8 * s + 6], x[8 * s + 7])};
  return __builtin_bit_cast(bf16x8, v);
}
constexpr int KROW = 208, VROW = 136, KBUF = 64 * KROW, VBUF = 64 * VROW;
DI void attn_task(const Params& p, int b, int h, int q0, int k0, int nk, char* lds) {
  const int tid = opaque_tid(), lane = tid & 63, wid = tid >> 6, r = lane & 31, hh = lane >> 5;
  const bf16_t* Qp = p.Q + ((size_t)(b * 6 + h) * TB + q0 + wid * 32 + r) * 96;
  const bf16_t* Kp = p.Kt + ((size_t)(b * 6 + h) * TB + k0) * 96;
  const bf16_t* Vp = p.VT + (size_t)(h * 64) * T_TOK + (size_t)b * TB + k0;
  bf16x8 qf[6];
#pragma unroll
  for (int ks = 0; ks < 6; ++ks) qf[ks] = *(const bf16x8*)(Qp + ks * 16 + hh * 8);
  int krow_[3], kch_[3];
#pragma unroll
  for (int i = 0; i < 3; ++i) { int id = tid + i * 256; krow_[i] = id / 12; kch_[i] = id % 12; }
  const int vd0 = tid >> 3, vch = tid & 7;
  u32x4 kreg[3], vreg[2];
  auto load_regs = [&](int kt) {
#pragma unroll
    for (int i = 0; i < 3; ++i) kreg[i] = *(const u32x4*)(Kp + (size_t)(kt * 64 + krow_[i]) * 96 + kch_[i] * 8);
#pragma unroll
    for (int i = 0; i < 2; ++i) vreg[i] = *(const u32x4*)(Vp + (size_t)(vd0 + 32 * i) * T_TOK + kt * 64 + vch * 8);
  };
  auto write_lds = [&](int buf) {
    char* kb = lds + buf * (KBUF + VBUF);
    char* vb = kb + KBUF;
#pragma unroll
    for (int i = 0; i < 3; ++i) *(u32x4*)(kb + krow_[i] * KROW + kch_[i] * 16) = kreg[i];
#pragma unroll
    for (int i = 0; i < 2; ++i) {
      char* d = vb + (vd0 + 32 * i) * VROW + vch * 16;
      *(u32x2*)d = (u32x2){vreg[i][0], vreg[i][1]};
      *(u32x2*)(d + 8) = (u32x2){vreg[i][2], vreg[i][3]};
    }
  };
  f32x16 o[2];
#pragma unroll
  for (int i = 0; i < 16; ++i) { o[0][i] = 0.f; o[1][i] = 0.f; }
  float m_run = -1e30f, l_run = 0.f;
  const int NT = nk >> 6;
  __syncthreads();
  load_regs(0);
  write_lds(0);
  for (int kt = 0; kt < NT; ++kt) {
    if (kt + 1 < NT) load_regs(kt + 1);
    __syncthreads();
    const char* kb = lds + (kt & 1) * (KBUF + VBUF);
    const char* vb = kb + KBUF;
    f32x16 st[2];
#pragma unroll
    for (int kbk = 0; kbk < 2; ++kbk) {
#pragma unroll
      for (int i = 0; i < 16; ++i) st[kbk][i] = 0.f;
#pragma unroll
      for (int ks = 0; ks < 6; ++ks) {
        bf16x8 kf = *(const bf16x8*)(kb + (kbk * 32 + r) * KROW + ks * 32 + hh * 16);
        st[kbk] = MFMA32(kf, qf[ks], st[kbk]);
      }
    }
    float mx = st[0][0];
#pragma unroll
    for (int i = 0; i < 16; ++i) { mx = fmaxf(mx, st[0][i]); mx = fmaxf(mx, st[1][i]); }
    mx = fmaxf(mx, __shfl_xor(mx, 32));
    const float m_new = fmaxf(m_run, mx);
    const float alpha = __builtin_amdgcn_exp2f(m_run - m_new);
    m_run = m_new;
    float psum = 0.f;
#pragma unroll
    for (int kbk = 0; kbk < 2; ++kbk)
#pragma unroll
      for (int i = 0; i < 16; ++i) { float e = __builtin_amdgcn_exp2f(st[kbk][i] - m_new); st[kbk][i] = e; psum += e; }
    psum += __shfl_xor(psum, 32);
    l_run = l_run * alpha + psum;
#pragma unroll
    for (int i = 0; i < 16; ++i) { o[0][i] *= alpha; o[1][i] *= alpha; }
#pragma unroll
    for (int ksv = 0; ksv < 4; ++ksv) {
      const bf16x8 pf = pack8(st[ksv >> 1], ksv & 1);
#pragma unroll
      for (int db = 0; db < 2; ++db) {
        const char* va = vb + (db * 32 + r) * VROW + (ksv * 16 + 4 * hh) * 2;
        s16x4 lo = *(const s16x4*)va, hi = *(const s16x4*)(va + 16);
        bf16x8 vf = __builtin_shufflevector(lo, hi, 0, 1, 2, 3, 4, 5, 6, 7);
        o[db] = MFMA32(vf, pf, o[db]);
      }
    }
    if (kt + 1 < NT) write_lds((kt + 1) & 1);
  }
  const float invl = 1.f / l_run;
  bf16_t* dst = p.HY + (size_t)(b * TB + q0 + wid * 32 + r) * DM + 384 + h * 64;
#pragma unroll
  for (int db = 0; db < 2; ++db)
#pragma unroll
    for (int g = 0; g < 4; ++g) {
      u32x2 w = {pk_bf16(o[db][4 * g] * invl, o[db][4 * g + 1] * invl), pk_bf16(o[db][4 * g + 2] * invl, o[db][4 * g + 3] * invl)};
      *(u32x2*)(dst + db * 32 + 8 * g + 4 * hh) = w;
    }
}

enum { VW = 0, VKK = 1, VB = 2, VKD = 3, VR = 4, VV = 5 };
DI void scan_task(const Params& p, int l, int b, int h, int dir, int half, char* lds) {
  float* cb = (float*)lds;
  float* tk = cb + 6 * 1024;
  float* ybuf = tk + 1024;
  const int tid = opaque_tid(), lane = tid & 63, wid = tid >> 6;
  const int st_p = tid >> 4, c4 = tid & 15;
  const int fr = lane & 15, fq = lane >> 4;
  const int rp = lane >> 4, g = lane & 15;
  const int hc = h * 64;
  bf16x8 bw[2], ba[2];
  {
    const bf16_t* wd = p.Wdecay + ((size_t)dir * 384 + hc + wid * 16 + fr) * 64;
    const bf16_t* wi = p.Wicl + ((size_t)dir * 384 + hc + wid * 16 + fr) * 64;
#pragma unroll
    for (int ks = 0; ks < 2; ++ks) { bw[ks] = *(const bf16x8*)(wd + ks * 32 + fq * 8); ba[ks] = *(const bf16x8*)(wi + ks * 32 + fq * 8); }
  }
  f32x4 mu0[3], mu1[3];
  const float* mu = p.tshift_mu + (size_t)l * 2 * LDPA;
#pragma unroll
  for (int sec = 0; sec < 3; ++sec) { mu0[sec] = *(const f32x4*)(mu + sec * 384 + hc + c4 * 4); mu1[sec] = *(const f32x4*)(mu + LDPA + sec * 384 + hc + c4 * 4); }
  const f32x4 kkg = *(const f32x4*)(p.k_k + l * 384 + hc + c4 * 4);
  const f32x4 rkg = *(const f32x4*)(p.r_k + l * 384 + hc + c4 * 4);
  const int colB = wid * 16 + fq * 4;
  const f32x4 w0 = *(const f32x4*)(p.decay_w0 + (size_t)(l * 2 + dir) * 384 + hc + colB);
  const f32x4 a0 = *(const f32x4*)(p.icl_a0 + (size_t)(l * 2 + dir) * 384 + hc + colB);
  const f32x4 kag = *(const f32x4*)(p.k_a + l * 384 + hc + colB);

  u32x2 ld[3][3];
  float mprev = 0.f, mnext = 0.f;
  bf16x8 aw[2], aa[2];
  auto chunk_lo = [&](int c) -> int { return dir == 0 ? 16 * c : (c < 16 ? 240 - 16 * c : 2544 - 16 * c); };
  auto issue_loads = [&](int c) {
    const int slo = chunk_lo(c);
    const int s = slo + st_p;
    const bool hasprev = (s != 0 && s != NCTX), hasnext = (s != NCTX - 1 && s != TB - 1);
    const bf16_t* pa = p.PA + (size_t)(b * TB + s) * LDPA + hc + c4 * 4;
    const int op = hasprev ? -LDPA : 0, on = hasnext ? LDPA : 0;
    mprev = hasprev ? 1.f : 0.f; mnext = hasnext ? 1.f : 0.f;
#pragma unroll
    for (int sec = 0; sec < 3; ++sec) {
      ld[sec][1] = *(const u32x2*)(pa + sec * 384);
      ld[sec][0] = *(const u32x2*)(pa + sec * 384 + op);
      ld[sec][2] = *(const u32x2*)(pa + sec * 384 + on);
    }
    const size_t trow = (size_t)(b * TB + slo + fr) * 64;
#pragma unroll
    for (int ks = 0; ks < 2; ++ks) { aw[ks] = *(const bf16x8*)(p.TW + trow + ks * 32 + fq * 8); aa[ks] = *(const bf16x8*)(p.TA + trow + ks * 32 + fq * 8); }
  };
  auto produce = [&](int c) {
    const int slo = chunk_lo(c);
    float ts[3][4];
#pragma unroll
    for (int sec = 0; sec < 3; ++sec) {
      float pc[4], pp[4], pn[4];
      unpack4(ld[sec][1], pc); unpack4(ld[sec][0], pp); unpack4(ld[sec][2], pn);
#pragma unroll
      for (int j = 0; j < 4; ++j) ts[sec][j] = pc[j] + mu0[sec][j] * (pp[j] * mprev - pc[j]) + mu1[sec][j] * (pn[j] * mnext - pc[j]);
    }
    *(f32x4*)(cb + VR * 1024 + st_p * 64 + c4 * 4) = (f32x4){ts[0][0], ts[0][1], ts[0][2], ts[0][3]};
    *(f32x4*)(cb + VV * 1024 + st_p * 64 + c4 * 4) = (f32x4){ts[2][0], ts[2][1], ts[2][2], ts[2][3]};
    *(f32x4*)(tk + st_p * 64 + c4 * 4) = (f32x4){ts[1][0], ts[1][1], ts[1][2], ts[1][3]};
    float kx[4], ss = 0.f;
#pragma unroll
    for (int j = 0; j < 4; ++j) { kx[j] = ts[1][j] * kkg[j]; ss += kx[j] * kx[j]; }
    ss = red16(ss);
    const float inv = rsqrtf(ss + 1e-12f);
    *(f32x4*)(cb + VKK * 1024 + st_p * 64 + c4 * 4) = (f32x4){kx[0] * inv, kx[1] * inv, kx[2] * inv, kx[3] * inv};
    __syncthreads();
    f32x4 dw = {0.f, 0.f, 0.f, 0.f}, da = {0.f, 0.f, 0.f, 0.f};
#pragma unroll
    for (int ks = 0; ks < 2; ++ks) {
      dw = __builtin_amdgcn_mfma_f32_16x16x32_bf16(bw[ks], aw[ks], dw, 0, 0, 0);
      da = __builtin_amdgcn_mfma_f32_16x16x32_bf16(ba[ks], aa[ks], da, 0, 0, 0);
    }
    {
      const f32x4 kv = *(const f32x4*)(tk + fr * 64 + colB);
      const f32x4 kkv = *(const f32x4*)(cb + VKK * 1024 + fr * 64 + colB);
      f32x4 wv, kdv, bv;
#pragma unroll
      for (int j = 0; j < 4; ++j) {
        wv[j] = __expf(-LOG_DECAY_SCALE * sigmoidf_(w0[j] + dw[j]));
        const float a = sigmoidf_(a0[j] + da[j]);
        kdv[j] = kv[j] * (1.f + (a - 1.f) * kag[j]);
        bv[j] = kkv[j] * a;
      }
      *(f32x4*)(cb + VW * 1024 + fr * 64 + colB) = wv;
      *(f32x4*)(cb + VKD * 1024 + fr * 64 + colB) = kdv;
      *(f32x4*)(cb + VB * 1024 + fr * 64 + colB) = bv;
    }
    __syncthreads();
    {
      const f32x4 rv = *(const f32x4*)(cb + VR * 1024 + st_p * 64 + c4 * 4);
      const f32x4 kdv = *(const f32x4*)(cb + VKD * 1024 + st_p * 64 + c4 * 4);
      float bs = rv[0] * kdv[0] * rkg[0] + rv[1] * kdv[1] * rkg[1] + rv[2] * kdv[2] * rkg[2] + rv[3] * kdv[3] * rkg[3];
      bs = red16(bs);
      if (c4 == 0 && half == 0) p.BON[(size_t)dir * T_TOK * 6 + (size_t)(b * TB + slo + st_p) * 6 + h] = bs;
    }
  };

  f32x2 S0[2], S1[2];
#pragma unroll
  for (int j = 0; j < 2; ++j) { S0[j] = (f32x2){0.f, 0.f}; S1[j] = (f32x2){0.f, 0.f}; }
  __syncthreads();
  issue_loads(0);
  produce(0);
  __syncthreads();
  const int NCH = TB / 16;
  const int rowl = half * 32 + wid * 8 + rp * 2;
  const int inc = dir ? -64 : 64;
  for (int c = 0; c < NCH; ++c) {
    if (c + 1 < NCH) issue_loads(c + 1);
    {
      const float* ps = cb + (dir ? 15 * 64 : 0) + g * 4;
      const float* pv = cb + VV * 1024 + (dir ? 15 * 64 : 0) + rowl;
      float* py = ybuf + (dir ? 15 * 512 : 0) + ((wid * 4 + rp) * 16 + g) * 2;
      f32x4 cw = *(const f32x4*)(ps + VW * 1024), ckk = *(const f32x4*)(ps + VKK * 1024), cbb = *(const f32x4*)(ps + VB * 1024),
            ckd = *(const f32x4*)(ps + VKD * 1024), crr = *(const f32x4*)(ps + VR * 1024);
      f32x2 cvv = *(const f32x2*)pv;
#pragma unroll
      for (int ii = 0; ii < 16; ++ii) {
        f32x4 nw = cw, nkk = ckk, nbb = cbb, nkd = ckd, nrr = crr; f32x2 nvv = cvv;
        if (ii < 15) {
          ps += inc; pv += inc;
          nw = *(const f32x4*)(ps + VW * 1024); nkk = *(const f32x4*)(ps + VKK * 1024); nbb = *(const f32x4*)(ps + VB * 1024);
          nkd = *(const f32x4*)(ps + VKD * 1024); nrr = *(const f32x4*)(ps + VR * 1024); nvv = *(const f32x2*)pv;
        }
        __builtin_amdgcn_sched_barrier(0x7);
        const f32x2 kk0 = {ckk[0], ckk[1]}, kk1 = {ckk[2], ckk[3]}, w0 = {cw[0], cw[1]}, w1 = {cw[2], cw[3]};
        const f32x2 b0 = {cbb[0], cbb[1]}, b1 = {cbb[2], cbb[3]}, kd0 = {ckd[0], ckd[1]}, kd1 = {ckd[2], ckd[3]};
        const f32x2 r0 = {crr[0], crr[1]}, r1 = {crr[2], crr[3]};
        const f32x2 p0 = S0[0] * kk0 + S0[1] * kk1, p1 = S1[0] * kk0 + S1[1] * kk1;
        const f32x2 u00 = S0[0] * w0 + kd0 * cvv[0], u01 = S0[1] * w1 + kd1 * cvv[0];
        const f32x2 u10 = S1[0] * w0 + kd0 * cvv[1], u11 = S1[1] * w1 + kd1 * cvv[1];
        const float q0 = red16(p0[0] + p0[1]), q1 = red16(p1[0] + p1[1]);
        S0[0] = u00 - b0 * q0; S0[1] = u01 - b1 * q0;
        S1[0] = u10 - b0 * q1; S1[1] = u11 - b1 * q1;
        const f32x2 y0 = S0[0] * r0 + S0[1] * r1, y1 = S1[0] * r0 + S1[1] * r1;
        *(f32x2*)py = (f32x2){y0[0] + y0[1], y1[0] + y1[1]};
        py += dir ? -512 : 512;
        cw = nw; ckk = nkk; cbb = nbb; ckd = nkd; crr = nrr; cvv = nvv;
      }
    }
    __syncthreads();
    {
      const int slo = chunk_lo(c);
      const float* yp = ybuf + (st_p * 16 + c4) * 32;
      f32x4 a = *(const f32x4*)yp;
#pragma unroll
      for (int i = 1; i < 8; ++i) a += *(const f32x4*)(yp + 4 * i);
      *(f32x2*)(p.Y + (size_t)dir * T_TOK * 384 + (size_t)(b * TB + slo + st_p) * 384 + hc + half * 32 + c4 * 2) = (f32x2){a[0] + a[2], a[1] + a[3]};
    }
    if (c + 1 < NCH) produce(c + 1);
    __syncthreads();
  }
}

DI int lat_tile(int i) { return (i >> 4) * 18 + 2 + (i & 15); }
DI bool xcd_tile(int bid, int G, int i, int MT, int NT, int& tm, int& tn) {
  if ((G & 7) || (MT & 7)) { const int t = bid + i * G; if (t >= MT * NT) return false; tm = t / NT; tn = t % NT; return true; }
  const int nbx = G >> 3, x = bid & 7, j = bid >> 3, MS = MT >> 3;
  const int q = j + nbx * i;
  if (q >= MS * NT) return false;
  const int full = NT >> 3, wl = NT & 7;
  int nb = q / (MS * 8), m, ni;
  if (nb < full) { const int rem = q - nb * MS * 8; m = rem >> 3; ni = rem & 7; }
  else { const int rem = q - full * MS * 8; nb = full; m = rem / wl; ni = rem % wl; }
  tm = x * MS + m; tn = nb * 8 + ni;
  return true;
}

template <int KSEL> DI void run_phase(const Params& p, int ph, char* lds) {
  const int bid = blockIdx.x, G = gridDim.x, tid = opaque_tid(), lane = tid & 63, wid = tid >> 6;
  if (ph == 0) {
    if (KSEL >= 0 && KSEL != 10) return;
    for (int t = bid; t < 384 + NCONV_W1 + 1; t += G) {
      if (t < 384) adaln_task(p, t, lds);
      else if (t < 384 + NCONV_W1) conv_w1_task(p, 0, t - 384, lds);
      else { for (int e = tid; e < 512; e += 256) { float cs, sn; rope_angle(e >> 3, e & 7, cs, sn); p.ROPE[2 * e] = cs; p.ROPE[2 * e + 1] = sn; } }
    }
    return;
  }
  if (KSEL == 10) return;
  const int l = (ph - 1) / 9, kq = (ph - 1) % 9, k = kq < 2 ? kq : kq + 1;
  const bool last = (l == 1);
  const int lb = ((G & 7) == 0) ? (bid & 7) * (G >> 3) + (bid >> 3) : bid;
  if (KSEL >= 0 && KSEL != 10 && k != (KSEL == 11 ? 4 : KSEL)) return;
  switch (k) {
    case 0:
      for (int i = bid * 256 + tid; i < 2 * T_TOK; i += G * 256) p.RSTD[i] = 0.f;
      modnorm_rows(p, l, 0, l == 0, false, bid * 4 + wid, G * 4, lane);
      break;
    case 1: {
      EpiP e{p.PA, p.PBC, p.RSTD};
      for (int i = 0, tm, tn; xcd_tile(bid, G, i, 144, 26, tm, tn); ++i) gemm_tile(p.HY, DM, p.Win, DM, DM, tm * 128, tn * 128, lds, e);
    } break;
    case 3: {
      const int nq = last ? 128 * 5 : 144 * 5;
      EpiQ eq{p.RSTD, p.q_nope_g + l * 64, p.q_rope_g + l * 32, p.ROPE, p.Q};
      EpiK ek{p.RSTD + T_TOK, p.k_nope_g + l * 64, p.Kt};
      EpiV ev{p.RSTD + T_TOK, p.VT};
      for (int t = bid; t < nq + 432 + 432 + T_TOK / 4; t += G) {
        if (t >= nq + 864) { prep_token(p, l, (t - nq - 864) * 4 + wid, lane); continue; }
        if (t < nq) { int i = t / 5; int tm = last ? lat_tile(i) : i; gemm_tile(p.PBC, LDPBC, p.Wuq, 768, 768, tm * 128, (t % 5) * 128, lds, eq); }
        else if (t < nq + 432) { int u = t - nq; gemm_tile(p.PBC + 768, LDPBC, p.WukvK, 256, 256, (u / 3) * 128, (u % 3) * 128, lds, ek); }
        else { int u = t - nq - 432; gemm_tile(p.WvT, 256, p.PBC + 768, LDPBC, 256, (u % 3) * 128, (u / 3) * 128, lds, ev); }
      }
    } break;
    case 4: {
      const int natt = 768 + (last ? 0 : 96);
      if (KSEL != 11) { if (bid < 192) { scan_task(p, l, bid / 24, (bid % 24) >> 2, (bid >> 1) & 1, bid & 1, lds); break; } if (KSEL == 4) break; }
      const int aoff = KSEL == 11 ? 0 : 192;
      if (KSEL == 11) {
        for (int t = bid; t < natt + NCONV_FF; t += G) {
          if (t < 768) { int bh = t >> 4, qb = t & 15; attn_task(p, bh / 6, bh % 6, NCTX + qb * 128, 0, TB, lds); }
          else if (t < natt) { int u = t - 768; int bh = u >> 1, qb = u & 1; attn_task(p, bh / 6, bh % 6, qb * 128, 0, NCTX, lds); }
          else conv_ff_task(p, l, t - natt, lds);
        }
      } else {
        volatile LAS unsigned* slot = (volatile LAS unsigned*)(lds + 65536 + 8);
        for (;;) {
          __syncthreads();
          if (tid == 0) *slot = __hip_atomic_fetch_add(p.BAR + 3456   + 64 * l, 1u, __ATOMIC_RELAXED, __HIP_MEMORY_SCOPE_AGENT);
          __syncthreads();
          const int t = (int)*slot;
          if (t >= natt + NCONV_FF) break;
          if (t < 768) { int bh = t >> 4, qb = t & 15; attn_task(p, bh / 6, bh % 6, NCTX + qb * 128, 0, TB, lds); }
          else if (t < natt) { int u = t - 768; int bh = u >> 1, qb = u & 1; attn_task(p, bh / 6, bh % 6, qb * 128, 0, NCTX, lds); }
          else conv_ff_task(p, l, t - natt, lds);
        }
      }
    } break;
    case 5: {
      EpiPost e{p.Y, p.BON, p.tshift_mu + (size_t)l * 2 * LDPA, p.lnx_g + l * 384, p.lnx_b + l * 384, p.PA, p.HY};
      const int nm = last ? 128 : 144;
      for (int t = bid; t < nm * 3; t += G) { int i = t / 3; int tm = last ? lat_tile(i) : i; gemm_tile(p.TG, 128, p.Wgate, 128, 128, tm * 128, (t % 3) * 128, lds, e); }
    } break;
    case 6: {
      EpiRes e{&p, l, l == 0, 2 * 1024};
      const int nm = last ? 128 : 144;
      for (int i = 0, tm, tn; xcd_tile(bid, G, i, nm, 8, tm, tn); ++i) gemm_tile(p.HY, DM, p.Wout, DM, DM, (last ? lat_tile(tm) : tm) * 128, tn * 128, lds, e);
    } break;
    case 7:
      modnorm_rows(p, l, 1, false, last, bid * 4 + wid, G * 4, lane);
      break;
    case 8: {
      EpiFfnIn e{p.ACT};
      const int nm = last ? 128 : 144;
      const int nconv = last ? 0 : NCONV_W1;
      for (int i = 0, tm, tn; xcd_tile(bid, G, i, nm, 44, tm, tn); ++i) gemm_tile(p.HY, DM, p.Wffi, DM, DM, (last ? lat_tile(tm) : tm) * 128, tn * 128, lds, e);
      for (int t = bid; t < nconv; t += G) conv_w1_task(p, 1, t, lds);
    } break;
    case 9: {
      EpiRes e{&p, l, false, 5 * 1024};
      const int nm = last ? 128 : 144;
      for (int i = 0, tm, tn; xcd_tile(bid, G, i, nm, 8, tm, tn); ++i) gemm_tile(p.ACT, 2816, p.Wffo, 2816, 2816, (last ? lat_tile(tm) : tm) * 128, tn * 128, lds, e);
    } break;
  }
}


#define XB_TMO      128
#define XB_XCNT(j)  (256  + 64 * (j))
#define XB_XSUB(j)  (1280 + 64 * (j))
#define XB_XGEN(j)  (2304 + 64 * (j))
#define XB_TOP      3328
#define XB_TOPGEN   3392
#define XCD_BAR_WORDS 3456
#define XB_SPIN_CAP (1u << 20)
DI unsigned xb_ld(unsigned* p) { return __hip_atomic_load(p, __ATOMIC_RELAXED, __HIP_MEMORY_SCOPE_AGENT); }
DI unsigned xb_add(unsigned* p, unsigned v) { return __hip_atomic_fetch_add(p, v, __ATOMIC_RELAXED, __HIP_MEMORY_SCOPE_AGENT); }
DI unsigned xb_xcc_id() { return (unsigned)__builtin_amdgcn_s_getreg((3 << 11) | 20) & 0xFu; }
#define XB_SPIN(cond, bar) do { unsigned _sp = 0; while (cond) { __builtin_amdgcn_s_sleep(1); \
    if ((++_sp & 255u) == 0u) { if (xb_ld(&(bar)[XB_TMO])) break; if (_sp > XB_SPIN_CAP) { atomicAdd(&(bar)[XB_TMO], 1u); break; } } } } while (0)
struct XcdBarrier { unsigned* bar; unsigned x; volatile LAS unsigned* st; };
DI XcdBarrier xcd_barrier_post(unsigned* bar, volatile LAS unsigned* st) {
  XcdBarrier b; b.bar = bar; b.x = xb_xcc_id(); b.st = st;
  if (threadIdx.x == 0) (void)xb_add(&bar[XB_XCNT(b.x)], 1u);
  return b;
}
DI void xcd_barrier_complete(unsigned* bar, unsigned x, unsigned& nloc, unsigned& nx) {
  const unsigned G = gridDim.x * gridDim.y * gridDim.z;
  unsigned sum, cnt, mine, sp = 0u;
  for (;;) {
    sum = 0u; cnt = 0u; mine = 0u;
#pragma unroll
    for (unsigned j = 0; j < 16; ++j) { const unsigned c = xb_ld(&bar[XB_XCNT(j)]); sum += c; cnt += (c > 0u) ? 1u : 0u; mine = (j == x) ? c : mine; }
    if (sum == G) break;
    __builtin_amdgcn_s_sleep(1);
    if ((++sp & 255u) == 0u) { if (xb_ld(&bar[XB_TMO])) break; if (sp > XB_SPIN_CAP) { atomicAdd(&bar[XB_TMO], 1u); break; } }
  }
  nloc = mine > 0u ? mine : 1u; nx = cnt > 0u ? cnt : 1u;
}
DI void xcd_barrier(const XcdBarrier& b) {
  asm volatile("s_waitcnt vmcnt(0)" ::: "memory");
  __syncthreads();
  if (threadIdx.x == 0) {
    unsigned* bar = b.bar;
    __builtin_amdgcn_s_waitcnt(0);
    unsigned nloc = b.st[0], nx = b.st[1];
    if (nloc == 0u) { xcd_barrier_complete(bar, b.x, nloc, nx); b.st[0] = nloc; b.st[1] = nx; }
    const unsigned old = xb_add(&bar[XB_XSUB(b.x)], 1u);
    const unsigned gen = old / nloc;
    if (old + 1u == (gen + 1u) * nloc) {
      __builtin_amdgcn_fence(__ATOMIC_RELEASE, "agent");
      asm volatile("s_waitcnt vmcnt(0)" ::: "memory");
      const unsigned og = xb_add(&bar[XB_TOP], 1u);
      const unsigned tg = og / nx;
      if (og + 1u == (tg + 1u) * nx) xb_add(&bar[XB_TOPGEN], 1u);
      else XB_SPIN(xb_ld(&bar[XB_TOPGEN]) == tg, bar);
      __builtin_amdgcn_fence(__ATOMIC_ACQUIRE, "agent");
      xb_add(&bar[XB_XGEN(b.x)], 1u);
      asm volatile("s_waitcnt vmcnt(0)" ::: "memory");
    } else {
      XB_SPIN(xb_ld(&bar[XB_XGEN(b.x)]) == gen, bar);
      __builtin_amdgcn_fence(__ATOMIC_ACQUIRE, "agent");
      asm volatile("s_waitcnt vmcnt(0)" ::: "memory");
    }
  }
  __syncthreads();
}

constexpr int NPHASE = 19;
#if !MULTI_LAUNCH
__global__ void __launch_bounds__(256, 2) mega(Params p, int ph_lo, int ph_hi) {
  __shared__ __attribute__((aligned(16))) char lds[65536 + 16];
  cg::grid_group grid = cg::this_grid();
  volatile LAS unsigned* st = (volatile LAS unsigned*)(lds + 65536);
  if (threadIdx.x == 0) { st[0] = 0u; st[1] = 0u; }
  if (blockIdx.x == 0) for (int i = threadIdx.x; i < XCD_BAR_WORDS + 128; i += 256) p.BAR[i] = 0u;
  __syncthreads();
  XcdBarrier xb;
  for (int ph = ph_lo; ph < ph_hi; ++ph) {
    if (ph == ph_lo + 1) { grid.sync(); xb = xcd_barrier_post(p.BAR, st); }
    else if (ph > ph_lo + 1) xcd_barrier(xb);
    run_phase<-1>(p, ph, lds);
  }
}
#endif
template <int KSEL> __global__ void __launch_bounds__(256, 2) phase_k(Params p, int ph) {
  __shared__ __attribute__((aligned(16))) char lds[65536];
  run_phase<KSEL>(p, ph, lds);
}

extern "C" void kernel_launch(void* const* d_in, const int* in_sizes, int n_in, void* d_out, int out_size, void* d_ws, size_t ws_size, hipStream_t stream) {
  static int grid_blocks = 0;
  if (!grid_blocks) {
    int dev = 0, cus = 0, per_cu = 0;
    (void)hipGetDevice(&dev);
    (void)hipDeviceGetAttribute(&cus, hipDeviceAttributeMultiprocessorCount, dev);
    #if MULTI_LAUNCH
    per_cu = 2;
#else
    (void)hipOccupancyMaxActiveBlocksPerMultiprocessor(&per_cu, mega, 256, 0);
#endif
    if (per_cu > 2) per_cu = 2;
    if (per_cu < 1) per_cu = 1;
    grid_blocks = cus * per_cu;
  }
  Params p{};
  const float** pin = (const float**)&p.x;
  for (int i = 0; i < 32; ++i) pin[i] = (const float*)d_in[i];
  p.out = (float*)d_out;
  char* w = (char*)d_ws;
  size_t off = 0;
  auto take = [&](size_t bytes) { char* r = w + off; off += (bytes + 255) & ~(size_t)255; return r; };
  p.BAR = (unsigned*)take((XCD_BAR_WORDS + 128) * 4);
  p.MOD = (float*)take(2 * 9 * 6144 * 4);
  p.ROPE = (float*)take(64 * 8 * 2 * 4);
  p.RSTD = (float*)take(2 * (size_t)T_TOK * 4);
  p.BON = (float*)take(2 * (size_t)T_TOK * 6 * 4);
  p.XCTX = (float*)take((size_t)8 * NCTX * DM * 4);
  p.Win = (bf16_t*)take((size_t)3328 * 1024 * 2);
  p.Wuq = (bf16_t*)take((size_t)640 * 768 * 2);
  p.WukvK = (bf16_t*)take((size_t)384 * 256 * 2);
  p.WvT = (bf16_t*)take((size_t)384 * 256 * 2);
  p.Wgate = (bf16_t*)take((size_t)384 * 128 * 2);
  p.Wdecay = (bf16_t*)take((size_t)2 * 384 * 64 * 2);
  p.Wicl = (bf16_t*)take((size_t)2 * 384 * 64 * 2);
  p.Wout = (bf16_t*)take((size_t)1024 * 1024 * 2);
  p.HY = (bf16_t*)take((size_t)T_TOK * DM * 2);
  p.TW = (bf16_t*)take((size_t)T_TOK * 64 * 2);
  p.TA = (bf16_t*)take((size_t)T_TOK * 64 * 2);
  p.TG = (bf16_t*)take((size_t)T_TOK * 128 * 2);
  char* qkv = take((size_t)T_TOK * 576 * 2 * 2 + (size_t)384 * T_TOK * 2);
  p.Q = (bf16_t*)qkv;
  p.Kt = (bf16_t*)(qkv + (size_t)T_TOK * 576 * 2);
  p.VT = (bf16_t*)(qkv + (size_t)T_TOK * 576 * 2 * 2);
  p.Wffi = (bf16_t*)take((size_t)5632 * 1024 * 2);
  p.Wffo = (bf16_t*)take((size_t)2816 * 1024 * 2);
  char* pr = take((size_t)T_TOK * (LDPA + LDPBC) * 2);
  p.PA = (bf16_t*)pr;
  p.PBC = (bf16_t*)(pr + (size_t)T_TOK * LDPA * 2);
  p.Y = (float*)p.PBC;
  p.ACT = (bf16_t*)pr;
  if (off > ws_size) { fprintf(stderr, "workspace too small: need %zu have %zu\n", off, ws_size); }
#if MULTI_LAUNCH
  hipLaunchKernelGGL(phase_k<10>, dim3(grid_blocks), dim3(256), 0, stream, p, 0);
  for (int l = 0; l < 2; ++l) {
    const int b0 = 1 + 10 * l;
    hipLaunchKernelGGL(phase_k<0>, dim3(grid_blocks), dim3(256), 0, stream, p, b0 + 0);
    hipLaunchKernelGGL(phase_k<1>, dim3(grid_blocks), dim3(256), 0, stream, p, b0 + 1);
    hipLaunchKernelGGL(phase_k<2>, dim3(grid_blocks), dim3(256), 0, stream, p, b0 + 2);
    hipLaunchKernelGGL(phase_k<3>, dim3(grid_blocks), dim3(256), 0, stream, p, b0 + 3);
    hipLaunchKernelGGL(phase_k<4>, dim3(192), dim3(256), 0, stream, p, b0 + 4);
    hipLaunchKernelGGL(phase_k<11>, dim3(grid_blocks), dim3(256), 0, stream, p, b0 + 4);
    hipLaunchKernelGGL(phase_k<5>, dim3(grid_blocks), dim3(256), 0, stream, p, b0 + 5);
    hipLaunchKernelGGL(phase_k<6>, dim3(grid_blocks), dim3(256), 0, stream, p, b0 + 6);
    hipLaunchKernelGGL(phase_k<7>, dim3(grid_blocks), dim3(256), 0, stream, p, b0 + 7);
    hipLaunchKernelGGL(phase_k<8>, dim3(grid_blocks), dim3(256), 0, stream, p, b0 + 8);
    hipLaunchKernelGGL(phase_k<9>, dim3(grid_blocks), dim3(256), 0, stream, p, b0 + 9);
  }
#else
  int lo = 0, hi = NPHASE;
  void* args[] = {&p, &lo, &hi};
  hipError_t e = hipLaunchCooperativeKernel((void*)mega, dim3(grid_blocks), dim3(256), args, 0, stream);
  if (e != hipSuccess) fprintf(stderr, "cooperative launch failed: %s (grid %d)\n", hipGetErrorString(e), grid_blocks);
#endif
}
```

```cpp
#include <hip/hip_runtime.h>
#include <hip/hip_cooperative_groups.h>
#include <cstdio>
namespace cg = cooperative_groups;

#ifndef MULTI_LAUNCH
#define MULTI_LAUNCH 0
#endif

#define DI __device__ __forceinline__
typedef unsigned short bf16_t;
typedef short bf16x8 __attribute__((ext_vector_type(8)));
typedef short s16x4 __attribute__((ext_vector_type(4)));
typedef float f32x4 __attribute__((ext_vector_type(4)));
typedef float f32x2 __attribute__((ext_vector_type(2)));
typedef float f32x16 __attribute__((ext_vector_type(16)));
typedef unsigned u32x4 __attribute__((ext_vector_type(4)));
typedef unsigned u32x2 __attribute__((ext_vector_type(2)));
#define LAS __attribute__((address_space(3)))

constexpr int T_TOK = 18432, TB = 2304, NCTX = 256, NLAT = 2048, DM = 1024;
constexpr int LDPA = 1408, LDPBC = 1920;
constexpr float EPSF = 1e-6f;
constexpr float LOG_DECAY_SCALE = 0.606531f;
constexpr float GN_EPS = 64e-5f;
constexpr float QSCALE = 0.10206207261596577f * 1.4426950408889634f;

struct Params {
  const float *x, *c, *ctx, *c_ctx, *ada_w, *ada_b, *norm1_g, *norm2_g, *w_in, *tshift_mu, *decay_w0, *decay_up,
      *icl_a0, *icl_up, *gate_up, *k_k, *k_a, *r_k, *lnx_g, *lnx_b, *q_norm_g, *kv_norm_g, *w_uq, *w_ukv, *q_nope_g,
      *k_nope_g, *q_rope_g, *k_rope_g, *conv_w, *w_out, *w_ffn_in, *w_ffn_out;
  float* out;
  float *MOD, *RSTD, *BON, *XCTX, *Y, *ROPE;
  unsigned* BAR;
  bf16_t *Win, *Wuq, *WukvK, *WvT, *Wgate, *Wdecay, *Wicl, *Wout, *Wffi, *Wffo;
  bf16_t *HY, *TW, *TA, *TG, *Q, *Kt, *VT, *PA, *PBC, *ACT;
};

typedef __bf16 bf16v2 __attribute__((ext_vector_type(2)));
DI unsigned pk_bf16(float lo, float hi) { f32x2 v = {lo, hi}; bf16v2 b = __builtin_convertvector(v, bf16v2); return __builtin_bit_cast(unsigned, b); }
DI float bflo(unsigned u) { return __uint_as_float(u << 16); }
DI float bfhi(unsigned u) { return __uint_as_float(u & 0xffff0000u); }
DI int opaque_tid() { int t = threadIdx.x; asm volatile("" : "+v"(t)); return t; }
DI float sigmoidf_(float x) { return 1.f / (1.f + __expf(-x)); }
template <int CTRL> DI float dppf(float x) { return __builtin_bit_cast(float, __builtin_amdgcn_update_dpp(0, __builtin_bit_cast(int, x), CTRL, 0xf, 0xf, true)); }
DI float red8(float x) { x += dppf<0xB1>(x); x += dppf<0x4E>(x); x += dppf<0x141>(x); return x; }
DI float red16(float x) { x = red8(x); x += dppf<0x140>(x); return x; }
DI float red64(float x) { for (int o = 32; o > 0; o >>= 1) x += __shfl_xor(x, o); return x; }

DI void unpack8(u32x4 v, float* f) {
  f[0] = bflo(v[0]); f[1] = bfhi(v[0]); f[2] = bflo(v[1]); f[3] = bfhi(v[1]);
  f[4] = bflo(v[2]); f[5] = bfhi(v[2]); f[6] = bflo(v[3]); f[7] = bfhi(v[3]);
}
DI void unpack4(u32x2 v, float* f) { f[0] = bflo(v[0]); f[1] = bfhi(v[0]); f[2] = bflo(v[1]); f[3] = bfhi(v[1]); }

DI const float* xsrc_row(const Params& p, bool from_inputs, int b, int s) {
  if (from_inputs) return s < NCTX ? p.ctx + (size_t)(b * NCTX + s) * DM : p.x + (size_t)(b * NLAT + s - NCTX) * DM;
  return s < NCTX ? p.XCTX + (size_t)(b * NCTX + s) * DM : p.out + (size_t)(b * NLAT + s - NCTX) * DM;
}
DI float* xdst_row(const Params& p, int b, int s) {
  return s < NCTX ? p.XCTX + (size_t)(b * NCTX + s) * DM : p.out + (size_t)(b * NLAT + s - NCTX) * DM;
}

DI void adaln_task(const Params& p, int task, char* lds) {
  float* s = (float*)lds;
  float* red = s + 9 * 1024;
  const int l = task / 192, cgi = task % 192, tid = opaque_tid();
  for (int i = tid; i < 9 * 1024; i += 256) {
    int r = i >> 10, k = i & 1023;
    float v = r < 8 ? p.c[r * 1024 + k] : p.c_ctx[k];
    s[i] = v / (1.f + __expf(-v));
  }
  __syncthreads();
  const int kg = tid >> 5, cc = tid & 31, col = cgi * 32 + cc;
  float acc[9];
#pragma unroll
  for (int r = 0; r < 9; ++r) acc[r] = 0.f;
  const float* w = p.ada_w + (size_t)l * 1024 * 6144 + col;
  for (int k0 = kg; k0 < 1024; k0 += 128) {
    float wv[16];
#pragma unroll
    for (int u = 0; u < 16; ++u) wv[u] = w[(size_t)(k0 + 8 * u) * 6144];
#pragma unroll
    for (int u = 0; u < 16; ++u)
#pragma unroll
      for (int r = 0; r < 9; ++r) acc[r] += s[r * 1024 + k0 + 8 * u] * wv[u];
  }
#pragma unroll
  for (int r = 0; r < 9; ++r) red[(kg * 9 + r) * 32 + cc] = acc[r];
  __syncthreads();
  for (int i = tid; i < 9 * 32; i += 256) {
    int r = i >> 5, c2 = i & 31;
    float sum = 0.f;
    for (int g = 0; g < 8; ++g) sum += red[(g * 9 + r) * 32 + c2];
    p.MOD[(size_t)(l * 9 + r) * 6144 + cgi * 32 + c2] = sum + p.ada_b[l * 6144 + cgi * 32 + c2];
  }
  __syncthreads();
}

DI int colmap(int mode, int n, int nvalid) {
  switch (mode) {
    case 0: return n < nvalid ? n : -1;
    case 1: if (n < 384) return (n >> 6) * 96 + (n & 63); if (n < 576) return ((n - 384) >> 5) * 96 + 64 + ((n - 384) & 31); return -1;
    case 2: return (n >> 6) * 128 + (n & 63);
    case 3: return (n >> 6) * 128 + 64 + (n & 63);
    default: { int t64 = n >> 6, w = n & 63; return w < 32 ? t64 * 32 + w : 2816 + t64 * 32 + (w - 32); }
  }
}
DI void conv_tile(const float* src, int ld, int K, int mode, int nvalid, const float* kscale, bf16_t* dst, int tile, int ntn, char* lds) {
  float(*tl)[65] = (float(*)[65])lds;
  const int tk = tile / ntn, tn = tile % ntn, tid = opaque_tid(), k0 = tk * 64;
  {
    const int nn = tid & 63, kk0 = tid >> 6;
    const int sc = colmap(mode, tn * 64 + nn, nvalid);
#pragma unroll 4
    for (int i = 0; i < 16; ++i) {
      const int kk = kk0 + 4 * i;
      float v = 0.f;
      if (sc >= 0) { v = src[(size_t)(k0 + kk) * ld + sc]; if (kscale) v *= kscale[k0 + kk]; }
      tl[kk][nn] = v;
    }
  }
  __syncthreads();
  {
    const int kk2 = (tid & 31) * 2, nn2 = tid >> 5;
#pragma unroll
    for (int i = 0; i < 8; ++i) {
      const int nn = nn2 + 8 * i;
      *(unsigned*)(dst + (size_t)(tn * 64 + nn) * K + k0 + kk2) = pk_bf16(tl[kk2][nn], tl[kk2 + 1][nn]);
    }
  }
  __syncthreads();
}
constexpr int NCONV_W1 = 1292, NCONV_FF = 2112;
DI void conv_w1_task(const Params& p, int l, int t, char* lds) {
  if (t < 832) { conv_tile(p.w_in + (size_t)l * 1024 * 3232, 3232, 1024, 0, 3232, nullptr, p.Win, t, 52, lds); return; } t -= 832;
  if (t < 120) { conv_tile(p.w_uq + (size_t)l * 768 * 576, 576, 768, 1, 0, p.q_norm_g + l * 768, p.Wuq, t, 10, lds); return; } t -= 120;
  if (t < 24) { conv_tile(p.w_ukv + (size_t)l * 256 * 768, 768, 256, 2, 0, p.kv_norm_g + l * 256, p.WukvK, t, 6, lds); return; } t -= 24;
  if (t < 24) { conv_tile(p.w_ukv + (size_t)l * 256 * 768, 768, 256, 3, 0, p.kv_norm_g + l * 256, p.WvT, t, 6, lds); return; } t -= 24;
  if (t < 12) { conv_tile(p.gate_up + (size_t)l * 128 * 384, 384, 128, 0, 384, nullptr, p.Wgate, t, 6, lds); return; } t -= 12;
  if (t < 12) { int d = t / 6; conv_tile(p.decay_up + (size_t)(l * 2 + d) * 64 * 384, 384, 64, 0, 384, nullptr, p.Wdecay + d * 384 * 64, t % 6, 6, lds); return; } t -= 12;
  if (t < 12) { int d = t / 6; conv_tile(p.icl_up + (size_t)(l * 2 + d) * 64 * 384, 384, 64, 0, 384, nullptr, p.Wicl + d * 384 * 64, t % 6, 6, lds); return; } t -= 12;
  conv_tile(p.w_out + (size_t)l * 1024 * 1024, 1024, 1024, 0, 1024, nullptr, p.Wout, t, 16, lds);
}
DI void conv_ff_task(const Params& p, int l, int t, char* lds) {
  if (t < 1408) { conv_tile(p.w_ffn_in + (size_t)l * 1024 * 5632, 5632, 1024, 4, 0, nullptr, p.Wffi, t, 88, lds); return; } t -= 1408;
  conv_tile(p.w_ffn_out + (size_t)l * 2816 * 1024, 1024, 2816, 0, 1024, nullptr, p.Wffo, t, 16, lds);
}

DI void modnorm_rows(const Params& p, int l, int which  , bool from_inputs, bool skip_ctx, int w0, int wstride, int lane) {
  const float* g = (which ? p.norm2_g : p.norm1_g) + l * DM;
  f32x4 gg[4];
#pragma unroll
  for (int i = 0; i < 4; ++i) gg[i] = *(const f32x4*)(g + i * 256 + lane * 4);
  const int nrows = skip_ctx ? 8 * NLAT : T_TOK;
  auto rowof = [&](int i) -> int { return skip_ctx ? (i / NLAT) * TB + NCTX + (i % NLAT) : i; };
  int i = w0;
  if (i >= nrows) return;
  f32x4 vn[4];
  {
    const int row = rowof(i); const float* src = xsrc_row(p, from_inputs, row / TB, row % TB);
#pragma unroll
    for (int q = 0; q < 4; ++q) vn[q] = *(const f32x4*)(src + q * 256 + lane * 4);
  }
  for (; i < nrows; i += wstride) {
    const int row = rowof(i); const int b = row / TB, s = row % TB;
    f32x4 v[4];
#pragma unroll
    for (int q = 0; q < 4; ++q) v[q] = vn[q];
    if (i + wstride < nrows) {
      const int rn = rowof(i + wstride); const float* src = xsrc_row(p, from_inputs, rn / TB, rn % TB);
#pragma unroll
      for (int q = 0; q < 4; ++q) vn[q] = *(const f32x4*)(src + q * 256 + lane * 4);
    }
    const float* mod = p.MOD + (size_t)(l * 9 + (s < NCTX ? 8 : b)) * 6144 + (which ? 3 * 1024 : 0);
    f32x4 sh[4], sc[4];
#pragma unroll
    for (int q = 0; q < 4; ++q) { sh[q] = *(const f32x4*)(mod + q * 256 + lane * 4); sc[q] = *(const f32x4*)(mod + 1024 + q * 256 + lane * 4); }
    float ss = 0.f;
#pragma unroll
    for (int q = 0; q < 4; ++q) ss += v[q][0] * v[q][0] + v[q][1] * v[q][1] + v[q][2] * v[q][2] + v[q][3] * v[q][3];
    ss = red64(ss);
    const float rs = rsqrtf(ss * (1.f / 1024.f) + EPSF);
    bf16_t* dst = p.HY + (size_t)row * DM;
#pragma unroll
    for (int q = 0; q < 4; ++q) {
      float o[4];
#pragma unroll
      for (int j = 0; j < 4; ++j) o[j] = (v[q][j] * rs * gg[q][j]) * (1.f + sc[q][j]) + sh[q][j];
      u32x2 w = {pk_bf16(o[0], o[1]), pk_bf16(o[2], o[3])};
      *(u32x2*)(dst + q * 256 + lane * 4) = w;
    }
  }
}

template <class Epi>
DI void gemm_tile(const bf16_t* __restrict__ A, int lda, const bf16_t* __restrict__ Bt, int ldb, int K, int row0, int col0, char* lds, const Epi& epi) {
  const int tid = opaque_tid(), lane = tid & 63, wid = tid >> 6, wr = wid >> 1, wc = wid & 1, fr = lane & 15, fq = lane >> 4;
  const bf16_t* ag[4];
  const bf16_t* bg[4];
#pragma unroll
  for (int i = 0; i < 4; ++i) {
    const int id = i * 256 + tid, r = id >> 3, cp = id & 7, c = cp ^ ((r >> 1) & 7);
    ag[i] = A + (size_t)(row0 + r) * lda + c * 8;
    bg[i] = Bt + (size_t)(col0 + r) * ldb + c * 8;
  }
  f32x4 acc[4][4];
#pragma unroll
  for (int m = 0; m < 4; ++m)
#pragma unroll
    for (int n = 0; n < 4; ++n) acc[m][n] = (f32x4){0.f, 0.f, 0.f, 0.f};
  const int KT = K >> 6;
  auto stage = [&](int kt, int buf) {
    char* sa = lds + buf * 32768;
    char* sb = sa + 16384;
#pragma unroll
    for (int i = 0; i < 4; ++i) {
      __builtin_amdgcn_global_load_lds((const void __attribute__((address_space(1)))*)(ag[i] + kt * 64), (void LAS*)(sa + (i * 256 + tid) * 16), 16, 0, 0);
      __builtin_amdgcn_global_load_lds((const void __attribute__((address_space(1)))*)(bg[i] + kt * 64), (void LAS*)(sb + (i * 256 + tid) * 16), 16, 0, 0);
    }
  };
  __syncthreads();
  stage(0, 0);
  const int swz = fr >> 1;
  for (int kt = 0; kt < KT; ++kt) {
    asm volatile("s_waitcnt vmcnt(0)" ::: "memory");
    __syncthreads();
    if (kt + 1 < KT) stage(kt + 1, (kt + 1) & 1);
    const char* sa = lds + (kt & 1) * 32768 + (wr * 64 + fr) * 128;
    const char* sb = lds + (kt & 1) * 32768 + 16384 + (wc * 64 + fr) * 128;
#pragma unroll
    for (int kk = 0; kk < 2; ++kk) {
      bf16x8 a[4], b[4];
      const int co = ((kk * 4 + fq) ^ swz) * 16;
#pragma unroll
      for (int m = 0; m < 4; ++m) a[m] = *(const bf16x8*)(sa + m * 2048 + co);
#pragma unroll
      for (int n = 0; n < 4; ++n) b[n] = *(const bf16x8*)(sb + n * 2048 + co);
#pragma unroll
      for (int m = 0; m < 4; ++m)
#pragma unroll
        for (int n = 0; n < 4; ++n) acc[m][n] = __builtin_amdgcn_mfma_f32_16x16x32_bf16(b[n], a[m], acc[m][n], 0, 0, 0);
    }
  }
  epi(acc, row0 + wr * 64, col0 + wc * 64, fr, fq);
}

struct EpiP {
  bf16_t *PA, *PBC; float* SSQ;
  DI void operator()(const f32x4 (&acc)[4][4], int r0, int c0, int fr, int fq) const {
    bf16_t* base; int ld, cb;
    if (c0 < LDPA) { base = PA; ld = LDPA; cb = c0; } else { base = PBC; ld = LDPBC; cb = c0 - LDPA; }
    if (c0 >= LDPA && cb < 1024) {
      float* dst = SSQ + (cb < 768 ? 0 : T_TOK);
#pragma unroll
      for (int m = 0; m < 4; ++m) {
        float ss = 0.f;
#pragma unroll
        for (int n = 0; n < 4; ++n)
#pragma unroll
          for (int j = 0; j < 4; ++j) ss += acc[m][n][j] * acc[m][n][j];
        ss += __shfl_xor(ss, 16); ss += __shfl_xor(ss, 32);
        if (fq == 0) atomicAdd(dst + r0 + m * 16 + fr, ss);
      }
    }
#pragma unroll
    for (int m = 0; m < 4; ++m)
#pragma unroll
      for (int n = 0; n < 4; ++n) {
        u32x2 v = {pk_bf16(acc[m][n][0], acc[m][n][1]), pk_bf16(acc[m][n][2], acc[m][n][3])};
        *(u32x2*)(base + (size_t)(r0 + m * 16 + fr) * ld + cb + n * 16 + fq * 4) = v;
      }
  }
};

DI void rope_angle(int pos, int i, float& cs, float& sn) {
  const float invf = __builtin_amdgcn_exp2f(-(float)i * (13.287712379549449f / 8.f));
  float ang = (float)pos * invf;
  float n = rintf(ang * 0.15915494309189535f);
  float r = fmaf(-n, 6.28125f, ang);
  r = fmaf(-n, 1.9353071795864769e-3f, r);
  cs = __cosf(r); sn = __sinf(r);
}

struct EpiQ {
  const float *rstd, *gn, *gr, *rope; bf16_t* Q;
  DI void operator()(const f32x4 (&acc)[4][4], int r0, int c0, int fr, int fq) const {
    if (c0 >= 576) return;
    if (c0 < 384) {
      const int h = c0 >> 6;
#pragma unroll
      for (int m = 0; m < 4; ++m) {
        const int row = r0 + m * 16 + fr; const float rs = rsqrtf(rstd[row] * (1.f / 768.f) + EPSF);
        float ss = 0.f;
#pragma unroll
        for (int n = 0; n < 4; ++n)
#pragma unroll
          for (int j = 0; j < 4; ++j) { float v = acc[m][n][j] * rs; ss += v * v; }
        ss += __shfl_xor(ss, 16); ss += __shfl_xor(ss, 32);
        const float inv = rsqrtf(ss * (1.f / 64.f) + EPSF) * rs * QSCALE;
        const int b = row / TB, s = row % TB;
        bf16_t* dst = Q + ((size_t)(b * 6 + h) * TB + s) * 96;
#pragma unroll
        for (int n = 0; n < 4; ++n) {
          const int d = n * 16 + fq * 4; f32x4 g = *(const f32x4*)(gn + d);
          u32x2 v = {pk_bf16(acc[m][n][0] * inv * g[0], acc[m][n][1] * inv * g[1]), pk_bf16(acc[m][n][2] * inv * g[2], acc[m][n][3] * inv * g[3])};
          *(u32x2*)(dst + d) = v;
        }
      }
    } else {
#pragma unroll
      for (int m = 0; m < 4; ++m) {
        const int row = r0 + m * 16 + fr; const float rs = rsqrtf(rstd[row] * (1.f / 768.f) + EPSF);
        const int b = row / TB, s = row % TB; const bool lat = s >= NCTX; const int sp = s - NCTX;
#pragma unroll
        for (int hh = 0; hh < 2; ++hh) {
          const int h = ((c0 - 384) >> 5) + hh;
          float ss = 0.f;
#pragma unroll
          for (int nn = 0; nn < 2; ++nn)
#pragma unroll
            for (int j = 0; j < 4; ++j) { float v = acc[m][hh * 2 + nn][j] * rs; ss += v * v; }
          ss += __shfl_xor(ss, 16); ss += __shfl_xor(ss, 32);
          const float inv = rsqrtf(ss * (1.f / 32.f) + EPSF) * rs;
          bf16_t* dst = Q + ((size_t)(b * 6 + h) * TB + s) * 96 + 64;
#pragma unroll
          for (int nn = 0; nn < 2; ++nn) {
            const int d = nn * 16 + fq * 4; f32x4 g = *(const f32x4*)(gr + d);
            float o[4];
#pragma unroll
            for (int j = 0; j < 4; ++j) {
              float val = acc[m][hh * 2 + nn][j] * inv * g[j];
              float partner = __shfl_xor(val, 32);
              if (lat) {
                const float* rt = rope + ((nn == 0 ? (sp >> 6) : (sp & 63)) * 8 + ((fq * 4 + j) & 7)) * 2; const float cs = rt[0], sn = rt[1];
                val = fq < 2 ? val * cs - partner * sn : val * cs + partner * sn;
              }
              o[j] = val * QSCALE;
            }
            u32x2 v = {pk_bf16(o[0], o[1]), pk_bf16(o[2], o[3])};
            *(u32x2*)(dst + d) = v;
          }
        }
      }
    }
  }
};

struct EpiK {
  const float *rstd, *gk; bf16_t* Kt;
  DI void operator()(const f32x4 (&acc)[4][4], int r0, int c0, int fr, int fq) const {
    const int h = c0 >> 6;
#pragma unroll
    for (int m = 0; m < 4; ++m) {
      const int row = r0 + m * 16 + fr; const float rs = rsqrtf(rstd[row] * (1.f / 256.f) + EPSF);
      float ss = 0.f;
#pragma unroll
      for (int n = 0; n < 4; ++n)
#pragma unroll
        for (int j = 0; j < 4; ++j) { float v = acc[m][n][j] * rs; ss += v * v; }
      ss += __shfl_xor(ss, 16); ss += __shfl_xor(ss, 32);
      const float inv = rsqrtf(ss * (1.f / 64.f) + EPSF) * rs;
      const int b = row / TB, s = row % TB;
      bf16_t* dst = Kt + ((size_t)(b * 6 + h) * TB + s) * 96;
#pragma unroll
      for (int n = 0; n < 4; ++n) {
        const int d = n * 16 + fq * 4; f32x4 g = *(const f32x4*)(gk + d);
        u32x2 v = {pk_bf16(acc[m][n][0] * inv * g[0], acc[m][n][1] * inv * g[1]), pk_bf16(acc[m][n][2] * inv * g[2], acc[m][n][3] * inv * g[3])};
        *(u32x2*)(dst + d) = v;
      }
    }
  }
};

struct EpiV {
  const float* rstd; bf16_t* VT;
  DI void operator()(const f32x4 (&acc)[4][4], int r0, int c0, int fr, int fq) const {
#pragma unroll
    for (int m = 0; m < 4; ++m)
#pragma unroll
      for (int n = 0; n < 4; ++n) {
        const int row = r0 + m * 16 + fr, col = c0 + n * 16 + fq * 4;
        f32x4 rs = *(const f32x4*)(rstd + col);
#pragma unroll
        for (int j = 0; j < 4; ++j) rs[j] = rsqrtf(rs[j] * (1.f / 256.f) + EPSF);
        u32x2 v = {pk_bf16(acc[m][n][0] * rs[0], acc[m][n][1] * rs[1]), pk_bf16(acc[m][n][2] * rs[2], acc[m][n][3] * rs[3])};
        *(u32x2*)(VT + (size_t)row * T_TOK + col) = v;
      }
  }
};

struct EpiPost {
  const float *Y, *BON, *mu, *lnx_g, *lnx_b; const bf16_t* PA; bf16_t* YC;
  DI void operator()(const f32x4 (&acc)[4][4], int r0, int c0, int fr, int fq) const {
    const int h = c0 >> 6;
#pragma unroll
    for (int m = 0; m < 4; ++m) {
      const int row = r0 + m * 16 + fr; const int s = row % TB;
      const bool hasprev = (s != 0 && s != NCTX), hasnext = (s != NCTX - 1 && s != TB - 1);
      f32x4 y[4];
      float s1 = 0.f;
#pragma unroll
      for (int n = 0; n < 4; ++n) {
        const size_t o = (size_t)row * 384 + c0 + n * 16 + fq * 4;
        y[n] = *(const f32x4*)(Y + o) + *(const f32x4*)(Y + (size_t)T_TOK * 384 + o);
        s1 += y[n][0] + y[n][1] + y[n][2] + y[n][3];
      }
      s1 += __shfl_xor(s1, 16); s1 += __shfl_xor(s1, 32);
      const float mean = s1 * (1.f / 64.f);
      float s2 = 0.f;
#pragma unroll
      for (int n = 0; n < 4; ++n)
#pragma unroll
        for (int j = 0; j < 4; ++j) { float d = y[n][j] - mean; s2 += d * d; }
      s2 += __shfl_xor(s2, 16); s2 += __shfl_xor(s2, 32);
      const float rstdv = rsqrtf(s2 * (1.f / 64.f) + GN_EPS);
      const float bon = BON[(size_t)row * 6 + h] + BON[(size_t)T_TOK * 6 + (size_t)row * 6 + h];
#pragma unroll
      for (int n = 0; n < 4; ++n) {
        const int col = c0 + n * 16 + fq * 4;
        const bf16_t* pv = PA + (size_t)row * LDPA + 768 + col;
        float vc[4], vp[4] = {0.f, 0.f, 0.f, 0.f}, vn[4] = {0.f, 0.f, 0.f, 0.f};
        unpack4(*(const u32x2*)pv, vc);
        if (hasprev) unpack4(*(const u32x2*)(pv - LDPA), vp);
        if (hasnext) unpack4(*(const u32x2*)(pv + LDPA), vn);
        f32x4 m0 = *(const f32x4*)(mu + 768 + col), m1 = *(const f32x4*)(mu + LDPA + 768 + col);
        f32x4 lg = *(const f32x4*)(lnx_g + col), lb = *(const f32x4*)(lnx_b + col);
        float o[4];
#pragma unroll
        for (int j = 0; j < 4; ++j) {
          const float v = vc[j] + m0[j] * (vp[j] - vc[j]) + m1[j] * (vn[j] - vc[j]);
          o[j] = ((y[n][j] - mean) * rstdv * lg[j] + lb[j] + bon * v) * acc[m][n][j];
        }
        u32x2 w = {pk_bf16(o[0], o[1]), pk_bf16(o[2], o[3])};
        *(u32x2*)(YC + (size_t)row * DM + col) = w;
      }
    }
  }
};

struct EpiRes {
  const Params* p; int l; bool from_inputs; int gate_off;
  DI void operator()(const f32x4 (&acc)[4][4], int r0, int c0, int fr, int fq) const {
#pragma unroll
    for (int m = 0; m < 4; ++m) {
      const int row = r0 + m * 16 + fr; const int b = row / TB, s = row % TB;
      const float* src = xsrc_row(*p, from_inputs, b, s);
      float* dst = xdst_row(*p, b, s);
      const float* gate = p->MOD + (size_t)(l * 9 + (s < NCTX ? 8 : b)) * 6144 + gate_off;
#pragma unroll
      for (int n = 0; n < 4; ++n) {
        const int col = c0 + n * 16 + fq * 4;
        f32x4 g = *(const f32x4*)(gate + col), xv = *(const f32x4*)(src + col);
        *(f32x4*)(dst + col) = xv + g * acc[m][n];
      }
    }
  }
};

struct EpiFfnIn {
  bf16_t* ACT;
  DI void operator()(const f32x4 (&acc)[4][4], int r0, int c0, int fr, int fq) const {
    const int cb = (c0 >> 6) * 32;
#pragma unroll
    for (int m = 0; m < 4; ++m)
#pragma unroll
      for (int n = 0; n < 2; ++n) {
        float o[4];
#pragma unroll
        for (int j = 0; j < 4; ++j) { float g = acc[m][n][j]; o[j] = g / (1.f + __expf(-g)) * acc[m][n + 2][j]; }
        u32x2 w = {pk_bf16(o[0], o[1]), pk_bf16(o[2], o[3])};
        *(u32x2*)(ACT + (size_t)(r0 + m * 16 + fr) * 2816 + cb + n * 16 + fq * 4) = w;
      }
  }
};

DI void prep_token(const Params& p, int l, int row, int lane) {
  const int b = row / TB, s = row % TB;
  const bool hasprev = (s != 0 && s != NCTX), hasnext = (s != NCTX - 1 && s != TB - 1);
  const float mp = hasprev ? 1.f : 0.f, mn = hasnext ? 1.f : 0.f;
  const bf16_t* pa = p.PA + (size_t)row * LDPA;
  const bf16_t* pbc = p.PBC + (size_t)row * LDPBC;
  const int opa = hasprev ? -LDPA : 0, ona = hasnext ? LDPA : 0, opb = hasprev ? -LDPBC : 0, onb = hasnext ? LDPBC : 0;
  const int l32 = lane & 31, c8 = l32 * 8, colA = 1152 + c8;
  const u32x4 la_c = *(const u32x4*)(pa + colA), la_p = *(const u32x4*)(pa + opa + colA), la_n = *(const u32x4*)(pa + ona + colA);
  const u32x4 lq0 = *(const u32x4*)(pbc + lane * 8), lq1 = *(const u32x4*)(pbc + 512 + c8), lkv = *(const u32x4*)(pbc + 768 + c8);
  const u32x4 lrp = *(const u32x4*)(pbc + 1024 + (lane & 3) * 8);
  const u32x4 lbg = *(const u32x4*)(pbc + 1056 + c8), lcc = *(const u32x4*)(pbc + 1312 + c8), lhh = *(const u32x4*)(pbc + 1568 + c8);
  const u32x4 lcp = *(const u32x4*)(pbc + opb + 1312 + c8), lhp = *(const u32x4*)(pbc + opb + 1568 + c8);
  const u32x4 lcn = *(const u32x4*)(pbc + onb + 1312 + c8), lhn = *(const u32x4*)(pbc + onb + 1568 + c8);
  const float* mu = p.tshift_mu + (size_t)l * 2 * LDPA;
  {
    float c[8], pv[8], nx[8], o[8];
    unpack8(la_c, c); unpack8(la_p, pv); unpack8(la_n, nx);
    const f32x4 m0a = *(const f32x4*)(mu + colA), m0b = *(const f32x4*)(mu + colA + 4), m1a = *(const f32x4*)(mu + LDPA + colA), m1b = *(const f32x4*)(mu + LDPA + colA + 4);
#pragma unroll
    for (int j = 0; j < 8; ++j) {
      const float m0 = j < 4 ? m0a[j & 3] : m0b[j & 3], m1 = j < 4 ? m1a[j & 3] : m1b[j & 3];
      float t = c[j] + m0 * (pv[j] * mp - c[j]) + m1 * (nx[j] * mn - c[j]);
      if (l32 < 8) { float e = __expf(2.f * t); t = 1.f - 2.f * __builtin_amdgcn_rcpf(1.f + e); }
      else if (l32 >= 16) t = __builtin_amdgcn_rcpf(1.f + __expf(-t));
      o[j] = t;
    }
    u32x4 w = {pk_bf16(o[0], o[1]), pk_bf16(o[2], o[3]), pk_bf16(o[4], o[5]), pk_bf16(o[6], o[7])};
    if (lane < 8) *(u32x4*)(p.TW + (size_t)row * 64 + lane * 8) = w;
    else if (lane < 16) *(u32x4*)(p.TA + (size_t)row * 64 + (lane - 8) * 8) = w;
    else if (lane < 32) *(u32x4*)(p.TG + (size_t)row * 128 + (lane - 16) * 8) = w;
  }
  float f[8], ss = 0.f, s2 = 0.f, s3 = 0.f, fr_[8];
  unpack8(lq0, f);
#pragma unroll
  for (int j = 0; j < 8; ++j) ss += f[j] * f[j];
  unpack8(lq1, f);
  if (lane < 32) {
#pragma unroll
    for (int j = 0; j < 8; ++j) ss += f[j] * f[j];
  }
  unpack8(lkv, f);
  if (lane < 32) {
#pragma unroll
    for (int j = 0; j < 8; ++j) s2 += f[j] * f[j];
  }
  unpack8(lrp, fr_);
  if (lane < 4) {
#pragma unroll
    for (int j = 0; j < 8; ++j) s3 += fr_[j] * fr_[j];
  }
  s3 += __shfl_xor(s3, 1); s3 += __shfl_xor(s3, 2);
  {
    const float inv = rsqrtf(s3 * (1.f / 32.f) + EPSF);
    const float* g = p.k_rope_g + l * 32;
    const bool lat = s >= NCTX; const int sp = lat ? s - NCTX : 0;
    const float* rt = p.ROPE + ((lane & 2) ? (sp & 63) : (sp >> 6)) * 16;
    float o[8];
#pragma unroll
    for (int j = 0; j < 8; ++j) {
      float val = fr_[j] * inv * g[(lane & 3) * 8 + j];
      float partner = __shfl_xor(val, 1);
      if (lat) {
        const float cs = rt[2 * j], sn = rt[2 * j + 1];
        val = (lane & 1) == 0 ? val * cs - partner * sn : val * cs + partner * sn;
      }
      o[j] = val;
    }
    if (lane < 4) {
      u32x4 w = {pk_bf16(o[0], o[1]), pk_bf16(o[2], o[3]), pk_bf16(o[4], o[5]), pk_bf16(o[6], o[7])};
#pragma unroll
      for (int hh = 0; hh < 6; ++hh) *(u32x4*)(p.Kt + ((size_t)(b * 6 + hh) * TB + s) * 96 + 64 + lane * 8) = w;
    }
  }
  {
    float bg[8], cc[8], hh[8], cp[8], hp[8], cn[8], hn[8], o[8];
    unpack8(lbg, bg); unpack8(lcc, cc); unpack8(lhh, hh); unpack8(lcp, cp); unpack8(lhp, hp); unpack8(lcn, cn); unpack8(lhn, hn);
    const float* cw = p.conv_w + (size_t)l * 3 * 256;
#pragma unroll
    for (int j = 0; j < 8; ++j) o[j] = bg[j] * (cw[c8 + j] * cp[j] * hp[j] * mp + cw[256 + c8 + j] * cc[j] * hh[j] + cw[512 + c8 + j] * cn[j] * hn[j] * mn);
    u32x4 w = {pk_bf16(o[0], o[1]), pk_bf16(o[2], o[3]), pk_bf16(o[4], o[5]), pk_bf16(o[6], o[7])};
    if (lane < 32) *(u32x4*)(p.HY + (size_t)row * DM + 768 + c8) = w;
  }
}

#define MFMA32(a, b, c) __builtin_amdgcn_mfma_f32_32x32x16_bf16((a), (b), (c), 0, 0, 0)
DI bf16x8 pack8(const f32x16& x, int s) {
  u32x4 v = {pk_bf16(x[8 * s], x[8 * s + 1]), pk_bf16(x[8 * s + 2], x[8 * s + 3]), pk_bf16(x[8 * s + 4], x[8 * s + 5]), pk_bf16(x[8 * s + 6], x[8 * s + 7])};
  return __builtin_bit_cast(bf16x8, v);
}
constexpr int KROW = 208, VROW = 136, KBUF = 64 * KROW, VBUF = 64 * VROW;
DI void attn_task(const Params& p, int b, int h, int q0, int k0, int nk, char* lds) {
  const int tid = opaque_tid(), lane = tid & 63, wid = tid >> 6, r = lane & 31, hh = lane >> 5;
  const bf16_t* Qp = p.Q + ((size_t)(b * 6 + h) * TB + q0 + wid * 32 + r) * 96;
  const bf16_t* Kp = p.Kt + ((size_t)(b * 6 + h) * TB + k0) * 96;
  const bf16_t* Vp = p.VT + (size_t)(h * 64) * T_TOK + (size_t)b * TB + k0;
  bf16x8 qf[6];
#pragma unroll
  for (int ks = 0; ks < 6; ++ks) qf[ks] = *(const bf16x8*)(Qp + ks * 16 + hh * 8);
  int krow_[3], kch_[3];
#pragma unroll
  for (int i = 0; i < 3; ++i) { int id = tid + i * 256; krow_[i] = id / 12; kch_[i] = id % 12; }
  const int vd0 = tid >> 3, vch = tid & 7;
  u32x4 kreg[3], vreg[2];
  auto load_regs = [&](int kt) {
#pragma unroll
    for (int i = 0; i < 3; ++i) kreg[i] = *(const u32x4*)(Kp + (size_t)(kt * 64 + krow_[i]) * 96 + kch_[i] * 8);
#pragma unroll
    for (int i = 0; i < 2; ++i) vreg[i] = *(const u32x4*)(Vp + (size_t)(vd0 + 32 * i) * T_TOK + kt * 64 + vch * 8);
  };
  auto write_lds = [&](int buf) {
    char* kb = lds + buf * (KBUF + VBUF);
    char* vb = kb + KBUF;
#pragma unroll
    for (int i = 0; i < 3; ++i) *(u32x4*)(kb + krow_[i] * KROW + kch_[i] * 16) = kreg[i];
#pragma unroll
    for (int i = 0; i < 2; ++i) {
      char* d = vb + (vd0 + 32 * i) * VROW + vch * 16;
      *(u32x2*)d = (u32x2){vreg[i][0], vreg[i][1]};
      *(u32x2*)(d + 8) = (u32x2){vreg[i][2], vreg[i][3]};
    }
  };
  f32x16 o[2];
#pragma unroll
  for (int i = 0; i < 16; ++i) { o[0][i] = 0.f; o[1][i] = 0.f; }
  float m_run = -1e30f, l_run = 0.f;
  const int NT = nk >> 6;
  __syncthreads();
  load_regs(0);
  write_lds(0);
  for (int kt = 0; kt < NT; ++kt) {
    if (kt + 1 < NT) load_regs(kt + 1);
    __syncthreads();
    const char* kb = lds + (kt & 1) * (KBUF + VBUF);
    const char* vb = kb + KBUF;
    f32x16 st[2];
#pragma unroll
    for (int kbk = 0; kbk < 2; ++kbk) {
#pragma unroll
      for (int i = 0; i < 16; ++i) st[kbk][i] = 0.f;
#pragma unroll
      for (int ks = 0; ks < 6; ++ks) {
        bf16x8 kf = *(const bf16x8*)(kb + (kbk * 32 + r) * KROW + ks * 32 + hh * 16);
        st[kbk] = MFMA32(kf, qf[ks], st[kbk]);
      }
    }
    float mx = st[0][0];
#pragma unroll
    for (int i = 0; i < 16; ++i) { mx = fmaxf(mx, st[0][i]); mx = fmaxf(mx, st[1][i]); }
    mx = fmaxf(mx, __shfl_xor(mx, 32));
    const float m_new = fmaxf(m_run, mx);
    const float alpha = __builtin_amdgcn_exp2f(m_run - m_new);
    m_run = m_new;
    float psum = 0.f;
#pragma unroll
    for (int kbk = 0; kbk < 2; ++kbk)
#pragma unroll
      for (int i = 0; i < 16; ++i) { float e = __builtin_amdgcn_exp2f(st[kbk][i] - m_new); st[kbk][i] = e; psum += e; }
    psum += __shfl_xor(psum, 32);
    l_run = l_run * alpha + psum;
#pragma unroll
    for (int i = 0; i < 16; ++i) { o[0][i] *= alpha; o[1][i] *= alpha; }
#pragma unroll
    for (int ksv = 0; ksv < 4; ++ksv) {
      const bf16x8 pf = pack8(st[ksv >> 1], ksv & 1);
#pragma unroll
      for (int db = 0; db < 2; ++db) {
        const char* va = vb + (db * 32 + r) * VROW + (ksv * 16 + 4 * hh) * 2;
        s16x4 lo = *(const s16x4*)va, hi = *(const s16x4*)(va + 16);
        bf16x8 vf = __builtin_shufflevector(lo, hi, 0, 1, 2, 3, 4, 5, 6, 7);
        o[db] = MFMA32(vf, pf, o[db]);
      }
    }
    if (kt + 1 < NT) write_lds((kt + 1) & 1);
  }
  const float invl = 1.f / l_run;
  bf16_t* dst = p.HY + (size_t)(b * TB + q0 + wid * 32 + r) * DM + 384 + h * 64;
#pragma unroll
  for (int db = 0; db < 2; ++db)
#pragma unroll
    for (int g = 0; g < 4; ++g) {
      u32x2 w = {pk_bf16(o[db][4 * g] * invl, o[db][4 * g + 1] * invl), pk_bf16(o[db][4 * g + 2] * invl, o[db][4 * g + 3] * invl)};
      *(u32x2*)(dst + db * 32 + 8 * g + 4 * hh) = w;
    }
}

enum { VW = 0, VKK = 1, VB = 2, VKD = 3, VR = 4, VV = 5 };
DI void scan_task(const Params& p, int l, int b, int h, int dir, int half, char* lds) {
  float* cb = (float*)lds;
  float* tk = cb + 6 * 1024;
  float* ybuf = tk + 1024;
  const int tid = opaque_tid(), lane = tid & 63, wid = tid >> 6;
  const int st_p = tid >> 4, c4 = tid & 15;
  const int fr = lane & 15, fq = lane >> 4;
  const int rp = lane >> 4, g = lane & 15;
  const int hc = h * 64;
  bf16x8 bw[2], ba[2];
  {
    const bf16_t* wd = p.Wdecay + ((size_t)dir * 384 + hc + wid * 16 + fr) * 64;
    const bf16_t* wi = p.Wicl + ((size_t)dir * 384 + hc + wid * 16 + fr) * 64;
#pragma unroll
    for (int ks = 0; ks < 2; ++ks) { bw[ks] = *(const bf16x8*)(wd + ks * 32 + fq * 8); ba[ks] = *(const bf16x8*)(wi + ks * 32 + fq * 8); }
  }
  f32x4 mu0[3], mu1[3];
  const float* mu = p.tshift_mu + (size_t)l * 2 * LDPA;
#pragma unroll
  for (int sec = 0; sec < 3; ++sec) { mu0[sec] = *(const f32x4*)(mu + sec * 384 + hc + c4 * 4); mu1[sec] = *(const f32x4*)(mu + LDPA + sec * 384 + hc + c4 * 4); }
  const f32x4 kkg = *(const f32x4*)(p.k_k + l * 384 + hc + c4 * 4);
  const f32x4 rkg = *(const f32x4*)(p.r_k + l * 384 + hc + c4 * 4);
  const int colB = wid * 16 + fq * 4;
  const f32x4 w0 = *(const f32x4*)(p.decay_w0 + (size_t)(l * 2 + dir) * 384 + hc + colB);
  const f32x4 a0 = *(const f32x4*)(p.icl_a0 + (size_t)(l * 2 + dir) * 384 + hc + colB);
  const f32x4 kag = *(const f32x4*)(p.k_a + l * 384 + hc + colB);

  u32x2 ld[3][3];
  float mprev = 0.f, mnext = 0.f;
  bf16x8 aw[2], aa[2];
  auto chunk_lo = [&](int c) -> int { return dir == 0 ? 16 * c : (c < 16 ? 240 - 16 * c : 2544 - 16 * c); };
  auto issue_loads = [&](int c) {
    const int slo = chunk_lo(c);
    const int s = slo + st_p;
    const bool hasprev = (s != 0 && s != NCTX), hasnext = (s != NCTX - 1 && s != TB - 1);
    const bf16_t* pa = p.PA + (size_t)(b * TB + s) * LDPA + hc + c4 * 4;
    const int op = hasprev ? -LDPA : 0, on = hasnext ? LDPA : 0;
    mprev = hasprev ? 1.f : 0.f; mnext = hasnext ? 1.f : 0.f;
#pragma unroll
    for (int sec = 0; sec < 3; ++sec) {
      ld[sec][1] = *(const u32x2*)(pa + sec * 384);
      ld[sec][0] = *(const u32x2*)(pa + sec * 384 + op);
      ld[sec][2] = *(const u32x2*)(pa + sec * 384 + on);
    }
    const size_t trow = (size_t)(b * TB + slo + fr) * 64;
#pragma unroll
    for (int ks = 0; ks < 2; ++ks) { aw[ks] = *(const bf16x8*)(p.TW + trow + ks * 32 + fq * 8); aa[ks] = *(const bf16x8*)(p.TA + trow + ks * 32 + fq * 8); }
  };
  auto produce = [&](int c) {
    const int slo = chunk_lo(c);
    float ts[3][4];
#pragma unroll
    for (int sec = 0; sec < 3; ++sec) {
      float pc[4], pp[4], pn[4];
      unpack4(ld[sec][1], pc); unpack4(ld[sec][0], pp); unpack4(ld[sec][2], pn);
#pragma unroll
      for (int j = 0; j < 4; ++j) ts[sec][j] = pc[j] + mu0[sec][j] * (pp[j] * mprev - pc[j]) + mu1[sec][j] * (pn[j] * mnext - pc[j]);
    }
    *(f32x4*)(cb + VR * 1024 + st_p * 64 + c4 * 4) = (f32x4){ts[0][0], ts[0][1], ts[0][2], ts[0][3]};
    *(f32x4*)(cb + VV * 1024 + st_p * 64 + c4 * 4) = (f32x4){ts[2][0], ts[2][1], ts[2][2], ts[2][3]};
    *(f32x4*)(tk + st_p * 64 + c4 * 4) = (f32x4){ts[1][0], ts[1][1], ts[1][2], ts[1][3]};
    float kx[4], ss = 0.f;
#pragma unroll
    for (int j = 0; j < 4; ++j) { kx[j] = ts[1][j] * kkg[j]; ss += kx[j] * kx[j]; }
    ss = red16(ss);
    const float inv = rsqrtf(ss + 1e-12f);
    *(f32x4*)(cb + VKK * 1024 + st_p * 64 + c4 * 4) = (f32x4){kx[0] * inv, kx[1] * inv, kx[2] * inv, kx[3] * inv};
    __syncthreads();
    f32x4 dw = {0.f, 0.f, 0.f, 0.f}, da = {0.f, 0.f, 0.f, 0.f};
#pragma unroll
    for (int ks = 0; ks < 2; ++ks) {
      dw = __builtin_amdgcn_mfma_f32_16x16x32_bf16(bw[ks], aw[ks], dw, 0, 0, 0);
      da = __builtin_amdgcn_mfma_f32_16x16x32_bf16(ba[ks], aa[ks], da, 0, 0, 0);
    }
    {
      const f32x4 kv = *(const f32x4*)(tk + fr * 64 + colB);
      const f32x4 kkv = *(const f32x4*)(cb + VKK * 1024 + fr * 64 + colB);
      f32x4 wv, kdv, bv;
#pragma unroll
      for (int j = 0; j < 4; ++j) {
        wv[j] = __expf(-LOG_DECAY_SCALE * sigmoidf_(w0[j] + dw[j]));
        const float a = sigmoidf_(a0[j] + da[j]);
        kdv[j] = kv[j] * (1.f + (a - 1.f) * kag[j]);
        bv[j] = kkv[j] * a;
      }
      *(f32x4*)(cb + VW * 1024 + fr * 64 + colB) = wv;
      *(f32x4*)(cb + VKD * 1024 + fr * 64 + colB) = kdv;
      *(f32x4*)(cb + VB * 1024 + fr * 64 + colB) = bv;
    }
    __syncthreads();
    {
      const f32x4 rv = *(const f32x4*)(cb + VR * 1024 + st_p * 64 + c4 * 4);
      const f32x4 kdv = *(const f32x4*)(cb + VKD * 1024 + st_p * 64 + c4 * 4);
      float bs = rv[0] * kdv[0] * rkg[0] + rv[1] * kdv[1] * rkg[1] + rv[2] * kdv[2] * rkg[2] + rv[3] * kdv[3] * rkg[3];
      bs = red16(bs);
      if (c4 == 0 && half == 0) p.BON[(size_t)dir * T_TOK * 6 + (size_t)(b * TB + slo + st_p) * 6 + h] = bs;
    }
  };

  f32x2 S0[2], S1[2];
#pragma unroll
  for (int j = 0; j < 2; ++j) { S0[j] = (f32x2){0.f, 0.f}; S1[j] = (f32x2){0.f, 0.f}; }
  __syncthreads();
  issue_loads(0);
  produce(0);
  __syncthreads();
  const int NCH = TB / 16;
  const int rowl = half * 32 + wid * 8 + rp * 2;
  const int inc = dir ? -64 : 64;
  for (int c = 0; c < NCH; ++c) {
    if (c + 1 < NCH) issue_loads(c + 1);
    {
      const float* ps = cb + (dir ? 15 * 64 : 0) + g * 4;
      const float* pv = cb + VV * 1024 + (dir ? 15 * 64 : 0) + rowl;
      float* py = ybuf + (dir ? 15 * 512 : 0) + ((wid * 4 + rp) * 16 + g) * 2;
      f32x4 cw = *(const f32x4*)(ps + VW * 1024), ckk = *(const f32x4*)(ps + VKK * 1024), cbb = *(const f32x4*)(ps + VB * 1024),
            ckd = *(const f32x4*)(ps + VKD * 1024), crr = *(const f32x4*)(ps + VR * 1024);
      f32x2 cvv = *(const f32x2*)pv;
#pragma unroll
      for (int ii = 0; ii < 16; ++ii) {
        f32x4 nw = cw, nkk = ckk, nbb = cbb, nkd = ckd, nrr = crr; f32x2 nvv = cvv;
        if (ii < 15) {
          ps += inc; pv += inc;
          nw = *(const f32x4*)(ps + VW * 1024); nkk = *(const f32x4*)(ps + VKK * 1024); nbb = *(const f32x4*)(ps + VB * 1024);
          nkd = *(const f32x4*)(ps + VKD * 1024); nrr = *(const f32x4*)(ps + VR * 1024); nvv = *(const f32x2*)pv;
        }
        __builtin_amdgcn_sched_barrier(0x7);
        const f32x2 kk0 = {ckk[0], ckk[1]}, kk1 = {ckk[2], ckk[3]}, w0 = {cw[0], cw[1]}, w1 = {cw[2], cw[3]};
        const f32x2 b0 = {cbb[0], cbb[1]}, b1 = {cbb[2], cbb[3]}, kd0 = {ckd[0], ckd[1]}, kd1 = {ckd[2], ckd[3]};
        const f32x2 r0 = {crr[0], crr[1]}, r1 = {crr[2], crr[3]};
        const f32x2 p0 = S0[0] * kk0 + S0[1] * kk1, p1 = S1[0] * kk0 + S1[1] * kk1;
        const f32x2 u00 = S0[0] * w0 + kd0 * cvv[0], u01 = S0[1] * w1 + kd1 * cvv[0];
        const f32x2 u10 = S1[0] * w0 + kd0 * cvv[1], u11 = S1[1] * w1 + kd1 * cvv[1];
        const float q0 = red16(p0[0] + p0[1]), q1 = red16(p1[0] + p1[1]);
        S0[0] = u00 - b0 * q0; S0[1] = u01 - b1 * q0;
        S1[0] = u10 - b0 * q1; S1[1] = u11 - b1 * q1;
        const f32x2 y0 = S0[0] * r0 + S0[1] * r1, y1 = S1[0] * r0 + S1[1] * r1;
        *(f32x2*)py = (f32x2){y0[0] + y0[1], y1[0] + y1[1]};
        py += dir ? -512 : 512;
        cw = nw; ckk = nkk; cbb = nbb; ckd = nkd; crr = nrr; cvv = nvv;
      }
    }
    __syncthreads();
    {
      const int slo = chunk_lo(c);
      const float* yp = ybuf + (st_p * 16 + c4) * 32;
      f32x4 a = *(const f32x4*)yp;
#pragma unroll
      for (int i = 1; i < 8; ++i) a += *(const f32x4*)(yp + 4 * i);
      *(f32x2*)(p.Y + (size_t)dir * T_TOK * 384 + (size_t)(b * TB + slo + st_p) * 384 + hc + half * 32 + c4 * 2) = (f32x2){a[0] + a[2], a[1] + a[3]};
    }
    if (c + 1 < NCH) produce(c + 1);
    __syncthreads();
  }
}

DI int lat_tile(int i) { return (i >> 4) * 18 + 2 + (i & 15); }
DI bool xcd_tile(int bid, int G, int i, int MT, int NT, int& tm, int& tn) {
  if ((G & 7) || (MT & 7)) { const int t = bid + i * G; if (t >= MT * NT) return false; tm = t / NT; tn = t % NT; return true; }
  const int nbx = G >> 3, x = bid & 7, j = bid >> 3, MS = MT >> 3;
  const int q = j + nbx * i;
  if (q >= MS * NT) return false;
  const int full = NT >> 3, wl = NT & 7;
  int nb = q / (MS * 8), m, ni;
  if (nb < full) { const int rem = q - nb * MS * 8; m = rem >> 3; ni = rem & 7; }
  else { const int rem = q - full * MS * 8; nb = full; m = rem / wl; ni = rem % wl; }
  tm = x * MS + m; tn = nb * 8 + ni;
  return true;
}

template <int KSEL> DI void run_phase(const Params& p, int ph, char* lds) {
  const int bid = blockIdx.x, G = gridDim.x, tid = opaque_tid(), lane = tid & 63, wid = tid >> 6;
  if (ph == 0) {
    if (KSEL >= 0 && KSEL != 10) return;
    for (int t = bid; t < 384 + NCONV_W1 + 1; t += G) {
      if (t < 384) adaln_task(p, t, lds);
      else if (t < 384 + NCONV_W1) conv_w1_task(p, 0, t - 384, lds);
      else { for (int e = tid; e < 512; e += 256) { float cs, sn; rope_angle(e >> 3, e & 7, cs, sn); p.ROPE[2 * e] = cs; p.ROPE[2 * e + 1] = sn; } }
    }
    return;
  }
  if (KSEL == 10) return;
  const int l = (ph - 1) / 9, kq = (ph - 1) % 9, k = kq < 2 ? kq : kq + 1;
  const bool last = (l == 1);
  const int lb = ((G & 7) == 0) ? (bid & 7) * (G >> 3) + (bid >> 3) : bid;
  if (KSEL >= 0 && KSEL != 10 && k != (KSEL == 11 ? 4 : KSEL)) return;
  switch (k) {
    case 0:
      for (int i = bid * 256 + tid; i < 2 * T_TOK; i += G * 256) p.RSTD[i] = 0.f;
      modnorm_rows(p, l, 0, l == 0, false, bid * 4 + wid, G * 4, lane);
      break;
    case 1: {
      EpiP e{p.PA, p.PBC, p.RSTD};
      for (int i = 0, tm, tn; xcd_tile(bid, G, i, 144, 26, tm, tn); ++i) gemm_tile(p.HY, DM, p.Win, DM, DM, tm * 128, tn * 128, lds, e);
    } break;
    case 3: {
      const int nq = last ? 128 * 5 : 144 * 5;
      EpiQ eq{p.RSTD, p.q_nope_g + l * 64, p.q_rope_g + l * 32, p.ROPE, p.Q};
      EpiK ek{p.RSTD + T_TOK, p.k_nope_g + l * 64, p.Kt};
      EpiV ev{p.RSTD + T_TOK, p.VT};
      if (KSEL >= 0) {
        for (int t = bid; t < nq + 432 + 432 + T_TOK / 4; t += G) {
          if (t >= nq + 864) { prep_token(p, l, (t - nq - 864) * 4 + wid, lane); continue; }
          if (t < nq) { int i = t / 5; int tm = last ? lat_tile(i) : i; gemm_tile(p.PBC, LDPBC, p.Wuq, 768, 768, tm * 128, (t % 5) * 128, lds, eq); }
          else if (t < nq + 432) { int u = t - nq; gemm_tile(p.PBC + 768, LDPBC, p.WukvK, 256, 256, (u / 3) * 128, (u % 3) * 128, lds, ek); }
          else { int u = t - nq - 432; gemm_tile(p.WvT, 256, p.PBC + 768, LDPBC, 256, (u % 3) * 128, (u / 3) * 128, lds, ev); }
        }
      } else {
        for (int t = bid; t < T_TOK / 4; t += G) prep_token(p, l, t * 4 + wid, lane);
        volatile LAS unsigned* slot = (volatile LAS unsigned*)(lds + 65536 + 8);
        unsigned* qg = p.BAR + 3456   + 64 * l + 16;
        for (;;) {
          __syncthreads();
          if (tid == 0) *slot = __hip_atomic_fetch_add(qg, 1u, __ATOMIC_RELAXED, __HIP_MEMORY_SCOPE_AGENT);
          __syncthreads();
          const int t = (int)*slot;
          if (t >= nq + 864) break;
          if (t < nq) { int i = t / 5; int tm = last ? lat_tile(i) : i; gemm_tile(p.PBC, LDPBC, p.Wuq, 768, 768, tm * 128, (t % 5) * 128, lds, eq); }
          else if (t < nq + 432) { int u = t - nq; gemm_tile(p.PBC + 768, LDPBC, p.WukvK, 256, 256, (u / 3) * 128, (u % 3) * 128, lds, ek); }
          else { int u = t - nq - 432; gemm_tile(p.WvT, 256, p.PBC + 768, LDPBC, 256, (u % 3) * 128, (u / 3) * 128, lds, ev); }
        }
      }
    } break;
    case 4: {
      const int natt = 768 + (last ? 0 : 96);
      if (KSEL != 11) { if (bid < 192) { scan_task(p, l, bid / 24, (bid % 24) >> 2, (bid >> 1) & 1, bid & 1, lds); break; } if (KSEL == 4) break; }
      const int aoff = KSEL == 11 ? 0 : 192;
      if (KSEL == 11) {
        for (int t = bid; t < natt + NCONV_FF; t += G) {
          if (t < 768) { int bh = t >> 4, qb = t & 15; attn_task(p, bh / 6, bh % 6, NCTX + qb * 128, 0, TB, lds); }
          else if (t < natt) { int u = t - 768; int bh = u >> 1, qb = u & 1; attn_task(p, bh / 6, bh % 6, qb * 128, 0, NCTX, lds); }
          else conv_ff_task(p, l, t - natt, lds);
        }
      } else {
        volatile LAS unsigned* slot = (volatile LAS unsigned*)(lds + 65536 + 8);
        for (;;) {
          __syncthreads();
          if (tid == 0) *slot = __hip_atomic_fetch_add(p.BAR + 3456   + 64 * l, 1u, __ATOMIC_RELAXED, __HIP_MEMORY_SCOPE_AGENT);
          __syncthreads();
          const int t = (int)*slot;
          if (t >= natt + NCONV_FF) break;
          if (t < 768) { int bh = t >> 4, qb = t & 15; attn_task(p, bh / 6, bh % 6, NCTX + qb * 128, 0, TB, lds); }
          else if (t < natt) { int u = t - 768; int bh = u >> 1, qb = u & 1; attn_task(p, bh / 6, bh % 6, qb * 128, 0, NCTX, lds); }
          else conv_ff_task(p, l, t - natt, lds);
        }
      }
    } break;
    case 5: {
      EpiPost e{p.Y, p.BON, p.tshift_mu + (size_t)l * 2 * LDPA, p.lnx_g + l * 384, p.lnx_b + l * 384, p.PA, p.HY};
      const int nm = last ? 128 : 144;
      for (int t = bid; t < nm * 3; t += G) { int i = t / 3; int tm = last ? lat_tile(i) : i; gemm_tile(p.TG, 128, p.Wgate, 128, 128, tm * 128, (t % 3) * 128, lds, e); }
    } break;
    case 6: {
      EpiRes e{&p, l, l == 0, 2 * 1024};
      const int nm = last ? 128 : 144;
      for (int i = 0, tm, tn; xcd_tile(bid, G, i, nm, 8, tm, tn); ++i) gemm_tile(p.HY, DM, p.Wout, DM, DM, (last ? lat_tile(tm) : tm) * 128, tn * 128, lds, e);
    } break;
    case 7:
      modnorm_rows(p, l, 1, false, last, bid * 4 + wid, G * 4, lane);
      break;
    case 8: {
      EpiFfnIn e{p.ACT};
      const int nm = last ? 128 : 144;
      const int nconv = last ? 0 : NCONV_W1;
      for (int i = 0, tm, tn; xcd_tile(bid, G, i, nm, 44, tm, tn); ++i) gemm_tile(p.HY, DM, p.Wffi, DM, DM, (last ? lat_tile(tm) : tm) * 128, tn * 128, lds, e);
      for (int t = bid; t < nconv; t += G) conv_w1_task(p, 1, t, lds);
    } break;
    case 9: {
      EpiRes e{&p, l, false, 5 * 1024};
      const int nm = last ? 128 : 144;
      for (int i = 0, tm, tn; xcd_tile(bid, G, i, nm, 8, tm, tn); ++i) gemm_tile(p.ACT, 2816, p.Wffo, 2816, 2816, (last ? lat_tile(tm) : tm) * 128, tn * 128, lds, e);
    } break;
  }
}


#define XB_TMO      128
#define XB_XCNT(j)  (256  + 64 * (j))
#define XB_XSUB(j)  (1280 + 64 * (j))
#define XB_XGEN(j)  (2304 + 64 * (j))
#define XB_TOP      3328
#define XB_TOPGEN   3392
#define XCD_BAR_WORDS 3456
#define XB_SPIN_CAP (1u << 20)
DI unsigned xb_ld(unsigned* p) { return __hip_atomic_load(p, __ATOMIC_RELAXED, __HIP_MEMORY_SCOPE_AGENT); }
DI unsigned xb_add(unsigned* p, unsigned v) { return __hip_atomic_fetch_add(p, v, __ATOMIC_RELAXED, __HIP_MEMORY_SCOPE_AGENT); }
DI unsigned xb_xcc_id() { return (unsigned)__builtin_amdgcn_s_getreg((3 << 11) | 20) & 0xFu; }
#define XB_SPIN(cond, bar) do { unsigned _sp = 0; while (cond) { __builtin_amdgcn_s_sleep(1); \
    if ((++_sp & 255u) == 0u) { if (xb_ld(&(bar)[XB_TMO])) break; if (_sp > XB_SPIN_CAP) { atomicAdd(&(bar)[XB_TMO], 1u); break; } } } } while (0)
struct XcdBarrier { unsigned* bar; unsigned x; volatile LAS unsigned* st; };
DI XcdBarrier xcd_barrier_post(unsigned* bar, volatile LAS unsigned* st) {
  XcdBarrier b; b.bar = bar; b.x = xb_xcc_id(); b.st = st;
  if (threadIdx.x == 0) (void)xb_add(&bar[XB_XCNT(b.x)], 1u);
  return b;
}
DI void xcd_barrier_complete(unsigned* bar, unsigned x, unsigned& nloc, unsigned& nx) {
  const unsigned G = gridDim.x * gridDim.y * gridDim.z;
  unsigned sum, cnt, mine, sp = 0u;
  for (;;) {
    sum = 0u; cnt = 0u; mine = 0u;
#pragma unroll
    for (unsigned j = 0; j < 16; ++j) { const unsigned c = xb_ld(&bar[XB_XCNT(j)]); sum += c; cnt += (c > 0u) ? 1u : 0u; mine = (j == x) ? c : mine; }
    if (sum == G) break;
    __builtin_amdgcn_s_sleep(1);
    if ((++sp & 255u) == 0u) { if (xb_ld(&bar[XB_TMO])) break; if (sp > XB_SPIN_CAP) { atomicAdd(&bar[XB_TMO], 1u); break; } }
  }
  nloc = mine > 0u ? mine : 1u; nx = cnt > 0u ? cnt : 1u;
}
DI void xcd_barrier(const XcdBarrier& b) {
  asm volatile("s_waitcnt vmcnt(0)" ::: "memory");
  __syncthreads();
  if (threadIdx.x == 0) {
    unsigned* bar = b.bar;
    __builtin_amdgcn_s_waitcnt(0);
    unsigned nloc = b.st[0], nx = b.st[1];
    if (nloc == 0u) { xcd_barrier_complete(bar, b.x, nloc, nx); b.st[0] = nloc; b.st[1] = nx; }
    const unsigned old = xb_add(&bar[XB_XSUB(b.x)], 1u);
    const unsigned gen = old / nloc;
    if (old + 1u == (gen + 1u) * nloc) {
      __builtin_amdgcn_fence(__ATOMIC_RELEASE, "agent");
      asm volatile("s_waitcnt vmcnt(0)" ::: "memory");
      const unsigned og = xb_add(&bar[XB_TOP], 1u);
      const unsigned tg = og / nx;
      if (og + 1u == (tg + 1u) * nx) xb_add(&bar[XB_TOPGEN], 1u);
      else XB_SPIN(xb_ld(&bar[XB_TOPGEN]) == tg, bar);
      __builtin_amdgcn_fence(__ATOMIC_ACQUIRE, "agent");
      xb_add(&bar[XB_XGEN(b.x)], 1u);
      asm volatile("s_waitcnt vmcnt(0)" ::: "memory");
    } else {
      XB_SPIN(xb_ld(&bar[XB_XGEN(b.x)]) == gen, bar);
      __builtin_amdgcn_fence(__ATOMIC_ACQUIRE, "agent");
      asm volatile("s_waitcnt vmcnt(0)" ::: "memory");
    }
  }
  __syncthreads();
}

constexpr int NPHASE = 19;
#if !MULTI_LAUNCH
__global__ void __launch_bounds__(256, 2) mega(Params p, int ph_lo, int ph_hi) {
  __shared__ __attribute__((aligned(16))) char lds[65536 + 16];
  cg::grid_group grid = cg::this_grid();
  volatile LAS unsigned* st = (volatile LAS unsigned*)(lds + 65536);
  if (threadIdx.x == 0) { st[0] = 0u; st[1] = 0u; }
  if (blockIdx.x == 0) for (int i = threadIdx.x; i < XCD_BAR_WORDS + 128; i += 256) p.BAR[i] = 0u;
  __syncthreads();
  XcdBarrier xb;
  for (int ph = ph_lo; ph < ph_hi; ++ph) {
    if (ph == ph_lo + 1) { grid.sync(); xb = xcd_barrier_post(p.BAR, st); }
    else if (ph > ph_lo + 1) xcd_barrier(xb);
    run_phase<-1>(p, ph, lds);
  }
}
#endif
template <int KSEL> __global__ void __launch_bounds__(256, 2) phase_k(Params p, int ph) {
  __shared__ __attribute__((aligned(16))) char lds[65536];
  run_phase<KSEL>(p, ph, lds);
}

extern "C" void kernel_launch(void* const* d_in, const int* in_sizes, int n_in, void* d_out, int out_size, void* d_ws, size_t ws_size, hipStream_t stream) {
  static int grid_blocks = 0;
  if (!grid_blocks) {
    int dev = 0, cus = 0, per_cu = 0;
    (void)hipGetDevice(&dev);
    (void)hipDeviceGetAttribute(&cus, hipDeviceAttributeMultiprocessorCount, dev);
    #if MULTI_LAUNCH
    per_cu = 2;
#else
    (void)hipOccupancyMaxActiveBlocksPerMultiprocessor(&per_cu, mega, 256, 0);
#endif
    if (per_cu > 2) per_cu = 2;
    if (per_cu < 1) per_cu = 1;
    grid_blocks = cus * per_cu;
  }
  Params p{};
  const float** pin = (const float**)&p.x;
  for (int i = 0; i < 32; ++i) pin[i] = (const float*)d_in[i];
  p.out = (float*)d_out;
  char* w = (char*)d_ws;
  size_t off = 0;
  auto take = [&](size_t bytes) { char* r = w + off; off += (bytes + 255) & ~(size_t)255; return r; };
  p.BAR = (unsigned*)take((XCD_BAR_WORDS + 128) * 4);
  p.MOD = (float*)take(2 * 9 * 6144 * 4);
  p.ROPE = (float*)take(64 * 8 * 2 * 4);
  p.RSTD = (float*)take(2 * (size_t)T_TOK * 4);
  p.BON = (float*)take(2 * (size_t)T_TOK * 6 * 4);
  p.XCTX = (float*)take((size_t)8 * NCTX * DM * 4);
  p.Win = (bf16_t*)take((size_t)3328 * 1024 * 2);
  p.Wuq = (bf16_t*)take((size_t)640 * 768 * 2);
  p.WukvK = (bf16_t*)take((size_t)384 * 256 * 2);
  p.WvT = (bf16_t*)take((size_t)384 * 256 * 2);
  p.Wgate = (bf16_t*)take((size_t)384 * 128 * 2);
  p.Wdecay = (bf16_t*)take((size_t)2 * 384 * 64 * 2);
  p.Wicl = (bf16_t*)take((size_t)2 * 384 * 64 * 2);
  p.Wout = (bf16_t*)take((size_t)1024 * 1024 * 2);
  p.HY = (bf16_t*)take((size_t)T_TOK * DM * 2);
  p.TW = (bf16_t*)take((size_t)T_TOK * 64 * 2);
  p.TA = (bf16_t*)take((size_t)T_TOK * 64 * 2);
  p.TG = (bf16_t*)take((size_t)T_TOK * 128 * 2);
  char* qkv = take((size_t)T_TOK * 576 * 2 * 2 + (size_t)384 * T_TOK * 2);
  p.Q = (bf16_t*)qkv;
  p.Kt = (bf16_t*)(qkv + (size_t)T_TOK * 576 * 2);
  p.VT = (bf16_t*)(qkv + (size_t)T_TOK * 576 * 2 * 2);
  p.Wffi = (bf16_t*)take((size_t)5632 * 1024 * 2);
  p.Wffo = (bf16_t*)take((size_t)2816 * 1024 * 2);
  char* pr = take((size_t)T_TOK * (LDPA + LDPBC) * 2);
  p.PA = (bf16_t*)pr;
  p.PBC = (bf16_t*)(pr + (size_t)T_TOK * LDPA * 2);
  p.Y = (float*)p.PBC;
  p.ACT = (bf16_t*)pr;
  if (off > ws_size) { fprintf(stderr, "workspace too small: need %zu have %zu\n", off, ws_size); }
#if MULTI_LAUNCH
  hipLaunchKernelGGL(phase_k<10>, dim3(grid_blocks), dim3(256), 0, stream, p, 0);
  for (int l = 0; l < 2; ++l) {
    const int b0 = 1 + 10 * l;
    hipLaunchKernelGGL(phase_k<0>, dim3(grid_blocks), dim3(256), 0, stream, p, b0 + 0);
    hipLaunchKernelGGL(phase_k<1>, dim3(grid_blocks), dim3(256), 0, stream, p, b0 + 1);
    hipLaunchKernelGGL(phase_k<2>, dim3(grid_blocks), dim3(256), 0, stream, p, b0 + 2);
    hipLaunchKernelGGL(phase_k<3>, dim3(grid_blocks), dim3(256), 0, stream, p, b0 + 3);
    hipLaunchKernelGGL(phase_k<4>, dim3(192), dim3(256), 0, stream, p, b0 + 4);
    hipLaunchKernelGGL(phase_k<11>, dim3(grid_blocks), dim3(256), 0, stream, p, b0 + 4);
    hipLaunchKernelGGL(phase_k<5>, dim3(grid_blocks), dim3(256), 0, stream, p, b0 + 5);
    hipLaunchKernelGGL(phase_k<6>, dim3(grid_blocks), dim3(256), 0, stream, p, b0 + 6);
    hipLaunchKernelGGL(phase_k<7>, dim3(grid_blocks), dim3(256), 0, stream, p, b0 + 7);
    hipLaunchKernelGGL(phase_k<8>, dim3(grid_blocks), dim3(256), 0, stream, p, b0 + 8);
    hipLaunchKernelGGL(phase_k<9>, dim3(grid_blocks), dim3(256), 0, stream, p, b0 + 9);
  }
#else
  int lo = 0, hi = NPHASE;
  void* args[] = {&p, &lo, &hi};
  hipError_t e = hipLaunchCooperativeKernel((void*)mega, dim3(grid_blocks), dim3(256), args, 0, stream);
  if (e != hipSuccess) fprintf(stderr, "cooperative launch failed: %s (grid %d)\n", hipGetErrorString(e), grid_blocks);
#endif
}
```

```cpp
#include <hip/hip_runtime.h>
#include <hip/hip_cooperative_groups.h>
#include <cstdio>
namespace cg = cooperative_groups;

#ifndef MULTI_LAUNCH
#define MULTI_LAUNCH 0
#endif

#define DI __device__ __forceinline__
typedef unsigned short bf16_t;
typedef short bf16x8 __attribute__((ext_vector_type(8)));
typedef short s16x4 __attribute__((ext_vector_type(4)));
typedef float f32x4 __attribute__((ext_vector_type(4)));
typedef float f32x2 __attribute__((ext_vector_type(2)));
typedef float f32x16 __attribute__((ext_vector_type(16)));
typedef unsigned u32x4 __attribute__((ext_vector_type(4)));
typedef unsigned u32x2 __attribute__((ext_vector_type(2)));
#define LAS __attribute__((address_space(3)))

constexpr int T_TOK = 18432, TB = 2304, NCTX = 256, NLAT = 2048, DM = 1024;
constexpr int LDPA = 1408, LDPBC = 1920;
constexpr float EPSF = 1e-6f;
constexpr float LOG_DECAY_SCALE = 0.606531f;
constexpr float GN_EPS = 64e-5f;
constexpr float QSCALE = 0.10206207261596577f * 1.4426950408889634f;

struct Params {
  const float *x, *c, *ctx, *c_ctx, *ada_w, *ada_b, *norm1_g, *norm2_g, *w_in, *tshift_mu, *decay_w0, *decay_up,
      *icl_a0, *icl_up, *gate_up, *k_k, *k_a, *r_k, *lnx_g, *lnx_b, *q_norm_g, *kv_norm_g, *w_uq, *w_ukv, *q_nope_g,
      *k_nope_g, *q_rope_g, *k_rope_g, *conv_w, *w_out, *w_ffn_in, *w_ffn_out;
  float* out;
  float *MOD, *RSTD, *BON, *XCTX, *Y, *ROPE;
  unsigned* BAR;
  bf16_t *Win, *Wuq, *WukvK, *WvT, *Wgate, *Wdecay, *Wicl, *Wout, *Wffi, *Wffo;
  bf16_t *HY, *TW, *TA, *TG, *Q, *Kt, *VT, *PA, *PBC, *ACT;
};

typedef __bf16 bf16v2 __attribute__((ext_vector_type(2)));
DI unsigned pk_bf16(float lo, float hi) { f32x2 v = {lo, hi}; bf16v2 b = __builtin_convertvector(v, bf16v2); return __builtin_bit_cast(unsigned, b); }
DI float bflo(unsigned u) { return __uint_as_float(u << 16); }
DI float bfhi(unsigned u) { return __uint_as_float(u & 0xffff0000u); }
DI int opaque_tid() { int t = threadIdx.x; asm volatile("" : "+v"(t)); return t; }
DI float sigmoidf_(float x) { return 1.f / (1.f + __expf(-x)); }
template <int CTRL> DI float dppf(float x) { return __builtin_bit_cast(float, __builtin_amdgcn_update_dpp(0, __builtin_bit_cast(int, x), CTRL, 0xf, 0xf, true)); }
DI float red8(float x) { x += dppf<0xB1>(x); x += dppf<0x4E>(x); x += dppf<0x141>(x); return x; }
DI float red16(float x) { x = red8(x); x += dppf<0x140>(x); return x; }
DI float red64(float x) { for (int o = 32; o > 0; o >>= 1) x += __shfl_xor(x, o); return x; }

DI void unpack8(u32x4 v, float* f) {
  f[0] = bflo(v[0]); f[1] = bfhi(v[0]); f[2] = bflo(v[1]); f[3] = bfhi(v[1]);
  f[4] = bflo(v[2]); f[5] = bfhi(v[2]); f[6] = bflo(v[3]); f[7] = bfhi(v[3]);
}
DI void unpack4(u32x2 v, float* f) { f[0] = bflo(v[0]); f[1] = bfhi(v[0]); f[2] = bflo(v[1]); f[3] = bfhi(v[1]); }

DI const float* xsrc_row(const Params& p, bool from_inputs, int b, int s) {
  if (from_inputs) return s < NCTX ? p.ctx + (size_t)(b * NCTX + s) * DM : p.x + (size_t)(b * NLAT + s - NCTX) * DM;
  return s < NCTX ? p.XCTX + (size_t)(b * NCTX + s) * DM : p.out + (size_t)(b * NLAT + s - NCTX) * DM;
}
DI float* xdst_row(const Params& p, int b, int s) {
  return s < NCTX ? p.XCTX + (size_t)(b * NCTX + s) * DM : p.out + (size_t)(b * NLAT + s - NCTX) * DM;
}

DI void adaln_task(const Params& p, int task, char* lds) {
  float* s = (float*)lds;
  float* red = s + 9 * 1024;
  const int l = task / 192, cgi = task % 192, tid = opaque_tid();
  for (int i = tid; i < 9 * 1024; i += 256) {
    int r = i >> 10, k = i & 1023;
    float v = r < 8 ? p.c[r * 1024 + k] : p.c_ctx[k];
    s[i] = v / (1.f + __expf(-v));
  }
  __syncthreads();
  const int kg = tid >> 5, cc = tid & 31, col = cgi * 32 + cc;
  float acc[9];
#pragma unroll
  for (int r = 0; r < 9; ++r) acc[r] = 0.f;
  const float* w = p.ada_w + (size_t)l * 1024 * 6144 + col;
  for (int k0 = kg; k0 < 1024; k0 += 128) {
    float wv[16];
#pragma unroll
    for (int u = 0; u < 16; ++u) wv[u] = w[(size_t)(k0 + 8 * u) * 6144];
#pragma unroll
    for (int u = 0; u < 16; ++u)
#pragma unroll
      for (int r = 0; r < 9; ++r) acc[r] += s[r * 1024 + k0 + 8 * u] * wv[u];
  }
#pragma unroll
  for (int r = 0; r < 9; ++r) red[(kg * 9 + r) * 32 + cc] = acc[r];
  __syncthreads();
  for (int i = tid; i < 9 * 32; i += 256) {
    int r = i >> 5, c2 = i & 31;
    float sum = 0.f;
    for (int g = 0; g < 8; ++g) sum += red[(g * 9 + r) * 32 + c2];
    p.MOD[(size_t)(l * 9 + r) * 6144 + cgi * 32 + c2] = sum + p.ada_b[l * 6144 + cgi * 32 + c2];
  }
  __syncthreads();
}

DI int colmap(int mode, int n, int nvalid) {
  switch (mode) {
    case 0: return n < nvalid ? n : -1;
    case 1: if (n < 384) return (n >> 6) * 96 + (n & 63); if (n < 576) return ((n - 384) >> 5) * 96 + 64 + ((n - 384) & 31); return -1;
    case 2: return (n >> 6) * 128 + (n & 63);
    case 3: return (n >> 6) * 128 + 64 + (n & 63);
    default: { int t64 = n >> 6, w = n & 63; return w < 32 ? t64 * 32 + w : 2816 + t64 * 32 + (w - 32); }
  }
}
DI void conv_tile(const float* src, int ld, int K, int mode, int nvalid, const float* kscale, bf16_t* dst, int tile, int ntn, char* lds) {
  float(*tl)[65] = (float(*)[65])lds;
  const int tk = tile / ntn, tn = tile % ntn, tid = opaque_tid(), k0 = tk * 64;
  {
    const int nn = tid & 63, kk0 = tid >> 6;
    const int sc = colmap(mode, tn * 64 + nn, nvalid);
#pragma unroll 4
    for (int i = 0; i < 16; ++i) {
      const int kk = kk0 + 4 * i;
      float v = 0.f;
      if (sc >= 0) { v = src[(size_t)(k0 + kk) * ld + sc]; if (kscale) v *= kscale[k0 + kk]; }
      tl[kk][nn] = v;
    }
  }
  __syncthreads();
  {
    const int kk2 = (tid & 31) * 2, nn2 = tid >> 5;
#pragma unroll
    for (int i = 0; i < 8; ++i) {
      const int nn = nn2 + 8 * i;
      *(unsigned*)(dst + (size_t)(tn * 64 + nn) * K + k0 + kk2) = pk_bf16(tl[kk2][nn], tl[kk2 + 1][nn]);
    }
  }
  __syncthreads();
}
constexpr int NCONV_W1 = 1292, NCONV_FF = 2112;
DI void conv_w1_task(const Params& p, int l, int t, char* lds) {
  if (t < 832) { conv_tile(p.w_in + (size_t)l * 1024 * 3232, 3232, 1024, 0, 3232, nullptr, p.Win, t, 52, lds); return; } t -= 832;
  if (t < 120) { conv_tile(p.w_uq + (size_t)l * 768 * 576, 576, 768, 1, 0, p.q_norm_g + l * 768, p.Wuq, t, 10, lds); return; } t -= 120;
  if (t < 24) { conv_tile(p.w_ukv + (size_t)l * 256 * 768, 768, 256, 2, 0, p.kv_norm_g + l * 256, p.WukvK, t, 6, lds); return; } t -= 24;
  if (t < 24) { conv_tile(p.w_ukv + (size_t)l * 256 * 768, 768, 256, 3, 0, p.kv_norm_g + l * 256, p.WvT, t, 6, lds); return; } t -= 24;
  if (t < 12) { conv_tile(p.gate_up + (size_t)l * 128 * 384, 384, 128, 0, 384, nullptr, p.Wgate, t, 6, lds); return; } t -= 12;
  if (t < 12) { int d = t / 6; conv_tile(p.decay_up + (size_t)(l * 2 + d) * 64 * 384, 384, 64, 0, 384, nullptr, p.Wdecay + d * 384 * 64, t % 6, 6, lds); return; } t -= 12;
  if (t < 12) { int d = t / 6; conv_tile(p.icl_up + (size_t)(l * 2 + d) * 64 * 384, 384, 64, 0, 384, nullptr, p.Wicl + d * 384 * 64, t % 6, 6, lds); return; } t -= 12;
  conv_tile(p.w_out + (size_t)l * 1024 * 1024, 1024, 1024, 0, 1024, nullptr, p.Wout, t, 16, lds);
}
DI void conv_ff_task(const Params& p, int l, int t, char* lds) {
  if (t < 1408) { conv_tile(p.w_ffn_in + (size_t)l * 1024 * 5632, 5632, 1024, 4, 0, nullptr, p.Wffi, t, 88, lds); return; } t -= 1408;
  conv_tile(p.w_ffn_out + (size_t)l * 2816 * 1024, 1024, 2816, 0, 1024, nullptr, p.Wffo, t, 16, lds);
}

DI void modnorm_rows(const Params& p, int l, int which  , bool from_inputs, bool skip_ctx, int w0, int wstride, int lane) {
  const float* g = (which ? p.norm2_g : p.norm1_g) + l * DM;
  f32x4 gg[4];
#pragma unroll
  for (int i = 0; i < 4; ++i) gg[i] = *(const f32x4*)(g + i * 256 + lane * 4);
  const int nrows = skip_ctx ? 8 * NLAT : T_TOK;
  auto rowof = [&](int i) -> int { return skip_ctx ? (i / NLAT) * TB + NCTX + (i % NLAT) : i; };
  int i = w0;
  if (i >= nrows) return;
  f32x4 vn[4];
  {
    const int row = rowof(i); const float* src = xsrc_row(p, from_inputs, row / TB, row % TB);
#pragma unroll
    for (int q = 0; q < 4; ++q) vn[q] = *(const f32x4*)(src + q * 256 + lane * 4);
  }
  for (; i < nrows; i += wstride) {
    const int row = rowof(i); const int b = row / TB, s = row % TB;
    f32x4 v[4];
#pragma unroll
    for (int q = 0; q < 4; ++q) v[q] = vn[q];
    if (i + wstride < nrows) {
      const int rn = rowof(i + wstride); const float* src = xsrc_row(p, from_inputs, rn / TB, rn % TB);
#pragma unroll
      for (int q = 0; q < 4; ++q) vn[q] = *(const f32x4*)(src + q * 256 + lane * 4);
    }
    const float* mod = p.MOD + (size_t)(l * 9 + (s < NCTX ? 8 : b)) * 6144 + (which ? 3 * 1024 : 0);
    f32x4 sh[4], sc[4];
#pragma unroll
    for (int q = 0; q < 4; ++q) { sh[q] = *(const f32x4*)(mod + q * 256 + lane * 4); sc[q] = *(const f32x4*)(mod + 1024 + q * 256 + lane * 4); }
    float ss = 0.f;
#pragma unroll
    for (int q = 0; q < 4; ++q) ss += v[q][0] * v[q][0] + v[q][1] * v[q][1] + v[q][2] * v[q][2] + v[q][3] * v[q][3];
    ss = red64(ss);
    const float rs = rsqrtf(ss * (1.f / 1024.f) + EPSF);
    bf16_t* dst = p.HY + (size_t)row * DM;
#pragma unroll
    for (int q = 0; q < 4; ++q) {
      float o[4];
#pragma unroll
      for (int j = 0; j < 4; ++j) o[j] = (v[q][j] * rs * gg[q][j]) * (1.f + sc[q][j]) + sh[q][j];
      u32x2 w = {pk_bf16(o[0], o[1]), pk_bf16(o[2], o[3])};
      *(u32x2*)(dst + q * 256 + lane * 4) = w;
    }
  }
}

template <class Epi>
DI void gemm_tile(const bf16_t* __restrict__ A, int lda, const bf16_t* __restrict__ Bt, int ldb, int K, int row0, int col0, char* lds, const Epi& epi) {
  const int tid = opaque_tid(), lane = tid & 63, wid = tid >> 6, wr = wid >> 1, wc = wid & 1, fr = lane & 15, fq = lane >> 4;
  const bf16_t* ag[4];
  const bf16_t* bg[4];
#pragma unroll
  for (int i = 0; i < 4; ++i) {
    const int id = i * 256 + tid, r = id >> 3, cp = id & 7, c = cp ^ ((r >> 1) & 7);
    ag[i] = A + (size_t)(row0 + r) * lda + c * 8;
    bg[i] = Bt + (size_t)(col0 + r) * ldb + c * 8;
  }
  f32x4 acc[4][4];
#pragma unroll
  for (int m = 0; m < 4; ++m)
#pragma unroll
    for (int n = 0; n < 4; ++n) acc[m][n] = (f32x4){0.f, 0.f, 0.f, 0.f};
  const int KT = K >> 6;
  auto stage_a = [&](int kt, int buf) {
    char* sa = lds + buf * 32768;
#pragma unroll
    for (int i = 0; i < 4; ++i)
      __builtin_amdgcn_global_load_lds((const void __attribute__((address_space(1)))*)(ag[i] + kt * 64), (void LAS*)(sa + (i * 256 + tid) * 16), 16, 0, 0);
  };
  auto stage_b = [&](int kt, int buf) {
    char* sb = lds + buf * 32768 + 16384;
#pragma unroll
    for (int i = 0; i < 4; ++i)
      __builtin_amdgcn_global_load_lds((const void __attribute__((address_space(1)))*)(bg[i] + kt * 64), (void LAS*)(sb + (i * 256 + tid) * 16), 16, 0, 0);
  };
  __syncthreads();
  stage_a(0, 0); stage_b(0, 0);
  const int swz = fr >> 1;
  for (int kt = 0; kt < KT; ++kt) {
    asm volatile("s_waitcnt vmcnt(0)" ::: "memory");
    __syncthreads();
    const char* sa = lds + (kt & 1) * 32768 + (wr * 64 + fr) * 128;
    const char* sb = lds + (kt & 1) * 32768 + 16384 + (wc * 64 + fr) * 128;
#pragma unroll
    for (int kk = 0; kk < 2; ++kk) {
      if (kt + 1 < KT) { if (kk == 0) stage_a(kt + 1, (kt + 1) & 1); else stage_b(kt + 1, (kt + 1) & 1); }
      bf16x8 a[4], b[4];
      const int co = ((kk * 4 + fq) ^ swz) * 16;
#pragma unroll
      for (int m = 0; m < 4; ++m) a[m] = *(const bf16x8*)(sa + m * 2048 + co);
#pragma unroll
      for (int n = 0; n < 4; ++n) b[n] = *(const bf16x8*)(sb + n * 2048 + co);
#pragma unroll
      for (int m = 0; m < 4; ++m)
#pragma unroll
        for (int n = 0; n < 4; ++n) acc[m][n] = __builtin_amdgcn_mfma_f32_16x16x32_bf16(b[n], a[m], acc[m][n], 0, 0, 0);
    }
  }
  epi(acc, row0 + wr * 64, col0 + wc * 64, fr, fq);
}

struct EpiP {
  bf16_t *PA, *PBC; float* SSQ;
  DI void operator()(const f32x4 (&acc)[4][4], int r0, int c0, int fr, int fq) const {
    bf16_t* base; int ld, cb;
    if (c0 < LDPA) { base = PA; ld = LDPA; cb = c0; } else { base = PBC; ld = LDPBC; cb = c0 - LDPA; }
    if (c0 >= LDPA && cb < 1024) {
      float* dst = SSQ + (cb < 768 ? 0 : T_TOK);
#pragma unroll
      for (int m = 0; m < 4; ++m) {
        float ss = 0.f;
#pragma unroll
        for (int n = 0; n < 4; ++n)
#pragma unroll
          for (int j = 0; j < 4; ++j) ss += acc[m][n][j] * acc[m][n][j];
        ss += __shfl_xor(ss, 16); ss += __shfl_xor(ss, 32);
        if (fq == 0) atomicAdd(dst + r0 + m * 16 + fr, ss);
      }
    }
#pragma unroll
    for (int m = 0; m < 4; ++m)
#pragma unroll
      for (int n = 0; n < 4; ++n) {
        u32x2 v = {pk_bf16(acc[m][n][0], acc[m][n][1]), pk_bf16(acc[m][n][2], acc[m][n][3])};
        *(u32x2*)(base + (size_t)(r0 + m * 16 + fr) * ld + cb + n * 16 + fq * 4) = v;
      }
  }
};

DI void rope_angle(int pos, int i, float& cs, float& sn) {
  const float invf = __builtin_amdgcn_exp2f(-(float)i * (13.287712379549449f / 8.f));
  float ang = (float)pos * invf;
  float n = rintf(ang * 0.15915494309189535f);
  float r = fmaf(-n, 6.28125f, ang);
  r = fmaf(-n, 1.9353071795864769e-3f, r);
  cs = __cosf(r); sn = __sinf(r);
}

struct EpiQ {
  const float *rstd, *gn, *gr, *rope; bf16_t* Q;
  DI void operator()(const f32x4 (&acc)[4][4], int r0, int c0, int fr, int fq) const {
    if (c0 >= 576) return;
    if (c0 < 384) {
      const int h = c0 >> 6;
#pragma unroll
      for (int m = 0; m < 4; ++m) {
        const int row = r0 + m * 16 + fr; const float rs = rsqrtf(rstd[row] * (1.f / 768.f) + EPSF);
        float ss = 0.f;
#pragma unroll
        for (int n = 0; n < 4; ++n)
#pragma unroll
          for (int j = 0; j < 4; ++j) { float v = acc[m][n][j] * rs; ss += v * v; }
        ss += __shfl_xor(ss, 16); ss += __shfl_xor(ss, 32);
        const float inv = rsqrtf(ss * (1.f / 64.f) + EPSF) * rs * QSCALE;
        const int b = row / TB, s = row % TB;
        bf16_t* dst = Q + ((size_t)(b * 6 + h) * TB + s) * 96;
#pragma unroll
        for (int n = 0; n < 4; ++n) {
          const int d = n * 16 + fq * 4; f32x4 g = *(const f32x4*)(gn + d);
          u32x2 v = {pk_bf16(acc[m][n][0] * inv * g[0], acc[m][n][1] * inv * g[1]), pk_bf16(acc[m][n][2] * inv * g[2], acc[m][n][3] * inv * g[3])};
          *(u32x2*)(dst + d) = v;
        }
      }
    } else {
#pragma unroll
      for (int m = 0; m < 4; ++m) {
        const int row = r0 + m * 16 + fr; const float rs = rsqrtf(rstd[row] * (1.f / 768.f) + EPSF);
        const int b = row / TB, s = row % TB; const bool lat = s >= NCTX; const int sp = s - NCTX;
#pragma unroll
        for (int hh = 0; hh < 2; ++hh) {
          const int h = ((c0 - 384) >> 5) + hh;
          float ss = 0.f;
#pragma unroll
          for (int nn = 0; nn < 2; ++nn)
#pragma unroll
            for (int j = 0; j < 4; ++j) { float v = acc[m][hh * 2 + nn][j] * rs; ss += v * v; }
          ss += __shfl_xor(ss, 16); ss += __shfl_xor(ss, 32);
          const float inv = rsqrtf(ss * (1.f / 32.f) + EPSF) * rs;
          bf16_t* dst = Q + ((size_t)(b * 6 + h) * TB + s) * 96 + 64;
#pragma unroll
          for (int nn = 0; nn < 2; ++nn) {
            const int d = nn * 16 + fq * 4; f32x4 g = *(const f32x4*)(gr + d);
            float o[4];
#pragma unroll
            for (int j = 0; j < 4; ++j) {
              float val = acc[m][hh * 2 + nn][j] * inv * g[j];
              float partner = __shfl_xor(val, 32);
              if (lat) {
                const float* rt = rope + ((nn == 0 ? (sp >> 6) : (sp & 63)) * 8 + ((fq * 4 + j) & 7)) * 2; const float cs = rt[0], sn = rt[1];
                val = fq < 2 ? val * cs - partner * sn : val * cs + partner * sn;
              }
              o[j] = val * QSCALE;
            }
            u32x2 v = {pk_bf16(o[0], o[1]), pk_bf16(o[2], o[3])};
            *(u32x2*)(dst + d) = v;
          }
        }
      }
    }
  }
};

struct EpiK {
  const float *rstd, *gk; bf16_t* Kt;
  DI void operator()(const f32x4 (&acc)[4][4], int r0, int c0, int fr, int fq) const {
    const int h = c0 >> 6;
#pragma unroll
    for (int m = 0; m < 4; ++m) {
      const int row = r0 + m * 16 + fr; const float rs = rsqrtf(rstd[row] * (1.f / 256.f) + EPSF);
      float ss = 0.f;
#pragma unroll
      for (int n = 0; n < 4; ++n)
#pragma unroll
        for (int j = 0; j < 4; ++j) { float v = acc[m][n][j] * rs; ss += v * v; }
      ss += __shfl_xor(ss, 16); ss += __shfl_xor(ss, 32);
      const float inv = rsqrtf(ss * (1.f / 64.f) + EPSF) * rs;
      const int b = row / TB, s = row % TB;
      bf16_t* dst = Kt + ((size_t)(b * 6 + h) * TB + s) * 96;
#pragma unroll
      for (int n = 0; n < 4; ++n) {
        const int d = n * 16 + fq * 4; f32x4 g = *(const f32x4*)(gk + d);
        u32x2 v = {pk_bf16(acc[m][n][0] * inv * g[0], acc[m][n][1] * inv * g[1]), pk_bf16(acc[m][n][2] * inv * g[2], acc[m][n][3] * inv * g[3])};
        *(u32x2*)(dst + d) = v;
      }
    }
  }
};

struct EpiV {
  const float* rstd; bf16_t* VT;
  DI void operator()(const f32x4 (&acc)[4][4], int r0, int c0, int fr, int fq) const {
#pragma unroll
    for (int m = 0; m < 4; ++m)
#pragma unroll
      for (int n = 0; n < 4; ++n) {
        const int row = r0 + m * 16 + fr, col = c0 + n * 16 + fq * 4;
        f32x4 rs = *(const f32x4*)(rstd + col);
#pragma unroll
        for (int j = 0; j < 4; ++j) rs[j] = rsqrtf(rs[j] * (1.f / 256.f) + EPSF);
        u32x2 v = {pk_bf16(acc[m][n][0] * rs[0], acc[m][n][1] * rs[1]), pk_bf16(acc[m][n][2] * rs[2], acc[m][n][3] * rs[3])};
        *(u32x2*)(VT + (size_t)row * T_TOK + col) = v;
      }
  }
};

struct EpiPost {
  const float *Y, *BON, *mu, *lnx_g, *lnx_b; const bf16_t* PA; bf16_t* YC;
  DI void operator()(const f32x4 (&acc)[4][4], int r0, int c0, int fr, int fq) const {
    const int h = c0 >> 6;
#pragma unroll
    for (int m = 0; m < 4; ++m) {
      const int row = r0 + m * 16 + fr; const int s = row % TB;
      const bool hasprev = (s != 0 && s != NCTX), hasnext = (s != NCTX - 1 && s != TB - 1);
      f32x4 y[4];
      float s1 = 0.f;
#pragma unroll
      for (int n = 0; n < 4; ++n) {
        const size_t o = (size_t)row * 384 + c0 + n * 16 + fq * 4;
        y[n] = *(const f32x4*)(Y + o) + *(const f32x4*)(Y + (size_t)T_TOK * 384 + o);
        s1 += y[n][0] + y[n][1] + y[n][2] + y[n][3];
      }
      s1 += __shfl_xor(s1, 16); s1 += __shfl_xor(s1, 32);
      const float mean = s1 * (1.f / 64.f);
      float s2 = 0.f;
#pragma unroll
      for (int n = 0; n < 4; ++n)
#pragma unroll
        for (int j = 0; j < 4; ++j) { float d = y[n][j] - mean; s2 += d * d; }
      s2 += __shfl_xor(s2, 16); s2 += __shfl_xor(s2, 32);
      const float rstdv = rsqrtf(s2 * (1.f / 64.f) + GN_EPS);
      const float bon = BON[(size_t)row * 6 + h] + BON[(size_t)T_TOK * 6 + (size_t)row * 6 + h];
#pragma unroll
      for (int n = 0; n < 4; ++n) {
        const int col = c0 + n * 16 + fq * 4;
        const bf16_t* pv = PA + (size_t)row * LDPA + 768 + col;
        float vc[4], vp[4] = {0.f, 0.f, 0.f, 0.f}, vn[4] = {0.f, 0.f, 0.f, 0.f};
        unpack4(*(const u32x2*)pv, vc);
        if (hasprev) unpack4(*(const u32x2*)(pv - LDPA), vp);
        if (hasnext) unpack4(*(const u32x2*)(pv + LDPA), vn);
        f32x4 m0 = *(const f32x4*)(mu + 768 + col), m1 = *(const f32x4*)(mu + LDPA + 768 + col);
        f32x4 lg = *(const f32x4*)(lnx_g + col), lb = *(const f32x4*)(lnx_b + col);
        float o[4];
#pragma unroll
        for (int j = 0; j < 4; ++j) {
          const float v = vc[j] + m0[j] * (vp[j] - vc[j]) + m1[j] * (vn[j] - vc[j]);
          o[j] = ((y[n][j] - mean) * rstdv * lg[j] + lb[j] + bon * v) * acc[m][n][j];
        }
        u32x2 w = {pk_bf16(o[0], o[1]), pk_bf16(o[2], o[3])};
        *(u32x2*)(YC + (size_t)row * DM + col) = w;
      }
    }
  }
};

struct EpiRes {
  const Params* p; int l; bool from_inputs; int gate_off;
  DI void operator()(const f32x4 (&acc)[4][4], int r0, int c0, int fr, int fq) const {
#pragma unroll
    for (int m = 0; m < 4; ++m) {
      const int row = r0 + m * 16 + fr; const int b = row / TB, s = row % TB;
      const float* src = xsrc_row(*p, from_inputs, b, s);
      float* dst = xdst_row(*p, b, s);
      const float* gate = p->MOD + (size_t)(l * 9 + (s < NCTX ? 8 : b)) * 6144 + gate_off;
#pragma unroll
      for (int n = 0; n < 4; ++n) {
        const int col = c0 + n * 16 + fq * 4;
        f32x4 g = *(const f32x4*)(gate + col), xv = *(const f32x4*)(src + col);
        *(f32x4*)(dst + col) = xv + g * acc[m][n];
      }
    }
  }
};

struct EpiFfnIn {
  bf16_t* ACT;
  DI void operator()(const f32x4 (&acc)[4][4], int r0, int c0, int fr, int fq) const {
    const int cb = (c0 >> 6) * 32;
#pragma unroll
    for (int m = 0; m < 4; ++m)
#pragma unroll
      for (int n = 0; n < 2; ++n) {
        float o[4];
#pragma unroll
        for (int j = 0; j < 4; ++j) { float g = acc[m][n][j]; o[j] = g / (1.f + __expf(-g)) * acc[m][n + 2][j]; }
        u32x2 w = {pk_bf16(o[0], o[1]), pk_bf16(o[2], o[3])};
        *(u32x2*)(ACT + (size_t)(r0 + m * 16 + fr) * 2816 + cb + n * 16 + fq * 4) = w;
      }
  }
};

DI void prep_token(const Params& p, int l, int row, int lane) {
  const int b = row / TB, s = row % TB;
  const bool hasprev = (s != 0 && s != NCTX), hasnext = (s != NCTX - 1 && s != TB - 1);
  const float mp = hasprev ? 1.f : 0.f, mn = hasnext ? 1.f : 0.f;
  const bf16_t* pa = p.PA + (size_t)row * LDPA;
  const bf16_t* pbc = p.PBC + (size_t)row * LDPBC;
  const int opa = hasprev ? -LDPA : 0, ona = hasnext ? LDPA : 0, opb = hasprev ? -LDPBC : 0, onb = hasnext ? LDPBC : 0;
  const int l32 = lane & 31, c8 = l32 * 8, colA = 1152 + c8;
  const u32x4 la_c = *(const u32x4*)(pa + colA), la_p = *(const u32x4*)(pa + opa + colA), la_n = *(const u32x4*)(pa + ona + colA);
  const u32x4 lq0 = *(const u32x4*)(pbc + lane * 8), lq1 = *(const u32x4*)(pbc + 512 + c8), lkv = *(const u32x4*)(pbc + 768 + c8);
  const u32x4 lrp = *(const u32x4*)(pbc + 1024 + (lane & 3) * 8);
  const u32x4 lbg = *(const u32x4*)(pbc + 1056 + c8), lcc = *(const u32x4*)(pbc + 1312 + c8), lhh = *(const u32x4*)(pbc + 1568 + c8);
  const u32x4 lcp = *(const u32x4*)(pbc + opb + 1312 + c8), lhp = *(const u32x4*)(pbc + opb + 1568 + c8);
  const u32x4 lcn = *(const u32x4*)(pbc + onb + 1312 + c8), lhn = *(const u32x4*)(pbc + onb + 1568 + c8);
  const float* mu = p.tshift_mu + (size_t)l * 2 * LDPA;
  {
    float c[8], pv[8], nx[8], o[8];
    unpack8(la_c, c); unpack8(la_p, pv); unpack8(la_n, nx);
    const f32x4 m0a = *(const f32x4*)(mu + colA), m0b = *(const f32x4*)(mu + colA + 4), m1a = *(const f32x4*)(mu + LDPA + colA), m1b = *(const f32x4*)(mu + LDPA + colA + 4);
#pragma unroll
    for (int j = 0; j < 8; ++j) {
      const float m0 = j < 4 ? m0a[j & 3] : m0b[j & 3], m1 = j < 4 ? m1a[j & 3] : m1b[j & 3];
      float t = c[j] + m0 * (pv[j] * mp - c[j]) + m1 * (nx[j] * mn - c[j]);
      if (l32 < 8) { float e = __expf(2.f * t); t = 1.f - 2.f * __builtin_amdgcn_rcpf(1.f + e); }
      else if (l32 >= 16) t = __builtin_amdgcn_rcpf(1.f + __expf(-t));
      o[j] = t;
    }
    u32x4 w = {pk_bf16(o[0], o[1]), pk_bf16(o[2], o[3]), pk_bf16(o[4], o[5]), pk_bf16(o[6], o[7])};
    if (lane < 8) *(u32x4*)(p.TW + (size_t)row * 64 + lane * 8) = w;
    else if (lane < 16) *(u32x4*)(p.TA + (size_t)row * 64 + (lane - 8) * 8) = w;
    else if (lane < 32) *(u32x4*)(p.TG + (size_t)row * 128 + (lane - 16) * 8) = w;
  }
  float f[8], ss = 0.f, s2 = 0.f, s3 = 0.f, fr_[8];
  unpack8(lq0, f);
#pragma unroll
  for (int j = 0; j < 8; ++j) ss += f[j] * f[j];
  unpack8(lq1, f);
  if (lane < 32) {
#pragma unroll
    for (int j = 0; j < 8; ++j) ss += f[j] * f[j];
  }
  unpack8(lkv, f);
  if (lane < 32) {
#pragma unroll
    for (int j = 0; j < 8; ++j) s2 += f[j] * f[j];
  }
  unpack8(lrp, fr_);
  if (lane < 4) {
#pragma unroll
    for (int j = 0; j < 8; ++j) s3 += fr_[j] * fr_[j];
  }
  s3 += __shfl_xor(s3, 1); s3 += __shfl_xor(s3, 2);
  {
    const float inv = rsqrtf(s3 * (1.f / 32.f) + EPSF);
    const float* g = p.k_rope_g + l * 32;
    const bool lat = s >= NCTX; const int sp = lat ? s - NCTX : 0;
    const float* rt = p.ROPE + ((lane & 2) ? (sp & 63) : (sp >> 6)) * 16;
    float o[8];
#pragma unroll
    for (int j = 0; j < 8; ++j) {
      float val = fr_[j] * inv * g[(lane & 3) * 8 + j];
      float partner = __shfl_xor(val, 1);
      if (lat) {
        const float cs = rt[2 * j], sn = rt[2 * j + 1];
        val = (lane & 1) == 0 ? val * cs - partner * sn : val * cs + partner * sn;
      }
      o[j] = val;
    }
    if (lane < 4) {
      u32x4 w = {pk_bf16(o[0], o[1]), pk_bf16(o[2], o[3]), pk_bf16(o[4], o[5]), pk_bf16(o[6], o[7])};
#pragma unroll
      for (int hh = 0; hh < 6; ++hh) *(u32x4*)(p.Kt + ((size_t)(b * 6 + hh) * TB + s) * 96 + 64 + lane * 8) = w;
    }
  }
  {
    float bg[8], cc[8], hh[8], cp[8], hp[8], cn[8], hn[8], o[8];
    unpack8(lbg, bg); unpack8(lcc, cc); unpack8(lhh, hh); unpack8(lcp, cp); unpack8(lhp, hp); unpack8(lcn, cn); unpack8(lhn, hn);
    const float* cw = p.conv_w + (size_t)l * 3 * 256;
#pragma unroll
    for (int j = 0; j < 8; ++j) o[j] = bg[j] * (cw[c8 + j] * cp[j] * hp[j] * mp + cw[256 + c8 + j] * cc[j] * hh[j] + cw[512 + c8 + j] * cn[j] * hn[j] * mn);
    u32x4 w = {pk_bf16(o[0], o[1]), pk_bf16(o[2], o[3]), pk_bf16(o[4], o[5]), pk_bf16(o[6], o[7])};
    if (lane < 32) *(u32x4*)(p.HY + (size_t)row * DM + 768 + c8) = w;
  }
}

#define MFMA32(a, b, c) __builtin_amdgcn_mfma_f32_32x32x16_bf16((a), (b), (c), 0, 0, 0)
DI bf16x8 pack8(const f32x16& x, int s) {
  u32x4 v = {pk_bf16(x[8 * s], x[8 * s + 1]), pk_bf16(x[8 * s + 2], x[8 * s + 3]), pk_bf16(x[8 * s + 4], x[8 * s + 5]), pk_bf16(x[8 * s + 6], x[8 * s + 7])};
  return __builtin_bit_cast(bf16x8, v);
}
constexpr int KROW = 208, VROW = 136, KBUF = 64 * KROW, VBUF = 64 * VROW;
DI void attn_task(const Params& p, int b, int h, int q0, int k0, int nk, char* lds) {
  const int tid = opaque_tid(), lane = tid & 63, wid = tid >> 6, r = lane & 31, hh = lane >> 5;
  const bf16_t* Qp = p.Q + ((size_t)(b * 6 + h) * TB + q0 + wid * 32 + r) * 96;
  const bf16_t* Kp = p.Kt + ((size_t)(b * 6 + h) * TB + k0) * 96;
  const bf16_t* Vp = p.VT + (size_t)(h * 64) * T_TOK + (size_t)b * TB + k0;
  bf16x8 qf[6];
#pragma unroll
  for (int ks = 0; ks < 6; ++ks) qf[ks] = *(const bf16x8*)(Qp + ks * 16 + hh * 8);
  int krow_[3], kch_[3];
#pragma unroll
  for (int i = 0; i < 3; ++i) { int id = tid + i * 256; krow_[i] = id / 12; kch_[i] = id % 12; }
  const int vd0 = tid >> 3, vch = tid & 7;
  u32x4 kreg[3], vreg[2];
  auto load_regs = [&](int kt) {
#pragma unroll
    for (int i = 0; i < 3; ++i) kreg[i] = *(const u32x4*)(Kp + (size_t)(kt * 64 + krow_[i]) * 96 + kch_[i] * 8);
#pragma unroll
    for (int i = 0; i < 2; ++i) vreg[i] = *(const u32x4*)(Vp + (size_t)(vd0 + 32 * i) * T_TOK + kt * 64 + vch * 8);
  };
  auto write_lds = [&](int buf) {
    char* kb = lds + buf * (KBUF + VBUF);
    char* vb = kb + KBUF;
#pragma unroll
    for (int i = 0; i < 3; ++i) *(u32x4*)(kb + krow_[i] * KROW + kch_[i] * 16) = kreg[i];
#pragma unroll
    for (int i = 0; i < 2; ++i) {
      char* d = vb + (vd0 + 32 * i) * VROW + vch * 16;
      *(u32x2*)d = (u32x2){vreg[i][0], vreg[i][1]};
      *(u32x2*)(d + 8) = (u32x2){vreg[i][2], vreg[i][3]};
    }
  };
  f32x16 o[2];
#pragma unroll
  for (int i = 0; i < 16; ++i) { o[0][i] = 0.f; o[1][i] = 0.f; }
  float m_run = -1e30f, l_run = 0.f;
  const int NT = nk >> 6;
  __syncthreads();
  load_regs(0);
  write_lds(0);
  for (int kt = 0; kt < NT; ++kt) {
    if (kt + 1 < NT) load_regs(kt + 1);
    __syncthreads();
    const char* kb = lds + (kt & 1) * (KBUF + VBUF);
    const char* vb = kb + KBUF;
    f32x16 st[2];
#pragma unroll
    for (int kbk = 0; kbk < 2; ++kbk) {
#pragma unroll
      for (int i = 0; i < 16; ++i) st[kbk][i] = 0.f;
#pragma unroll
      for (int ks = 0; ks < 6; ++ks) {
        bf16x8 kf = *(const bf16x8*)(kb + (kbk * 32 + r) * KROW + ks * 32 + hh * 16);
        st[kbk] = MFMA32(kf, qf[ks], st[kbk]);
      }
    }
    float mx = st[0][0];
#pragma unroll
    for (int i = 0; i < 16; ++i) { mx = fmaxf(mx, st[0][i]); mx = fmaxf(mx, st[1][i]); }
    mx = fmaxf(mx, __shfl_xor(mx, 32));
    const float m_new = fmaxf(m_run, mx);
    const float alpha = __builtin_amdgcn_exp2f(m_run - m_new);
    m_run = m_new;
    float psum = 0.f;
#pragma unroll
    for (int kbk = 0; kbk < 2; ++kbk)
#pragma unroll
      for (int i = 0; i < 16; ++i) { float e = __builtin_amdgcn_exp2f(st[kbk][i] - m_new); st[kbk][i] = e; psum += e; }
    psum += __shfl_xor(psum, 32);
    l_run = l_run * alpha + psum;
#pragma unroll
    for (int i = 0; i < 16; ++i) { o[0][i] *= alpha; o[1][i] *= alpha; }
#pragma unroll
    for (int ksv = 0; ksv < 4; ++ksv) {
      const bf16x8 pf = pack8(st[ksv >> 1], ksv & 1);
#pragma unroll
      for (int db = 0; db < 2; ++db) {
        const char* va = vb + (db * 32 + r) * VROW + (ksv * 16 + 4 * hh) * 2;
        s16x4 lo = *(const s16x4*)va, hi = *(const s16x4*)(va + 16);
        bf16x8 vf = __builtin_shufflevector(lo, hi, 0, 1, 2, 3, 4, 5, 6, 7);
        o[db] = MFMA32(vf, pf, o[db]);
      }
    }
    if (kt + 1 < NT) write_lds((kt + 1) & 1);
  }
  const float invl = 1.f / l_run;
  bf16_t* dst = p.HY + (size_t)(b * TB + q0 + wid * 32 + r) * DM + 384 + h * 64;
#pragma unroll
  for (int db = 0; db < 2; ++db)
#pragma unroll
    for (int g = 0; g < 4; ++g) {
      u32x2 w = {pk_bf16(o[db][4 * g] * invl, o[db][4 * g + 1] * invl), pk_bf16(o[db][4 * g + 2] * invl, o[db][4 * g + 3] * invl)};
      *(u32x2*)(dst + db * 32 + 8 * g + 4 * hh) = w;
    }
}

enum { VW = 0, VKK = 1, VB = 2, VKD = 3, VR = 4, VV = 5 };
DI void scan_task(const Params& p, int l, int b, int h, int dir, int half, char* lds) {
  float* cb = (float*)lds;
  float* tk = cb + 6 * 1024;
  float* ybuf = tk + 1024;
  const int tid = opaque_tid(), lane = tid & 63, wid = tid >> 6;
  const int st_p = tid >> 4, c4 = tid & 15;
  const int fr = lane & 15, fq = lane >> 4;
  const int rp = lane >> 4, g = lane & 15;
  const int hc = h * 64;
  bf16x8 bw[2], ba[2];
  {
    const bf16_t* wd = p.Wdecay + ((size_t)dir * 384 + hc + wid * 16 + fr) * 64;
    const bf16_t* wi = p.Wicl + ((size_t)dir * 384 + hc + wid * 16 + fr) * 64;
#pragma unroll
    for (int ks = 0; ks < 2; ++ks) { bw[ks] = *(const bf16x8*)(wd + ks * 32 + fq * 8); ba[ks] = *(const bf16x8*)(wi + ks * 32 + fq * 8); }
  }
  f32x4 mu0[3], mu1[3];
  const float* mu = p.tshift_mu + (size_t)l * 2 * LDPA;
#pragma unroll
  for (int sec = 0; sec < 3; ++sec) { mu0[sec] = *(const f32x4*)(mu + sec * 384 + hc + c4 * 4); mu1[sec] = *(const f32x4*)(mu + LDPA + sec * 384 + hc + c4 * 4); }
  const f32x4 kkg = *(const f32x4*)(p.k_k + l * 384 + hc + c4 * 4);
  const f32x4 rkg = *(const f32x4*)(p.r_k + l * 384 + hc + c4 * 4);
  const int colB = wid * 16 + fq * 4;
  const f32x4 w0 = *(const f32x4*)(p.decay_w0 + (size_t)(l * 2 + dir) * 384 + hc + colB);
  const f32x4 a0 = *(const f32x4*)(p.icl_a0 + (size_t)(l * 2 + dir) * 384 + hc + colB);
  const f32x4 kag = *(const f32x4*)(p.k_a + l * 384 + hc + colB);

  u32x2 ld[3][3];
  float mprev = 0.f, mnext = 0.f;
  bf16x8 aw[2], aa[2];
  auto chunk_lo = [&](int c) -> int { return dir == 0 ? 16 * c : (c < 16 ? 240 - 16 * c : 2544 - 16 * c); };
  auto issue_loads = [&](int c) {
    const int slo = chunk_lo(c);
    const int s = slo + st_p;
    const bool hasprev = (s != 0 && s != NCTX), hasnext = (s != NCTX - 1 && s != TB - 1);
    const bf16_t* pa = p.PA + (size_t)(b * TB + s) * LDPA + hc + c4 * 4;
    const int op = hasprev ? -LDPA : 0, on = hasnext ? LDPA : 0;
    mprev = hasprev ? 1.f : 0.f; mnext = hasnext ? 1.f : 0.f;
#pragma unroll
    for (int sec = 0; sec < 3; ++sec) {
      ld[sec][1] = *(const u32x2*)(pa + sec * 384);
      ld[sec][0] = *(const u32x2*)(pa + sec * 384 + op);
      ld[sec][2] = *(const u32x2*)(pa + sec * 384 + on);
    }
    const size_t trow = (size_t)(b * TB + slo + fr) * 64;
#pragma unroll
    for (int ks = 0; ks < 2; ++ks) { aw[ks] = *(const bf16x8*)(p.TW + trow + ks * 32 + fq * 8); aa[ks] = *(const bf16x8*)(p.TA + trow + ks * 32 + fq * 8); }
  };
  auto produce = [&](int c) {
    const int slo = chunk_lo(c);
    float ts[3][4];
#pragma unroll
    for (int sec = 0; sec < 3; ++sec) {
      float pc[4], pp[4], pn[4];
      unpack4(ld[sec][1], pc); unpack4(ld[sec][0], pp); unpack4(ld[sec][2], pn);
#pragma unroll
      for (int j = 0; j < 4; ++j) ts[sec][j] = pc[j] + mu0[sec][j] * (pp[j] * mprev - pc[j]) + mu1[sec][j] * (pn[j] * mnext - pc[j]);
    }
    *(f32x4*)(cb + VR * 1024 + st_p * 64 + c4 * 4) = (f32x4){ts[0][0], ts[0][1], ts[0][2], ts[0][3]};
    *(f32x4*)(cb + VV * 1024 + st_p * 64 + c4 * 4) = (f32x4){ts[2][0], ts[2][1], ts[2][2], ts[2][3]};
    *(f32x4*)(tk + st_p * 64 + c4 * 4) = (f32x4){ts[1][0], ts[1][1], ts[1][2], ts[1][3]};
    float kx[4], ss = 0.f;
#pragma unroll
    for (int j = 0; j < 4; ++j) { kx[j] = ts[1][j] * kkg[j]; ss += kx[j] * kx[j]; }
    ss = red16(ss);
    const float inv = rsqrtf(ss + 1e-12f);
    *(f32x4*)(cb + VKK * 1024 + st_p * 64 + c4 * 4) = (f32x4){kx[0] * inv, kx[1] * inv, kx[2] * inv, kx[3] * inv};
    __syncthreads();
    f32x4 dw = {0.f, 0.f, 0.f, 0.f}, da = {0.f, 0.f, 0.f, 0.f};
#pragma unroll
    for (int ks = 0; ks < 2; ++ks) {
      dw = __builtin_amdgcn_mfma_f32_16x16x32_bf16(bw[ks], aw[ks], dw, 0, 0, 0);
      da = __builtin_amdgcn_mfma_f32_16x16x32_bf16(ba[ks], aa[ks], da, 0, 0, 0);
    }
    {
      const f32x4 kv = *(const f32x4*)(tk + fr * 64 + colB);
      const f32x4 kkv = *(const f32x4*)(cb + VKK * 1024 + fr * 64 + colB);
      f32x4 wv, kdv, bv;
#pragma unroll
      for (int j = 0; j < 4; ++j) {
        wv[j] = __expf(-LOG_DECAY_SCALE * sigmoidf_(w0[j] + dw[j]));
        const float a = sigmoidf_(a0[j] + da[j]);
        kdv[j] = kv[j] * (1.f + (a - 1.f) * kag[j]);
        bv[j] = kkv[j] * a;
      }
      *(f32x4*)(cb + VW * 1024 + fr * 64 + colB) = wv;
      *(f32x4*)(cb + VKD * 1024 + fr * 64 + colB) = kdv;
      *(f32x4*)(cb + VB * 1024 + fr * 64 + colB) = bv;
    }
    __syncthreads();
    {
      const f32x4 rv = *(const f32x4*)(cb + VR * 1024 + st_p * 64 + c4 * 4);
      const f32x4 kdv = *(const f32x4*)(cb + VKD * 1024 + st_p * 64 + c4 * 4);
      float bs = rv[0] * kdv[0] * rkg[0] + rv[1] * kdv[1] * rkg[1] + rv[2] * kdv[2] * rkg[2] + rv[3] * kdv[3] * rkg[3];
      bs = red16(bs);
      if (c4 == 0 && half == 0) p.BON[(size_t)dir * T_TOK * 6 + (size_t)(b * TB + slo + st_p) * 6 + h] = bs;
    }
  };

  f32x2 S0[2], S1[2];
#pragma unroll
  for (int j = 0; j < 2; ++j) { S0[j] = (f32x2){0.f, 0.f}; S1[j] = (f32x2){0.f, 0.f}; }
  __syncthreads();
  issue_loads(0);
  produce(0);
  __syncthreads();
  const int NCH = TB / 16;
  const int rowl = half * 32 + wid * 8 + rp * 2;
  const int inc = dir ? -64 : 64;
  for (int c = 0; c < NCH; ++c) {
    if (c + 1 < NCH) issue_loads(c + 1);
    {
      const float* ps = cb + (dir ? 15 * 64 : 0) + g * 4;
      const float* pv = cb + VV * 1024 + (dir ? 15 * 64 : 0) + rowl;
      float* py = ybuf + (dir ? 15 * 512 : 0) + ((wid * 4 + rp) * 16 + g) * 2;
      f32x4 cw = *(const f32x4*)(ps + VW * 1024), ckk = *(const f32x4*)(ps + VKK * 1024), cbb = *(const f32x4*)(ps + VB * 1024),
            ckd = *(const f32x4*)(ps + VKD * 1024), crr = *(const f32x4*)(ps + VR * 1024);
      f32x2 cvv = *(const f32x2*)pv;
#pragma unroll
      for (int ii = 0; ii < 16; ++ii) {
        f32x4 nw = cw, nkk = ckk, nbb = cbb, nkd = ckd, nrr = crr; f32x2 nvv = cvv;
        if (ii < 15) {
          ps += inc; pv += inc;
          nw = *(const f32x4*)(ps + VW * 1024); nkk = *(const f32x4*)(ps + VKK * 1024); nbb = *(const f32x4*)(ps + VB * 1024);
          nkd = *(const f32x4*)(ps + VKD * 1024); nrr = *(const f32x4*)(ps + VR * 1024); nvv = *(const f32x2*)pv;
        }
        __builtin_amdgcn_sched_barrier(0x7);
        const f32x2 kk0 = {ckk[0], ckk[1]}, kk1 = {ckk[2], ckk[3]}, w0 = {cw[0], cw[1]}, w1 = {cw[2], cw[3]};
        const f32x2 b0 = {cbb[0], cbb[1]}, b1 = {cbb[2], cbb[3]}, kd0 = {ckd[0], ckd[1]}, kd1 = {ckd[2], ckd[3]};
        const f32x2 r0 = {crr[0], crr[1]}, r1 = {crr[2], crr[3]};
        const f32x2 p0 = S0[0] * kk0 + S0[1] * kk1, p1 = S1[0] * kk0 + S1[1] * kk1;
        const f32x2 u00 = S0[0] * w0 + kd0 * cvv[0], u01 = S0[1] * w1 + kd1 * cvv[0];
        const f32x2 u10 = S1[0] * w0 + kd0 * cvv[1], u11 = S1[1] * w1 + kd1 * cvv[1];
        const float q0 = red16(p0[0] + p0[1]), q1 = red16(p1[0] + p1[1]);
        S0[0] = u00 - b0 * q0; S0[1] = u01 - b1 * q0;
        S1[0] = u10 - b0 * q1; S1[1] = u11 - b1 * q1;
        const f32x2 y0 = S0[0] * r0 + S0[1] * r1, y1 = S1[0] * r0 + S1[1] * r1;
        *(f32x2*)py = (f32x2){y0[0] + y0[1], y1[0] + y1[1]};
        py += dir ? -512 : 512;
        cw = nw; ckk = nkk; cbb = nbb; ckd = nkd; crr = nrr; cvv = nvv;
      }
    }
    __syncthreads();
    {
      const int slo = chunk_lo(c);
      const float* yp = ybuf + (st_p * 16 + c4) * 32;
      f32x4 a = *(const f32x4*)yp;
#pragma unroll
      for (int i = 1; i < 8; ++i) a += *(const f32x4*)(yp + 4 * i);
      *(f32x2*)(p.Y + (size_t)dir * T_TOK * 384 + (size_t)(b * TB + slo + st_p) * 384 + hc + half * 32 + c4 * 2) = (f32x2){a[0] + a[2], a[1] + a[3]};
    }
    if (c + 1 < NCH) produce(c + 1);
    __syncthreads();
  }
}

DI int lat_tile(int i) { return (i >> 4) * 18 + 2 + (i & 15); }
DI bool xcd_tile(int bid, int G, int i, int MT, int NT, int& tm, int& tn) {
  if ((G & 7) || (MT & 7)) { const int t = bid + i * G; if (t >= MT * NT) return false; tm = t / NT; tn = t % NT; return true; }
  const int nbx = G >> 3, x = bid & 7, j = bid >> 3, MS = MT >> 3;
  const int q = j + nbx * i;
  if (q >= MS * NT) return false;
  const int full = NT >> 3, wl = NT & 7;
  int nb = q / (MS * 8), m, ni;
  if (nb < full) { const int rem = q - nb * MS * 8; m = rem >> 3; ni = rem & 7; }
  else { const int rem = q - full * MS * 8; nb = full; m = rem / wl; ni = rem % wl; }
  tm = x * MS + m; tn = nb * 8 + ni;
  return true;
}

template <int KSEL> DI void run_phase(const Params& p, int ph, char* lds) {
  const int bid = blockIdx.x, G = gridDim.x, tid = opaque_tid(), lane = tid & 63, wid = tid >> 6;
  if (ph == 0) {
    if (KSEL >= 0 && KSEL != 10) return;
    for (int t = bid; t < 384 + NCONV_W1 + 1; t += G) {
      if (t < 384) adaln_task(p, t, lds);
      else if (t < 384 + NCONV_W1) conv_w1_task(p, 0, t - 384, lds);
      else { for (int e = tid; e < 512; e += 256) { float cs, sn; rope_angle(e >> 3, e & 7, cs, sn); p.ROPE[2 * e] = cs; p.ROPE[2 * e + 1] = sn; } }
    }
    return;
  }
  if (KSEL == 10) return;
  const int l = (ph - 1) / 9, kq = (ph - 1) % 9, k = kq < 2 ? kq : kq + 1;
  const bool last = (l == 1);
  const int lb = ((G & 7) == 0) ? (bid & 7) * (G >> 3) + (bid >> 3) : bid;
  if (KSEL >= 0 && KSEL != 10 && k != (KSEL == 11 ? 4 : KSEL)) return;
  switch (k) {
    case 0:
      for (int i = bid * 256 + tid; i < 2 * T_TOK; i += G * 256) p.RSTD[i] = 0.f;
      modnorm_rows(p, l, 0, l == 0, false, bid * 4 + wid, G * 4, lane);
      break;
    case 1: {
      EpiP e{p.PA, p.PBC, p.RSTD};
      for (int i = 0, tm, tn; xcd_tile(bid, G, i, 144, 26, tm, tn); ++i) gemm_tile(p.HY, DM, p.Win, DM, DM, tm * 128, tn * 128, lds, e);
    } break;
    case 3: {
      const int nq = last ? 128 * 5 : 144 * 5;
      EpiQ eq{p.RSTD, p.q_nope_g + l * 64, p.q_rope_g + l * 32, p.ROPE, p.Q};
      EpiK ek{p.RSTD + T_TOK, p.k_nope_g + l * 64, p.Kt};
      EpiV ev{p.RSTD + T_TOK, p.VT};
      if (KSEL >= 0) {
        for (int t = bid; t < nq + 432 + 432 + T_TOK / 4; t += G) {
          if (t >= nq + 864) { prep_token(p, l, (t - nq - 864) * 4 + wid, lane); continue; }
          if (t < nq) { int i = t / 5; int tm = last ? lat_tile(i) : i; gemm_tile(p.PBC, LDPBC, p.Wuq, 768, 768, tm * 128, (t % 5) * 128, lds, eq); }
          else if (t < nq + 432) { int u = t - nq; gemm_tile(p.PBC + 768, LDPBC, p.WukvK, 256, 256, (u / 3) * 128, (u % 3) * 128, lds, ek); }
          else { int u = t - nq - 432; gemm_tile(p.WvT, 256, p.PBC + 768, LDPBC, 256, (u % 3) * 128, (u / 3) * 128, lds, ev); }
        }
      } else {
        for (int t = bid; t < T_TOK / 4; t += G) prep_token(p, l, t * 4 + wid, lane);
        volatile LAS unsigned* slot = (volatile LAS unsigned*)(lds + 65536 + 8);
        unsigned* qg = p.BAR + 3456   + 64 * l + 16;
        for (;;) {
          __syncthreads();
          if (tid == 0) *slot = __hip_atomic_fetch_add(qg, 1u, __ATOMIC_RELAXED, __HIP_MEMORY_SCOPE_AGENT);
          __syncthreads();
          const int t = (int)*slot;
          if (t >= nq + 864) break;
          if (t < nq) { int i = t / 5; int tm = last ? lat_tile(i) : i; gemm_tile(p.PBC, LDPBC, p.Wuq, 768, 768, tm * 128, (t % 5) * 128, lds, eq); }
          else if (t < nq + 432) { int u = t - nq; gemm_tile(p.PBC + 768, LDPBC, p.WukvK, 256, 256, (u / 3) * 128, (u % 3) * 128, lds, ek); }
          else { int u = t - nq - 432; gemm_tile(p.WvT, 256, p.PBC + 768, LDPBC, 256, (u % 3) * 128, (u / 3) * 128, lds, ev); }
        }
      }
    } break;
    case 4: {
      const int natt = 768 + (last ? 0 : 96);
      if (KSEL != 11) { if (bid < 192) { scan_task(p, l, bid / 24, (bid % 24) >> 2, (bid >> 1) & 1, bid & 1, lds); break; } if (KSEL == 4) break; }
      const int aoff = KSEL == 11 ? 0 : 192;
      if (KSEL == 11) {
        for (int t = bid; t < natt + NCONV_FF; t += G) {
          if (t < 768) { int bh = t >> 4, qb = t & 15; attn_task(p, bh / 6, bh % 6, NCTX + qb * 128, 0, TB, lds); }
          else if (t < natt) { int u = t - 768; int bh = u >> 1, qb = u & 1; attn_task(p, bh / 6, bh % 6, qb * 128, 0, NCTX, lds); }
          else conv_ff_task(p, l, t - natt, lds);
        }
      } else {
        volatile LAS unsigned* slot = (volatile LAS unsigned*)(lds + 65536 + 8);
        for (;;) {
          __syncthreads();
          if (tid == 0) *slot = __hip_atomic_fetch_add(p.BAR + 3456   + 64 * l, 1u, __ATOMIC_RELAXED, __HIP_MEMORY_SCOPE_AGENT);
          __syncthreads();
          const int t = (int)*slot;
          if (t >= natt + NCONV_FF) break;
          if (t < 768) { int bh = t >> 4, qb = t & 15; attn_task(p, bh / 6, bh % 6, NCTX + qb * 128, 0, TB, lds); }
          else if (t < natt) { int u = t - 768; int bh = u >> 1, qb = u & 1; attn_task(p, bh / 6, bh % 6, qb * 128, 0, NCTX, lds); }
          else conv_ff_task(p, l, t - natt, lds);
        }
      }
    } break;
    case 5: {
      EpiPost e{p.Y, p.BON, p.tshift_mu + (size_t)l * 2 * LDPA, p.lnx_g + l * 384, p.lnx_b + l * 384, p.PA, p.HY};
      const int nm = last ? 128 : 144;
      for (int t = bid; t < nm * 3; t += G) { int i = t / 3; int tm = last ? lat_tile(i) : i; gemm_tile(p.TG, 128, p.Wgate, 128, 128, tm * 128, (t % 3) * 128, lds, e); }
    } break;
    case 6: {
      EpiRes e{&p, l, l == 0, 2 * 1024};
      const int nm = last ? 128 : 144;
      for (int i = 0, tm, tn; xcd_tile(bid, G, i, nm, 8, tm, tn); ++i) gemm_tile(p.HY, DM, p.Wout, DM, DM, (last ? lat_tile(tm) : tm) * 128, tn * 128, lds, e);
    } break;
    case 7:
      modnorm_rows(p, l, 1, false, last, bid * 4 + wid, G * 4, lane);
      break;
    case 8: {
      EpiFfnIn e{p.ACT};
      const int nm = last ? 128 : 144;
      const int nconv = last ? 0 : NCONV_W1;
      for (int i = 0, tm, tn; xcd_tile(bid, G, i, nm, 44, tm, tn); ++i) gemm_tile(p.HY, DM, p.Wffi, DM, DM, (last ? lat_tile(tm) : tm) * 128, tn * 128, lds, e);
      for (int t = bid; t < nconv; t += G) conv_w1_task(p, 1, t, lds);
    } break;
    case 9: {
      EpiRes e{&p, l, false, 5 * 1024};
      const int nm = last ? 128 : 144;
      for (int i = 0, tm, tn; xcd_tile(bid, G, i, nm, 8, tm, tn); ++i) gemm_tile(p.ACT, 2816, p.Wffo, 2816, 2816, (last ? lat_tile(tm) : tm) * 128, tn * 128, lds, e);
    } break;
  }
}


#define XB_TMO      128
#define XB_XCNT(j)  (256  + 64 * (j))
#define XB_XSUB(j)  (1280 + 64 * (j))
#define XB_XGEN(j)  (2304 + 64 * (j))
#define XB_TOP      3328
#define XB_TOPGEN   3392
#define XCD_BAR_WORDS 3456
#define XB_SPIN_CAP (1u << 20)
DI unsigned xb_ld(unsigned* p) { return __hip_atomic_load(p, __ATOMIC_RELAXED, __HIP_MEMORY_SCOPE_AGENT); }
DI unsigned xb_add(unsigned* p, unsigned v) { return __hip_atomic_fetch_add(p, v, __ATOMIC_RELAXED, __HIP_MEMORY_SCOPE_AGENT); }
DI unsigned xb_xcc_id() { return (unsigned)__builtin_amdgcn_s_getreg((3 << 11) | 20) & 0xFu; }
#define XB_SPIN(cond, bar) do { unsigned _sp = 0; while (cond) { __builtin_amdgcn_s_sleep(1); \
    if ((++_sp & 255u) == 0u) { if (xb_ld(&(bar)[XB_TMO])) break; if (_sp > XB_SPIN_CAP) { atomicAdd(&(bar)[XB_TMO], 1u); break; } } } } while (0)
struct XcdBarrier { unsigned* bar; unsigned x; volatile LAS unsigned* st; };
DI XcdBarrier xcd_barrier_post(unsigned* bar, volatile LAS unsigned* st) {
  XcdBarrier b; b.bar = bar; b.x = xb_xcc_id(); b.st = st;
  if (threadIdx.x == 0) (void)xb_add(&bar[XB_XCNT(b.x)], 1u);
  return b;
}
DI void xcd_barrier_complete(unsigned* bar, unsigned x, unsigned& nloc, unsigned& nx) {
  const unsigned G = gridDim.x * gridDim.y * gridDim.z;
  unsigned sum, cnt, mine, sp = 0u;
  for (;;) {
    sum = 0u; cnt = 0u; mine = 0u;
#pragma unroll
    for (unsigned j = 0; j < 16; ++j) { const unsigned c = xb_ld(&bar[XB_XCNT(j)]); sum += c; cnt += (c > 0u) ? 1u : 0u; mine = (j == x) ? c : mine; }
    if (sum == G) break;
    __builtin_amdgcn_s_sleep(1);
    if ((++sp & 255u) == 0u) { if (xb_ld(&bar[XB_TMO])) break; if (sp > XB_SPIN_CAP) { atomicAdd(&bar[XB_TMO], 1u); break; } }
  }
  nloc = mine > 0u ? mine : 1u; nx = cnt > 0u ? cnt : 1u;
}
DI void xcd_barrier(const XcdBarrier& b) {
  asm volatile("s_waitcnt vmcnt(0)" ::: "memory");
  __syncthreads();
  if (threadIdx.x == 0) {
    unsigned* bar = b.bar;
    __builtin_amdgcn_s_waitcnt(0);
    unsigned nloc = b.st[0], nx = b.st[1];
    if (nloc == 0u) { xcd_barrier_complete(bar, b.x, nloc, nx); b.st[0] = nloc; b.st[1] = nx; }
    const unsigned old = xb_add(&bar[XB_XSUB(b.x)], 1u);
    const unsigned gen = old / nloc;
    if (old + 1u == (gen + 1u) * nloc) {
      __builtin_amdgcn_fence(__ATOMIC_RELEASE, "agent");
      asm volatile("s_waitcnt vmcnt(0)" ::: "memory");
      const unsigned og = xb_add(&bar[XB_TOP], 1u);
      const unsigned tg = og / nx;
      if (og + 1u == (tg + 1u) * nx) xb_add(&bar[XB_TOPGEN], 1u);
      else XB_SPIN(xb_ld(&bar[XB_TOPGEN]) == tg, bar);
      __builtin_amdgcn_fence(__ATOMIC_ACQUIRE, "agent");
      xb_add(&bar[XB_XGEN(b.x)], 1u);
      asm volatile("s_waitcnt vmcnt(0)" ::: "memory");
    } else {
      XB_SPIN(xb_ld(&bar[XB_XGEN(b.x)]) == gen, bar);
      __builtin_amdgcn_fence(__ATOMIC_ACQUIRE, "agent");
      asm volatile("s_waitcnt vmcnt(0)" ::: "memory");
    }
  }
  __syncthreads();
}

constexpr int NPHASE = 19;
#if !MULTI_LAUNCH
__global__ void __launch_bounds__(256, 2) mega(Params p, int ph_lo, int ph_hi) {
  __shared__ __attribute__((aligned(16))) char lds[65536 + 16];
  cg::grid_group grid = cg::this_grid();
  volatile LAS unsigned* st = (volatile LAS unsigned*)(lds + 65536);
  if (threadIdx.x == 0) { st[0] = 0u; st[1] = 0u; }
  if (blockIdx.x == 0) for (int i = threadIdx.x; i < XCD_BAR_WORDS + 128; i += 256) p.BAR[i] = 0u;
  __syncthreads();
  XcdBarrier xb;
  for (int ph = ph_lo; ph < ph_hi; ++ph) {
    if (ph == ph_lo + 1) { grid.sync(); xb = xcd_barrier_post(p.BAR, st); }
    else if (ph > ph_lo + 1) xcd_barrier(xb);
    run_phase<-1>(p, ph, lds);
  }
}
#endif
template <int KSEL> __global__ void __launch_bounds__(256, 2) phase_k(Params p, int ph) {
  __shared__ __attribute__((aligned(16))) char lds[65536];
  run_phase<KSEL>(p, ph, lds);
}

extern "C" void kernel_launch(void* const* d_in, const int* in_sizes, int n_in, void* d_out, int out_size, void* d_ws, size_t ws_size, hipStream_t stream) {
  static int grid_blocks = 0;
  if (!grid_blocks) {
    int dev = 0, cus = 0, per_cu = 0;
    (void)hipGetDevice(&dev);
    (void)hipDeviceGetAttribute(&cus, hipDeviceAttributeMultiprocessorCount, dev);
    #if MULTI_LAUNCH
    per_cu = 2;
#else
    (void)hipOccupancyMaxActiveBlocksPerMultiprocessor(&per_cu, mega, 256, 0);
#endif
    if (per_cu > 2) per_cu = 2;
    if (per_cu < 1) per_cu = 1;
    grid_blocks = cus * per_cu;
  }
  Params p{};
  const float** pin = (const float**)&p.x;
  for (int i = 0; i < 32; ++i) pin[i] = (const float*)d_in[i];
  p.out = (float*)d_out;
  char* w = (char*)d_ws;
  size_t off = 0;
  auto take = [&](size_t bytes) { char* r = w + off; off += (bytes + 255) & ~(size_t)255; return r; };
  p.BAR = (unsigned*)take((XCD_BAR_WORDS + 128) * 4);
  p.MOD = (float*)take(2 * 9 * 6144 * 4);
  p.ROPE = (float*)take(64 * 8 * 2 * 4);
  p.RSTD = (float*)take(2 * (size_t)T_TOK * 4);
  p.BON = (float*)take(2 * (size_t)T_TOK * 6 * 4);
  p.XCTX = (float*)take((size_t)8 * NCTX * DM * 4);
  p.Win = (bf16_t*)take((size_t)3328 * 1024 * 2);
  p.Wuq = (bf16_t*)take((size_t)640 * 768 * 2);
  p.WukvK = (bf16_t*)take((size_t)384 * 256 * 2);
  p.WvT = (bf16_t*)take((size_t)384 * 256 * 2);
  p.Wgate = (bf16_t*)take((size_t)384 * 128 * 2);
  p.Wdecay = (bf16_t*)take((size_t)2 * 384 * 64 * 2);
  p.Wicl = (bf16_t*)take((size_t)2 * 384 * 64 * 2);
  p.Wout = (bf16_t*)take((size_t)1024 * 1024 * 2);
  p.HY = (bf16_t*)take((size_t)T_TOK * DM * 2);
  p.TW = (bf16_t*)take((size_t)T_TOK * 64 * 2);
  p.TA = (bf16_t*)take((size_t)T_TOK * 64 * 2);
  p.TG = (bf16_t*)take((size_t)T_TOK * 128 * 2);
  char* qkv = take((size_t)T_TOK * 576 * 2 * 2 + (size_t)384 * T_TOK * 2);
  p.Q = (bf16_t*)qkv;
  p.Kt = (bf16_t*)(qkv + (size_t)T_TOK * 576 * 2);
  p.VT = (bf16_t*)(qkv + (size_t)T_TOK * 576 * 2 * 2);
  p.Wffi = (bf16_t*)take((size_t)5632 * 1024 * 2);
  p.Wffo = (bf16_t*)take((size_t)2816 * 1024 * 2);
  char* pr = take((size_t)T_TOK * (LDPA + LDPBC) * 2);
  p.PA = (bf16_t*)pr;
  p.PBC = (bf16_t*)(pr + (size_t)T_TOK * LDPA * 2);
  p.Y = (float*)p.PBC;
  p.ACT = (bf16_t*)pr;
  if (off > ws_size) { fprintf(stderr, "workspace too small: need %zu have %zu\n", off, ws_size); }
#if MULTI_LAUNCH
  hipLaunchKernelGGL(phase_k<10>, dim3(grid_blocks), dim3(256), 0, stream, p, 0);
  for (int l = 0; l < 2; ++l) {
    const int b0 = 1 + 10 * l;
    hipLaunchKernelGGL(phase_k<0>, dim3(grid_blocks), dim3(256), 0, stream, p, b0 + 0);
    hipLaunchKernelGGL(phase_k<1>, dim3(grid_blocks), dim3(256), 0, stream, p, b0 + 1);
    hipLaunchKernelGGL(phase_k<2>, dim3(grid_blocks), dim3(256), 0, stream, p, b0 + 2);
    hipLaunchKernelGGL(phase_k<3>, dim3(grid_blocks), dim3(256), 0, stream, p, b0 + 3);
    hipLaunchKernelGGL(phase_k<4>, dim3(192), dim3(256), 0, stream, p, b0 + 4);
    hipLaunchKernelGGL(phase_k<11>, dim3(grid_blocks), dim3(256), 0, stream, p, b0 + 4);
    hipLaunchKernelGGL(phase_k<5>, dim3(grid_blocks), dim3(256), 0, stream, p, b0 + 5);
    hipLaunchKernelGGL(phase_k<6>, dim3(grid_blocks), dim3(256), 0, stream, p, b0 + 6);
    hipLaunchKernelGGL(phase_k<7>, dim3(grid_blocks), dim3(256), 0, stream, p, b0 + 7);
    hipLaunchKernelGGL(phase_k<8>, dim3(grid_blocks), dim3(256), 0, stream, p, b0 + 8);
    hipLaunchKernelGGL(phase_k<9>, dim3(grid_blocks), dim3(256), 0, stream, p, b0 + 9);
  }
#else
  int lo = 0, hi = NPHASE;
  void* args[] = {&p, &lo, &hi};
  hipError_t e = hipLaunchCooperativeKernel((void*)mega, dim3(grid_blocks), dim3(256), args, 0, stream);
  if (e != hipSuccess) fprintf(stderr, "cooperative launch failed: %s (grid %d)\n", hipGetErrorString(e), grid_blocks);
#endif
}
```

```cpp
#include <hip/hip_runtime.h>
#include <hip/hip_cooperative_groups.h>
#include <cstdio>
namespace cg = cooperative_groups;

#ifndef MULTI_LAUNCH
#define MULTI_LAUNCH 0
#endif

#define DI __device__ __forceinline__
typedef unsigned short bf16_t;
typedef short bf16x8 __attribute__((ext_vector_type(8)));
typedef short s16x4 __attribute__((ext_vector_type(4)));
typedef float f32x4 __attribute__((ext_vector_type(4)));
typedef float f32x2 __attribute__((ext_vector_type(2)));
typedef float f32x16 __attribute__((ext_vector_type(16)));
typedef unsigned u32x4 __attribute__((ext_vector_type(4)));
typedef unsigned u32x2 __attribute__((ext_vector_type(2)));
#define LAS __attribute__((address_space(3)))

constexpr int T_TOK = 18432, TB = 2304, NCTX = 256, NLAT = 2048, DM = 1024;
constexpr int LDPA = 1408, LDPBC = 1920;
constexpr float EPSF = 1e-6f;
constexpr float LOG_DECAY_SCALE = 0.606531f;
constexpr float GN_EPS = 64e-5f;
constexpr float QSCALE = 0.10206207261596577f * 1.4426950408889634f;

struct Params {
  const float *x, *c, *ctx, *c_ctx, *ada_w, *ada_b, *norm1_g, *norm2_g, *w_in, *tshift_mu, *decay_w0, *decay_up,
      *icl_a0, *icl_up, *gate_up, *k_k, *k_a, *r_k, *lnx_g, *lnx_b, *q_norm_g, *kv_norm_g, *w_uq, *w_ukv, *q_nope_g,
      *k_nope_g, *q_rope_g, *k_rope_g, *conv_w, *w_out, *w_ffn_in, *w_ffn_out;
  float* out;
  float *MOD, *RSTD, *BON, *XCTX, *Y, *ROPE;
  unsigned* BAR;
  bf16_t *Win, *Wuq, *WukvK, *WvT, *Wgate, *Wdecay, *Wicl, *Wout, *Wffi, *Wffo;
  bf16_t *HY, *TW, *TA, *TG, *Q, *Kt, *VT, *PA, *PBC, *ACT;
};

typedef __bf16 bf16v2 __attribute__((ext_vector_type(2)));
DI unsigned pk_bf16(float lo, float hi) { f32x2 v = {lo, hi}; bf16v2 b = __builtin_convertvector(v, bf16v2); return __builtin_bit_cast(unsigned, b); }
DI float bflo(unsigned u) { return __uint_as_float(u << 16); }
DI float bfhi(unsigned u) { return __uint_as_float(u & 0xffff0000u); }
DI int opaque_tid() { int t = threadIdx.x; asm volatile("" : "+v"(t)); return t; }
DI float sigmoidf_(float x) { return 1.f / (1.f + __expf(-x)); }
template <int CTRL> DI float dppf(float x) { return __builtin_bit_cast(float, __builtin_amdgcn_update_dpp(0, __builtin_bit_cast(int, x), CTRL, 0xf, 0xf, true)); }
DI float red8(float x) { x += dppf<0xB1>(x); x += dppf<0x4E>(x); x += dppf<0x141>(x); return x; }
DI float red16(float x) { x = red8(x); x += dppf<0x140>(x); return x; }
DI float red64(float x) { for (int o = 32; o > 0; o >>= 1) x += __shfl_xor(x, o); return x; }

DI void unpack8(u32x4 v, float* f) {
  f[0] = bflo(v[0]); f[1] = bfhi(v[0]); f[2] = bflo(v[1]); f[3] = bfhi(v[1]);
  f[4] = bflo(v[2]); f[5] = bfhi(v[2]); f[6] = bflo(v[3]); f[7] = bfhi(v[3]);
}
DI void unpack4(u32x2 v, float* f) { f[0] = bflo(v[0]); f[1] = bfhi(v[0]); f[2] = bflo(v[1]); f[3] = bfhi(v[1]); }

DI const float* xsrc_row(const Params& p, bool from_inputs, int b, int s) {
  if (from_inputs) return s < NCTX ? p.ctx + (size_t)(b * NCTX + s) * DM : p.x + (size_t)(b * NLAT + s - NCTX) * DM;
  return s < NCTX ? p.XCTX + (size_t)(b * NCTX + s) * DM : p.out + (size_t)(b * NLAT + s - NCTX) * DM;
}
DI float* xdst_row(const Params& p, int b, int s) {
  return s < NCTX ? p.XCTX + (size_t)(b * NCTX + s) * DM : p.out + (size_t)(b * NLAT + s - NCTX) * DM;
}

DI void adaln_task(const Params& p, int task, char* lds) {
  float* s = (float*)lds;
  float* red = s + 9 * 1024;
  const int l = task / 192, cgi = task % 192, tid = opaque_tid();
  for (int i = tid; i < 9 * 1024; i += 256) {
    int r = i >> 10, k = i & 1023;
    float v = r < 8 ? p.c[r * 1024 + k] : p.c_ctx[k];
    s[i] = v / (1.f + __expf(-v));
  }
  __syncthreads();
  const int kg = tid >> 5, cc = tid & 31, col = cgi * 32 + cc;
  float acc[9];
#pragma unroll
  for (int r = 0; r < 9; ++r) acc[r] = 0.f;
  const float* w = p.ada_w + (size_t)l * 1024 * 6144 + col;
  for (int k0 = kg; k0 < 1024; k0 += 128) {
    float wv[16];
#pragma unroll
    for (int u = 0; u < 16; ++u) wv[u] = w[(size_t)(k0 + 8 * u) * 6144];
#pragma unroll
    for (int u = 0; u < 16; ++u)
#pragma unroll
      for (int r = 0; r < 9; ++r) acc[r] += s[r * 1024 + k0 + 8 * u] * wv[u];
  }
#pragma unroll
  for (int r = 0; r < 9; ++r) red[(kg * 9 + r) * 32 + cc] = acc[r];
  __syncthreads();
  for (int i = tid; i < 9 * 32; i += 256) {
    int r = i >> 5, c2 = i & 31;
    float sum = 0.f;
    for (int g = 0; g < 8; ++g) sum += red[(g * 9 + r) * 32 + c2];
    p.MOD[(size_t)(l * 9 + r) * 6144 + cgi * 32 + c2] = sum + p.ada_b[l * 6144 + cgi * 32 + c2];
  }
  __syncthreads();
}

DI int colmap(int mode, int n, int nvalid) {
  switch (mode) {
    case 0: return n < nvalid ? n : -1;
    case 1: if (n < 384) return (n >> 6) * 96 + (n & 63); if (n < 576) return ((n - 384) >> 5) * 96 + 64 + ((n - 384) & 31); return -1;
    case 2: return (n >> 6) * 128 + (n & 63);
    case 3: return (n >> 6) * 128 + 64 + (n & 63);
    default: { int t64 = n >> 6, w = n & 63; return w < 32 ? t64 * 32 + w : 2816 + t64 * 32 + (w - 32); }
  }
}
DI void conv_tile(const float* src, int ld, int K, int mode, int nvalid, const float* kscale, bf16_t* dst, int tile, int ntn, char* lds) {
  float(*tl)[65] = (float(*)[65])lds;
  const int tk = tile / ntn, tn = tile % ntn, tid = opaque_tid(), k0 = tk * 64;
  {
    const int nn = tid & 63, kk0 = tid >> 6;
    const int sc = colmap(mode, tn * 64 + nn, nvalid);
#pragma unroll 4
    for (int i = 0; i < 16; ++i) {
      const int kk = kk0 + 4 * i;
      float v = 0.f;
      if (sc >= 0) { v = src[(size_t)(k0 + kk) * ld + sc]; if (kscale) v *= kscale[k0 + kk]; }
      tl[kk][nn] = v;
    }
  }
  __syncthreads();
  {
    const int kk2 = (tid & 31) * 2, nn2 = tid >> 5;
#pragma unroll
    for (int i = 0; i < 8; ++i) {
      const int nn = nn2 + 8 * i;
      *(unsigned*)(dst + (size_t)(tn * 64 + nn) * K + k0 + kk2) = pk_bf16(tl[kk2][nn], tl[kk2 + 1][nn]);
    }
  }
  __syncthreads();
}
constexpr int NCONV_W1 = 1292, NCONV_FF = 2112;
DI void conv_w1_task(const Params& p, int l, int t, char* lds) {
  if (t < 832) { conv_tile(p.w_in + (size_t)l * 1024 * 3232, 3232, 1024, 0, 3232, nullptr, p.Win, t, 52, lds); return; } t -= 832;
  if (t < 120) { conv_tile(p.w_uq + (size_t)l * 768 * 576, 576, 768, 1, 0, p.q_norm_g + l * 768, p.Wuq, t, 10, lds); return; } t -= 120;
  if (t < 24) { conv_tile(p.w_ukv + (size_t)l * 256 * 768, 768, 256, 2, 0, p.kv_norm_g + l * 256, p.WukvK, t, 6, lds); return; } t -= 24;
  if (t < 24) { conv_tile(p.w_ukv + (size_t)l * 256 * 768, 768, 256, 3, 0, p.kv_norm_g + l * 256, p.WvT, t, 6, lds); return; } t -= 24;
  if (t < 12) { conv_tile(p.gate_up + (size_t)l * 128 * 384, 384, 128, 0, 384, nullptr, p.Wgate, t, 6, lds); return; } t -= 12;
  if (t < 12) { int d = t / 6; conv_tile(p.decay_up + (size_t)(l * 2 + d) * 64 * 384, 384, 64, 0, 384, nullptr, p.Wdecay + d * 384 * 64, t % 6, 6, lds); return; } t -= 12;
  if (t < 12) { int d = t / 6; conv_tile(p.icl_up + (size_t)(l * 2 + d) * 64 * 384, 384, 64, 0, 384, nullptr, p.Wicl + d * 384 * 64, t % 6, 6, lds); return; } t -= 12;
  conv_tile(p.w_out + (size_t)l * 1024 * 1024, 1024, 1024, 0, 1024, nullptr, p.Wout, t, 16, lds);
}
DI void conv_ff_task(const Params& p, int l, int t, char* lds) {
  if (t < 1408) { conv_tile(p.w_ffn_in + (size_t)l * 1024 * 5632, 5632, 1024, 4, 0, nullptr, p.Wffi, t, 88, lds); return; } t -= 1408;
  conv_tile(p.w_ffn_out + (size_t)l * 2816 * 1024, 1024, 2816, 0, 1024, nullptr, p.Wffo, t, 16, lds);
}

DI void modnorm_rows(const Params& p, int l, int which  , bool from_inputs, bool skip_ctx, int w0, int wstride, int lane) {
  const float* g = (which ? p.norm2_g : p.norm1_g) + l * DM;
  f32x4 gg[4];
#pragma unroll
  for (int i = 0; i < 4; ++i) gg[i] = *(const f32x4*)(g + i * 256 + lane * 4);
  const int nrows = skip_ctx ? 8 * NLAT : T_TOK;
  auto rowof = [&](int i) -> int { return skip_ctx ? (i / NLAT) * TB + NCTX + (i % NLAT) : i; };
  int i = w0;
  if (i >= nrows) return;
  f32x4 vn[4];
  {
    const int row = rowof(i); const float* src = xsrc_row(p, from_inputs, row / TB, row % TB);
#pragma unroll
    for (int q = 0; q < 4; ++q) vn[q] = *(const f32x4*)(src + q * 256 + lane * 4);
  }
  for (; i < nrows; i += wstride) {
    const int row = rowof(i); const int b = row / TB, s = row % TB;
    f32x4 v[4];
#pragma unroll
    for (int q = 0; q < 4; ++q) v[q] = vn[q];
    if (i + wstride < nrows) {
      const int rn = rowof(i + wstride); const float* src = xsrc_row(p, from_inputs, rn / TB, rn % TB);
#pragma unroll
      for (int q = 0; q < 4; ++q) vn[q] = *(const f32x4*)(src + q * 256 + lane * 4);
    }
    const float* mod = p.MOD + (size_t)(l * 9 + (s < NCTX ? 8 : b)) * 6144 + (which ? 3 * 1024 : 0);
    f32x4 sh[4], sc[4];
#pragma unroll
    for (int q = 0; q < 4; ++q) { sh[q] = *(const f32x4*)(mod + q * 256 + lane * 4); sc[q] = *(const f32x4*)(mod + 1024 + q * 256 + lane * 4); }
    float ss = 0.f;
#pragma unroll
    for (int q = 0; q < 4; ++q) ss += v[q][0] * v[q][0] + v[q][1] * v[q][1] + v[q][2] * v[q][2] + v[q][3] * v[q][3];
    ss = red64(ss);
    const float rs = rsqrtf(ss * (1.f / 1024.f) + EPSF);
    bf16_t* dst = p.HY + (size_t)row * DM;
#pragma unroll
    for (int q = 0; q < 4; ++q) {
      float o[4];
#pragma unroll
      for (int j = 0; j < 4; ++j) o[j] = (v[q][j] * rs * gg[q][j]) * (1.f + sc[q][j]) + sh[q][j];
      u32x2 w = {pk_bf16(o[0], o[1]), pk_bf16(o[2], o[3])};
      *(u32x2*)(dst + q * 256 + lane * 4) = w;
    }
  }
}

template <class Epi>
DI void gemm_tile(const bf16_t* __restrict__ A, int lda, const bf16_t* __restrict__ Bt, int ldb, int K, int row0, int col0, char* lds, const Epi& epi) {
  const int tid = opaque_tid(), lane = tid & 63, wid = tid >> 6, wr = wid >> 1, wc = wid & 1, fr = lane & 15, fq = lane >> 4;
  const bf16_t* ag[4];
  const bf16_t* bg[4];
#pragma unroll
  for (int i = 0; i < 4; ++i) {
    const int id = i * 256 + tid, r = id >> 3, cp = id & 7, c = cp ^ ((r >> 1) & 7);
    ag[i] = A + (size_t)(row0 + r) * lda + c * 8;
    bg[i] = Bt + (size_t)(col0 + r) * ldb + c * 8;
  }
  f32x4 acc[4][4];
#pragma unroll
  for (int m = 0; m < 4; ++m)
#pragma unroll
    for (int n = 0; n < 4; ++n) acc[m][n] = (f32x4){0.f, 0.f, 0.f, 0.f};
  const int KT = K >> 6;
  auto stage_a = [&](int kt, int buf) {
    char* sa = lds + buf * 32768;
#pragma unroll
    for (int i = 0; i < 4; ++i)
      __builtin_amdgcn_global_load_lds((const void __attribute__((address_space(1)))*)(ag[i] + kt * 64), (void LAS*)(sa + (i * 256 + tid) * 16), 16, 0, 0);
  };
  auto stage_b = [&](int kt, int buf) {
    char* sb = lds + buf * 32768 + 16384;
#pragma unroll
    for (int i = 0; i < 4; ++i)
      __builtin_amdgcn_global_load_lds((const void __attribute__((address_space(1)))*)(bg[i] + kt * 64), (void LAS*)(sb + (i * 256 + tid) * 16), 16, 0, 0);
  };
  __syncthreads();
  stage_a(0, 0); stage_b(0, 0);
  const int swz = fr >> 1;
  for (int kt = 0; kt < KT; ++kt) {
    asm volatile("s_waitcnt vmcnt(0)" ::: "memory");
    __syncthreads();
    const char* sa = lds + (kt & 1) * 32768 + (wr * 64 + fr) * 128;
    const char* sb = lds + (kt & 1) * 32768 + 16384 + (wc * 64 + fr) * 128;
#pragma unroll
    for (int kk = 0; kk < 2; ++kk) {
      if (kt + 1 < KT) { if (kk == 0) stage_a(kt + 1, (kt + 1) & 1); else stage_b(kt + 1, (kt + 1) & 1); }
      bf16x8 a[4], b[4];
      const int co = ((kk * 4 + fq) ^ swz) * 16;
#pragma unroll
      for (int m = 0; m < 4; ++m) a[m] = *(const bf16x8*)(sa + m * 2048 + co);
#pragma unroll
      for (int n = 0; n < 4; ++n) b[n] = *(const bf16x8*)(sb + n * 2048 + co);
#pragma unroll
      for (int m = 0; m < 4; ++m)
#pragma unroll
        for (int n = 0; n < 4; ++n) acc[m][n] = __builtin_amdgcn_mfma_f32_16x16x32_bf16(b[n], a[m], acc[m][n], 0, 0, 0);
    }
  }
  epi(acc, row0 + wr * 64, col0 + wc * 64, fr, fq);
}

struct EpiP {
  bf16_t *PA, *PBC; float* SSQ;
  DI void operator()(const f32x4 (&acc)[4][4], int r0, int c0, int fr, int fq) const {
    bf16_t* base; int ld, cb;
    if (c0 < LDPA) { base = PA; ld = LDPA; cb = c0; } else { base = PBC; ld = LDPBC; cb = c0 - LDPA; }
    if (c0 >= LDPA && cb < 1024) {
      float* dst = SSQ + (cb < 768 ? 0 : T_TOK);
#pragma unroll
      for (int m = 0; m < 4; ++m) {
        float ss = 0.f;
#pragma unroll
        for (int n = 0; n < 4; ++n)
#pragma unroll
          for (int j = 0; j < 4; ++j) ss += acc[m][n][j] * acc[m][n][j];
        ss += __shfl_xor(ss, 16); ss += __shfl_xor(ss, 32);
        if (fq == 0) atomicAdd(dst + r0 + m * 16 + fr, ss);
      }
    }
#pragma unroll
    for (int m = 0; m < 4; ++m)
#pragma unroll
      for (int n = 0; n < 4; ++n) {
        u32x2 v = {pk_bf16(acc[m][n][0], acc[m][n][1]), pk_bf16(acc[m][n][2], acc[m][n][3])};
        *(u32x2*)(base + (size_t)(r0 + m * 16 + fr) * ld + cb + n * 16 + fq * 4) = v;
      }
  }
};

DI void rope_angle(int pos, int i, float& cs, float& sn) {
  const float invf = __builtin_amdgcn_exp2f(-(float)i * (13.287712379549449f / 8.f));
  float ang = (float)pos * invf;
  float n = rintf(ang * 0.15915494309189535f);
  float r = fmaf(-n, 6.28125f, ang);
  r = fmaf(-n, 1.9353071795864769e-3f, r);
  cs = __cosf(r); sn = __sinf(r);
}

struct EpiQ {
  const float *rstd, *gn, *gr, *rope; bf16_t* Q;
  DI void operator()(const f32x4 (&acc)[4][4], int r0, int c0, int fr, int fq) const {
    if (c0 >= 576) return;
    if (c0 < 384) {
      const int h = c0 >> 6;
#pragma unroll
      for (int m = 0; m < 4; ++m) {
        const int row = r0 + m * 16 + fr; const float rs = rsqrtf(rstd[row] * (1.f / 768.f) + EPSF);
        float ss = 0.f;
#pragma unroll
        for (int n = 0; n < 4; ++n)
#pragma unroll
          for (int j = 0; j < 4; ++j) { float v = acc[m][n][j] * rs; ss += v * v; }
        ss += __shfl_xor(ss, 16); ss += __shfl_xor(ss, 32);
        const float inv = rsqrtf(ss * (1.f / 64.f) + EPSF) * rs * QSCALE;
        const int b = row / TB, s = row % TB;
        bf16_t* dst = Q + ((size_t)(b * 6 + h) * TB + s) * 96;
#pragma unroll
        for (int n = 0; n < 4; ++n) {
          const int d = n * 16 + fq * 4; f32x4 g = *(const f32x4*)(gn + d);
          u32x2 v = {pk_bf16(acc[m][n][0] * inv * g[0], acc[m][n][1] * inv * g[1]), pk_bf16(acc[m][n][2] * inv * g[2], acc[m][n][3] * inv * g[3])};
          *(u32x2*)(dst + d) = v;
        }
      }
    } else {
#pragma unroll
      for (int m = 0; m < 4; ++m) {
        const int row = r0 + m * 16 + fr; const float rs = rsqrtf(rstd[row] * (1.f / 768.f) + EPSF);
        const int b = row / TB, s = row % TB; const bool lat = s >= NCTX; const int sp = s - NCTX;
#pragma unroll
        for (int hh = 0; hh < 2; ++hh) {
          const int h = ((c0 - 384) >> 5) + hh;
          float ss = 0.f;
#pragma unroll
          for (int nn = 0; nn < 2; ++nn)
#pragma unroll
            for (int j = 0; j < 4; ++j) { float v = acc[m][hh * 2 + nn][j] * rs; ss += v * v; }
          ss += __shfl_xor(ss, 16); ss += __shfl_xor(ss, 32);
          const float inv = rsqrtf(ss * (1.f / 32.f) + EPSF) * rs;
          bf16_t* dst = Q + ((size_t)(b * 6 + h) * TB + s) * 96 + 64;
#pragma unroll
          for (int nn = 0; nn < 2; ++nn) {
            const int d = nn * 16 + fq * 4; f32x4 g = *(const f32x4*)(gr + d);
            float o[4];
#pragma unroll
            for (int j = 0; j < 4; ++j) {
              float val = acc[m][hh * 2 + nn][j] * inv * g[j];
              float partner = __shfl_xor(val, 32);
              if (lat) {
                const float* rt = rope + ((nn == 0 ? (sp >> 6) : (sp & 63)) * 8 + ((fq * 4 + j) & 7)) * 2; const float cs = rt[0], sn = rt[1];
                val = fq < 2 ? val * cs - partner * sn : val * cs + partner * sn;
              }
              o[j] = val * QSCALE;
            }
            u32x2 v = {pk_bf16(o[0], o[1]), pk_bf16(o[2], o[3])};
            *(u32x2*)(dst + d) = v;
          }
        }
      }
    }
  }
};

struct EpiK {
  const float *rstd, *gk; bf16_t* Kt;
  DI void operator()(const f32x4 (&acc)[4][4], int r0, int c0, int fr, int fq) const {
    const int h = c0 >> 6;
#pragma unroll
    for (int m = 0; m < 4; ++m) {
      const int row = r0 + m * 16 + fr; const float rs = rsqrtf(rstd[row] * (1.f / 256.f) + EPSF);
      float ss = 0.f;
#pragma unroll
      for (int n = 0; n < 4; ++n)
#pragma unroll
        for (int j = 0; j < 4; ++j) { float v = acc[m][n][j] * rs; ss += v * v; }
      ss += __shfl_xor(ss, 16); ss += __shfl_xor(ss, 32);
      const float inv = rsqrtf(ss * (1.f / 64.f) + EPSF) * rs;
      const int b = row / TB, s = row % TB;
      bf16_t* dst = Kt + ((size_t)(b * 6 + h) * TB + s) * 96;
#pragma unroll
      for (int n = 0; n < 4; ++n) {
        const int d = n * 16 + fq * 4; f32x4 g = *(const f32x4*)(gk + d);
        u32x2 v = {pk_bf16(acc[m][n][0] * inv * g[0], acc[m][n][1] * inv * g[1]), pk_bf16(acc[m][n][2] * inv * g[2], acc[m][n][3] * inv * g[3])};
        *(u32x2*)(dst + d) = v;
      }
    }
  }
};

struct EpiV {
  const float* rstd; bf16_t* VT;
  DI void operator()(const f32x4 (&acc)[4][4], int r0, int c0, int fr, int fq) const {
#pragma unroll
    for (int m = 0; m < 4; ++m)
#pragma unroll
      for (int n = 0; n < 4; ++n) {
        const int row = r0 + m * 16 + fr, col = c0 + n * 16 + fq * 4;
        f32x4 rs = *(const f32x4*)(rstd + col);
#pragma unroll
        for (int j = 0; j < 4; ++j) rs[j] = rsqrtf(rs[j] * (1.f / 256.f) + EPSF);
        u32x2 v = {pk_bf16(acc[m][n][0] * rs[0], acc[m][n][1] * rs[1]), pk_bf16(acc[m][n][2] * rs[2], acc[m][n][3] * rs[3])};
        *(u32x2*)(VT + (size_t)row * T_TOK + col) = v;
      }
  }
};

struct EpiPost {
  const float *Y, *BON, *mu, *lnx_g, *lnx_b; const bf16_t* PA; bf16_t* YC;
  DI void operator()(const f32x4 (&acc)[4][4], int r0, int c0, int fr, int fq) const {
    const int h = c0 >> 6;
#pragma unroll
    for (int m = 0; m < 4; ++m) {
      const int row = r0 + m * 16 + fr; const int s = row % TB;
      const bool hasprev = (s != 0 && s != NCTX), hasnext = (s != NCTX - 1 && s != TB - 1);
      f32x4 y[4];
      float s1 = 0.f;
#pragma unroll
      for (int n = 0; n < 4; ++n) {
        const size_t o = (size_t)row * 384 + c0 + n * 16 + fq * 4;
        y[n] = *(const f32x4*)(Y + o) + *(const f32x4*)(Y + (size_t)T_TOK * 384 + o);
        s1 += y[n][0] + y[n][1] + y[n][2] + y[n][3];
      }
      s1 += __shfl_xor(s1, 16); s1 += __shfl_xor(s1, 32);
      const float mean = s1 * (1.f / 64.f);
      float s2 = 0.f;
#pragma unroll
      for (int n = 0; n < 4; ++n)
#pragma unroll
        for (int j = 0; j < 4; ++j) { float d = y[n][j] - mean; s2 += d * d; }
      s2 += __shfl_xor(s2, 16); s2 += __shfl_xor(s2, 32);
      const float rstdv = rsqrtf(s2 * (1.f / 64.f) + GN_EPS);
      const float bon = BON[(size_t)row * 6 + h] + BON[(size_t)T_TOK * 6 + (size_t)row * 6 + h];
#pragma unroll
      for (int n = 0; n < 4; ++n) {
        const int col = c0 + n * 16 + fq * 4;
        const bf16_t* pv = PA + (size_t)row * LDPA + 768 + col;
        float vc[4], vp[4] = {0.f, 0.f, 0.f, 0.f}, vn[4] = {0.f, 0.f, 0.f, 0.f};
        unpack4(*(const u32x2*)pv, vc);
        if (hasprev) unpack4(*(const u32x2*)(pv - LDPA), vp);
        if (hasnext) unpack4(*(const u32x2*)(pv + LDPA), vn);
        f32x4 m0 = *(const f32x4*)(mu + 768 + col), m1 = *(const f32x4*)(mu + LDPA + 768 + col);
        f32x4 lg = *(const f32x4*)(lnx_g + col), lb = *(const f32x4*)(lnx_b + col);
        float o[4];
#pragma unroll
        for (int j = 0; j < 4; ++j) {
          const float v = vc[j] + m0[j] * (vp[j] - vc[j]) + m1[j] * (vn[j] - vc[j]);
          o[j] = ((y[n][j] - mean) * rstdv * lg[j] + lb[j] + bon * v) * acc[m][n][j];
        }
        u32x2 w = {pk_bf16(o[0], o[1]), pk_bf16(o[2], o[3])};
        *(u32x2*)(YC + (size_t)row * DM + col) = w;
      }
    }
  }
};

struct EpiRes {
  const Params* p; int l; bool from_inputs; int gate_off;
  DI void operator()(const f32x4 (&acc)[4][4], int r0, int c0, int fr, int fq) const {
#pragma unroll
    for (int m = 0; m < 4; ++m) {
      const int row = r0 + m * 16 + fr; const int b = row / TB, s = row % TB;
      const float* src = xsrc_row(*p, from_inputs, b, s);
      float* dst = xdst_row(*p, b, s);
      const float* gate = p->MOD + (size_t)(l * 9 + (s < NCTX ? 8 : b)) * 6144 + gate_off;
#pragma unroll
      for (int n = 0; n < 4; ++n) {
        const int col = c0 + n * 16 + fq * 4;
        f32x4 g = *(const f32x4*)(gate + col), xv = *(const f32x4*)(src + col);
        *(f32x4*)(dst + col) = xv + g * acc[m][n];
      }
    }
  }
};

struct EpiFfnIn {
  bf16_t* ACT;
  DI void operator()(const f32x4 (&acc)[4][4], int r0, int c0, int fr, int fq) const {
    const int cb = (c0 >> 6) * 32;
#pragma unroll
    for (int m = 0; m < 4; ++m)
#pragma unroll
      for (int n = 0; n < 2; ++n) {
        float o[4];
#pragma unroll
        for (int j = 0; j < 4; ++j) { float g = acc[m][n][j]; o[j] = g / (1.f + __expf(-g)) * acc[m][n + 2][j]; }
        u32x2 w = {pk_bf16(o[0], o[1]), pk_bf16(o[2], o[3])};
        *(u32x2*)(ACT + (size_t)(r0 + m * 16 + fr) * 2816 + cb + n * 16 + fq * 4) = w;
      }
  }
};

DI void prep_token(const Params& p, int l, int row, int lane) {
  const int b = row / TB, s = row % TB;
  const bool hasprev = (s != 0 && s != NCTX), hasnext = (s != NCTX - 1 && s != TB - 1);
  const float mp = hasprev ? 1.f : 0.f, mn = hasnext ? 1.f : 0.f;
  const bf16_t* pa = p.PA + (size_t)row * LDPA;
  const bf16_t* pbc = p.PBC + (size_t)row * LDPBC;
  const int opa = hasprev ? -LDPA : 0, ona = hasnext ? LDPA : 0, opb = hasprev ? -LDPBC : 0, onb = hasnext ? LDPBC : 0;
  const int l32 = lane & 31, c8 = l32 * 8, colA = 1152 + c8;
  const u32x4 la_c = *(const u32x4*)(pa + colA), la_p = *(const u32x4*)(pa + opa + colA), la_n = *(const u32x4*)(pa + ona + colA);
  const u32x4 lq0 = *(const u32x4*)(pbc + lane * 8), lq1 = *(const u32x4*)(pbc + 512 + c8), lkv = *(const u32x4*)(pbc + 768 + c8);
  const u32x4 lrp = *(const u32x4*)(pbc + 1024 + (lane & 3) * 8);
  const u32x4 lbg = *(const u32x4*)(pbc + 1056 + c8), lcc = *(const u32x4*)(pbc + 1312 + c8), lhh = *(const u32x4*)(pbc + 1568 + c8);
  const u32x4 lcp = *(const u32x4*)(pbc + opb + 1312 + c8), lhp = *(const u32x4*)(pbc + opb + 1568 + c8);
  const u32x4 lcn = *(const u32x4*)(pbc + onb + 1312 + c8), lhn = *(const u32x4*)(pbc + onb + 1568 + c8);
  const float* mu = p.tshift_mu + (size_t)l * 2 * LDPA;
  {
    float c[8], pv[8], nx[8], o[8];
    unpack8(la_c, c); unpack8(la_p, pv); unpack8(la_n, nx);
    const f32x4 m0a = *(const f32x4*)(mu + colA), m0b = *(const f32x4*)(mu + colA + 4), m1a = *(const f32x4*)(mu + LDPA + colA), m1b = *(const f32x4*)(mu + LDPA + colA + 4);
#pragma unroll
    for (int j = 0; j < 8; ++j) {
      const float m0 = j < 4 ? m0a[j & 3] : m0b[j & 3], m1 = j < 4 ? m1a[j & 3] : m1b[j & 3];
      float t = c[j] + m0 * (pv[j] * mp - c[j]) + m1 * (nx[j] * mn - c[j]);
      if (l32 < 8) { float e = __expf(2.f * t); t = 1.f - 2.f * __builtin_amdgcn_rcpf(1.f + e); }
      else if (l32 >= 16) t = __builtin_amdgcn_rcpf(1.f + __expf(-t));
      o[j] = t;
    }
    u32x4 w = {pk_bf16(o[0], o[1]), pk_bf16(o[2], o[3]), pk_bf16(o[4], o[5]), pk_bf16(o[6], o[7])};
    if (lane < 8) *(u32x4*)(p.TW + (size_t)row * 64 + lane * 8) = w;
    else if (lane < 16) *(u32x4*)(p.TA + (size_t)row * 64 + (lane - 8) * 8) = w;
    else if (lane < 32) *(u32x4*)(p.TG + (size_t)row * 128 + (lane - 16) * 8) = w;
  }
  float f[8], ss = 0.f, s2 = 0.f, s3 = 0.f, fr_[8];
  unpack8(lq0, f);
#pragma unroll
  for (int j = 0; j < 8; ++j) ss += f[j] * f[j];
  unpack8(lq1, f);
  if (lane < 32) {
#pragma unroll
    for (int j = 0; j < 8; ++j) ss += f[j] * f[j];
  }
  unpack8(lkv, f);
  if (lane < 32) {
#pragma unroll
    for (int j = 0; j < 8; ++j) s2 += f[j] * f[j];
  }
  unpack8(lrp, fr_);
  if (lane < 4) {
#pragma unroll
    for (int j = 0; j < 8; ++j) s3 += fr_[j] * fr_[j];
  }
  s3 += __shfl_xor(s3, 1); s3 += __shfl_xor(s3, 2);
  {
    const float inv = rsqrtf(s3 * (1.f / 32.f) + EPSF);
    const float* g = p.k_rope_g + l * 32;
    const bool lat = s >= NCTX; const int sp = lat ? s - NCTX : 0;
    const float* rt = p.ROPE + ((lane & 2) ? (sp & 63) : (sp >> 6)) * 16;
    float o[8];
#pragma unroll
    for (int j = 0; j < 8; ++j) {
      float val = fr_[j] * inv * g[(lane & 3) * 8 + j];
      float partner = __shfl_xor(val, 1);
      if (lat) {
        const float cs = rt[2 * j], sn = rt[2 * j + 1];
        val = (lane & 1) == 0 ? val * cs - partner * sn : val * cs + partner * sn;
      }
      o[j] = val;
    }
    if (lane < 4) {
      u32x4 w = {pk_bf16(o[0], o[1]), pk_bf16(o[2], o[3]), pk_bf16(o[4], o[5]), pk_bf16(o[6], o[7])};
#pragma unroll
      for (int hh = 0; hh < 6; ++hh) *(u32x4*)(p.Kt + ((size_t)(b * 6 + hh) * TB + s) * 96 + 64 + lane * 8) = w;
    }
  }
  {
    float bg[8], cc[8], hh[8], cp[8], hp[8], cn[8], hn[8], o[8];
    unpack8(lbg, bg); unpack8(lcc, cc); unpack8(lhh, hh); unpack8(lcp, cp); unpack8(lhp, hp); unpack8(lcn, cn); unpack8(lhn, hn);
    const float* cw = p.conv_w + (size_t)l * 3 * 256;
#pragma unroll
    for (int j = 0; j < 8; ++j) o[j] = bg[j] * (cw[c8 + j] * cp[j] * hp[j] * mp + cw[256 + c8 + j] * cc[j] * hh[j] + cw[512 + c8 + j] * cn[j] * hn[j] * mn);
    u32x4 w = {pk_bf16(o[0], o[1]), pk_bf16(o[2], o[3]), pk_bf16(o[4], o[5]), pk_bf16(o[6], o[7])};
    if (lane < 32) *(u32x4*)(p.HY + (size_t)row * DM + 768 + c8) = w;
  }
}

#define MFMA32(a, b, c) __builtin_amdgcn_mfma_f32_32x32x16_bf16((a), (b), (c), 0, 0, 0)
DI bf16x8 pack8(const f32x16& x, int s) {
  u32x4 v = {pk_bf16(x[8 * s], x[8 * s + 1]), pk_bf16(x[8 * s + 2], x[8 * s + 3]), pk_bf16(x[8 * s + 4], x[8 * s + 5]), pk_bf16(x[8 * s + 6], x[8 * s + 7])};
  return __builtin_bit_cast(bf16x8, v);
}
constexpr int KROW = 208, VROW = 136, KBUF = 64 * KROW, VBUF = 64 * VROW;
DI void attn_task(const Params& p, int b, int h, int q0, int k0, int nk, char* lds) {
  const int tid = opaque_tid(), lane = tid & 63, wid = tid >> 6, r = lane & 31, hh = lane >> 5;
  const bf16_t* Qp = p.Q + ((size_t)(b * 6 + h) * TB + q0 + wid * 32 + r) * 96;
  const bf16_t* Kp = p.Kt + ((size_t)(b * 6 + h) * TB + k0) * 96;
  const bf16_t* Vp = p.VT + (size_t)(h * 64) * T_TOK + (size_t)b * TB + k0;
  bf16x8 qf[6];
#pragma unroll
  for (int ks = 0; ks < 6; ++ks) qf[ks] = *(const bf16x8*)(Qp + ks * 16 + hh * 8);
  int krow_[3], kch_[3];
#pragma unroll
  for (int i = 0; i < 3; ++i) { int id = tid + i * 256; krow_[i] = id / 12; kch_[i] = id % 12; }
  const int vd0 = tid >> 3, vch = tid & 7;
  u32x4 kreg[3], vreg[2];
  auto load_regs = [&](int kt) {
#pragma unroll
    for (int i = 0; i < 3; ++i) kreg[i] = *(const u32x4*)(Kp + (size_t)(kt * 64 + krow_[i]) * 96 + kch_[i] * 8);
#pragma unroll
    for (int i = 0; i < 2; ++i) vreg[i] = *(const u32x4*)(Vp + (size_t)(vd0 + 32 * i) * T_TOK + kt * 64 + vch * 8);
  };
  auto write_lds = [&](int buf) {
    char* kb = lds + buf * (KBUF + VBUF);
    char* vb = kb + KBUF;
#pragma unroll
    for (int i = 0; i < 3; ++i) *(u32x4*)(kb + krow_[i] * KROW + kch_[i] * 16) = kreg[i];
#pragma unroll
    for (int i = 0; i < 2; ++i) {
      char* d = vb + (vd0 + 32 * i) * VROW + vch * 16;
      *(u32x2*)d = (u32x2){vreg[i][0], vreg[i][1]};
      *(u32x2*)(d + 8) = (u32x2){vreg[i][2], vreg[i][3]};
    }
  };
  f32x16 o[2];
#pragma unroll
  for (int i = 0; i < 16; ++i) { o[0][i] = 0.f; o[1][i] = 0.f; }
  float m_run = -1e30f, l_run = 0.f;
  const int NT = nk >> 6;
  __syncthreads();
  load_regs(0);
  write_lds(0);
  for (int kt = 0; kt < NT; ++kt) {
    if (kt + 1 < NT) load_regs(kt + 1);
    __syncthreads();
    const char* kb = lds + (kt & 1) * (KBUF + VBUF);
    const char* vb = kb + KBUF;
    f32x16 st[2];
#pragma unroll
    for (int kbk = 0; kbk < 2; ++kbk) {
#pragma unroll
      for (int i = 0; i < 16; ++i) st[kbk][i] = 0.f;
#pragma unroll
      for (int ks = 0; ks < 6; ++ks) {
        bf16x8 kf = *(const bf16x8*)(kb + (kbk * 32 + r) * KROW + ks * 32 + hh * 16);
        st[kbk] = MFMA32(kf, qf[ks], st[kbk]);
      }
    }
    float mx = st[0][0];
#pragma unroll
    for (int i = 0; i < 16; ++i) { mx = fmaxf(mx, st[0][i]); mx = fmaxf(mx, st[1][i]); }
    mx = fmaxf(mx, __shfl_xor(mx, 32));
    const float m_new = fmaxf(m_run, mx);
    const float alpha = __builtin_amdgcn_exp2f(m_run - m_new);
    m_run = m_new;
    float psum = 0.f;
#pragma unroll
    for (int kbk = 0; kbk < 2; ++kbk)
#pragma unroll
      for (int i = 0; i < 16; ++i) { float e = __builtin_amdgcn_exp2f(st[kbk][i] - m_new); st[kbk][i] = e; psum += e; }
    psum += __shfl_xor(psum, 32);
    l_run = l_run * alpha + psum;
#pragma unroll
    for (int i = 0; i < 16; ++i) { o[0][i] *= alpha; o[1][i] *= alpha; }
#pragma unroll
    for (int ksv = 0; ksv < 4; ++ksv) {
      const bf16x8 pf = pack8(st[ksv >> 1], ksv & 1);
#pragma unroll
      for (int db = 0; db < 2; ++db) {
        const char* va = vb + (db * 32 + r) * VROW + (ksv * 16 + 4 * hh) * 2;
        s16x4 lo = *(const s16x4*)va, hi = *(const s16x4*)(va + 16);
        bf16x8 vf = __builtin_shufflevector(lo, hi, 0, 1, 2, 3, 4, 5, 6, 7);
        o[db] = MFMA32(vf, pf, o[db]);
      }
    }
    if (kt + 1 < NT) write_lds((kt + 1) & 1);
  }
  const float invl = 1.f / l_run;
  bf16_t* dst = p.HY + (size_t)(b * TB + q0 + wid * 32 + r) * DM + 384 + h * 64;
#pragma unroll
  for (int db = 0; db < 2; ++db)
#pragma unroll
    for (int g = 0; g < 4; ++g) {
      u32x2 w = {pk_bf16(o[db][4 * g] * invl, o[db][4 * g + 1] * invl), pk_bf16(o[db][4 * g + 2] * invl, o[db][4 * g + 3] * invl)};
      *(u32x2*)(dst + db * 32 + 8 * g + 4 * hh) = w;
    }
}

enum { VW = 0, VKK = 1, VB = 2, VKD = 3, VR = 4, VV = 5 };
DI void scan_task(const Params& p, int l, int b, int h, int dir, int half, char* lds) {
  float* cb = (float*)lds;
  float* tk = cb + 6 * 1024;
  float* ybuf = tk + 1024;
  const int tid = opaque_tid(), lane = tid & 63, wid = tid >> 6;
  const int st_p = tid >> 4, c4 = tid & 15;
  const int fr = lane & 15, fq = lane >> 4;
  const int rp = lane >> 4, g = lane & 15;
  const int hc = h * 64;
  bf16x8 bw[2], ba[2];
  {
    const bf16_t* wd = p.Wdecay + ((size_t)dir * 384 + hc + wid * 16 + fr) * 64;
    const bf16_t* wi = p.Wicl + ((size_t)dir * 384 + hc + wid * 16 + fr) * 64;
#pragma unroll
    for (int ks = 0; ks < 2; ++ks) { bw[ks] = *(const bf16x8*)(wd + ks * 32 + fq * 8); ba[ks] = *(const bf16x8*)(wi + ks * 32 + fq * 8); }
  }
  f32x4 mu0[3], mu1[3];
  const float* mu = p.tshift_mu + (size_t)l * 2 * LDPA;
#pragma unroll
  for (int sec = 0; sec < 3; ++sec) { mu0[sec] = *(const f32x4*)(mu + sec * 384 + hc + c4 * 4); mu1[sec] = *(const f32x4*)(mu + LDPA + sec * 384 + hc + c4 * 4); }
  const f32x4 kkg = *(const f32x4*)(p.k_k + l * 384 + hc + c4 * 4);
  const f32x4 rkg = *(const f32x4*)(p.r_k + l * 384 + hc + c4 * 4);
  const int colB = wid * 16 + fq * 4;
  const f32x4 w0 = *(const f32x4*)(p.decay_w0 + (size_t)(l * 2 + dir) * 384 + hc + colB);
  const f32x4 a0 = *(const f32x4*)(p.icl_a0 + (size_t)(l * 2 + dir) * 384 + hc + colB);
  const f32x4 kag = *(const f32x4*)(p.k_a + l * 384 + hc + colB);

  u32x2 ld[3][3];
  float mprev = 0.f, mnext = 0.f;
  bf16x8 aw[2], aa[2];
  auto chunk_lo = [&](int c) -> int { return dir == 0 ? 16 * c : (c < 16 ? 240 - 16 * c : 2544 - 16 * c); };
  auto issue_loads = [&](int c) {
    const int slo = chunk_lo(c);
    const int s = slo + st_p;
    const bool hasprev = (s != 0 && s != NCTX), hasnext = (s != NCTX - 1 && s != TB - 1);
    const bf16_t* pa = p.PA + (size_t)(b * TB + s) * LDPA + hc + c4 * 4;
    const int op = hasprev ? -LDPA : 0, on = hasnext ? LDPA : 0;
    mprev = hasprev ? 1.f : 0.f; mnext = hasnext ? 1.f : 0.f;
#pragma unroll
    for (int sec = 0; sec < 3; ++sec) {
      ld[sec][1] = *(const u32x2*)(pa + sec * 384);
      ld[sec][0] = *(const u32x2*)(pa + sec * 384 + op);
      ld[sec][2] = *(const u32x2*)(pa + sec * 384 + on);
    }
    const size_t trow = (size_t)(b * TB + slo + fr) * 64;
#pragma unroll
    for (int ks = 0; ks < 2; ++ks) { aw[ks] = *(const bf16x8*)(p.TW + trow + ks * 32 + fq * 8); aa[ks] = *(const bf16x8*)(p.TA + trow + ks * 32 + fq * 8); }
  };
  auto produce = [&](int c) {
    const int slo = chunk_lo(c);
    float ts[3][4];
#pragma unroll
    for (int sec = 0; sec < 3; ++sec) {
      float pc[4], pp[4], pn[4];
      unpack4(ld[sec][1], pc); unpack4(ld[sec][0], pp); unpack4(ld[sec][2], pn);
#pragma unroll
      for (int j = 0; j < 4; ++j) ts[sec][j] = pc[j] + mu0[sec][j] * (pp[j] * mprev - pc[j]) + mu1[sec][j] * (pn[j] * mnext - pc[j]);
    }
    *(f32x4*)(cb + VR * 1024 + st_p * 64 + c4 * 4) = (f32x4){ts[0][0], ts[0][1], ts[0][2], ts[0][3]};
    *(f32x4*)(cb + VV * 1024 + st_p * 64 + c4 * 4) = (f32x4){ts[2][0], ts[2][1], ts[2][2], ts[2][3]};
    *(f32x4*)(tk + st_p * 64 + c4 * 4) = (f32x4){ts[1][0], ts[1][1], ts[1][2], ts[1][3]};
    float kx[4], ss = 0.f;
#pragma unroll
    for (int j = 0; j < 4; ++j) { kx[j] = ts[1][j] * kkg[j]; ss += kx[j] * kx[j]; }
    ss = red16(ss);
    const float inv = rsqrtf(ss + 1e-12f);
    *(f32x4*)(cb + VKK * 1024 + st_p * 64 + c4 * 4) = (f32x4){kx[0] * inv, kx[1] * inv, kx[2] * inv, kx[3] * inv};
    __syncthreads();
    f32x4 dw = {0.f, 0.f, 0.f, 0.f}, da = {0.f, 0.f, 0.f, 0.f};
#pragma unroll
    for (int ks = 0; ks < 2; ++ks) {
      dw = __builtin_amdgcn_mfma_f32_16x16x32_bf16(bw[ks], aw[ks], dw, 0, 0, 0);
      da = __builtin_amdgcn_mfma_f32_16x16x32_bf16(ba[ks], aa[ks], da, 0, 0, 0);
    }
    {
      const f32x4 kv = *(const f32x4*)(tk + fr * 64 + colB);
      const f32x4 kkv = *(const f32x4*)(cb + VKK * 1024 + fr * 64 + colB);
      f32x4 wv, kdv, bv;
#pragma unroll
      for (int j = 0; j < 4; ++j) {
        wv[j] = __expf(-LOG_DECAY_SCALE * sigmoidf_(w0[j] + dw[j]));
        const float a = sigmoidf_(a0[j] + da[j]);
        kdv[j] = kv[j] * (1.f + (a - 1.f) * kag[j]);
        bv[j] = kkv[j] * a;
      }
      *(f32x4*)(cb + VW * 1024 + fr * 64 + colB) = wv;
      *(f32x4*)(cb + VKD * 1024 + fr * 64 + colB) = kdv;
      *(f32x4*)(cb + VB * 1024 + fr * 64 + colB) = bv;
    }
    __syncthreads();
    {
      const f32x4 rv = *(const f32x4*)(cb + VR * 1024 + st_p * 64 + c4 * 4);
      const f32x4 kdv = *(const f32x4*)(cb + VKD * 1024 + st_p * 64 + c4 * 4);
      float bs = rv[0] * kdv[0] * rkg[0] + rv[1] * kdv[1] * rkg[1] + rv[2] * kdv[2] * rkg[2] + rv[3] * kdv[3] * rkg[3];
      bs = red16(bs);
      if (c4 == 0 && half == 0) p.BON[(size_t)dir * T_TOK * 6 + (size_t)(b * TB + slo + st_p) * 6 + h] = bs;
    }
  };

  f32x2 S0[2], S1[2];
#pragma unroll
  for (int j = 0; j < 2; ++j) { S0[j] = (f32x2){0.f, 0.f}; S1[j] = (f32x2){0.f, 0.f}; }
  __syncthreads();
  issue_loads(0);
  produce(0);
  __syncthreads();
  const int NCH = TB / 16;
  const int rowl = half * 32 + wid * 8 + rp * 2;
  const int inc = dir ? -64 : 64;
  for (int c = 0; c < NCH; ++c) {
    if (c + 1 < NCH) issue_loads(c + 1);
    {
      const float* ps = cb + (dir ? 15 * 64 : 0) + g * 4;
      const float* pv = cb + VV * 1024 + (dir ? 15 * 64 : 0) + rowl;
      float* py = ybuf + (dir ? 15 * 512 : 0) + ((wid * 4 + rp) * 16 + g) * 2;
      f32x4 cw = *(const f32x4*)(ps + VW * 1024), ckk = *(const f32x4*)(ps + VKK * 1024), cbb = *(const f32x4*)(ps + VB * 1024),
            ckd = *(const f32x4*)(ps + VKD * 1024), crr = *(const f32x4*)(ps + VR * 1024);
      f32x2 cvv = *(const f32x2*)pv;
#pragma unroll
      for (int ii = 0; ii < 16; ++ii) {
        f32x4 nw = cw, nkk = ckk, nbb = cbb, nkd = ckd, nrr = crr; f32x2 nvv = cvv;
        if (ii < 15) {
          ps += inc; pv += inc;
          nw = *(const f32x4*)(ps + VW * 1024); nkk = *(const f32x4*)(ps + VKK * 1024); nbb = *(const f32x4*)(ps + VB * 1024);
          nkd = *(const f32x4*)(ps + VKD * 1024); nrr = *(const f32x4*)(ps + VR * 1024); nvv = *(const f32x2*)pv;
        }
        __builtin_amdgcn_sched_barrier(0x7);
        const f32x2 kk0 = {ckk[0], ckk[1]}, kk1 = {ckk[2], ckk[3]}, w0 = {cw[0], cw[1]}, w1 = {cw[2], cw[3]};
        const f32x2 b0 = {cbb[0], cbb[1]}, b1 = {cbb[2], cbb[3]}, kd0 = {ckd[0], ckd[1]}, kd1 = {ckd[2], ckd[3]};
        const f32x2 r0 = {crr[0], crr[1]}, r1 = {crr[2], crr[3]};
        const f32x2 p0 = S0[0] * kk0 + S0[1] * kk1, p1 = S1[0] * kk0 + S1[1] * kk1;
        const f32x2 u00 = S0[0] * w0 + kd0 * cvv[0], u01 = S0[1] * w1 + kd1 * cvv[0];
        const f32x2 u10 = S1[0] * w0 + kd0 * cvv[1], u11 = S1[1] * w1 + kd1 * cvv[1];
        const float q0 = red16(p0[0] + p0[1]), q1 = red16(p1[0] + p1[1]);
        S0[0] = u00 - b0 * q0; S0[1] = u01 - b1 * q0;
        S1[0] = u10 - b0 * q1; S1[1] = u11 - b1 * q1;
        const f32x2 y0 = S0[0] * r0 + S0[1] * r1, y1 = S1[0] * r0 + S1[1] * r1;
        *(f32x2*)py = (f32x2){y0[0] + y0[1], y1[0] + y1[1]};
        py += dir ? -512 : 512;
        cw = nw; ckk = nkk; cbb = nbb; ckd = nkd; crr = nrr; cvv = nvv;
      }
    }
    __syncthreads();
    {
      const int slo = chunk_lo(c);
      const float* yp = ybuf + (st_p * 16 + c4) * 32;
      f32x4 a = *(const f32x4*)yp;
#pragma unroll
      for (int i = 1; i < 8; ++i) a += *(const f32x4*)(yp + 4 * i);
      *(f32x2*)(p.Y + (size_t)dir * T_TOK * 384 + (size_t)(b * TB + slo + st_p) * 384 + hc + half * 32 + c4 * 2) = (f32x2){a[0] + a[2], a[1] + a[3]};
    }
    if (c + 1 < NCH) produce(c + 1);
    __syncthreads();
  }
}

DI int lat_tile(int i) { return (i >> 4) * 18 + 2 + (i & 15); }
DI bool xcd_tile(int bid, int G, int i, int MT, int NT, int& tm, int& tn) {
  if ((G & 7) || (MT & 7)) { const int t = bid + i * G; if (t >= MT * NT) return false; tm = t / NT; tn = t % NT; return true; }
  const int nbx = G >> 3, x = bid & 7, j = bid >> 3, MS = MT >> 3;
  const int q = j + nbx * i;
  if (q >= MS * NT) return false;
  const int full = NT >> 3, wl = NT & 7;
  int nb = q / (MS * 8), m, ni;
  if (nb < full) { const int rem = q - nb * MS * 8; m = rem >> 3; ni = rem & 7; }
  else { const int rem = q - full * MS * 8; nb = full; m = rem / wl; ni = rem % wl; }
  tm = x * MS + m; tn = nb * 8 + ni;
  return true;
}

template <int KSEL> DI void run_phase(const Params& p, int ph, char* lds) {
  const int bid = blockIdx.x, G = gridDim.x, tid = opaque_tid(), lane = tid & 63, wid = tid >> 6;
  if (ph == 0) {
    if (KSEL >= 0 && KSEL != 10) return;
    for (int t = bid; t < 384 + NCONV_W1 + 1; t += G) {
      if (t < 384) adaln_task(p, t, lds);
      else if (t < 384 + NCONV_W1) conv_w1_task(p, 0, t - 384, lds);
      else { for (int e = tid; e < 512; e += 256) { float cs, sn; rope_angle(e >> 3, e & 7, cs, sn); p.ROPE[2 * e] = cs; p.ROPE[2 * e + 1] = sn; } }
    }
    return;
  }
  if (KSEL == 10) return;
  const int l = (ph - 1) / 9, kq = (ph - 1) % 9, k = kq < 2 ? kq : kq + 1;
  const bool last = (l == 1);
  const int lb = ((G & 7) == 0) ? (bid & 7) * (G >> 3) + (bid >> 3) : bid;
  if (KSEL >= 0 && KSEL != 10 && k != (KSEL == 11 ? 4 : KSEL)) return;
  switch (k) {
    case 0:
      for (int i = bid * 256 + tid; i < 2 * T_TOK; i += G * 256) p.RSTD[i] = 0.f;
      modnorm_rows(p, l, 0, l == 0, false, bid * 4 + wid, G * 4, lane);
      break;
    case 1: {
      EpiP e{p.PA, p.PBC, p.RSTD};
      for (int i = 0, tm, tn; xcd_tile(bid, G, i, 144, 26, tm, tn); ++i) gemm_tile(p.HY, DM, p.Win, DM, DM, tm * 128, tn * 128, lds, e);
    } break;
    case 3: {
      const int nq = last ? 128 * 5 : 144 * 5;
      EpiQ eq{p.RSTD, p.q_nope_g + l * 64, p.q_rope_g + l * 32, p.ROPE, p.Q};
      EpiK ek{p.RSTD + T_TOK, p.k_nope_g + l * 64, p.Kt};
      EpiV ev{p.RSTD + T_TOK, p.VT};
      if (KSEL >= 0) {
        for (int t = bid; t < nq + 432 + 432 + T_TOK / 4; t += G) {
          if (t >= nq + 864) { prep_token(p, l, (t - nq - 864) * 4 + wid, lane); continue; }
          if (t < nq) { int i = t / 5; int tm = last ? lat_tile(i) : i; gemm_tile(p.PBC, LDPBC, p.Wuq, 768, 768, tm * 128, (t % 5) * 128, lds, eq); }
          else if (t < nq + 432) { int u = t - nq; gemm_tile(p.PBC + 768, LDPBC, p.WukvK, 256, 256, (u / 3) * 128, (u % 3) * 128, lds, ek); }
          else { int u = t - nq - 432; gemm_tile(p.WvT, 256, p.PBC + 768, LDPBC, 256, (u % 3) * 128, (u / 3) * 128, lds, ev); }
        }
      } else {
        for (int t = bid; t < T_TOK / 4; t += G) prep_token(p, l, t * 4 + wid, lane);
        volatile LAS unsigned* slot = (volatile LAS unsigned*)(lds + 65536 + 8);
        unsigned* qg = p.BAR + 3456   + 64 * l + 16;
        for (;;) {
          __syncthreads();
          if (tid == 0) *slot = __hip_atomic_fetch_add(qg, 1u, __ATOMIC_RELAXED, __HIP_MEMORY_SCOPE_AGENT);
          __syncthreads();
          const int t = (int)*slot;
          if (t >= nq + 864) break;
          if (t < nq) { int i = t / 5; int tm = last ? lat_tile(i) : i; gemm_tile(p.PBC, LDPBC, p.Wuq, 768, 768, tm * 128, (t % 5) * 128, lds, eq); }
          else if (t < nq + 432) { int u = t - nq; gemm_tile(p.PBC + 768, LDPBC, p.WukvK, 256, 256, (u / 3) * 128, (u % 3) * 128, lds, ek); }
          else { int u = t - nq - 432; gemm_tile(p.WvT, 256, p.PBC + 768, LDPBC, 256, (u % 3) * 128, (u / 3) * 128, lds, ev); }
        }
      }
    } break;
    case 4: {
      const int natt = 768 + (last ? 0 : 96);
      if (KSEL != 11) { if (bid < 192) { scan_task(p, l, bid / 24, (bid % 24) >> 2, (bid >> 1) & 1, bid & 1, lds); break; } if (KSEL == 4) break; }
      const int aoff = KSEL == 11 ? 0 : 192;
      if (KSEL == 11) {
        for (int t = bid; t < natt + NCONV_FF; t += G) {
          if (t < 768) { int bh = t >> 4, qb = t & 15; attn_task(p, bh / 6, bh % 6, NCTX + qb * 128, 0, TB, lds); }
          else if (t < natt) { int u = t - 768; int bh = u >> 1, qb = u & 1; attn_task(p, bh / 6, bh % 6, qb * 128, 0, NCTX, lds); }
          else conv_ff_task(p, l, t - natt, lds);
        }
      } else {
        volatile LAS unsigned* slot = (volatile LAS unsigned*)(lds + 65536 + 8);
        for (;;) {
          __syncthreads();
          if (tid == 0) *slot = __hip_atomic_fetch_add(p.BAR + 3456   + 64 * l, 1u, __ATOMIC_RELAXED, __HIP_MEMORY_SCOPE_AGENT);
          __syncthreads();
          const int t = (int)*slot;
          if (t >= natt + NCONV_FF) break;
          if (t < 768) { int bh = t >> 4, qb = t & 15; attn_task(p, bh / 6, bh % 6, NCTX + qb * 128, 0, TB, lds); }
          else if (t < natt) { int u = t - 768; int bh = u >> 1, qb = u & 1; attn_task(p, bh / 6, bh % 6, qb * 128, 0, NCTX, lds); }
          else conv_ff_task(p, l, t - natt, lds);
        }
      }
    } break;
    case 5: {
      EpiPost e{p.Y, p.BON, p.tshift_mu + (size_t)l * 2 * LDPA, p.lnx_g + l * 384, p.lnx_b + l * 384, p.PA, p.HY};
      const int nm = last ? 128 : 144;
      for (int t = bid; t < nm * 3; t += G) { int i = t / 3; int tm = last ? lat_tile(i) : i; gemm_tile(p.TG, 128, p.Wgate, 128, 128, tm * 128, (t % 3) * 128, lds, e); }
    } break;
    case 6: {
      EpiRes e{&p, l, l == 0, 2 * 1024};
      const int nm = last ? 128 : 144;
      for (int i = 0, tm, tn; xcd_tile(bid, G, i, nm, 8, tm, tn); ++i) gemm_tile(p.HY, DM, p.Wout, DM, DM, (last ? lat_tile(tm) : tm) * 128, tn * 128, lds, e);
    } break;
    case 7:
      modnorm_rows(p, l, 1, false, last, bid * 4 + wid, G * 4, lane);
      break;
    case 8: {
      EpiFfnIn e{p.ACT};
      const int nm = last ? 128 : 144;
      const int nconv = last ? 0 : NCONV_W1;
      for (int i = 0, tm, tn; xcd_tile(bid, G, i, nm, 44, tm, tn); ++i) gemm_tile(p.HY, DM, p.Wffi, DM, DM, (last ? lat_tile(tm) : tm) * 128, tn * 128, lds, e);
      for (int t = bid; t < nconv; t += G) conv_w1_task(p, 1, t, lds);
    } break;
    case 9: {
      EpiRes e{&p, l, false, 5 * 1024};
      const int nm = last ? 128 : 144;
      for (int i = 0, tm, tn; xcd_tile(bid, G, i, nm, 8, tm, tn); ++i) gemm_tile(p.ACT, 2816, p.Wffo, 2816, 2816, (last ? lat_tile(tm) : tm) * 128, tn * 128, lds, e);
    } break;
  }
}


#define XB_TMO      128
#define XB_XCNT(j)  (256  + 64 * (j))
#define XB_XSUB(j)  (1280 + 64 * (j))
#define XB_XGEN(j)  (2304 + 64 * (j))
#define XB_TOP      3328
#define XB_TOPGEN   3392
#define XCD_BAR_WORDS 3456
#define XB_SPIN_CAP (1u << 20)
DI unsigned xb_ld(unsigned* p) { return __hip_atomic_load(p, __ATOMIC_RELAXED, __HIP_MEMORY_SCOPE_AGENT); }
DI unsigned xb_add(unsigned* p, unsigned v) { return __hip_atomic_fetch_add(p, v, __ATOMIC_RELAXED, __HIP_MEMORY_SCOPE_AGENT); }
DI unsigned xb_xcc_id() { return (unsigned)__builtin_amdgcn_s_getreg((3 << 11) | 20) & 0xFu; }
#define XB_SPIN(cond, bar) do { unsigned _sp = 0; while (cond) { __builtin_amdgcn_s_sleep(1); \
    if ((++_sp & 255u) == 0u) { if (xb_ld(&(bar)[XB_TMO])) break; if (_sp > XB_SPIN_CAP) { atomicAdd(&(bar)[XB_TMO], 1u); break; } } } } while (0)
struct XcdBarrier { unsigned* bar; unsigned x; volatile LAS unsigned* st; };
DI XcdBarrier xcd_barrier_post(unsigned* bar, volatile LAS unsigned* st) {
  XcdBarrier b; b.bar = bar; b.x = xb_xcc_id(); b.st = st;
  if (threadIdx.x == 0) (void)xb_add(&bar[XB_XCNT(b.x)], 1u);
  return b;
}
DI void xcd_barrier_complete(unsigned* bar, unsigned x, unsigned& nloc, unsigned& nx) {
  const unsigned G = gridDim.x * gridDim.y * gridDim.z;
  unsigned sum, cnt, mine, sp = 0u;
  for (;;) {
    sum = 0u; cnt = 0u; mine = 0u;
#pragma unroll
    for (unsigned j = 0; j < 16; ++j) { const unsigned c = xb_ld(&bar[XB_XCNT(j)]); sum += c; cnt += (c > 0u) ? 1u : 0u; mine = (j == x) ? c : mine; }
    if (sum == G) break;
    __builtin_amdgcn_s_sleep(1);
    if ((++sp & 255u) == 0u) { if (xb_ld(&bar[XB_TMO])) break; if (sp > XB_SPIN_CAP) { atomicAdd(&bar[XB_TMO], 1u); break; } }
  }
  nloc = mine > 0u ? mine : 1u; nx = cnt > 0u ? cnt : 1u;
}
DI void xcd_barrier(const XcdBarrier& b) {
  asm volatile("s_waitcnt vmcnt(0)" ::: "memory");
  __syncthreads();
  if (threadIdx.x == 0) {
    unsigned* bar = b.bar;
    __builtin_amdgcn_s_waitcnt(0);
    unsigned nloc = b.st[0], nx = b.st[1];
    if (nloc == 0u) { xcd_barrier_complete(bar, b.x, nloc, nx); b.st[0] = nloc; b.st[1] = nx; }
    const unsigned old = xb_add(&bar[XB_XSUB(b.x)], 1u);
    const unsigned gen = old / nloc;
    if (old + 1u == (gen + 1u) * nloc) {
      __builtin_amdgcn_fence(__ATOMIC_RELEASE, "agent");
      asm volatile("s_waitcnt vmcnt(0)" ::: "memory");
      const unsigned og = xb_add(&bar[XB_TOP], 1u);
      const unsigned tg = og / nx;
      if (og + 1u == (tg + 1u) * nx) xb_add(&bar[XB_TOPGEN], 1u);
      else XB_SPIN(xb_ld(&bar[XB_TOPGEN]) == tg, bar);
      __builtin_amdgcn_fence(__ATOMIC_ACQUIRE, "agent");
      xb_add(&bar[XB_XGEN(b.x)], 1u);
      asm volatile("s_waitcnt vmcnt(0)" ::: "memory");
    } else {
      XB_SPIN(xb_ld(&bar[XB_XGEN(b.x)]) == gen, bar);
      __builtin_amdgcn_fence(__ATOMIC_ACQUIRE, "agent");
      asm volatile("s_waitcnt vmcnt(0)" ::: "memory");
    }
  }
  __syncthreads();
}

constexpr int NPHASE = 19;
#if !MULTI_LAUNCH
__global__ void __launch_bounds__(256, 2) mega(Params p, int ph_lo, int ph_hi) {
  __shared__ __attribute__((aligned(16))) char lds[65536 + 16];
  cg::grid_group grid = cg::this_grid();
  volatile LAS unsigned* st = (volatile LAS unsigned*)(lds + 65536);
  if (threadIdx.x == 0) { st[0] = 0u; st[1] = 0u; }
  __syncthreads();
  XcdBarrier xb = xcd_barrier_post(p.BAR, st);
  for (int ph = ph_lo; ph < ph_hi; ++ph) {
    if (ph > ph_lo) xcd_barrier(xb);
    run_phase<-1>(p, ph, lds);
  }
  if (ph_hi > NPHASE) grid.sync();
}
#endif
template <int KSEL> __global__ void __launch_bounds__(256, 2) phase_k(Params p, int ph) {
  __shared__ __attribute__((aligned(16))) char lds[65536];
  run_phase<KSEL>(p, ph, lds);
}

extern "C" void kernel_launch(void* const* d_in, const int* in_sizes, int n_in, void* d_out, int out_size, void* d_ws, size_t ws_size, hipStream_t stream) {
  static int grid_blocks = 0;
  if (!grid_blocks) {
    int dev = 0, cus = 0, per_cu = 0;
    (void)hipGetDevice(&dev);
    (void)hipDeviceGetAttribute(&cus, hipDeviceAttributeMultiprocessorCount, dev);
    #if MULTI_LAUNCH
    per_cu = 2;
#else
    (void)hipOccupancyMaxActiveBlocksPerMultiprocessor(&per_cu, mega, 256, 0);
#endif
    if (per_cu > 2) per_cu = 2;
    if (per_cu < 1) per_cu = 1;
    grid_blocks = cus * per_cu;
  }
  Params p{};
  const float** pin = (const float**)&p.x;
  for (int i = 0; i < 32; ++i) pin[i] = (const float*)d_in[i];
  p.out = (float*)d_out;
  char* w = (char*)d_ws;
  size_t off = 0;
  auto take = [&](size_t bytes) { char* r = w + off; off += (bytes + 255) & ~(size_t)255; return r; };
  p.BAR = (unsigned*)take((XCD_BAR_WORDS + 128) * 4);
  p.MOD = (float*)take(2 * 9 * 6144 * 4);
  p.ROPE = (float*)take(64 * 8 * 2 * 4);
  p.RSTD = (float*)take(2 * (size_t)T_TOK * 4);
  p.BON = (float*)take(2 * (size_t)T_TOK * 6 * 4);
  p.XCTX = (float*)take((size_t)8 * NCTX * DM * 4);
  p.Win = (bf16_t*)take((size_t)3328 * 1024 * 2);
  p.Wuq = (bf16_t*)take((size_t)640 * 768 * 2);
  p.WukvK = (bf16_t*)take((size_t)384 * 256 * 2);
  p.WvT = (bf16_t*)take((size_t)384 * 256 * 2);
  p.Wgate = (bf16_t*)take((size_t)384 * 128 * 2);
  p.Wdecay = (bf16_t*)take((size_t)2 * 384 * 64 * 2);
  p.Wicl = (bf16_t*)take((size_t)2 * 384 * 64 * 2);
  p.Wout = (bf16_t*)take((size_t)1024 * 1024 * 2);
  p.HY = (bf16_t*)take((size_t)T_TOK * DM * 2);
  p.TW = (bf16_t*)take((size_t)T_TOK * 64 * 2);
  p.TA = (bf16_t*)take((size_t)T_TOK * 64 * 2);
  p.TG = (bf16_t*)take((size_t)T_TOK * 128 * 2);
  char* qkv = take((size_t)T_TOK * 576 * 2 * 2 + (size_t)384 * T_TOK * 2);
  p.Q = (bf16_t*)qkv;
  p.Kt = (bf16_t*)(qkv + (size_t)T_TOK * 576 * 2);
  p.VT = (bf16_t*)(qkv + (size_t)T_TOK * 576 * 2 * 2);
  p.Wffi = (bf16_t*)take((size_t)5632 * 1024 * 2);
  p.Wffo = (bf16_t*)take((size_t)2816 * 1024 * 2);
  char* pr = take((size_t)T_TOK * (LDPA + LDPBC) * 2);
  p.PA = (bf16_t*)pr;
  p.PBC = (bf16_t*)(pr + (size_t)T_TOK * LDPA * 2);
  p.Y = (float*)p.PBC;
  p.ACT = (bf16_t*)pr;
  if (off > ws_size) { fprintf(stderr, "workspace too small: need %zu have %zu\n", off, ws_size); }
#if MULTI_LAUNCH
  hipLaunchKernelGGL(phase_k<10>, dim3(grid_blocks), dim3(256), 0, stream, p, 0);
  for (int l = 0; l < 2; ++l) {
    const int b0 = 1 + 10 * l;
    hipLaunchKernelGGL(phase_k<0>, dim3(grid_blocks), dim3(256), 0, stream, p, b0 + 0);
    hipLaunchKernelGGL(phase_k<1>, dim3(grid_blocks), dim3(256), 0, stream, p, b0 + 1);
    hipLaunchKernelGGL(phase_k<2>, dim3(grid_blocks), dim3(256), 0, stream, p, b0 + 2);
    hipLaunchKernelGGL(phase_k<3>, dim3(grid_blocks), dim3(256), 0, stream, p, b0 + 3);
    hipLaunchKernelGGL(phase_k<4>, dim3(192), dim3(256), 0, stream, p, b0 + 4);
    hipLaunchKernelGGL(phase_k<11>, dim3(grid_blocks), dim3(256), 0, stream, p, b0 + 4);
    hipLaunchKernelGGL(phase_k<5>, dim3(grid_blocks), dim3(256), 0, stream, p, b0 + 5);
    hipLaunchKernelGGL(phase_k<6>, dim3(grid_blocks), dim3(256), 0, stream, p, b0 + 6);
    hipLaunchKernelGGL(phase_k<7>, dim3(grid_blocks), dim3(256), 0, stream, p, b0 + 7);
    hipLaunchKernelGGL(phase_k<8>, dim3(grid_blocks), dim3(256), 0, stream, p, b0 + 8);
    hipLaunchKernelGGL(phase_k<9>, dim3(grid_blocks), dim3(256), 0, stream, p, b0 + 9);
  }
#else
  int lo = 0, hi = NPHASE;
  void* args[] = {&p, &lo, &hi};
  (void)hipMemsetAsync(p.BAR, 0, (XCD_BAR_WORDS + 128) * 4, stream);
  hipError_t e = hipLaunchCooperativeKernel((void*)mega, dim3(grid_blocks), dim3(256), args, 0, stream);
  if (e != hipSuccess) fprintf(stderr, "cooperative launch failed: %s (grid %d)\n", hipGetErrorString(e), grid_blocks);
#endif
}
```

```cpp
#include <hip/hip_runtime.h>
#include <hip/hip_cooperative_groups.h>
#include <cstdio>
namespace cg = cooperative_groups;

#ifndef MULTI_LAUNCH
#define MULTI_LAUNCH 0
#endif

#define DI __device__ __forceinline__
typedef unsigned short bf16_t;
typedef short bf16x8 __attribute__((ext_vector_type(8)));
typedef short s16x4 __attribute__((ext_vector_type(4)));
typedef float f32x4 __attribute__((ext_vector_type(4)));
typedef float f32x2 __attribute__((ext_vector_type(2)));
typedef float f32x16 __attribute__((ext_vector_type(16)));
typedef unsigned u32x4 __attribute__((ext_vector_type(4)));
typedef unsigned u32x2 __attribute__((ext_vector_type(2)));
#define LAS __attribute__((address_space(3)))

constexpr int T_TOK = 18432, TB = 2304, NCTX = 256, NLAT = 2048, DM = 1024;
constexpr int LDPA = 1408, LDPBC = 1920;
constexpr float EPSF = 1e-6f;
constexpr float LOG_DECAY_SCALE = 0.606531f;
constexpr float GN_EPS = 64e-5f;
constexpr float QSCALE = 0.10206207261596577f * 1.4426950408889634f;

struct Params {
  const float *x, *c, *ctx, *c_ctx, *ada_w, *ada_b, *norm1_g, *norm2_g, *w_in, *tshift_mu, *decay_w0, *decay_up,
      *icl_a0, *icl_up, *gate_up, *k_k, *k_a, *r_k, *lnx_g, *lnx_b, *q_norm_g, *kv_norm_g, *w_uq, *w_ukv, *q_nope_g,
      *k_nope_g, *q_rope_g, *k_rope_g, *conv_w, *w_out, *w_ffn_in, *w_ffn_out;
  float* out;
  float *MOD, *RSTD, *BON, *XCTX, *Y, *ROPE;
  unsigned* BAR;
  bf16_t *Win, *Wuq, *WukvK, *WvT, *Wgate, *Wdecay, *Wicl, *Wout, *Wffi, *Wffo;
  bf16_t *HY, *TW, *TA, *TG, *Q, *Kt, *VT, *PA, *PBC, *ACT;
};

typedef __bf16 bf16v2 __attribute__((ext_vector_type(2)));
DI unsigned pk_bf16(float lo, float hi) { f32x2 v = {lo, hi}; bf16v2 b = __builtin_convertvector(v, bf16v2); return __builtin_bit_cast(unsigned, b); }
DI float bflo(unsigned u) { return __uint_as_float(u << 16); }
DI float bfhi(unsigned u) { return __uint_as_float(u & 0xffff0000u); }
DI int opaque_tid() { int t = threadIdx.x; asm volatile("" : "+v"(t)); return t; }
DI float sigmoidf_(float x) { return __builtin_amdgcn_rcpf(1.f + __expf(-x)); }
template <int CTRL> DI float dppf(float x) { return __builtin_bit_cast(float, __builtin_amdgcn_update_dpp(0, __builtin_bit_cast(int, x), CTRL, 0xf, 0xf, true)); }
DI float red8(float x) { x += dppf<0xB1>(x); x += dppf<0x4E>(x); x += dppf<0x141>(x); return x; }
DI float red16(float x) { x = red8(x); x += dppf<0x140>(x); return x; }
DI float red64(float x) { for (int o = 32; o > 0; o >>= 1) x += __shfl_xor(x, o); return x; }

DI void unpack8(u32x4 v, float* f) {
  f[0] = bflo(v[0]); f[1] = bfhi(v[0]); f[2] = bflo(v[1]); f[3] = bfhi(v[1]);
  f[4] = bflo(v[2]); f[5] = bfhi(v[2]); f[6] = bflo(v[3]); f[7] = bfhi(v[3]);
}
DI void unpack4(u32x2 v, float* f) { f[0] = bflo(v[0]); f[1] = bfhi(v[0]); f[2] = bflo(v[1]); f[3] = bfhi(v[1]); }

DI const float* xsrc_row(const Params& p, bool from_inputs, int b, int s) {
  if (from_inputs) return s < NCTX ? p.ctx + (size_t)(b * NCTX + s) * DM : p.x + (size_t)(b * NLAT + s - NCTX) * DM;
  return s < NCTX ? p.XCTX + (size_t)(b * NCTX + s) * DM : p.out + (size_t)(b * NLAT + s - NCTX) * DM;
}
DI float* xdst_row(const Params& p, int b, int s) {
  return s < NCTX ? p.XCTX + (size_t)(b * NCTX + s) * DM : p.out + (size_t)(b * NLAT + s - NCTX) * DM;
}

DI void adaln_task(const Params& p, int task, char* lds) {
  float* s = (float*)lds;
  float* red = s + 9 * 1024;
  const int l = task / 192, cgi = task % 192, tid = opaque_tid();
  for (int i = tid; i < 9 * 1024; i += 256) {
    int r = i >> 10, k = i & 1023;
    float v = r < 8 ? p.c[r * 1024 + k] : p.c_ctx[k];
    s[i] = v / (1.f + __expf(-v));
  }
  __syncthreads();
  const int kg = tid >> 5, cc = tid & 31, col = cgi * 32 + cc;
  float acc[9];
#pragma unroll
  for (int r = 0; r < 9; ++r) acc[r] = 0.f;
  const float* w = p.ada_w + (size_t)l * 1024 * 6144 + col;
  for (int k0 = kg; k0 < 1024; k0 += 128) {
    float wv[16];
#pragma unroll
    for (int u = 0; u < 16; ++u) wv[u] = w[(size_t)(k0 + 8 * u) * 6144];
#pragma unroll
    for (int u = 0; u < 16; ++u)
#pragma unroll
      for (int r = 0; r < 9; ++r) acc[r] += s[r * 1024 + k0 + 8 * u] * wv[u];
  }
#pragma unroll
  for (int r = 0; r < 9; ++r) red[(kg * 9 + r) * 32 + cc] = acc[r];
  __syncthreads();
  for (int i = tid; i < 9 * 32; i += 256) {
    int r = i >> 5, c2 = i & 31;
    float sum = 0.f;
    for (int g = 0; g < 8; ++g) sum += red[(g * 9 + r) * 32 + c2];
    p.MOD[(size_t)(l * 9 + r) * 6144 + cgi * 32 + c2] = sum + p.ada_b[l * 6144 + cgi * 32 + c2];
  }
  __syncthreads();
}

DI int colmap(int mode, int n, int nvalid) {
  switch (mode) {
    case 0: return n < nvalid ? n : -1;
    case 1: if (n < 384) return (n >> 6) * 96 + (n & 63); if (n < 576) return ((n - 384) >> 5) * 96 + 64 + ((n - 384) & 31); return -1;
    case 2: return (n >> 6) * 128 + (n & 63);
    case 3: return (n >> 6) * 128 + 64 + (n & 63);
    default: { int t64 = n >> 6, w = n & 63; return w < 32 ? t64 * 32 + w : 2816 + t64 * 32 + (w - 32); }
  }
}
DI void conv_tile(const float* src, int ld, int K, int mode, int nvalid, const float* kscale, bf16_t* dst, int tile, int ntn, char* lds) {
  float(*tl)[65] = (float(*)[65])lds;
  const int tk = tile / ntn, tn = tile % ntn, tid = opaque_tid(), k0 = tk * 64;
  {
    const int nn = tid & 63, kk0 = tid >> 6;
    const int sc = colmap(mode, tn * 64 + nn, nvalid);
#pragma unroll 4
    for (int i = 0; i < 16; ++i) {
      const int kk = kk0 + 4 * i;
      float v = 0.f;
      if (sc >= 0) { v = src[(size_t)(k0 + kk) * ld + sc]; if (kscale) v *= kscale[k0 + kk]; }
      tl[kk][nn] = v;
    }
  }
  __syncthreads();
  {
    const int kk2 = (tid & 31) * 2, nn2 = tid >> 5;
#pragma unroll
    for (int i = 0; i < 8; ++i) {
      const int nn = nn2 + 8 * i;
      *(unsigned*)(dst + (size_t)(tn * 64 + nn) * K + k0 + kk2) = pk_bf16(tl[kk2][nn], tl[kk2 + 1][nn]);
    }
  }
  __syncthreads();
}
constexpr int NCONV_W1 = 1292, NCONV_FF = 2112;
DI void conv_w1_task(const Params& p, int l, int t, char* lds) {
  if (t < 832) { conv_tile(p.w_in + (size_t)l * 1024 * 3232, 3232, 1024, 0, 3232, nullptr, p.Win, t, 52, lds); return; } t -= 832;
  if (t < 120) { conv_tile(p.w_uq + (size_t)l * 768 * 576, 576, 768, 1, 0, p.q_norm_g + l * 768, p.Wuq, t, 10, lds); return; } t -= 120;
  if (t < 24) { conv_tile(p.w_ukv + (size_t)l * 256 * 768, 768, 256, 2, 0, p.kv_norm_g + l * 256, p.WukvK, t, 6, lds); return; } t -= 24;
  if (t < 24) { conv_tile(p.w_ukv + (size_t)l * 256 * 768, 768, 256, 3, 0, p.kv_norm_g + l * 256, p.WvT, t, 6, lds); return; } t -= 24;
  if (t < 12) { conv_tile(p.gate_up + (size_t)l * 128 * 384, 384, 128, 0, 384, nullptr, p.Wgate, t, 6, lds); return; } t -= 12;
  if (t < 12) { int d = t / 6; conv_tile(p.decay_up + (size_t)(l * 2 + d) * 64 * 384, 384, 64, 0, 384, nullptr, p.Wdecay + d * 384 * 64, t % 6, 6, lds); return; } t -= 12;
  if (t < 12) { int d = t / 6; conv_tile(p.icl_up + (size_t)(l * 2 + d) * 64 * 384, 384, 64, 0, 384, nullptr, p.Wicl + d * 384 * 64, t % 6, 6, lds); return; } t -= 12;
  conv_tile(p.w_out + (size_t)l * 1024 * 1024, 1024, 1024, 0, 1024, nullptr, p.Wout, t, 16, lds);
}
DI void conv_ff_task(const Params& p, int l, int t, char* lds) {
  if (t < 1408) { conv_tile(p.w_ffn_in + (size_t)l * 1024 * 5632, 5632, 1024, 4, 0, nullptr, p.Wffi, t, 88, lds); return; } t -= 1408;
  conv_tile(p.w_ffn_out + (size_t)l * 2816 * 1024, 1024, 2816, 0, 1024, nullptr, p.Wffo, t, 16, lds);
}

DI void modnorm_rows(const Params& p, int l, int which  , bool from_inputs, bool skip_ctx, int w0, int wstride, int lane) {
  const float* g = (which ? p.norm2_g : p.norm1_g) + l * DM;
  f32x4 gg[4];
#pragma unroll
  for (int i = 0; i < 4; ++i) gg[i] = *(const f32x4*)(g + i * 256 + lane * 4);
  const int nrows = skip_ctx ? 8 * NLAT : T_TOK;
  auto rowof = [&](int i) -> int { return skip_ctx ? (i / NLAT) * TB + NCTX + (i % NLAT) : i; };
  int i = w0;
  if (i >= nrows) return;
  f32x4 vn[4];
  {
    const int row = rowof(i); const float* src = xsrc_row(p, from_inputs, row / TB, row % TB);
#pragma unroll
    for (int q = 0; q < 4; ++q) vn[q] = *(const f32x4*)(src + q * 256 + lane * 4);
  }
  for (; i < nrows; i += wstride) {
    const int row = rowof(i); const int b = row / TB, s = row % TB;
    f32x4 v[4];
#pragma unroll
    for (int q = 0; q < 4; ++q) v[q] = vn[q];
    if (i + wstride < nrows) {
      const int rn = rowof(i + wstride); const float* src = xsrc_row(p, from_inputs, rn / TB, rn % TB);
#pragma unroll
      for (int q = 0; q < 4; ++q) vn[q] = *(const f32x4*)(src + q * 256 + lane * 4);
    }
    const float* mod = p.MOD + (size_t)(l * 9 + (s < NCTX ? 8 : b)) * 6144 + (which ? 3 * 1024 : 0);
    f32x4 sh[4], sc[4];
#pragma unroll
    for (int q = 0; q < 4; ++q) { sh[q] = *(const f32x4*)(mod + q * 256 + lane * 4); sc[q] = *(const f32x4*)(mod + 1024 + q * 256 + lane * 4); }
    float ss = 0.f;
#pragma unroll
    for (int q = 0; q < 4; ++q) ss += v[q][0] * v[q][0] + v[q][1] * v[q][1] + v[q][2] * v[q][2] + v[q][3] * v[q][3];
    ss = red64(ss);
    const float rs = rsqrtf(ss * (1.f / 1024.f) + EPSF);
    bf16_t* dst = p.HY + (size_t)row * DM;
#pragma unroll
    for (int q = 0; q < 4; ++q) {
      float o[4];
#pragma unroll
      for (int j = 0; j < 4; ++j) o[j] = (v[q][j] * rs * gg[q][j]) * (1.f + sc[q][j]) + sh[q][j];
      u32x2 w = {pk_bf16(o[0], o[1]), pk_bf16(o[2], o[3])};
      *(u32x2*)(dst + q * 256 + lane * 4) = w;
    }
  }
}

template <class Epi>
DI void gemm_tile(const bf16_t* __restrict__ A, int lda, const bf16_t* __restrict__ Bt, int ldb, int K, int row0, int col0, char* lds, const Epi& epi) {
  const int tid = opaque_tid(), lane = tid & 63, wid = tid >> 6, wr = wid >> 1, wc = wid & 1, fr = lane & 15, fq = lane >> 4;
  const bf16_t* ag[4];
  const bf16_t* bg[4];
#pragma unroll
  for (int i = 0; i < 4; ++i) {
    const int id = i * 256 + tid, r = id >> 3, cp = id & 7, c = cp ^ ((r >> 1) & 7);
    ag[i] = A + (size_t)(row0 + r) * lda + c * 8;
    bg[i] = Bt + (size_t)(col0 + r) * ldb + c * 8;
  }
  f32x4 acc[4][4];
#pragma unroll
  for (int m = 0; m < 4; ++m)
#pragma unroll
    for (int n = 0; n < 4; ++n) acc[m][n] = (f32x4){0.f, 0.f, 0.f, 0.f};
  const int KT = K >> 6;
  auto stage_a = [&](int kt, int buf) {
    char* sa = lds + buf * 32768;
#pragma unroll
    for (int i = 0; i < 4; ++i)
      __builtin_amdgcn_global_load_lds((const void __attribute__((address_space(1)))*)(ag[i] + kt * 64), (void LAS*)(sa + (i * 256 + tid) * 16), 16, 0, 0);
  };
  auto stage_b = [&](int kt, int buf) {
    char* sb = lds + buf * 32768 + 16384;
#pragma unroll
    for (int i = 0; i < 4; ++i)
      __builtin_amdgcn_global_load_lds((const void __attribute__((address_space(1)))*)(bg[i] + kt * 64), (void LAS*)(sb + (i * 256 + tid) * 16), 16, 0, 0);
  };
  __syncthreads();
  stage_a(0, 0); stage_b(0, 0);
  const int swz = fr >> 1;
  for (int kt = 0; kt < KT; ++kt) {
    asm volatile("s_waitcnt vmcnt(0)" ::: "memory");
    __syncthreads();
    const char* sa = lds + (kt & 1) * 32768 + (wr * 64 + fr) * 128;
    const char* sb = lds + (kt & 1) * 32768 + 16384 + (wc * 64 + fr) * 128;
#pragma unroll
    for (int kk = 0; kk < 2; ++kk) {
      if (kt + 1 < KT) { if (kk == 0) stage_a(kt + 1, (kt + 1) & 1); else stage_b(kt + 1, (kt + 1) & 1); }
      bf16x8 a[4], b[4];
      const int co = ((kk * 4 + fq) ^ swz) * 16;
#pragma unroll
      for (int m = 0; m < 4; ++m) a[m] = *(const bf16x8*)(sa + m * 2048 + co);
#pragma unroll
      for (int n = 0; n < 4; ++n) b[n] = *(const bf16x8*)(sb + n * 2048 + co);
#pragma unroll
      for (int m = 0; m < 4; ++m)
#pragma unroll
        for (int n = 0; n < 4; ++n) acc[m][n] = __builtin_amdgcn_mfma_f32_16x16x32_bf16(b[n], a[m], acc[m][n], 0, 0, 0);
    }
  }
  epi(acc, row0 + wr * 64, col0 + wc * 64, fr, fq);
}

struct EpiP {
  bf16_t *PA, *PBC; float* SSQ;
  DI void operator()(const f32x4 (&acc)[4][4], int r0, int c0, int fr, int fq) const {
    bf16_t* base; int ld, cb;
    if (c0 < LDPA) { base = PA; ld = LDPA; cb = c0; } else { base = PBC; ld = LDPBC; cb = c0 - LDPA; }
    if (c0 >= LDPA && cb < 1024) {
      float* dst = SSQ + (cb < 768 ? 0 : T_TOK);
#pragma unroll
      for (int m = 0; m < 4; ++m) {
        float ss = 0.f;
#pragma unroll
        for (int n = 0; n < 4; ++n)
#pragma unroll
          for (int j = 0; j < 4; ++j) ss += acc[m][n][j] * acc[m][n][j];
        ss += __shfl_xor(ss, 16); ss += __shfl_xor(ss, 32);
        if (fq == 0) atomicAdd(dst + r0 + m * 16 + fr, ss);
      }
    }
#pragma unroll
    for (int m = 0; m < 4; ++m)
#pragma unroll
      for (int n = 0; n < 4; ++n) {
        u32x2 v = {pk_bf16(acc[m][n][0], acc[m][n][1]), pk_bf16(acc[m][n][2], acc[m][n][3])};
        *(u32x2*)(base + (size_t)(r0 + m * 16 + fr) * ld + cb + n * 16 + fq * 4) = v;
      }
  }
};

DI void rope_angle(int pos, int i, float& cs, float& sn) {
  const float invf = __builtin_amdgcn_exp2f(-(float)i * (13.287712379549449f / 8.f));
  float ang = (float)pos * invf;
  float n = rintf(ang * 0.15915494309189535f);
  float r = fmaf(-n, 6.28125f, ang);
  r = fmaf(-n, 1.9353071795864769e-3f, r);
  cs = __cosf(r); sn = __sinf(r);
}

struct EpiQ {
  const float *rstd, *gn, *gr, *rope; bf16_t* Q;
  DI void operator()(const f32x4 (&acc)[4][4], int r0, int c0, int fr, int fq) const {
    if (c0 >= 576) return;
    if (c0 < 384) {
      const int h = c0 >> 6;
#pragma unroll
      for (int m = 0; m < 4; ++m) {
        const int row = r0 + m * 16 + fr; const float rs = rsqrtf(rstd[row] * (1.f / 768.f) + EPSF);
        float ss = 0.f;
#pragma unroll
        for (int n = 0; n < 4; ++n)
#pragma unroll
          for (int j = 0; j < 4; ++j) { float v = acc[m][n][j] * rs; ss += v * v; }
        ss += __shfl_xor(ss, 16); ss += __shfl_xor(ss, 32);
        const float inv = rsqrtf(ss * (1.f / 64.f) + EPSF) * rs * QSCALE;
        const int b = row / TB, s = row % TB;
        bf16_t* dst = Q + ((size_t)(b * 6 + h) * TB + s) * 96;
#pragma unroll
        for (int n = 0; n < 4; ++n) {
          const int d = n * 16 + fq * 4; f32x4 g = *(const f32x4*)(gn + d);
          u32x2 v = {pk_bf16(acc[m][n][0] * inv * g[0], acc[m][n][1] * inv * g[1]), pk_bf16(acc[m][n][2] * inv * g[2], acc[m][n][3] * inv * g[3])};
          *(u32x2*)(dst + d) = v;
        }
      }
    } else {
#pragma unroll
      for (int m = 0; m < 4; ++m) {
        const int row = r0 + m * 16 + fr; const float rs = rsqrtf(rstd[row] * (1.f / 768.f) + EPSF);
        const int b = row / TB, s = row % TB; const bool lat = s >= NCTX; const int sp = s - NCTX;
#pragma unroll
        for (int hh = 0; hh < 2; ++hh) {
          const int h = ((c0 - 384) >> 5) + hh;
          float ss = 0.f;
#pragma unroll
          for (int nn = 0; nn < 2; ++nn)
#pragma unroll
            for (int j = 0; j < 4; ++j) { float v = acc[m][hh * 2 + nn][j] * rs; ss += v * v; }
          ss += __shfl_xor(ss, 16); ss += __shfl_xor(ss, 32);
          const float inv = rsqrtf(ss * (1.f / 32.f) + EPSF) * rs;
          bf16_t* dst = Q + ((size_t)(b * 6 + h) * TB + s) * 96 + 64;
#pragma unroll
          for (int nn = 0; nn < 2; ++nn) {
            const int d = nn * 16 + fq * 4; f32x4 g = *(const f32x4*)(gr + d);
            float o[4];
#pragma unroll
            for (int j = 0; j < 4; ++j) {
              float val = acc[m][hh * 2 + nn][j] * inv * g[j];
              float partner = __shfl_xor(val, 32);
              if (lat) {
                const float* rt = rope + ((nn == 0 ? (sp >> 6) : (sp & 63)) * 8 + ((fq * 4 + j) & 7)) * 2; const float cs = rt[0], sn = rt[1];
                val = fq < 2 ? val * cs - partner * sn : val * cs + partner * sn;
              }
              o[j] = val * QSCALE;
            }
            u32x2 v = {pk_bf16(o[0], o[1]), pk_bf16(o[2], o[3])};
            *(u32x2*)(dst + d) = v;
          }
        }
      }
    }
  }
};

struct EpiK {
  const float *rstd, *gk; bf16_t* Kt;
  DI void operator()(const f32x4 (&acc)[4][4], int r0, int c0, int fr, int fq) const {
    const int h = c0 >> 6;
#pragma unroll
    for (int m = 0; m < 4; ++m) {
      const int row = r0 + m * 16 + fr; const float rs = rsqrtf(rstd[row] * (1.f / 256.f) + EPSF);
      float ss = 0.f;
#pragma unroll
      for (int n = 0; n < 4; ++n)
#pragma unroll
        for (int j = 0; j < 4; ++j) { float v = acc[m][n][j] * rs; ss += v * v; }
      ss += __shfl_xor(ss, 16); ss += __shfl_xor(ss, 32);
      const float inv = rsqrtf(ss * (1.f / 64.f) + EPSF) * rs;
      const int b = row / TB, s = row % TB;
      bf16_t* dst = Kt + ((size_t)(b * 6 + h) * TB + s) * 96;
#pragma unroll
      for (int n = 0; n < 4; ++n) {
        const int d = n * 16 + fq * 4; f32x4 g = *(const f32x4*)(gk + d);
        u32x2 v = {pk_bf16(acc[m][n][0] * inv * g[0], acc[m][n][1] * inv * g[1]), pk_bf16(acc[m][n][2] * inv * g[2], acc[m][n][3] * inv * g[3])};
        *(u32x2*)(dst + d) = v;
      }
    }
  }
};

struct EpiV {
  const float* rstd; bf16_t* VT;
  DI void operator()(const f32x4 (&acc)[4][4], int r0, int c0, int fr, int fq) const {
#pragma unroll
    for (int m = 0; m < 4; ++m)
#pragma unroll
      for (int n = 0; n < 4; ++n) {
        const int row = r0 + m * 16 + fr, col = c0 + n * 16 + fq * 4;
        f32x4 rs = *(const f32x4*)(rstd + col);
#pragma unroll
        for (int j = 0; j < 4; ++j) rs[j] = rsqrtf(rs[j] * (1.f / 256.f) + EPSF);
        u32x2 v = {pk_bf16(acc[m][n][0] * rs[0], acc[m][n][1] * rs[1]), pk_bf16(acc[m][n][2] * rs[2], acc[m][n][3] * rs[3])};
        *(u32x2*)(VT + (size_t)row * T_TOK + col) = v;
      }
  }
};

struct EpiPost {
  const float *Y, *BON, *mu, *lnx_g, *lnx_b; const bf16_t* PA; bf16_t* YC;
  DI void operator()(const f32x4 (&acc)[4][4], int r0, int c0, int fr, int fq) const {
    const int h = c0 >> 6;
#pragma unroll
    for (int m = 0; m < 4; ++m) {
      const int row = r0 + m * 16 + fr; const int s = row % TB;
      const bool hasprev = (s != 0 && s != NCTX), hasnext = (s != NCTX - 1 && s != TB - 1);
      f32x4 y[4];
      float s1 = 0.f;
#pragma unroll
      for (int n = 0; n < 4; ++n) {
        const size_t o = (size_t)row * 384 + c0 + n * 16 + fq * 4;
        y[n] = *(const f32x4*)(Y + o) + *(const f32x4*)(Y + (size_t)T_TOK * 384 + o);
        s1 += y[n][0] + y[n][1] + y[n][2] + y[n][3];
      }
      s1 += __shfl_xor(s1, 16); s1 += __shfl_xor(s1, 32);
      const float mean = s1 * (1.f / 64.f);
      float s2 = 0.f;
#pragma unroll
      for (int n = 0; n < 4; ++n)
#pragma unroll
        for (int j = 0; j < 4; ++j) { float d = y[n][j] - mean; s2 += d * d; }
      s2 += __shfl_xor(s2, 16); s2 += __shfl_xor(s2, 32);
      const float rstdv = rsqrtf(s2 * (1.f / 64.f) + GN_EPS);
      const float bon = BON[(size_t)row * 6 + h] + BON[(size_t)T_TOK * 6 + (size_t)row * 6 + h];
#pragma unroll
      for (int n = 0; n < 4; ++n) {
        const int col = c0 + n * 16 + fq * 4;
        const bf16_t* pv = PA + (size_t)row * LDPA + 768 + col;
        float vc[4], vp[4] = {0.f, 0.f, 0.f, 0.f}, vn[4] = {0.f, 0.f, 0.f, 0.f};
        unpack4(*(const u32x2*)pv, vc);
        if (hasprev) unpack4(*(const u32x2*)(pv - LDPA), vp);
        if (hasnext) unpack4(*(const u32x2*)(pv + LDPA), vn);
        f32x4 m0 = *(const f32x4*)(mu + 768 + col), m1 = *(const f32x4*)(mu + LDPA + 768 + col);
        f32x4 lg = *(const f32x4*)(lnx_g + col), lb = *(const f32x4*)(lnx_b + col);
        float o[4];
#pragma unroll
        for (int j = 0; j < 4; ++j) {
          const float v = vc[j] + m0[j] * (vp[j] - vc[j]) + m1[j] * (vn[j] - vc[j]);
          o[j] = ((y[n][j] - mean) * rstdv * lg[j] + lb[j] + bon * v) * acc[m][n][j];
        }
        u32x2 w = {pk_bf16(o[0], o[1]), pk_bf16(o[2], o[3])};
        *(u32x2*)(YC + (size_t)row * DM + col) = w;
      }
    }
  }
};

struct EpiRes {
  const Params* p; int l; bool from_inputs; int gate_off;
  DI void operator()(const f32x4 (&acc)[4][4], int r0, int c0, int fr, int fq) const {
#pragma unroll
    for (int m = 0; m < 4; ++m) {
      const int row = r0 + m * 16 + fr; const int b = row / TB, s = row % TB;
      const float* src = xsrc_row(*p, from_inputs, b, s);
      float* dst = xdst_row(*p, b, s);
      const float* gate = p->MOD + (size_t)(l * 9 + (s < NCTX ? 8 : b)) * 6144 + gate_off;
#pragma unroll
      for (int n = 0; n < 4; ++n) {
        const int col = c0 + n * 16 + fq * 4;
        f32x4 g = *(const f32x4*)(gate + col), xv = *(const f32x4*)(src + col);
        *(f32x4*)(dst + col) = xv + g * acc[m][n];
      }
    }
  }
};

struct EpiFfnIn {
  bf16_t* ACT;
  DI void operator()(const f32x4 (&acc)[4][4], int r0, int c0, int fr, int fq) const {
    const int cb = (c0 >> 6) * 32;
#pragma unroll
    for (int m = 0; m < 4; ++m)
#pragma unroll
      for (int n = 0; n < 2; ++n) {
        float o[4];
#pragma unroll
        for (int j = 0; j < 4; ++j) { float g = acc[m][n][j]; o[j] = g * __builtin_amdgcn_rcpf(1.f + __expf(-g)) * acc[m][n + 2][j]; }
        u32x2 w = {pk_bf16(o[0], o[1]), pk_bf16(o[2], o[3])};
        *(u32x2*)(ACT + (size_t)(r0 + m * 16 + fr) * 2816 + cb + n * 16 + fq * 4) = w;
      }
  }
};

DI void prep_token(const Params& p, int l, int row, int lane) {
  const int b = row / TB, s = row % TB;
  const bool hasprev = (s != 0 && s != NCTX), hasnext = (s != NCTX - 1 && s != TB - 1);
  const float mp = hasprev ? 1.f : 0.f, mn = hasnext ? 1.f : 0.f;
  const bf16_t* pa = p.PA + (size_t)row * LDPA;
  const bf16_t* pbc = p.PBC + (size_t)row * LDPBC;
  const int opa = hasprev ? -LDPA : 0, ona = hasnext ? LDPA : 0, opb = hasprev ? -LDPBC : 0, onb = hasnext ? LDPBC : 0;
  const int l32 = lane & 31, c8 = l32 * 8, colA = 1152 + c8;
  const u32x4 la_c = *(const u32x4*)(pa + colA), la_p = *(const u32x4*)(pa + opa + colA), la_n = *(const u32x4*)(pa + ona + colA);
  const u32x4 lq0 = *(const u32x4*)(pbc + lane * 8), lq1 = *(const u32x4*)(pbc + 512 + c8), lkv = *(const u32x4*)(pbc + 768 + c8);
  const u32x4 lrp = *(const u32x4*)(pbc + 1024 + (lane & 3) * 8);
  const u32x4 lbg = *(const u32x4*)(pbc + 1056 + c8), lcc = *(const u32x4*)(pbc + 1312 + c8), lhh = *(const u32x4*)(pbc + 1568 + c8);
  const u32x4 lcp = *(const u32x4*)(pbc + opb + 1312 + c8), lhp = *(const u32x4*)(pbc + opb + 1568 + c8);
  const u32x4 lcn = *(const u32x4*)(pbc + onb + 1312 + c8), lhn = *(const u32x4*)(pbc + onb + 1568 + c8);
  const float* mu = p.tshift_mu + (size_t)l * 2 * LDPA;
  {
    float c[8], pv[8], nx[8], o[8];
    unpack8(la_c, c); unpack8(la_p, pv); unpack8(la_n, nx);
    const f32x4 m0a = *(const f32x4*)(mu + colA), m0b = *(const f32x4*)(mu + colA + 4), m1a = *(const f32x4*)(mu + LDPA + colA), m1b = *(const f32x4*)(mu + LDPA + colA + 4);
#pragma unroll
    for (int j = 0; j < 8; ++j) {
      const float m0 = j < 4 ? m0a[j & 3] : m0b[j & 3], m1 = j < 4 ? m1a[j & 3] : m1b[j & 3];
      float t = c[j] + m0 * (pv[j] * mp - c[j]) + m1 * (nx[j] * mn - c[j]);
      if (l32 < 8) { float e = __expf(2.f * t); t = 1.f - 2.f * __builtin_amdgcn_rcpf(1.f + e); }
      else if (l32 >= 16) t = __builtin_amdgcn_rcpf(1.f + __expf(-t));
      o[j] = t;
    }
    u32x4 w = {pk_bf16(o[0], o[1]), pk_bf16(o[2], o[3]), pk_bf16(o[4], o[5]), pk_bf16(o[6], o[7])};
    if (lane < 8) *(u32x4*)(p.TW + (size_t)row * 64 + lane * 8) = w;
    else if (lane < 16) *(u32x4*)(p.TA + (size_t)row * 64 + (lane - 8) * 8) = w;
    else if (lane < 32) *(u32x4*)(p.TG + (size_t)row * 128 + (lane - 16) * 8) = w;
  }
  float f[8], ss = 0.f, s2 = 0.f, s3 = 0.f, fr_[8];
  unpack8(lq0, f);
#pragma unroll
  for (int j = 0; j < 8; ++j) ss += f[j] * f[j];
  unpack8(lq1, f);
  if (lane < 32) {
#pragma unroll
    for (int j = 0; j < 8; ++j) ss += f[j] * f[j];
  }
  unpack8(lkv, f);
  if (lane < 32) {
#pragma unroll
    for (int j = 0; j < 8; ++j) s2 += f[j] * f[j];
  }
  unpack8(lrp, fr_);
  if (lane < 4) {
#pragma unroll
    for (int j = 0; j < 8; ++j) s3 += fr_[j] * fr_[j];
  }
  s3 += __shfl_xor(s3, 1); s3 += __shfl_xor(s3, 2);
  {
    const float inv = rsqrtf(s3 * (1.f / 32.f) + EPSF);
    const float* g = p.k_rope_g + l * 32;
    const bool lat = s >= NCTX; const int sp = lat ? s - NCTX : 0;
    const float* rt = p.ROPE + ((lane & 2) ? (sp & 63) : (sp >> 6)) * 16;
    float o[8];
#pragma unroll
    for (int j = 0; j < 8; ++j) {
      float val = fr_[j] * inv * g[(lane & 3) * 8 + j];
      float partner = __shfl_xor(val, 1);
      if (lat) {
        const float cs = rt[2 * j], sn = rt[2 * j + 1];
        val = (lane & 1) == 0 ? val * cs - partner * sn : val * cs + partner * sn;
      }
      o[j] = val;
    }
    if (lane < 4) {
      u32x4 w = {pk_bf16(o[0], o[1]), pk_bf16(o[2], o[3]), pk_bf16(o[4], o[5]), pk_bf16(o[6], o[7])};
#pragma unroll
      for (int hh = 0; hh < 6; ++hh) *(u32x4*)(p.Kt + ((size_t)(b * 6 + hh) * TB + s) * 96 + 64 + lane * 8) = w;
    }
  }
  {
    float bg[8], cc[8], hh[8], cp[8], hp[8], cn[8], hn[8], o[8];
    unpack8(lbg, bg); unpack8(lcc, cc); unpack8(lhh, hh); unpack8(lcp, cp); unpack8(lhp, hp); unpack8(lcn, cn); unpack8(lhn, hn);
    const float* cw = p.conv_w + (size_t)l * 3 * 256;
#pragma unroll
    for (int j = 0; j < 8; ++j) o[j] = bg[j] * (cw[c8 + j] * cp[j] * hp[j] * mp + cw[256 + c8 + j] * cc[j] * hh[j] + cw[512 + c8 + j] * cn[j] * hn[j] * mn);
    u32x4 w = {pk_bf16(o[0], o[1]), pk_bf16(o[2], o[3]), pk_bf16(o[4], o[5]), pk_bf16(o[6], o[7])};
    if (lane < 32) *(u32x4*)(p.HY + (size_t)row * DM + 768 + c8) = w;
  }
}

#define MFMA32(a, b, c) __builtin_amdgcn_mfma_f32_32x32x16_bf16((a), (b), (c), 0, 0, 0)
DI bf16x8 pack8(const f32x16& x, int s) {
  u32x4 v = {pk_bf16(x[8 * s], x[8 * s + 1]), pk_bf16(x[8 * s + 2], x[8 * s + 3]), pk_bf16(x[8 * s + 4], x[8 * s + 5]), pk_bf16(x[8 * s + 6], x[8 * s + 7])};
  return __builtin_bit_cast(bf16x8, v);
}
constexpr int KROW = 208, VROW = 136, KBUF = 64 * KROW, VBUF = 64 * VROW;
DI void attn_task(const Params& p, int b, int h, int q0, int k0, int nk, char* lds) {
  const int tid = opaque_tid(), lane = tid & 63, wid = tid >> 6, r = lane & 31, hh = lane >> 5;
  const bf16_t* Qp = p.Q + ((size_t)(b * 6 + h) * TB + q0 + wid * 32 + r) * 96;
  const bf16_t* Kp = p.Kt + ((size_t)(b * 6 + h) * TB + k0) * 96;
  const bf16_t* Vp = p.VT + (size_t)(h * 64) * T_TOK + (size_t)b * TB + k0;
  bf16x8 qf[6];
#pragma unroll
  for (int ks = 0; ks < 6; ++ks) qf[ks] = *(const bf16x8*)(Qp + ks * 16 + hh * 8);
  int krow_[3], kch_[3];
#pragma unroll
  for (int i = 0; i < 3; ++i) { int id = tid + i * 256; krow_[i] = id / 12; kch_[i] = id % 12; }
  const int vd0 = tid >> 3, vch = tid & 7;
  u32x4 kreg[3], vreg[2];
  auto load_regs = [&](int kt) {
#pragma unroll
    for (int i = 0; i < 3; ++i) kreg[i] = *(const u32x4*)(Kp + (size_t)(kt * 64 + krow_[i]) * 96 + kch_[i] * 8);
#pragma unroll
    for (int i = 0; i < 2; ++i) vreg[i] = *(const u32x4*)(Vp + (size_t)(vd0 + 32 * i) * T_TOK + kt * 64 + vch * 8);
  };
  auto write_lds = [&](int buf) {
    char* kb = lds + buf * (KBUF + VBUF);
    char* vb = kb + KBUF;
#pragma unroll
    for (int i = 0; i < 3; ++i) *(u32x4*)(kb + krow_[i] * KROW + kch_[i] * 16) = kreg[i];
#pragma unroll
    for (int i = 0; i < 2; ++i) {
      char* d = vb + (vd0 + 32 * i) * VROW + vch * 16;
      *(u32x2*)d = (u32x2){vreg[i][0], vreg[i][1]};
      *(u32x2*)(d + 8) = (u32x2){vreg[i][2], vreg[i][3]};
    }
  };
  f32x16 o[2];
#pragma unroll
  for (int i = 0; i < 16; ++i) { o[0][i] = 0.f; o[1][i] = 0.f; }
  float m_run = -1e30f, l_run = 0.f;
  const int NT = nk >> 6;
  __syncthreads();
  load_regs(0);
  write_lds(0);
  for (int kt = 0; kt < NT; ++kt) {
    if (kt + 1 < NT) load_regs(kt + 1);
    __syncthreads();
    const char* kb = lds + (kt & 1) * (KBUF + VBUF);
    const char* vb = kb + KBUF;
    f32x16 st[2];
#pragma unroll
    for (int kbk = 0; kbk < 2; ++kbk) {
#pragma unroll
      for (int i = 0; i < 16; ++i) st[kbk][i] = 0.f;
#pragma unroll
      for (int ks = 0; ks < 6; ++ks) {
        bf16x8 kf = *(const bf16x8*)(kb + (kbk * 32 + r) * KROW + ks * 32 + hh * 16);
        st[kbk] = MFMA32(kf, qf[ks], st[kbk]);
      }
    }
    float mx = st[0][0];
#pragma unroll
    for (int i = 0; i < 16; ++i) { mx = fmaxf(mx, st[0][i]); mx = fmaxf(mx, st[1][i]); }
    mx = fmaxf(mx, __shfl_xor(mx, 32));
    const float m_new = fmaxf(m_run, mx);
    const float alpha = __builtin_amdgcn_exp2f(m_run - m_new);
    m_run = m_new;
    float psum = 0.f;
#pragma unroll
    for (int kbk = 0; kbk < 2; ++kbk)
#pragma unroll
      for (int i = 0; i < 16; ++i) { float e = __builtin_amdgcn_exp2f(st[kbk][i] - m_new); st[kbk][i] = e; psum += e; }
    psum += __shfl_xor(psum, 32);
    l_run = l_run * alpha + psum;
#pragma unroll
    for (int i = 0; i < 16; ++i) { o[0][i] *= alpha; o[1][i] *= alpha; }
#pragma unroll
    for (int ksv = 0; ksv < 4; ++ksv) {
      const bf16x8 pf = pack8(st[ksv >> 1], ksv & 1);
#pragma unroll
      for (int db = 0; db < 2; ++db) {
        const char* va = vb + (db * 32 + r) * VROW + (ksv * 16 + 4 * hh) * 2;
        s16x4 lo = *(const s16x4*)va, hi = *(const s16x4*)(va + 16);
        bf16x8 vf = __builtin_shufflevector(lo, hi, 0, 1, 2, 3, 4, 5, 6, 7);
        o[db] = MFMA32(vf, pf, o[db]);
      }
    }
    if (kt + 1 < NT) write_lds((kt + 1) & 1);
  }
  const float invl = 1.f / l_run;
  bf16_t* dst = p.HY + (size_t)(b * TB + q0 + wid * 32 + r) * DM + 384 + h * 64;
#pragma unroll
  for (int db = 0; db < 2; ++db)
#pragma unroll
    for (int g = 0; g < 4; ++g) {
      u32x2 w = {pk_bf16(o[db][4 * g] * invl, o[db][4 * g + 1] * invl), pk_bf16(o[db][4 * g + 2] * invl, o[db][4 * g + 3] * invl)};
      *(u32x2*)(dst + db * 32 + 8 * g + 4 * hh) = w;
    }
}

enum { VW = 0, VKK = 1, VB = 2, VKD = 3, VR = 4, VV = 5 };
DI void scan_task(const Params& p, int l, int b, int h, int dir, int half, char* lds) {
  float* cb = (float*)lds;
  float* tk = cb + 6 * 1024;
  float* ybuf = tk + 1024;
  const int tid = opaque_tid(), lane = tid & 63, wid = tid >> 6;
  const int st_p = tid >> 4, c4 = tid & 15;
  const int fr = lane & 15, fq = lane >> 4;
  const int rp = lane >> 4, g = lane & 15;
  const int hc = h * 64;
  bf16x8 bw[2], ba[2];
  {
    const bf16_t* wd = p.Wdecay + ((size_t)dir * 384 + hc + wid * 16 + fr) * 64;
    const bf16_t* wi = p.Wicl + ((size_t)dir * 384 + hc + wid * 16 + fr) * 64;
#pragma unroll
    for (int ks = 0; ks < 2; ++ks) { bw[ks] = *(const bf16x8*)(wd + ks * 32 + fq * 8); ba[ks] = *(const bf16x8*)(wi + ks * 32 + fq * 8); }
  }
  f32x4 mu0[3], mu1[3];
  const float* mu = p.tshift_mu + (size_t)l * 2 * LDPA;
#pragma unroll
  for (int sec = 0; sec < 3; ++sec) { mu0[sec] = *(const f32x4*)(mu + sec * 384 + hc + c4 * 4); mu1[sec] = *(const f32x4*)(mu + LDPA + sec * 384 + hc + c4 * 4); }
  const f32x4 kkg = *(const f32x4*)(p.k_k + l * 384 + hc + c4 * 4);
  const f32x4 rkg = *(const f32x4*)(p.r_k + l * 384 + hc + c4 * 4);
  const int colB = wid * 16 + fq * 4;
  const f32x4 w0 = *(const f32x4*)(p.decay_w0 + (size_t)(l * 2 + dir) * 384 + hc + colB);
  const f32x4 a0 = *(const f32x4*)(p.icl_a0 + (size_t)(l * 2 + dir) * 384 + hc + colB);
  const f32x4 kag = *(const f32x4*)(p.k_a + l * 384 + hc + colB);

  u32x2 ld[3][3];
  float mprev = 0.f, mnext = 0.f;
  bf16x8 aw[2], aa[2];
  auto chunk_lo = [&](int c) -> int { return dir == 0 ? 16 * c : (c < 16 ? 240 - 16 * c : 2544 - 16 * c); };
  auto issue_loads = [&](int c) {
    const int slo = chunk_lo(c);
    const int s = slo + st_p;
    const bool hasprev = (s != 0 && s != NCTX), hasnext = (s != NCTX - 1 && s != TB - 1);
    const bf16_t* pa = p.PA + (size_t)(b * TB + s) * LDPA + hc + c4 * 4;
    const int op = hasprev ? -LDPA : 0, on = hasnext ? LDPA : 0;
    mprev = hasprev ? 1.f : 0.f; mnext = hasnext ? 1.f : 0.f;
#pragma unroll
    for (int sec = 0; sec < 3; ++sec) {
      ld[sec][1] = *(const u32x2*)(pa + sec * 384);
      ld[sec][0] = *(const u32x2*)(pa + sec * 384 + op);
      ld[sec][2] = *(const u32x2*)(pa + sec * 384 + on);
    }
    const size_t trow = (size_t)(b * TB + slo + fr) * 64;
#pragma unroll
    for (int ks = 0; ks < 2; ++ks) { aw[ks] = *(const bf16x8*)(p.TW + trow + ks * 32 + fq * 8); aa[ks] = *(const bf16x8*)(p.TA + trow + ks * 32 + fq * 8); }
  };
  auto produce = [&](int c) {
    const int slo = chunk_lo(c);
    float ts[3][4];
#pragma unroll
    for (int sec = 0; sec < 3; ++sec) {
      float pc[4], pp[4], pn[4];
      unpack4(ld[sec][1], pc); unpack4(ld[sec][0], pp); unpack4(ld[sec][2], pn);
#pragma unroll
      for (int j = 0; j < 4; ++j) ts[sec][j] = pc[j] + mu0[sec][j] * (pp[j] * mprev - pc[j]) + mu1[sec][j] * (pn[j] * mnext - pc[j]);
    }
    *(f32x4*)(cb + VR * 1024 + st_p * 64 + c4 * 4) = (f32x4){ts[0][0], ts[0][1], ts[0][2], ts[0][3]};
    *(f32x4*)(cb + VV * 1024 + st_p * 64 + c4 * 4) = (f32x4){ts[2][0], ts[2][1], ts[2][2], ts[2][3]};
    *(f32x4*)(tk + st_p * 64 + c4 * 4) = (f32x4){ts[1][0], ts[1][1], ts[1][2], ts[1][3]};
    float kx[4], ss = 0.f;
#pragma unroll
    for (int j = 0; j < 4; ++j) { kx[j] = ts[1][j] * kkg[j]; ss += kx[j] * kx[j]; }
    ss = red16(ss);
    const float inv = rsqrtf(ss + 1e-12f);
    *(f32x4*)(cb + VKK * 1024 + st_p * 64 + c4 * 4) = (f32x4){kx[0] * inv, kx[1] * inv, kx[2] * inv, kx[3] * inv};
    __syncthreads();
    f32x4 dw = {0.f, 0.f, 0.f, 0.f}, da = {0.f, 0.f, 0.f, 0.f};
#pragma unroll
    for (int ks = 0; ks < 2; ++ks) {
      dw = __builtin_amdgcn_mfma_f32_16x16x32_bf16(bw[ks], aw[ks], dw, 0, 0, 0);
      da = __builtin_amdgcn_mfma_f32_16x16x32_bf16(ba[ks], aa[ks], da, 0, 0, 0);
    }
    {
      const f32x4 kv = *(const f32x4*)(tk + fr * 64 + colB);
      const f32x4 kkv = *(const f32x4*)(cb + VKK * 1024 + fr * 64 + colB);
      f32x4 wv, kdv, bv;
#pragma unroll
      for (int j = 0; j < 4; ++j) {
        wv[j] = __expf(-LOG_DECAY_SCALE * sigmoidf_(w0[j] + dw[j]));
        const float a = sigmoidf_(a0[j] + da[j]);
        kdv[j] = kv[j] * (1.f + (a - 1.f) * kag[j]);
        bv[j] = kkv[j] * a;
      }
      *(f32x4*)(cb + VW * 1024 + fr * 64 + colB) = wv;
      *(f32x4*)(cb + VKD * 1024 + fr * 64 + colB) = kdv;
      *(f32x4*)(cb + VB * 1024 + fr * 64 + colB) = bv;
    }
    __syncthreads();
    {
      const f32x4 rv = *(const f32x4*)(cb + VR * 1024 + st_p * 64 + c4 * 4);
      const f32x4 kdv = *(const f32x4*)(cb + VKD * 1024 + st_p * 64 + c4 * 4);
      float bs = rv[0] * kdv[0] * rkg[0] + rv[1] * kdv[1] * rkg[1] + rv[2] * kdv[2] * rkg[2] + rv[3] * kdv[3] * rkg[3];
      bs = red16(bs);
      if (c4 == 0 && half == 0) p.BON[(size_t)dir * T_TOK * 6 + (size_t)(b * TB + slo + st_p) * 6 + h] = bs;
    }
  };

  f32x2 S0[2], S1[2];
#pragma unroll
  for (int j = 0; j < 2; ++j) { S0[j] = (f32x2){0.f, 0.f}; S1[j] = (f32x2){0.f, 0.f}; }
  __syncthreads();
  issue_loads(0);
  produce(0);
  __syncthreads();
  const int NCH = TB / 16;
  const int rowl = half * 32 + wid * 8 + rp * 2;
  const int inc = dir ? -64 : 64;
  for (int c = 0; c < NCH; ++c) {
    if (c + 1 < NCH) issue_loads(c + 1);
    {
      const float* ps = cb + (dir ? 15 * 64 : 0) + g * 4;
      const float* pv = cb + VV * 1024 + (dir ? 15 * 64 : 0) + rowl;
      float* py = ybuf + (dir ? 15 * 512 : 0) + ((wid * 4 + rp) * 16 + g) * 2;
      f32x4 cw = *(const f32x4*)(ps + VW * 1024), ckk = *(const f32x4*)(ps + VKK * 1024), cbb = *(const f32x4*)(ps + VB * 1024),
            ckd = *(const f32x4*)(ps + VKD * 1024), crr = *(const f32x4*)(ps + VR * 1024);
      f32x2 cvv = *(const f32x2*)pv;
#pragma unroll
      for (int ii = 0; ii < 16; ++ii) {
        f32x4 nw = cw, nkk = ckk, nbb = cbb, nkd = ckd, nrr = crr; f32x2 nvv = cvv;
        if (ii < 15) {
          ps += inc; pv += inc;
          nw = *(const f32x4*)(ps + VW * 1024); nkk = *(const f32x4*)(ps + VKK * 1024); nbb = *(const f32x4*)(ps + VB * 1024);
          nkd = *(const f32x4*)(ps + VKD * 1024); nrr = *(const f32x4*)(ps + VR * 1024); nvv = *(const f32x2*)pv;
        }
        __builtin_amdgcn_sched_barrier(0x7);
        const f32x2 kk0 = {ckk[0], ckk[1]}, kk1 = {ckk[2], ckk[3]}, w0 = {cw[0], cw[1]}, w1 = {cw[2], cw[3]};
        const f32x2 b0 = {cbb[0], cbb[1]}, b1 = {cbb[2], cbb[3]}, kd0 = {ckd[0], ckd[1]}, kd1 = {ckd[2], ckd[3]};
        const f32x2 r0 = {crr[0], crr[1]}, r1 = {crr[2], crr[3]};
        const f32x2 p0 = S0[0] * kk0 + S0[1] * kk1, p1 = S1[0] * kk0 + S1[1] * kk1;
        const f32x2 u00 = S0[0] * w0 + kd0 * cvv[0], u01 = S0[1] * w1 + kd1 * cvv[0];
        const f32x2 u10 = S1[0] * w0 + kd0 * cvv[1], u11 = S1[1] * w1 + kd1 * cvv[1];
        const float q0 = red16(p0[0] + p0[1]), q1 = red16(p1[0] + p1[1]);
        S0[0] = u00 - b0 * q0; S0[1] = u01 - b1 * q0;
        S1[0] = u10 - b0 * q1; S1[1] = u11 - b1 * q1;
        const f32x2 y0 = S0[0] * r0 + S0[1] * r1, y1 = S1[0] * r0 + S1[1] * r1;
        *(f32x2*)py = (f32x2){y0[0] + y0[1], y1[0] + y1[1]};
        py += dir ? -512 : 512;
        cw = nw; ckk = nkk; cbb = nbb; ckd = nkd; crr = nrr; cvv = nvv;
      }
    }
    __syncthreads();
    {
      const int slo = chunk_lo(c);
      const float* yp = ybuf + (st_p * 16 + c4) * 32;
      f32x4 a = *(const f32x4*)yp;
#pragma unroll
      for (int i = 1; i < 8; ++i) a += *(const f32x4*)(yp + 4 * i);
      *(f32x2*)(p.Y + (size_t)dir * T_TOK * 384 + (size_t)(b * TB + slo + st_p) * 384 + hc + half * 32 + c4 * 2) = (f32x2){a[0] + a[2], a[1] + a[3]};
    }
    if (c + 1 < NCH) produce(c + 1);
    __syncthreads();
  }
}

DI int lat_tile(int i) { return (i >> 4) * 18 + 2 + (i & 15); }
DI bool xcd_tile(int bid, int G, int i, int MT, int NT, int& tm, int& tn) {
  if ((G & 7) || (MT & 7)) { const int t = bid + i * G; if (t >= MT * NT) return false; tm = t / NT; tn = t % NT; return true; }
  const int nbx = G >> 3, x = bid & 7, j = bid >> 3, MS = MT >> 3;
  const int q = j + nbx * i;
  if (q >= MS * NT) return false;
  const int full = NT >> 3, wl = NT & 7;
  int nb = q / (MS * 8), m, ni;
  if (nb < full) { const int rem = q - nb * MS * 8; m = rem >> 3; ni = rem & 7; }
  else { const int rem = q - full * MS * 8; nb = full; m = rem / wl; ni = rem % wl; }
  tm = x * MS + m; tn = nb * 8 + ni;
  return true;
}

template <int KSEL> DI void run_phase(const Params& p, int ph, char* lds) {
  const int bid = blockIdx.x, G = gridDim.x, tid = opaque_tid(), lane = tid & 63, wid = tid >> 6;
  if (ph == 0) {
    if (KSEL >= 0 && KSEL != 10) return;
    for (int t = bid; t < 384 + NCONV_W1 + 1; t += G) {
      if (t < 384) adaln_task(p, t, lds);
      else if (t < 384 + NCONV_W1) conv_w1_task(p, 0, t - 384, lds);
      else { for (int e = tid; e < 512; e += 256) { float cs, sn; rope_angle(e >> 3, e & 7, cs, sn); p.ROPE[2 * e] = cs; p.ROPE[2 * e + 1] = sn; } }
    }
    return;
  }
  if (KSEL == 10) return;
  const int l = (ph - 1) / 9, kq = (ph - 1) % 9, k = kq < 2 ? kq : kq + 1;
  const bool last = (l == 1);
  const int lb = ((G & 7) == 0) ? (bid & 7) * (G >> 3) + (bid >> 3) : bid;
  if (KSEL >= 0 && KSEL != 10 && k != (KSEL == 11 ? 4 : KSEL)) return;
  switch (k) {
    case 0:
      for (int i = bid * 256 + tid; i < 2 * T_TOK; i += G * 256) p.RSTD[i] = 0.f;
      modnorm_rows(p, l, 0, l == 0, false, bid * 4 + wid, G * 4, lane);
      break;
    case 1: {
      EpiP e{p.PA, p.PBC, p.RSTD};
      for (int i = 0, tm, tn; xcd_tile(bid, G, i, 144, 26, tm, tn); ++i) gemm_tile(p.HY, DM, p.Win, DM, DM, tm * 128, tn * 128, lds, e);
    } break;
    case 3: {
      const int nq = last ? 128 * 5 : 144 * 5;
      EpiQ eq{p.RSTD, p.q_nope_g + l * 64, p.q_rope_g + l * 32, p.ROPE, p.Q};
      EpiK ek{p.RSTD + T_TOK, p.k_nope_g + l * 64, p.Kt};
      EpiV ev{p.RSTD + T_TOK, p.VT};
      if (KSEL >= 0) {
        for (int t = bid; t < nq + 432 + 432 + T_TOK / 4; t += G) {
          if (t >= nq + 864) { prep_token(p, l, (t - nq - 864) * 4 + wid, lane); continue; }
          if (t < nq) { int i = t / 5; int tm = last ? lat_tile(i) : i; gemm_tile(p.PBC, LDPBC, p.Wuq, 768, 768, tm * 128, (t % 5) * 128, lds, eq); }
          else if (t < nq + 432) { int u = t - nq; gemm_tile(p.PBC + 768, LDPBC, p.WukvK, 256, 256, (u / 3) * 128, (u % 3) * 128, lds, ek); }
          else { int u = t - nq - 432; gemm_tile(p.WvT, 256, p.PBC + 768, LDPBC, 256, (u % 3) * 128, (u / 3) * 128, lds, ev); }
        }
      } else {
        for (int t = bid; t < T_TOK / 4; t += G) prep_token(p, l, t * 4 + wid, lane);
        volatile LAS unsigned* slot = (volatile LAS unsigned*)(lds + 65536 + 8);
        unsigned* qg = p.BAR + 3456   + 64 * l + 16;
        for (;;) {
          __syncthreads();
          if (tid == 0) *slot = __hip_atomic_fetch_add(qg, 1u, __ATOMIC_RELAXED, __HIP_MEMORY_SCOPE_AGENT);
          __syncthreads();
          const int t = (int)*slot;
          if (t >= nq + 864) break;
          if (t < nq) { int i = t / 5; int tm = last ? lat_tile(i) : i; gemm_tile(p.PBC, LDPBC, p.Wuq, 768, 768, tm * 128, (t % 5) * 128, lds, eq); }
          else if (t < nq + 432) { int u = t - nq; gemm_tile(p.PBC + 768, LDPBC, p.WukvK, 256, 256, (u / 3) * 128, (u % 3) * 128, lds, ek); }
          else { int u = t - nq - 432; gemm_tile(p.WvT, 256, p.PBC + 768, LDPBC, 256, (u % 3) * 128, (u / 3) * 128, lds, ev); }
        }
      }
    } break;
    case 4: {
      const int natt = 768 + (last ? 0 : 96);
      if (KSEL != 11) { if (bid < 192) { scan_task(p, l, bid / 24, (bid % 24) >> 2, (bid >> 1) & 1, bid & 1, lds); break; } if (KSEL == 4) break; }
      const int aoff = KSEL == 11 ? 0 : 192;
      if (KSEL == 11) {
        for (int t = bid; t < natt + NCONV_FF; t += G) {
          if (t < 768) { int bh = t >> 4, qb = t & 15; attn_task(p, bh / 6, bh % 6, NCTX + qb * 128, 0, TB, lds); }
          else if (t < natt) { int u = t - 768; int bh = u >> 1, qb = u & 1; attn_task(p, bh / 6, bh % 6, qb * 128, 0, NCTX, lds); }
          else conv_ff_task(p, l, t - natt, lds);
        }
      } else {
        volatile LAS unsigned* slot = (volatile LAS unsigned*)(lds + 65536 + 8);
        for (;;) {
          __syncthreads();
          if (tid == 0) *slot = __hip_atomic_fetch_add(p.BAR + 3456   + 64 * l, 1u, __ATOMIC_RELAXED, __HIP_MEMORY_SCOPE_AGENT);
          __syncthreads();
          const int t = (int)*slot;
          if (t >= natt + NCONV_FF) break;
          if (t < 768) { int bh = t >> 4, qb = t & 15; attn_task(p, bh / 6, bh % 6, NCTX + qb * 128, 0, TB, lds); }
          else if (t < natt) { int u = t - 768; int bh = u >> 1, qb = u & 1; attn_task(p, bh / 6, bh % 6, qb * 128, 0, NCTX, lds); }
          else conv_ff_task(p, l, t - natt, lds);
        }
      }
    } break;
    case 5: {
      EpiPost e{p.Y, p.BON, p.tshift_mu + (size_t)l * 2 * LDPA, p.lnx_g + l * 384, p.lnx_b + l * 384, p.PA, p.HY};
      const int nm = last ? 128 : 144;
      for (int t = bid; t < nm * 3; t += G) { int i = t / 3; int tm = last ? lat_tile(i) : i; gemm_tile(p.TG, 128, p.Wgate, 128, 128, tm * 128, (t % 3) * 128, lds, e); }
    } break;
    case 6: {
      EpiRes e{&p, l, l == 0, 2 * 1024};
      const int nm = last ? 128 : 144;
      for (int i = 0, tm, tn; xcd_tile(bid, G, i, nm, 8, tm, tn); ++i) gemm_tile(p.HY, DM, p.Wout, DM, DM, (last ? lat_tile(tm) : tm) * 128, tn * 128, lds, e);
    } break;
    case 7:
      modnorm_rows(p, l, 1, false, last, bid * 4 + wid, G * 4, lane);
      break;
    case 8: {
      EpiFfnIn e{p.ACT};
      const int nm = last ? 128 : 144;
      const int nconv = last ? 0 : NCONV_W1;
      for (int i = 0, tm, tn; xcd_tile(bid, G, i, nm, 44, tm, tn); ++i) gemm_tile(p.HY, DM, p.Wffi, DM, DM, (last ? lat_tile(tm) : tm) * 128, tn * 128, lds, e);
      for (int t = bid; t < nconv; t += G) conv_w1_task(p, 1, t, lds);
    } break;
    case 9: {
      EpiRes e{&p, l, false, 5 * 1024};
      const int nm = last ? 128 : 144;
      for (int i = 0, tm, tn; xcd_tile(bid, G, i, nm, 8, tm, tn); ++i) gemm_tile(p.ACT, 2816, p.Wffo, 2816, 2816, (last ? lat_tile(tm) : tm) * 128, tn * 128, lds, e);
    } break;
  }
}


#define XB_TMO      128
#define XB_XCNT(j)  (256  + 64 * (j))
#define XB_XSUB(j)  (1280 + 64 * (j))
#define XB_XGEN(j)  (2304 + 64 * (j))
#define XB_TOP      3328
#define XB_TOPGEN   3392
#define XCD_BAR_WORDS 3456
#define XB_SPIN_CAP (1u << 20)
DI unsigned xb_ld(unsigned* p) { return __hip_atomic_load(p, __ATOMIC_RELAXED, __HIP_MEMORY_SCOPE_AGENT); }
DI unsigned xb_add(unsigned* p, unsigned v) { return __hip_atomic_fetch_add(p, v, __ATOMIC_RELAXED, __HIP_MEMORY_SCOPE_AGENT); }
DI unsigned xb_xcc_id() { return (unsigned)__builtin_amdgcn_s_getreg((3 << 11) | 20) & 0xFu; }
#define XB_SPIN(cond, bar) do { unsigned _sp = 0; while (cond) { __builtin_amdgcn_s_sleep(1); \
    if ((++_sp & 255u) == 0u) { if (xb_ld(&(bar)[XB_TMO])) break; if (_sp > XB_SPIN_CAP) { atomicAdd(&(bar)[XB_TMO], 1u); break; } } } } while (0)
struct XcdBarrier { unsigned* bar; unsigned x; volatile LAS unsigned* st; };
DI XcdBarrier xcd_barrier_post(unsigned* bar, volatile LAS unsigned* st) {
  XcdBarrier b; b.bar = bar; b.x = xb_xcc_id(); b.st = st;
  if (threadIdx.x == 0) (void)xb_add(&bar[XB_XCNT(b.x)], 1u);
  return b;
}
DI void xcd_barrier_complete(unsigned* bar, unsigned x, unsigned& nloc, unsigned& nx) {
  const unsigned G = gridDim.x * gridDim.y * gridDim.z;
  unsigned sum, cnt, mine, sp = 0u;
  for (;;) {
    sum = 0u; cnt = 0u; mine = 0u;
#pragma unroll
    for (unsigned j = 0; j < 16; ++j) { const unsigned c = xb_ld(&bar[XB_XCNT(j)]); sum += c; cnt += (c > 0u) ? 1u : 0u; mine = (j == x) ? c : mine; }
    if (sum == G) break;
    __builtin_amdgcn_s_sleep(1);
    if ((++sp & 255u) == 0u) { if (xb_ld(&bar[XB_TMO])) break; if (sp > XB_SPIN_CAP) { atomicAdd(&bar[XB_TMO], 1u); break; } }
  }
  nloc = mine > 0u ? mine : 1u; nx = cnt > 0u ? cnt : 1u;
}
DI void xcd_barrier(const XcdBarrier& b) {
  asm volatile("s_waitcnt vmcnt(0)" ::: "memory");
  __syncthreads();
  if (threadIdx.x == 0) {
    unsigned* bar = b.bar;
    __builtin_amdgcn_s_waitcnt(0);
    unsigned nloc = b.st[0], nx = b.st[1];
    if (nloc == 0u) { xcd_barrier_complete(bar, b.x, nloc, nx); b.st[0] = nloc; b.st[1] = nx; }
    const unsigned old = xb_add(&bar[XB_XSUB(b.x)], 1u);
    const unsigned gen = old / nloc;
    if (old + 1u == (gen + 1u) * nloc) {
      __builtin_amdgcn_fence(__ATOMIC_RELEASE, "agent");
      asm volatile("s_waitcnt vmcnt(0)" ::: "memory");
      const unsigned og = xb_add(&bar[XB_TOP], 1u);
      const unsigned tg = og / nx;
      if (og + 1u == (tg + 1u) * nx) xb_add(&bar[XB_TOPGEN], 1u);
      else XB_SPIN(xb_ld(&bar[XB_TOPGEN]) == tg, bar);
      __builtin_amdgcn_fence(__ATOMIC_ACQUIRE, "agent");
      xb_add(&bar[XB_XGEN(b.x)], 1u);
      asm volatile("s_waitcnt vmcnt(0)" ::: "memory");
    } else {
      XB_SPIN(xb_ld(&bar[XB_XGEN(b.x)]) == gen, bar);
      __builtin_amdgcn_fence(__ATOMIC_ACQUIRE, "agent");
      asm volatile("s_waitcnt vmcnt(0)" ::: "memory");
    }
  }
  __syncthreads();
}

constexpr int NPHASE = 19;
#if !MULTI_LAUNCH
__global__ void __launch_bounds__(256, 2) mega(Params p, int ph_lo, int ph_hi) {
  __shared__ __attribute__((aligned(16))) char lds[65536 + 16];
  cg::grid_group grid = cg::this_grid();
  volatile LAS unsigned* st = (volatile LAS unsigned*)(lds + 65536);
  if (threadIdx.x == 0) { st[0] = 0u; st[1] = 0u; }
  __syncthreads();
  XcdBarrier xb = xcd_barrier_post(p.BAR, st);
  for (int ph = ph_lo; ph < ph_hi; ++ph) {
    if (ph > ph_lo) xcd_barrier(xb);
    run_phase<-1>(p, ph, lds);
  }
  if (ph_hi > NPHASE) grid.sync();
}
#endif
template <int KSEL> __global__ void __launch_bounds__(256, 2) phase_k(Params p, int ph) {
  __shared__ __attribute__((aligned(16))) char lds[65536];
  run_phase<KSEL>(p, ph, lds);
}

extern "C" void kernel_launch(void* const* d_in, const int* in_sizes, int n_in, void* d_out, int out_size, void* d_ws, size_t ws_size, hipStream_t stream) {
  static int grid_blocks = 0;
  if (!grid_blocks) {
    int dev = 0, cus = 0, per_cu = 0;
    (void)hipGetDevice(&dev);
    (void)hipDeviceGetAttribute(&cus, hipDeviceAttributeMultiprocessorCount, dev);
    #if MULTI_LAUNCH
    per_cu = 2;
#else
    (void)hipOccupancyMaxActiveBlocksPerMultiprocessor(&per_cu, mega, 256, 0);
#endif
    if (per_cu > 2) per_cu = 2;
    if (per_cu < 1) per_cu = 1;
    grid_blocks = cus * per_cu;
  }
  Params p{};
  const float** pin = (const float**)&p.x;
  for (int i = 0; i < 32; ++i) pin[i] = (const float*)d_in[i];
  p.out = (float*)d_out;
  char* w = (char*)d_ws;
  size_t off = 0;
  auto take = [&](size_t bytes) { char* r = w + off; off += (bytes + 255) & ~(size_t)255; return r; };
  p.BAR = (unsigned*)take((XCD_BAR_WORDS + 128) * 4);
  p.MOD = (float*)take(2 * 9 * 6144 * 4);
  p.ROPE = (float*)take(64 * 8 * 2 * 4);
  p.RSTD = (float*)take(2 * (size_t)T_TOK * 4);
  p.BON = (float*)take(2 * (size_t)T_TOK * 6 * 4);
  p.XCTX = (float*)take((size_t)8 * NCTX * DM * 4);
  p.Win = (bf16_t*)take((size_t)3328 * 1024 * 2);
  p.Wuq = (bf16_t*)take((size_t)640 * 768 * 2);
  p.WukvK = (bf16_t*)take((size_t)384 * 256 * 2);
  p.WvT = (bf16_t*)take((size_t)384 * 256 * 2);
  p.Wgate = (bf16_t*)take((size_t)384 * 128 * 2);
  p.Wdecay = (bf16_t*)take((size_t)2 * 384 * 64 * 2);
  p.Wicl = (bf16_t*)take((size_t)2 * 384 * 64 * 2);
  p.Wout = (bf16_t*)take((size_t)1024 * 1024 * 2);
  p.HY = (bf16_t*)take((size_t)T_TOK * DM * 2);
  p.TW = (bf16_t*)take((size_t)T_TOK * 64 * 2);
  p.TA = (bf16_t*)take((size_t)T_TOK * 64 * 2);
  p.TG = (bf16_t*)take((size_t)T_TOK * 128 * 2);
  char* qkv = take((size_t)T_TOK * 576 * 2 * 2 + (size_t)384 * T_TOK * 2);
  p.Q = (bf16_t*)qkv;
  p.Kt = (bf16_t*)(qkv + (size_t)T_TOK * 576 * 2);
  p.VT = (bf16_t*)(qkv + (size_t)T_TOK * 576 * 2 * 2);
  p.Wffi = (bf16_t*)take((size_t)5632 * 1024 * 2);
  p.Wffo = (bf16_t*)take((size_t)2816 * 1024 * 2);
  char* pr = take((size_t)T_TOK * (LDPA + LDPBC) * 2);
  p.PA = (bf16_t*)pr;
  p.PBC = (bf16_t*)(pr + (size_t)T_TOK * LDPA * 2);
  p.Y = (float*)p.PBC;
  p.ACT = (bf16_t*)pr;
  if (off > ws_size) { fprintf(stderr, "workspace too small: need %zu have %zu\n", off, ws_size); }
#if MULTI_LAUNCH
  hipLaunchKernelGGL(phase_k<10>, dim3(grid_blocks), dim3(256), 0, stream, p, 0);
  for (int l = 0; l < 2; ++l) {
    const int b0 = 1 + 10 * l;
    hipLaunchKernelGGL(phase_k<0>, dim3(grid_blocks), dim3(256), 0, stream, p, b0 + 0);
    hipLaunchKernelGGL(phase_k<1>, dim3(grid_blocks), dim3(256), 0, stream, p, b0 + 1);
    hipLaunchKernelGGL(phase_k<2>, dim3(grid_blocks), dim3(256), 0, stream, p, b0 + 2);
    hipLaunchKernelGGL(phase_k<3>, dim3(grid_blocks), dim3(256), 0, stream, p, b0 + 3);
    hipLaunchKernelGGL(phase_k<4>, dim3(192), dim3(256), 0, stream, p, b0 + 4);
    hipLaunchKernelGGL(phase_k<11>, dim3(grid_blocks), dim3(256), 0, stream, p, b0 + 4);
    hipLaunchKernelGGL(phase_k<5>, dim3(grid_blocks), dim3(256), 0, stream, p, b0 + 5);
    hipLaunchKernelGGL(phase_k<6>, dim3(grid_blocks), dim3(256), 0, stream, p, b0 + 6);
    hipLaunchKernelGGL(phase_k<7>, dim3(grid_blocks), dim3(256), 0, stream, p, b0 + 7);
    hipLaunchKernelGGL(phase_k<8>, dim3(grid_blocks), dim3(256), 0, stream, p, b0 + 8);
    hipLaunchKernelGGL(phase_k<9>, dim3(grid_blocks), dim3(256), 0, stream, p, b0 + 9);
  }
#else
  int lo = 0, hi = NPHASE;
  void* args[] = {&p, &lo, &hi};
  (void)hipMemsetAsync(p.BAR, 0, (XCD_BAR_WORDS + 128) * 4, stream);
  hipError_t e = hipLaunchCooperativeKernel((void*)mega, dim3(grid_blocks), dim3(256), args, 0, stream);
  if (e != hipSuccess) fprintf(stderr, "cooperative launch failed: %s (grid %d)\n", hipGetErrorString(e), grid_blocks);
#endif
}
```

```cpp
#include <hip/hip_runtime.h>
#include <hip/hip_cooperative_groups.h>
#include <cstdio>
namespace cg = cooperative_groups;

#ifndef MULTI_LAUNCH
#define MULTI_LAUNCH 0
#endif

#define DI __device__ __forceinline__
typedef unsigned short bf16_t;
typedef short bf16x8 __attribute__((ext_vector_type(8)));
typedef short s16x4 __attribute__((ext_vector_type(4)));
typedef float f32x4 __attribute__((ext_vector_type(4)));
typedef float f32x2 __attribute__((ext_vector_type(2)));
typedef float f32x16 __attribute__((ext_vector_type(16)));
typedef unsigned u32x4 __attribute__((ext_vector_type(4)));
typedef unsigned u32x2 __attribute__((ext_vector_type(2)));
#define LAS __attribute__((address_space(3)))

constexpr int T_TOK = 18432, TB = 2304, NCTX = 256, NLAT = 2048, DM = 1024;
constexpr int LDPA = 1408, LDPBC = 1920;
constexpr float EPSF = 1e-6f;
constexpr float LOG_DECAY_SCALE = 0.606531f;
constexpr float GN_EPS = 64e-5f;
constexpr float QSCALE = 0.10206207261596577f * 1.4426950408889634f;

struct Params {
  const float *x, *c, *ctx, *c_ctx, *ada_w, *ada_b, *norm1_g, *norm2_g, *w_in, *tshift_mu, *decay_w0, *decay_up,
      *icl_a0, *icl_up, *gate_up, *k_k, *k_a, *r_k, *lnx_g, *lnx_b, *q_norm_g, *kv_norm_g, *w_uq, *w_ukv, *q_nope_g,
      *k_nope_g, *q_rope_g, *k_rope_g, *conv_w, *w_out, *w_ffn_in, *w_ffn_out;
  float* out;
  float *MOD, *RSTD, *BON, *XCTX, *Y, *ROPE;
  unsigned* BAR;
  bf16_t *Win, *Wuq, *WukvK, *WvT, *Wgate, *Wdecay, *Wicl, *Wout, *Wffi, *Wffo;
  bf16_t *HY, *TW, *TA, *TG, *Q, *Kt, *VT, *PA, *PBC, *ACT;
};

typedef __bf16 bf16v2 __attribute__((ext_vector_type(2)));
DI unsigned pk_bf16(float lo, float hi) { f32x2 v = {lo, hi}; bf16v2 b = __builtin_convertvector(v, bf16v2); return __builtin_bit_cast(unsigned, b); }
DI float bflo(unsigned u) { return __uint_as_float(u << 16); }
DI float bfhi(unsigned u) { return __uint_as_float(u & 0xffff0000u); }
DI int opaque_tid() { int t = threadIdx.x; asm volatile("" : "+v"(t)); return t; }
DI float sigmoidf_(float x) { return __builtin_amdgcn_rcpf(1.f + __expf(-x)); }
template <int CTRL> DI float dppf(float x) { return __builtin_bit_cast(float, __builtin_amdgcn_update_dpp(0, __builtin_bit_cast(int, x), CTRL, 0xf, 0xf, true)); }
DI float red8(float x) { x += dppf<0xB1>(x); x += dppf<0x4E>(x); x += dppf<0x141>(x); return x; }
DI float red16(float x) { x = red8(x); x += dppf<0x140>(x); return x; }
DI float red64(float x) { for (int o = 32; o > 0; o >>= 1) x += __shfl_xor(x, o); return x; }

DI void unpack8(u32x4 v, float* f) {
  f[0] = bflo(v[0]); f[1] = bfhi(v[0]); f[2] = bflo(v[1]); f[3] = bfhi(v[1]);
  f[4] = bflo(v[2]); f[5] = bfhi(v[2]); f[6] = bflo(v[3]); f[7] = bfhi(v[3]);
}
DI void unpack4(u32x2 v, float* f) { f[0] = bflo(v[0]); f[1] = bfhi(v[0]); f[2] = bflo(v[1]); f[3] = bfhi(v[1]); }

DI const float* xsrc_row(const Params& p, bool from_inputs, int b, int s) {
  if (from_inputs) return s < NCTX ? p.ctx + (size_t)(b * NCTX + s) * DM : p.x + (size_t)(b * NLAT + s - NCTX) * DM;
  return s < NCTX ? p.XCTX + (size_t)(b * NCTX + s) * DM : p.out + (size_t)(b * NLAT + s - NCTX) * DM;
}
DI float* xdst_row(const Params& p, int b, int s) {
  return s < NCTX ? p.XCTX + (size_t)(b * NCTX + s) * DM : p.out + (size_t)(b * NLAT + s - NCTX) * DM;
}

DI void adaln_task(const Params& p, int task, char* lds) {
  float* s = (float*)lds;
  float* red = s + 9 * 1024;
  const int l = task / 192, cgi = task % 192, tid = opaque_tid();
  for (int i = tid; i < 9 * 1024; i += 256) {
    int r = i >> 10, k = i & 1023;
    float v = r < 8 ? p.c[r * 1024 + k] : p.c_ctx[k];
    s[i] = v / (1.f + __expf(-v));
  }
  __syncthreads();
  const int kg = tid >> 5, cc = tid & 31, col = cgi * 32 + cc;
  float acc[9];
#pragma unroll
  for (int r = 0; r < 9; ++r) acc[r] = 0.f;
  const float* w = p.ada_w + (size_t)l * 1024 * 6144 + col;
  for (int k0 = kg; k0 < 1024; k0 += 128) {
    float wv[16];
#pragma unroll
    for (int u = 0; u < 16; ++u) wv[u] = w[(size_t)(k0 + 8 * u) * 6144];
#pragma unroll
    for (int u = 0; u < 16; ++u)
#pragma unroll
      for (int r = 0; r < 9; ++r) acc[r] += s[r * 1024 + k0 + 8 * u] * wv[u];
  }
#pragma unroll
  for (int r = 0; r < 9; ++r) red[(kg * 9 + r) * 32 + cc] = acc[r];
  __syncthreads();
  for (int i = tid; i < 9 * 32; i += 256) {
    int r = i >> 5, c2 = i & 31;
    float sum = 0.f;
    for (int g = 0; g < 8; ++g) sum += red[(g * 9 + r) * 32 + c2];
    p.MOD[(size_t)(l * 9 + r) * 6144 + cgi * 32 + c2] = sum + p.ada_b[l * 6144 + cgi * 32 + c2];
  }
  __syncthreads();
}

DI int colmap(int mode, int n, int nvalid) {
  switch (mode) {
    case 0: return n < nvalid ? n : -1;
    case 1: if (n < 384) return (n >> 6) * 96 + (n & 63); if (n < 576) return ((n - 384) >> 5) * 96 + 64 + ((n - 384) & 31); return -1;
    case 2: return (n >> 6) * 128 + (n & 63);
    case 3: return (n >> 6) * 128 + 64 + (n & 63);
    default: { int t64 = n >> 6, w = n & 63; return w < 32 ? t64 * 32 + w : 2816 + t64 * 32 + (w - 32); }
  }
}
DI void conv_tile(const float* src, int ld, int K, int mode, int nvalid, const float* kscale, bf16_t* dst, int tile, int ntn, char* lds) {
  float(*tl)[65] = (float(*)[65])lds;
  const int tk = tile / ntn, tn = tile % ntn, tid = opaque_tid(), k0 = tk * 64;
  {
    const int nn = tid & 63, kk0 = tid >> 6;
    const int sc = colmap(mode, tn * 64 + nn, nvalid);
#pragma unroll 4
    for (int i = 0; i < 16; ++i) {
      const int kk = kk0 + 4 * i;
      float v = 0.f;
      if (sc >= 0) { v = src[(size_t)(k0 + kk) * ld + sc]; if (kscale) v *= kscale[k0 + kk]; }
      tl[kk][nn] = v;
    }
  }
  __syncthreads();
  {
    const int kk2 = (tid & 31) * 2, nn2 = tid >> 5;
#pragma unroll
    for (int i = 0; i < 8; ++i) {
      const int nn = nn2 + 8 * i;
      *(unsigned*)(dst + (size_t)(tn * 64 + nn) * K + k0 + kk2) = pk_bf16(tl[kk2][nn], tl[kk2 + 1][nn]);
    }
  }
  __syncthreads();
}
constexpr int NCONV_W1 = 1292, NCONV_FF = 2112;
DI void conv_w1_task(const Params& p, int l, int t, char* lds) {
  if (t < 832) { conv_tile(p.w_in + (size_t)l * 1024 * 3232, 3232, 1024, 0, 3232, nullptr, p.Win, t, 52, lds); return; } t -= 832;
  if (t < 120) { conv_tile(p.w_uq + (size_t)l * 768 * 576, 576, 768, 1, 0, p.q_norm_g + l * 768, p.Wuq, t, 10, lds); return; } t -= 120;
  if (t < 24) { conv_tile(p.w_ukv + (size_t)l * 256 * 768, 768, 256, 2, 0, p.kv_norm_g + l * 256, p.WukvK, t, 6, lds); return; } t -= 24;
  if (t < 24) { conv_tile(p.w_ukv + (size_t)l * 256 * 768, 768, 256, 3, 0, p.kv_norm_g + l * 256, p.WvT, t, 6, lds); return; } t -= 24;
  if (t < 12) { conv_tile(p.gate_up + (size_t)l * 128 * 384, 384, 128, 0, 384, nullptr, p.Wgate, t, 6, lds); return; } t -= 12;
  if (t < 12) { int d = t / 6; conv_tile(p.decay_up + (size_t)(l * 2 + d) * 64 * 384, 384, 64, 0, 384, nullptr, p.Wdecay + d * 384 * 64, t % 6, 6, lds); return; } t -= 12;
  if (t < 12) { int d = t / 6; conv_tile(p.icl_up + (size_t)(l * 2 + d) * 64 * 384, 384, 64, 0, 384, nullptr, p.Wicl + d * 384 * 64, t % 6, 6, lds); return; } t -= 12;
  conv_tile(p.w_out + (size_t)l * 1024 * 1024, 1024, 1024, 0, 1024, nullptr, p.Wout, t, 16, lds);
}
DI void conv_ff_task(const Params& p, int l, int t, char* lds) {
  if (t < 1408) { conv_tile(p.w_ffn_in + (size_t)l * 1024 * 5632, 5632, 1024, 4, 0, nullptr, p.Wffi, t, 88, lds); return; } t -= 1408;
  conv_tile(p.w_ffn_out + (size_t)l * 2816 * 1024, 1024, 2816, 0, 1024, nullptr, p.Wffo, t, 16, lds);
}

DI void modnorm_rows(const Params& p, int l, int which  , bool from_inputs, bool skip_ctx, int w0, int wstride, int lane) {
  const float* g = (which ? p.norm2_g : p.norm1_g) + l * DM;
  f32x4 gg[4];
#pragma unroll
  for (int i = 0; i < 4; ++i) gg[i] = *(const f32x4*)(g + i * 256 + lane * 4);
  const int nrows = skip_ctx ? 8 * NLAT : T_TOK;
  auto rowof = [&](int i) -> int { return skip_ctx ? (i / NLAT) * TB + NCTX + (i % NLAT) : i; };
  int i = w0;
  if (i >= nrows) return;
  f32x4 vn[4];
  {
    const int row = rowof(i); const float* src = xsrc_row(p, from_inputs, row / TB, row % TB);
#pragma unroll
    for (int q = 0; q < 4; ++q) vn[q] = *(const f32x4*)(src + q * 256 + lane * 4);
  }
  for (; i < nrows; i += wstride) {
    const int row = rowof(i); const int b = row / TB, s = row % TB;
    f32x4 v[4];
#pragma unroll
    for (int q = 0; q < 4; ++q) v[q] = vn[q];
    if (i + wstride < nrows) {
      const int rn = rowof(i + wstride); const float* src = xsrc_row(p, from_inputs, rn / TB, rn % TB);
#pragma unroll
      for (int q = 0; q < 4; ++q) vn[q] = *(const f32x4*)(src + q * 256 + lane * 4);
    }
    const float* mod = p.MOD + (size_t)(l * 9 + (s < NCTX ? 8 : b)) * 6144 + (which ? 3 * 1024 : 0);
    f32x4 sh[4], sc[4];
#pragma unroll
    for (int q = 0; q < 4; ++q) { sh[q] = *(const f32x4*)(mod + q * 256 + lane * 4); sc[q] = *(const f32x4*)(mod + 1024 + q * 256 + lane * 4); }
    float ss = 0.f;
#pragma unroll
    for (int q = 0; q < 4; ++q) ss += v[q][0] * v[q][0] + v[q][1] * v[q][1] + v[q][2] * v[q][2] + v[q][3] * v[q][3];
    ss = red64(ss);
    const float rs = rsqrtf(ss * (1.f / 1024.f) + EPSF);
    bf16_t* dst = p.HY + (size_t)row * DM;
#pragma unroll
    for (int q = 0; q < 4; ++q) {
      float o[4];
#pragma unroll
      for (int j = 0; j < 4; ++j) o[j] = (v[q][j] * rs * gg[q][j]) * (1.f + sc[q][j]) + sh[q][j];
      u32x2 w = {pk_bf16(o[0], o[1]), pk_bf16(o[2], o[3])};
      *(u32x2*)(dst + q * 256 + lane * 4) = w;
    }
  }
}

template <class Epi>
DI void gemm_tile(const bf16_t* __restrict__ A, int lda, const bf16_t* __restrict__ Bt, int ldb, int K, int row0, int col0, char* lds, const Epi& epi) {
  const int tid = opaque_tid(), lane = tid & 63, wid = tid >> 6, wr = wid >> 1, wc = wid & 1, fr = lane & 15, fq = lane >> 4;
  const bf16_t* ag[4];
  const bf16_t* bg[4];
#pragma unroll
  for (int i = 0; i < 4; ++i) {
    const int id = i * 256 + tid, r = id >> 3, cp = id & 7, c = cp ^ ((r >> 1) & 7);
    ag[i] = A + (size_t)(row0 + r) * lda + c * 8;
    bg[i] = Bt + (size_t)(col0 + r) * ldb + c * 8;
  }
  f32x4 acc[4][4];
#pragma unroll
  for (int m = 0; m < 4; ++m)
#pragma unroll
    for (int n = 0; n < 4; ++n) acc[m][n] = (f32x4){0.f, 0.f, 0.f, 0.f};
  const int KT = K >> 6;
  auto stage_a = [&](int kt, int buf) {
    char* sa = lds + buf * 32768;
#pragma unroll
    for (int i = 0; i < 4; ++i)
      __builtin_amdgcn_global_load_lds((const void __attribute__((address_space(1)))*)(ag[i] + kt * 64), (void LAS*)(sa + (i * 256 + tid) * 16), 16, 0, 0);
  };
  auto stage_b = [&](int kt, int buf) {
    char* sb = lds + buf * 32768 + 16384;
#pragma unroll
    for (int i = 0; i < 4; ++i)
      __builtin_amdgcn_global_load_lds((const void __attribute__((address_space(1)))*)(bg[i] + kt * 64), (void LAS*)(sb + (i * 256 + tid) * 16), 16, 0, 0);
  };
  __syncthreads();
  stage_a(0, 0); stage_b(0, 0);
  const int swz = fr >> 1;
  for (int kt = 0; kt < KT; ++kt) {
    asm volatile("s_waitcnt vmcnt(0)" ::: "memory");
    __syncthreads();
    const char* sa = lds + (kt & 1) * 32768 + (wr * 64 + fr) * 128;
    const char* sb = lds + (kt & 1) * 32768 + 16384 + (wc * 64 + fr) * 128;
#pragma unroll
    for (int kk = 0; kk < 2; ++kk) {
      if (kt + 1 < KT) { if (kk == 0) stage_a(kt + 1, (kt + 1) & 1); else stage_b(kt + 1, (kt + 1) & 1); }
      bf16x8 a[4], b[4];
      const int co = ((kk * 4 + fq) ^ swz) * 16;
#pragma unroll
      for (int m = 0; m < 4; ++m) a[m] = *(const bf16x8*)(sa + m * 2048 + co);
#pragma unroll
      for (int n = 0; n < 4; ++n) b[n] = *(const bf16x8*)(sb + n * 2048 + co);
#pragma unroll
      for (int m = 0; m < 4; ++m)
#pragma unroll
        for (int n = 0; n < 4; ++n) acc[m][n] = __builtin_amdgcn_mfma_f32_16x16x32_bf16(b[n], a[m], acc[m][n], 0, 0, 0);
    }
  }
  epi(acc, row0 + wr * 64, col0 + wc * 64, fr, fq);
}

struct EpiP {
  bf16_t *PA, *PBC; float* SSQ;
  DI void operator()(const f32x4 (&acc)[4][4], int r0, int c0, int fr, int fq) const {
    bf16_t* base; int ld, cb;
    if (c0 < LDPA) { base = PA; ld = LDPA; cb = c0; } else { base = PBC; ld = LDPBC; cb = c0 - LDPA; }
    if (c0 >= LDPA && cb < 1024) {
      float* dst = SSQ + (cb < 768 ? 0 : T_TOK);
#pragma unroll
      for (int m = 0; m < 4; ++m) {
        float ss = 0.f;
#pragma unroll
        for (int n = 0; n < 4; ++n)
#pragma unroll
          for (int j = 0; j < 4; ++j) ss += acc[m][n][j] * acc[m][n][j];
        ss += __shfl_xor(ss, 16); ss += __shfl_xor(ss, 32);
        if (fq == 0) atomicAdd(dst + r0 + m * 16 + fr, ss);
      }
    }
#pragma unroll
    for (int m = 0; m < 4; ++m)
#pragma unroll
      for (int n = 0; n < 4; ++n) {
        u32x2 v = {pk_bf16(acc[m][n][0], acc[m][n][1]), pk_bf16(acc[m][n][2], acc[m][n][3])};
        *(u32x2*)(base + (size_t)(r0 + m * 16 + fr) * ld + cb + n * 16 + fq * 4) = v;
      }
  }
};

DI void rope_angle(int pos, int i, float& cs, float& sn) {
  const float invf = __builtin_amdgcn_exp2f(-(float)i * (13.287712379549449f / 8.f));
  float ang = (float)pos * invf;
  float n = rintf(ang * 0.15915494309189535f);
  float r = fmaf(-n, 6.28125f, ang);
  r = fmaf(-n, 1.9353071795864769e-3f, r);
  cs = __cosf(r); sn = __sinf(r);
}

struct EpiQ {
  const float *rstd, *gn, *gr, *rope; bf16_t* Q;
  DI void operator()(const f32x4 (&acc)[4][4], int r0, int c0, int fr, int fq) const {
    if (c0 >= 576) return;
    if (c0 < 384) {
      const int h = c0 >> 6;
#pragma unroll
      for (int m = 0; m < 4; ++m) {
        const int row = r0 + m * 16 + fr; const float rs = rsqrtf(rstd[row] * (1.f / 768.f) + EPSF);
        float ss = 0.f;
#pragma unroll
        for (int n = 0; n < 4; ++n)
#pragma unroll
          for (int j = 0; j < 4; ++j) { float v = acc[m][n][j] * rs; ss += v * v; }
        ss += __shfl_xor(ss, 16); ss += __shfl_xor(ss, 32);
        const float inv = rsqrtf(ss * (1.f / 64.f) + EPSF) * rs * QSCALE;
        const int b = row / TB, s = row % TB;
        bf16_t* dst = Q + ((size_t)(b * 6 + h) * TB + s) * 96;
#pragma unroll
        for (int n = 0; n < 4; ++n) {
          const int d = n * 16 + fq * 4; f32x4 g = *(const f32x4*)(gn + d);
          u32x2 v = {pk_bf16(acc[m][n][0] * inv * g[0], acc[m][n][1] * inv * g[1]), pk_bf16(acc[m][n][2] * inv * g[2], acc[m][n][3] * inv * g[3])};
          *(u32x2*)(dst + d) = v;
        }
      }
    } else {
#pragma unroll
      for (int m = 0; m < 4; ++m) {
        const int row = r0 + m * 16 + fr; const float rs = rsqrtf(rstd[row] * (1.f / 768.f) + EPSF);
        const int b = row / TB, s = row % TB; const bool lat = s >= NCTX; const int sp = s - NCTX;
#pragma unroll
        for (int hh = 0; hh < 2; ++hh) {
          const int h = ((c0 - 384) >> 5) + hh;
          float ss = 0.f;
#pragma unroll
          for (int nn = 0; nn < 2; ++nn)
#pragma unroll
            for (int j = 0; j < 4; ++j) { float v = acc[m][hh * 2 + nn][j] * rs; ss += v * v; }
          ss += __shfl_xor(ss, 16); ss += __shfl_xor(ss, 32);
          const float inv = rsqrtf(ss * (1.f / 32.f) + EPSF) * rs;
          bf16_t* dst = Q + ((size_t)(b * 6 + h) * TB + s) * 96 + 64;
#pragma unroll
          for (int nn = 0; nn < 2; ++nn) {
            const int d = nn * 16 + fq * 4; f32x4 g = *(const f32x4*)(gr + d);
            float o[4];
#pragma unroll
            for (int j = 0; j < 4; ++j) {
              float val = acc[m][hh * 2 + nn][j] * inv * g[j];
              float partner = __shfl_xor(val, 32);
              if (lat) {
                const float* rt = rope + ((nn == 0 ? (sp >> 6) : (sp & 63)) * 8 + ((fq * 4 + j) & 7)) * 2; const float cs = rt[0], sn = rt[1];
                val = fq < 2 ? val * cs - partner * sn : val * cs + partner * sn;
              }
              o[j] = val * QSCALE;
            }
            u32x2 v = {pk_bf16(o[0], o[1]), pk_bf16(o[2], o[3])};
            *(u32x2*)(dst + d) = v;
          }
        }
      }
    }
  }
};

struct EpiK {
  const float *rstd, *gk; bf16_t* Kt;
  DI void operator()(const f32x4 (&acc)[4][4], int r0, int c0, int fr, int fq) const {
    const int h = c0 >> 6;
#pragma unroll
    for (int m = 0; m < 4; ++m) {
      const int row = r0 + m * 16 + fr; const float rs = rsqrtf(rstd[row] * (1.f / 256.f) + EPSF);
      float ss = 0.f;
#pragma unroll
      for (int n = 0; n < 4; ++n)
#pragma unroll
        for (int j = 0; j < 4; ++j) { float v = acc[m][n][j] * rs; ss += v * v; }
      ss += __shfl_xor(ss, 16); ss += __shfl_xor(ss, 32);
      const float inv = rsqrtf(ss * (1.f / 64.f) + EPSF) * rs;
      const int b = row / TB, s = row % TB;
      bf16_t* dst = Kt + ((size_t)(b * 6 + h) * TB + s) * 96;
#pragma unroll
      for (int n = 0; n < 4; ++n) {
        const int d = n * 16 + fq * 4; f32x4 g = *(const f32x4*)(gk + d);
        u32x2 v = {pk_bf16(acc[m][n][0] * inv * g[0], acc[m][n][1] * inv * g[1]), pk_bf16(acc[m][n][2] * inv * g[2], acc[m][n][3] * inv * g[3])};
        *(u32x2*)(dst + d) = v;
      }
    }
  }
};

struct EpiV {
  const float* rstd; bf16_t* VT;
  DI void operator()(const f32x4 (&acc)[4][4], int r0, int c0, int fr, int fq) const {
#pragma unroll
    for (int m = 0; m < 4; ++m)
#pragma unroll
      for (int n = 0; n < 4; ++n) {
        const int row = r0 + m * 16 + fr, col = c0 + n * 16 + fq * 4;
        f32x4 rs = *(const f32x4*)(rstd + col);
#pragma unroll
        for (int j = 0; j < 4; ++j) rs[j] = rsqrtf(rs[j] * (1.f / 256.f) + EPSF);
        u32x2 v = {pk_bf16(acc[m][n][0] * rs[0], acc[m][n][1] * rs[1]), pk_bf16(acc[m][n][2] * rs[2], acc[m][n][3] * rs[3])};
        *(u32x2*)(VT + (size_t)row * T_TOK + col) = v;
      }
  }
};

struct EpiPost {
  const float *Y, *BON, *mu, *lnx_g, *lnx_b; const bf16_t* PA; bf16_t* YC;
  DI void operator()(const f32x4 (&acc)[4][4], int r0, int c0, int fr, int fq) const {
    const int h = c0 >> 6;
#pragma unroll
    for (int m = 0; m < 4; ++m) {
      const int row = r0 + m * 16 + fr; const int s = row % TB;
      const bool hasprev = (s != 0 && s != NCTX), hasnext = (s != NCTX - 1 && s != TB - 1);
      f32x4 y[4];
      float s1 = 0.f;
#pragma unroll
      for (int n = 0; n < 4; ++n) {
        const size_t o = (size_t)row * 384 + c0 + n * 16 + fq * 4;
        y[n] = *(const f32x4*)(Y + o) + *(const f32x4*)(Y + (size_t)T_TOK * 384 + o);
        s1 += y[n][0] + y[n][1] + y[n][2] + y[n][3];
      }
      s1 += __shfl_xor(s1, 16); s1 += __shfl_xor(s1, 32);
      const float mean = s1 * (1.f / 64.f);
      float s2 = 0.f;
#pragma unroll
      for (int n = 0; n < 4; ++n)
#pragma unroll
        for (int j = 0; j < 4; ++j) { float d = y[n][j] - mean; s2 += d * d; }
      s2 += __shfl_xor(s2, 16); s2 += __shfl_xor(s2, 32);
      const float rstdv = rsqrtf(s2 * (1.f / 64.f) + GN_EPS);
      const float bon = BON[(size_t)row * 6 + h] + BON[(size_t)T_TOK * 6 + (size_t)row * 6 + h];
#pragma unroll
      for (int n = 0; n < 4; ++n) {
        const int col = c0 + n * 16 + fq * 4;
        const bf16_t* pv = PA + (size_t)row * LDPA + 768 + col;
        float vc[4], vp[4] = {0.f, 0.f, 0.f, 0.f}, vn[4] = {0.f, 0.f, 0.f, 0.f};
        unpack4(*(const u32x2*)pv, vc);
        if (hasprev) unpack4(*(const u32x2*)(pv - LDPA), vp);
        if (hasnext) unpack4(*(const u32x2*)(pv + LDPA), vn);
        f32x4 m0 = *(const f32x4*)(mu + 768 + col), m1 = *(const f32x4*)(mu + LDPA + 768 + col);
        f32x4 lg = *(const f32x4*)(lnx_g + col), lb = *(const f32x4*)(lnx_b + col);
        float o[4];
#pragma unroll
        for (int j = 0; j < 4; ++j) {
          const float v = vc[j] + m0[j] * (vp[j] - vc[j]) + m1[j] * (vn[j] - vc[j]);
          o[j] = ((y[n][j] - mean) * rstdv * lg[j] + lb[j] + bon * v) * acc[m][n][j];
        }
        u32x2 w = {pk_bf16(o[0], o[1]), pk_bf16(o[2], o[3])};
        *(u32x2*)(YC + (size_t)row * DM + col) = w;
      }
    }
  }
};

struct EpiRes {
  const Params* p; int l; bool from_inputs; int gate_off;
  DI void operator()(const f32x4 (&acc)[4][4], int r0, int c0, int fr, int fq) const {
#pragma unroll
    for (int m = 0; m < 4; ++m) {
      const int row = r0 + m * 16 + fr; const int b = row / TB, s = row % TB;
      const float* src = xsrc_row(*p, from_inputs, b, s);
      float* dst = xdst_row(*p, b, s);
      const float* gate = p->MOD + (size_t)(l * 9 + (s < NCTX ? 8 : b)) * 6144 + gate_off;
#pragma unroll
      for (int n = 0; n < 4; ++n) {
        const int col = c0 + n * 16 + fq * 4;
        f32x4 g = *(const f32x4*)(gate + col), xv = *(const f32x4*)(src + col);
        *(f32x4*)(dst + col) = xv + g * acc[m][n];
      }
    }
  }
};

struct EpiFfnIn {
  bf16_t* ACT;
  DI void operator()(const f32x4 (&acc)[4][4], int r0, int c0, int fr, int fq) const {
    const int cb = (c0 >> 6) * 32;
#pragma unroll
    for (int m = 0; m < 4; ++m)
#pragma unroll
      for (int n = 0; n < 2; ++n) {
        float o[4];
#pragma unroll
        for (int j = 0; j < 4; ++j) { float g = acc[m][n][j]; o[j] = g * __builtin_amdgcn_rcpf(1.f + __expf(-g)) * acc[m][n + 2][j]; }
        u32x2 w = {pk_bf16(o[0], o[1]), pk_bf16(o[2], o[3])};
        *(u32x2*)(ACT + (size_t)(r0 + m * 16 + fr) * 2816 + cb + n * 16 + fq * 4) = w;
      }
  }
};

DI void prep_token(const Params& p, int l, int row, int lane) {
  const int b = row / TB, s = row % TB;
  const bool hasprev = (s != 0 && s != NCTX), hasnext = (s != NCTX - 1 && s != TB - 1);
  const float mp = hasprev ? 1.f : 0.f, mn = hasnext ? 1.f : 0.f;
  const bf16_t* pa = p.PA + (size_t)row * LDPA;
  const bf16_t* pbc = p.PBC + (size_t)row * LDPBC;
  const int opa = hasprev ? -LDPA : 0, ona = hasnext ? LDPA : 0, opb = hasprev ? -LDPBC : 0, onb = hasnext ? LDPBC : 0;
  const int l32 = lane & 31, c8 = l32 * 8, colA = 1152 + c8;
  const u32x4 la_c = *(const u32x4*)(pa + colA), la_p = *(const u32x4*)(pa + opa + colA), la_n = *(const u32x4*)(pa + ona + colA);
  const u32x4 lq0 = *(const u32x4*)(pbc + lane * 8), lq1 = *(const u32x4*)(pbc + 512 + c8), lkv = *(const u32x4*)(pbc + 768 + c8);
  const u32x4 lrp = *(const u32x4*)(pbc + 1024 + (lane & 3) * 8);
  const u32x4 lbg = *(const u32x4*)(pbc + 1056 + c8), lcc = *(const u32x4*)(pbc + 1312 + c8), lhh = *(const u32x4*)(pbc + 1568 + c8);
  const u32x4 lcp = *(const u32x4*)(pbc + opb + 1312 + c8), lhp = *(const u32x4*)(pbc + opb + 1568 + c8);
  const u32x4 lcn = *(const u32x4*)(pbc + onb + 1312 + c8), lhn = *(const u32x4*)(pbc + onb + 1568 + c8);
  const float* mu = p.tshift_mu + (size_t)l * 2 * LDPA;
  {
    float c[8], pv[8], nx[8], o[8];
    unpack8(la_c, c); unpack8(la_p, pv); unpack8(la_n, nx);
    const f32x4 m0a = *(const f32x4*)(mu + colA), m0b = *(const f32x4*)(mu + colA + 4), m1a = *(const f32x4*)(mu + LDPA + colA), m1b = *(const f32x4*)(mu + LDPA + colA + 4);
#pragma unroll
    for (int j = 0; j < 8; ++j) {
      const float m0 = j < 4 ? m0a[j & 3] : m0b[j & 3], m1 = j < 4 ? m1a[j & 3] : m1b[j & 3];
      float t = c[j] + m0 * (pv[j] * mp - c[j]) + m1 * (nx[j] * mn - c[j]);
      if (l32 < 8) { float e = __expf(2.f * t); t = 1.f - 2.f * __builtin_amdgcn_rcpf(1.f + e); }
      else if (l32 >= 16) t = __builtin_amdgcn_rcpf(1.f + __expf(-t));
      o[j] = t;
    }
    u32x4 w = {pk_bf16(o[0], o[1]), pk_bf16(o[2], o[3]), pk_bf16(o[4], o[5]), pk_bf16(o[6], o[7])};
    if (lane < 8) *(u32x4*)(p.TW + (size_t)row * 64 + lane * 8) = w;
    else if (lane < 16) *(u32x4*)(p.TA + (size_t)row * 64 + (lane - 8) * 8) = w;
    else if (lane < 32) *(u32x4*)(p.TG + (size_t)row * 128 + (lane - 16) * 8) = w;
  }
  float f[8], ss = 0.f, s2 = 0.f, s3 = 0.f, fr_[8];
  unpack8(lq0, f);
#pragma unroll
  for (int j = 0; j < 8; ++j) ss += f[j] * f[j];
  unpack8(lq1, f);
  if (lane < 32) {
#pragma unroll
    for (int j = 0; j < 8; ++j) ss += f[j] * f[j];
  }
  unpack8(lkv, f);
  if (lane < 32) {
#pragma unroll
    for (int j = 0; j < 8; ++j) s2 += f[j] * f[j];
  }
  unpack8(lrp, fr_);
  if (lane < 4) {
#pragma unroll
    for (int j = 0; j < 8; ++j) s3 += fr_[j] * fr_[j];
  }
  s3 += __shfl_xor(s3, 1); s3 += __shfl_xor(s3, 2);
  {
    const float inv = rsqrtf(s3 * (1.f / 32.f) + EPSF);
    const float* g = p.k_rope_g + l * 32;
    const bool lat = s >= NCTX; const int sp = lat ? s - NCTX : 0;
    const float* rt = p.ROPE + ((lane & 2) ? (sp & 63) : (sp >> 6)) * 16;
    float o[8];
#pragma unroll
    for (int j = 0; j < 8; ++j) {
      float val = fr_[j] * inv * g[(lane & 3) * 8 + j];
      float partner = __shfl_xor(val, 1);
      if (lat) {
        const float cs = rt[2 * j], sn = rt[2 * j + 1];
        val = (lane & 1) == 0 ? val * cs - partner * sn : val * cs + partner * sn;
      }
      o[j] = val;
    }
    if (lane < 4) {
      u32x4 w = {pk_bf16(o[0], o[1]), pk_bf16(o[2], o[3]), pk_bf16(o[4], o[5]), pk_bf16(o[6], o[7])};
#pragma unroll
      for (int hh = 0; hh < 6; ++hh) *(u32x4*)(p.Kt + ((size_t)(b * 6 + hh) * TB + s) * 96 + 64 + lane * 8) = w;
    }
  }
  {
    float bg[8], cc[8], hh[8], cp[8], hp[8], cn[8], hn[8], o[8];
    unpack8(lbg, bg); unpack8(lcc, cc); unpack8(lhh, hh); unpack8(lcp, cp); unpack8(lhp, hp); unpack8(lcn, cn); unpack8(lhn, hn);
    const float* cw = p.conv_w + (size_t)l * 3 * 256;
#pragma unroll
    for (int j = 0; j < 8; ++j) o[j] = bg[j] * (cw[c8 + j] * cp[j] * hp[j] * mp + cw[256 + c8 + j] * cc[j] * hh[j] + cw[512 + c8 + j] * cn[j] * hn[j] * mn);
    u32x4 w = {pk_bf16(o[0], o[1]), pk_bf16(o[2], o[3]), pk_bf16(o[4], o[5]), pk_bf16(o[6], o[7])};
    if (lane < 32) *(u32x4*)(p.HY + (size_t)row * DM + 768 + c8) = w;
  }
}

#define MFMA32(a, b, c) __builtin_amdgcn_mfma_f32_32x32x16_bf16((a), (b), (c), 0, 0, 0)
DI bf16x8 pack8(const f32x16& x, int s) {
  u32x4 v = {pk_bf16(x[8 * s], x[8 * s + 1]), pk_bf16(x[8 * s + 2], x[8 * s + 3]), pk_bf16(x[8 * s + 4], x[8 * s + 5]), pk_bf16(x[8 * s + 6], x[8 * s + 7])};
  return __builtin_bit_cast(bf16x8, v);
}
constexpr int KROW = 208, VROW = 136, KBUF = 64 * KROW, VBUF = 64 * VROW;
DI void attn_task(const Params& p, int b, int h, int q0, int k0, int nk, char* lds) {
  const int tid = opaque_tid(), lane = tid & 63, wid = tid >> 6, r = lane & 31, hh = lane >> 5;
  const bf16_t* Qp = p.Q + ((size_t)(b * 6 + h) * TB + q0 + wid * 32 + r) * 96;
  const bf16_t* Kp = p.Kt + ((size_t)(b * 6 + h) * TB + k0) * 96;
  const bf16_t* Vp = p.VT + (size_t)(h * 64) * T_TOK + (size_t)b * TB + k0;
  bf16x8 qf[6];
#pragma unroll
  for (int ks = 0; ks < 6; ++ks) qf[ks] = *(const bf16x8*)(Qp + ks * 16 + hh * 8);
  int krow_[3], kch_[3];
#pragma unroll
  for (int i = 0; i < 3; ++i) { int id = tid + i * 256; krow_[i] = id / 12; kch_[i] = id % 12; }
  const int vd0 = tid >> 3, vch = tid & 7;
  u32x4 kreg[3], vreg[2];
  auto load_regs = [&](int kt) {
#pragma unroll
    for (int i = 0; i < 3; ++i) kreg[i] = *(const u32x4*)(Kp + (size_t)(kt * 64 + krow_[i]) * 96 + kch_[i] * 8);
#pragma unroll
    for (int i = 0; i < 2; ++i) vreg[i] = *(const u32x4*)(Vp + (size_t)(vd0 + 32 * i) * T_TOK + kt * 64 + vch * 8);
  };
  auto write_lds = [&](int buf) {
    char* kb = lds + buf * (KBUF + VBUF);
    char* vb = kb + KBUF;
#pragma unroll
    for (int i = 0; i < 3; ++i) *(u32x4*)(kb + krow_[i] * KROW + kch_[i] * 16) = kreg[i];
#pragma unroll
    for (int i = 0; i < 2; ++i) {
      char* d = vb + (vd0 + 32 * i) * VROW + vch * 16;
      *(u32x2*)d = (u32x2){vreg[i][0], vreg[i][1]};
      *(u32x2*)(d + 8) = (u32x2){vreg[i][2], vreg[i][3]};
    }
  };
  f32x16 o[2];
#pragma unroll
  for (int i = 0; i < 16; ++i) { o[0][i] = 0.f; o[1][i] = 0.f; }
  float m_run = -1e30f, l_run = 0.f;
  const int NT = nk >> 6;
  __syncthreads();
  load_regs(0);
  write_lds(0);
  for (int kt = 0; kt < NT; ++kt) {
    if (kt + 1 < NT) load_regs(kt + 1);
    __syncthreads();
    const char* kb = lds + (kt & 1) * (KBUF + VBUF);
    const char* vb = kb + KBUF;
    f32x16 st[2];
#pragma unroll
    for (int kbk = 0; kbk < 2; ++kbk) {
#pragma unroll
      for (int i = 0; i < 16; ++i) st[kbk][i] = 0.f;
#pragma unroll
      for (int ks = 0; ks < 6; ++ks) {
        bf16x8 kf = *(const bf16x8*)(kb + (kbk * 32 + r) * KROW + ks * 32 + hh * 16);
        st[kbk] = MFMA32(kf, qf[ks], st[kbk]);
      }
    }
    float mx = st[0][0];
#pragma unroll
    for (int i = 0; i < 16; ++i) { mx = fmaxf(mx, st[0][i]); mx = fmaxf(mx, st[1][i]); }
    mx = fmaxf(mx, __shfl_xor(mx, 32));
    const float m_new = fmaxf(m_run, mx);
    const float alpha = __builtin_amdgcn_exp2f(m_run - m_new);
    m_run = m_new;
    float psum = 0.f;
#pragma unroll
    for (int kbk = 0; kbk < 2; ++kbk)
#pragma unroll
      for (int i = 0; i < 16; ++i) { float e = __builtin_amdgcn_exp2f(st[kbk][i] - m_new); st[kbk][i] = e; psum += e; }
    psum += __shfl_xor(psum, 32);
    l_run = l_run * alpha + psum;
#pragma unroll
    for (int i = 0; i < 16; ++i) { o[0][i] *= alpha; o[1][i] *= alpha; }
#pragma unroll
    for (int ksv = 0; ksv < 4; ++ksv) {
      const bf16x8 pf = pack8(st[ksv >> 1], ksv & 1);
#pragma unroll
      for (int db = 0; db < 2; ++db) {
        const char* va = vb + (db * 32 + r) * VROW + (ksv * 16 + 4 * hh) * 2;
        s16x4 lo = *(const s16x4*)va, hi = *(const s16x4*)(va + 16);
        bf16x8 vf = __builtin_shufflevector(lo, hi, 0, 1, 2, 3, 4, 5, 6, 7);
        o[db] = MFMA32(vf, pf, o[db]);
      }
    }
    if (kt + 1 < NT) write_lds((kt + 1) & 1);
  }
  const float invl = 1.f / l_run;
  bf16_t* dst = p.HY + (size_t)(b * TB + q0 + wid * 32 + r) * DM + 384 + h * 64;
#pragma unroll
  for (int db = 0; db < 2; ++db)
#pragma unroll
    for (int g = 0; g < 4; ++g) {
      u32x2 w = {pk_bf16(o[db][4 * g] * invl, o[db][4 * g + 1] * invl), pk_bf16(o[db][4 * g + 2] * invl, o[db][4 * g + 3] * invl)};
      *(u32x2*)(dst + db * 32 + 8 * g + 4 * hh) = w;
    }
}

enum { VW = 0, VKK = 1, VB = 2, VKD = 3, VR = 4, VV = 5 };
constexpr int CS = 68, CP = 16 * CS;
DI void scan_task(const Params& p, int l, int b, int h, int dir, int half, char* lds) {
  float* cb = (float*)lds;
  float* tk = cb + 6 * CP;
  float* ybuf = tk + CP;
  const int tid = opaque_tid(), lane = tid & 63, wid = tid >> 6;
  const int st_p = tid >> 4, c4 = tid & 15;
  const int fr = lane & 15, fq = lane >> 4;
  const int rp = lane >> 4, g = lane & 15;
  const int hc = h * 64;
  bf16x8 bw[2], ba[2];
  {
    const bf16_t* wd = p.Wdecay + ((size_t)dir * 384 + hc + wid * 16 + fr) * 64;
    const bf16_t* wi = p.Wicl + ((size_t)dir * 384 + hc + wid * 16 + fr) * 64;
#pragma unroll
    for (int ks = 0; ks < 2; ++ks) { bw[ks] = *(const bf16x8*)(wd + ks * 32 + fq * 8); ba[ks] = *(const bf16x8*)(wi + ks * 32 + fq * 8); }
  }
  f32x4 mu0[3], mu1[3];
  const float* mu = p.tshift_mu + (size_t)l * 2 * LDPA;
#pragma unroll
  for (int sec = 0; sec < 3; ++sec) { mu0[sec] = *(const f32x4*)(mu + sec * 384 + hc + c4 * 4); mu1[sec] = *(const f32x4*)(mu + LDPA + sec * 384 + hc + c4 * 4); }
  const f32x4 kkg = *(const f32x4*)(p.k_k + l * 384 + hc + c4 * 4);
  const f32x4 rkg = *(const f32x4*)(p.r_k + l * 384 + hc + c4 * 4);
  const int colB = wid * 16 + fq * 4;
  const f32x4 w0 = *(const f32x4*)(p.decay_w0 + (size_t)(l * 2 + dir) * 384 + hc + colB);
  const f32x4 a0 = *(const f32x4*)(p.icl_a0 + (size_t)(l * 2 + dir) * 384 + hc + colB);
  const f32x4 kag = *(const f32x4*)(p.k_a + l * 384 + hc + colB);

  u32x2 ld[3][3];
  float mprev = 0.f, mnext = 0.f;
  bf16x8 aw[2], aa[2];
  auto chunk_lo = [&](int c) -> int { return dir == 0 ? 16 * c : (c < 16 ? 240 - 16 * c : 2544 - 16 * c); };
  auto issue_loads = [&](int c) {
    const int slo = chunk_lo(c);
    const int s = slo + st_p;
    const bool hasprev = (s != 0 && s != NCTX), hasnext = (s != NCTX - 1 && s != TB - 1);
    const bf16_t* pa = p.PA + (size_t)(b * TB + s) * LDPA + hc + c4 * 4;
    const int op = hasprev ? -LDPA : 0, on = hasnext ? LDPA : 0;
    mprev = hasprev ? 1.f : 0.f; mnext = hasnext ? 1.f : 0.f;
#pragma unroll
    for (int sec = 0; sec < 3; ++sec) {
      ld[sec][1] = *(const u32x2*)(pa + sec * 384);
      ld[sec][0] = *(const u32x2*)(pa + sec * 384 + op);
      ld[sec][2] = *(const u32x2*)(pa + sec * 384 + on);
    }
    const size_t trow = (size_t)(b * TB + slo + fr) * 64;
#pragma unroll
    for (int ks = 0; ks < 2; ++ks) { aw[ks] = *(const bf16x8*)(p.TW + trow + ks * 32 + fq * 8); aa[ks] = *(const bf16x8*)(p.TA + trow + ks * 32 + fq * 8); }
  };
  auto produce = [&](int c) {
    const int slo = chunk_lo(c);
    float ts[3][4];
#pragma unroll
    for (int sec = 0; sec < 3; ++sec) {
      float pc[4], pp[4], pn[4];
      unpack4(ld[sec][1], pc); unpack4(ld[sec][0], pp); unpack4(ld[sec][2], pn);
#pragma unroll
      for (int j = 0; j < 4; ++j) ts[sec][j] = pc[j] + mu0[sec][j] * (pp[j] * mprev - pc[j]) + mu1[sec][j] * (pn[j] * mnext - pc[j]);
    }
    *(f32x4*)(cb + VR * CP + st_p * CS + c4 * 4) = (f32x4){ts[0][0], ts[0][1], ts[0][2], ts[0][3]};
    *(f32x4*)(cb + VV * CP + st_p * CS + c4 * 4) = (f32x4){ts[2][0], ts[2][1], ts[2][2], ts[2][3]};
    *(f32x4*)(tk + st_p * CS + c4 * 4) = (f32x4){ts[1][0], ts[1][1], ts[1][2], ts[1][3]};
    float kx[4], ss = 0.f;
#pragma unroll
    for (int j = 0; j < 4; ++j) { kx[j] = ts[1][j] * kkg[j]; ss += kx[j] * kx[j]; }
    ss = red16(ss);
    const float inv = rsqrtf(ss + 1e-12f);
    *(f32x4*)(cb + VKK * CP + st_p * CS + c4 * 4) = (f32x4){kx[0] * inv, kx[1] * inv, kx[2] * inv, kx[3] * inv};
    __syncthreads();
    f32x4 dw = {0.f, 0.f, 0.f, 0.f}, da = {0.f, 0.f, 0.f, 0.f};
#pragma unroll
    for (int ks = 0; ks < 2; ++ks) {
      dw = __builtin_amdgcn_mfma_f32_16x16x32_bf16(bw[ks], aw[ks], dw, 0, 0, 0);
      da = __builtin_amdgcn_mfma_f32_16x16x32_bf16(ba[ks], aa[ks], da, 0, 0, 0);
    }
    {
      const f32x4 kv = *(const f32x4*)(tk + fr * CS + colB);
      const f32x4 kkv = *(const f32x4*)(cb + VKK * CP + fr * CS + colB);
      f32x4 wv, kdv, bv;
#pragma unroll
      for (int j = 0; j < 4; ++j) {
        wv[j] = __expf(-LOG_DECAY_SCALE * sigmoidf_(w0[j] + dw[j]));
        const float a = sigmoidf_(a0[j] + da[j]);
        kdv[j] = kv[j] * (1.f + (a - 1.f) * kag[j]);
        bv[j] = kkv[j] * a;
      }
      *(f32x4*)(cb + VW * CP + fr * CS + colB) = wv;
      *(f32x4*)(cb + VKD * CP + fr * CS + colB) = kdv;
      *(f32x4*)(cb + VB * CP + fr * CS + colB) = bv;
    }
    __syncthreads();
    {
      const f32x4 rv = *(const f32x4*)(cb + VR * CP + st_p * CS + c4 * 4);
      const f32x4 kdv = *(const f32x4*)(cb + VKD * CP + st_p * CS + c4 * 4);
      float bs = rv[0] * kdv[0] * rkg[0] + rv[1] * kdv[1] * rkg[1] + rv[2] * kdv[2] * rkg[2] + rv[3] * kdv[3] * rkg[3];
      bs = red16(bs);
      if (c4 == 0 && half == 0) p.BON[(size_t)dir * T_TOK * 6 + (size_t)(b * TB + slo + st_p) * 6 + h] = bs;
    }
  };

  f32x2 S0[2], S1[2];
#pragma unroll
  for (int j = 0; j < 2; ++j) { S0[j] = (f32x2){0.f, 0.f}; S1[j] = (f32x2){0.f, 0.f}; }
  __syncthreads();
  issue_loads(0);
  produce(0);
  __syncthreads();
  const int NCH = TB / 16;
  const int rowl = half * 32 + wid * 8 + rp * 2;
  const int inc = dir ? -CS : CS;
  for (int c = 0; c < NCH; ++c) {
    if (c + 1 < NCH) issue_loads(c + 1);
    {
      const float* ps = cb + (dir ? 15 * CS : 0) + g * 4;
      const float* pv = cb + VV * CP + (dir ? 15 * CS : 0) + rowl;
      float* py = ybuf + (dir ? 15 * 512 : 0) + ((wid * 4 + rp) * 16 + g) * 2;
      f32x4 cw = *(const f32x4*)(ps + VW * CP), ckk = *(const f32x4*)(ps + VKK * CP), cbb = *(const f32x4*)(ps + VB * CP),
            ckd = *(const f32x4*)(ps + VKD * CP), crr = *(const f32x4*)(ps + VR * CP);
      f32x2 cvv = *(const f32x2*)pv;
#pragma unroll
      for (int ii = 0; ii < 16; ++ii) {
        f32x4 nw = cw, nkk = ckk, nbb = cbb, nkd = ckd, nrr = crr; f32x2 nvv = cvv;
        if (ii < 15) {
          ps += inc; pv += inc;
          nw = *(const f32x4*)(ps + VW * CP); nkk = *(const f32x4*)(ps + VKK * CP); nbb = *(const f32x4*)(ps + VB * CP);
          nkd = *(const f32x4*)(ps + VKD * CP); nrr = *(const f32x4*)(ps + VR * CP); nvv = *(const f32x2*)pv;
        }
        __builtin_amdgcn_sched_barrier(0x7);
        const f32x2 kk0 = {ckk[0], ckk[1]}, kk1 = {ckk[2], ckk[3]}, w0 = {cw[0], cw[1]}, w1 = {cw[2], cw[3]};
        const f32x2 b0 = {cbb[0], cbb[1]}, b1 = {cbb[2], cbb[3]}, kd0 = {ckd[0], ckd[1]}, kd1 = {ckd[2], ckd[3]};
        const f32x2 r0 = {crr[0], crr[1]}, r1 = {crr[2], crr[3]};
        const f32x2 p0 = S0[0] * kk0 + S0[1] * kk1, p1 = S1[0] * kk0 + S1[1] * kk1;
        const f32x2 u00 = S0[0] * w0 + kd0 * cvv[0], u01 = S0[1] * w1 + kd1 * cvv[0];
        const f32x2 u10 = S1[0] * w0 + kd0 * cvv[1], u11 = S1[1] * w1 + kd1 * cvv[1];
        const float q0 = red16(p0[0] + p0[1]), q1 = red16(p1[0] + p1[1]);
        S0[0] = u00 - b0 * q0; S0[1] = u01 - b1 * q0;
        S1[0] = u10 - b0 * q1; S1[1] = u11 - b1 * q1;
        const f32x2 y0 = S0[0] * r0 + S0[1] * r1, y1 = S1[0] * r0 + S1[1] * r1;
        *(f32x2*)py = (f32x2){y0[0] + y0[1], y1[0] + y1[1]};
        py += dir ? -512 : 512;
        cw = nw; ckk = nkk; cbb = nbb; ckd = nkd; crr = nrr; cvv = nvv;
      }
    }
    __syncthreads();
    {
      const int slo = chunk_lo(c);
      const float* yp = ybuf + (st_p * 16 + c4) * 32;
      f32x4 a = *(const f32x4*)(yp + 4 * (c4 & 7));
#pragma unroll
      for (int i = 1; i < 8; ++i) a += *(const f32x4*)(yp + 4 * ((i + c4) & 7));
      *(f32x2*)(p.Y + (size_t)dir * T_TOK * 384 + (size_t)(b * TB + slo + st_p) * 384 + hc + half * 32 + c4 * 2) = (f32x2){a[0] + a[2], a[1] + a[3]};
    }
    if (c + 1 < NCH) produce(c + 1);
    __syncthreads();
  }
}

DI int lat_tile(int i) { return (i >> 4) * 18 + 2 + (i & 15); }
DI bool xcd_tile(int bid, int G, int i, int MT, int NT, int& tm, int& tn) {
  if ((G & 7) || (MT & 7)) { const int t = bid + i * G; if (t >= MT * NT) return false; tm = t / NT; tn = t % NT; return true; }
  const int nbx = G >> 3, x = bid & 7, j = bid >> 3, MS = MT >> 3;
  const int q = j + nbx * i;
  if (q >= MS * NT) return false;
  const int full = NT >> 3, wl = NT & 7;
  int nb = q / (MS * 8), m, ni;
  if (nb < full) { const int rem = q - nb * MS * 8; m = rem >> 3; ni = rem & 7; }
  else { const int rem = q - full * MS * 8; nb = full; m = rem / wl; ni = rem % wl; }
  tm = x * MS + m; tn = nb * 8 + ni;
  return true;
}

template <int KSEL> DI void run_phase(const Params& p, int ph, char* lds) {
  const int bid = blockIdx.x, G = gridDim.x, tid = opaque_tid(), lane = tid & 63, wid = tid >> 6;
  if (ph == 0) {
    if (KSEL >= 0 && KSEL != 10) return;
    for (int t = bid; t < 384 + NCONV_W1 + 1; t += G) {
      if (t < 384) adaln_task(p, t, lds);
      else if (t < 384 + NCONV_W1) conv_w1_task(p, 0, t - 384, lds);
      else { for (int e = tid; e < 512; e += 256) { float cs, sn; rope_angle(e >> 3, e & 7, cs, sn); p.ROPE[2 * e] = cs; p.ROPE[2 * e + 1] = sn; } }
    }
    return;
  }
  if (KSEL == 10) return;
  const int l = (ph - 1) / 9, kq = (ph - 1) % 9, k = kq < 2 ? kq : kq + 1;
  const bool last = (l == 1);
  const int lb = ((G & 7) == 0) ? (bid & 7) * (G >> 3) + (bid >> 3) : bid;
  if (KSEL >= 0 && KSEL != 10 && k != (KSEL == 11 ? 4 : KSEL)) return;
  switch (k) {
    case 0:
      for (int i = bid * 256 + tid; i < 2 * T_TOK; i += G * 256) p.RSTD[i] = 0.f;
      modnorm_rows(p, l, 0, l == 0, false, bid * 4 + wid, G * 4, lane);
      break;
    case 1: {
      EpiP e{p.PA, p.PBC, p.RSTD};
      for (int i = 0, tm, tn; xcd_tile(bid, G, i, 144, 26, tm, tn); ++i) gemm_tile(p.HY, DM, p.Win, DM, DM, tm * 128, tn * 128, lds, e);
    } break;
    case 3: {
      const int nq = last ? 128 * 5 : 144 * 5;
      EpiQ eq{p.RSTD, p.q_nope_g + l * 64, p.q_rope_g + l * 32, p.ROPE, p.Q};
      EpiK ek{p.RSTD + T_TOK, p.k_nope_g + l * 64, p.Kt};
      EpiV ev{p.RSTD + T_TOK, p.VT};
      if (KSEL >= 0) {
        for (int t = bid; t < nq + 432 + 432 + T_TOK / 4; t += G) {
          if (t >= nq + 864) { prep_token(p, l, (t - nq - 864) * 4 + wid, lane); continue; }
          if (t < nq) { int i = t / 5; int tm = last ? lat_tile(i) : i; gemm_tile(p.PBC, LDPBC, p.Wuq, 768, 768, tm * 128, (t % 5) * 128, lds, eq); }
          else if (t < nq + 432) { int u = t - nq; gemm_tile(p.PBC + 768, LDPBC, p.WukvK, 256, 256, (u / 3) * 128, (u % 3) * 128, lds, ek); }
          else { int u = t - nq - 432; gemm_tile(p.WvT, 256, p.PBC + 768, LDPBC, 256, (u % 3) * 128, (u / 3) * 128, lds, ev); }
        }
      } else {
        for (int t = bid; t < T_TOK / 4; t += G) prep_token(p, l, t * 4 + wid, lane);
        volatile LAS unsigned* slot = (volatile LAS unsigned*)(lds + 65536 + 8);
        unsigned* qg = p.BAR + 3456   + 64 * l + 16;
        for (;;) {
          __syncthreads();
          if (tid == 0) *slot = __hip_atomic_fetch_add(qg, 1u, __ATOMIC_RELAXED, __HIP_MEMORY_SCOPE_AGENT);
          __syncthreads();
          const int t = (int)*slot;
          if (t >= nq + 864) break;
          if (t < nq) { int i = t / 5; int tm = last ? lat_tile(i) : i; gemm_tile(p.PBC, LDPBC, p.Wuq, 768, 768, tm * 128, (t % 5) * 128, lds, eq); }
          else if (t < nq + 432) { int u = t - nq; gemm_tile(p.PBC + 768, LDPBC, p.WukvK, 256, 256, (u / 3) * 128, (u % 3) * 128, lds, ek); }
          else { int u = t - nq - 432; gemm_tile(p.WvT, 256, p.PBC + 768, LDPBC, 256, (u % 3) * 128, (u / 3) * 128, lds, ev); }
        }
      }
    } break;
    case 4: {
      const int natt = 768 + (last ? 0 : 96);
      if (KSEL != 11) { if (bid < 192) { scan_task(p, l, bid / 24, (bid % 24) >> 2, (bid >> 1) & 1, bid & 1, lds); break; } if (KSEL == 4) break; }
      const int aoff = KSEL == 11 ? 0 : 192;
      if (KSEL == 11) {
        for (int t = bid; t < natt + NCONV_FF; t += G) {
          if (t < 768) { int bh = t >> 4, qb = t & 15; attn_task(p, bh / 6, bh % 6, NCTX + qb * 128, 0, TB, lds); }
          else if (t < natt) { int u = t - 768; int bh = u >> 1, qb = u & 1; attn_task(p, bh / 6, bh % 6, qb * 128, 0, NCTX, lds); }
          else conv_ff_task(p, l, t - natt, lds);
        }
      } else {
        volatile LAS unsigned* slot = (volatile LAS unsigned*)(lds + 65536 + 8);
        for (;;) {
          __syncthreads();
          if (tid == 0) *slot = __hip_atomic_fetch_add(p.BAR + 3456   + 64 * l, 1u, __ATOMIC_RELAXED, __HIP_MEMORY_SCOPE_AGENT);
          __syncthreads();
          const int t = (int)*slot;
          if (t >= natt + NCONV_FF) break;
          if (t < 768) { int bh = t >> 4, qb = t & 15; attn_task(p, bh / 6, bh % 6, NCTX + qb * 128, 0, TB, lds); }
          else if (t < natt) { int u = t - 768; int bh = u >> 1, qb = u & 1; attn_task(p, bh / 6, bh % 6, qb * 128, 0, NCTX, lds); }
          else conv_ff_task(p, l, t - natt, lds);
        }
      }
    } break;
    case 5: {
      EpiPost e{p.Y, p.BON, p.tshift_mu + (size_t)l * 2 * LDPA, p.lnx_g + l * 384, p.lnx_b + l * 384, p.PA, p.HY};
      const int nm = last ? 128 : 144;
      for (int t = bid; t < nm * 3; t += G) { int i = t / 3; int tm = last ? lat_tile(i) : i; gemm_tile(p.TG, 128, p.Wgate, 128, 128, tm * 128, (t % 3) * 128, lds, e); }
    } break;
    case 6: {
      EpiRes e{&p, l, l == 0, 2 * 1024};
      const int nm = last ? 128 : 144;
      for (int i = 0, tm, tn; xcd_tile(bid, G, i, nm, 8, tm, tn); ++i) gemm_tile(p.HY, DM, p.Wout, DM, DM, (last ? lat_tile(tm) : tm) * 128, tn * 128, lds, e);
    } break;
    case 7:
      modnorm_rows(p, l, 1, false, last, bid * 4 + wid, G * 4, lane);
      break;
    case 8: {
      EpiFfnIn e{p.ACT};
      const int nm = last ? 128 : 144;
      const int nconv = last ? 0 : NCONV_W1;
      for (int i = 0, tm, tn; xcd_tile(bid, G, i, nm, 44, tm, tn); ++i) gemm_tile(p.HY, DM, p.Wffi, DM, DM, (last ? lat_tile(tm) : tm) * 128, tn * 128, lds, e);
      for (int t = bid; t < nconv; t += G) conv_w1_task(p, 1, t, lds);
    } break;
    case 9: {
      EpiRes e{&p, l, false, 5 * 1024};
      const int nm = last ? 128 : 144;
      for (int i = 0, tm, tn; xcd_tile(bid, G, i, nm, 8, tm, tn); ++i) gemm_tile(p.ACT, 2816, p.Wffo, 2816, 2816, (last ? lat_tile(tm) : tm) * 128, tn * 128, lds, e);
    } break;
  }
}


#define XB_TMO      128
#define XB_XCNT(j)  (256  + 64 * (j))
#define XB_XSUB(j)  (1280 + 64 * (j))
#define XB_XGEN(j)  (2304 + 64 * (j))
#define XB_TOP      3328
#define XB_TOPGEN   3392
#define XCD_BAR_WORDS 3456
#define XB_SPIN_CAP (1u << 20)
DI unsigned xb_ld(unsigned* p) { return __hip_atomic_load(p, __ATOMIC_RELAXED, __HIP_MEMORY_SCOPE_AGENT); }
DI unsigned xb_add(unsigned* p, unsigned v) { return __hip_atomic_fetch_add(p, v, __ATOMIC_RELAXED, __HIP_MEMORY_SCOPE_AGENT); }
DI unsigned xb_xcc_id() { return (unsigned)__builtin_amdgcn_s_getreg((3 << 11) | 20) & 0xFu; }
#define XB_SPIN(cond, bar) do { unsigned _sp = 0; while (cond) { __builtin_amdgcn_s_sleep(1); \
    if ((++_sp & 255u) == 0u) { if (xb_ld(&(bar)[XB_TMO])) break; if (_sp > XB_SPIN_CAP) { atomicAdd(&(bar)[XB_TMO], 1u); break; } } } } while (0)
struct XcdBarrier { unsigned* bar; unsigned x; volatile LAS unsigned* st; };
DI XcdBarrier xcd_barrier_post(unsigned* bar, volatile LAS unsigned* st) {
  XcdBarrier b; b.bar = bar; b.x = xb_xcc_id(); b.st = st;
  if (threadIdx.x == 0) (void)xb_add(&bar[XB_XCNT(b.x)], 1u);
  return b;
}
DI void xcd_barrier_complete(unsigned* bar, unsigned x, unsigned& nloc, unsigned& nx) {
  const unsigned G = gridDim.x * gridDim.y * gridDim.z;
  unsigned sum, cnt, mine, sp = 0u;
  for (;;) {
    sum = 0u; cnt = 0u; mine = 0u;
#pragma unroll
    for (unsigned j = 0; j < 16; ++j) { const unsigned c = xb_ld(&bar[XB_XCNT(j)]); sum += c; cnt += (c > 0u) ? 1u : 0u; mine = (j == x) ? c : mine; }
    if (sum == G) break;
    __builtin_amdgcn_s_sleep(1);
    if ((++sp & 255u) == 0u) { if (xb_ld(&bar[XB_TMO])) break; if (sp > XB_SPIN_CAP) { atomicAdd(&bar[XB_TMO], 1u); break; } }
  }
  nloc = mine > 0u ? mine : 1u; nx = cnt > 0u ? cnt : 1u;
}
DI void xcd_barrier(const XcdBarrier& b) {
  asm volatile("s_waitcnt vmcnt(0)" ::: "memory");
  __syncthreads();
  if (threadIdx.x == 0) {
    unsigned* bar = b.bar;
    __builtin_amdgcn_s_waitcnt(0);
    unsigned nloc = b.st[0], nx = b.st[1];
    if (nloc == 0u) { xcd_barrier_complete(bar, b.x, nloc, nx); b.st[0] = nloc; b.st[1] = nx; }
    const unsigned old = xb_add(&bar[XB_XSUB(b.x)], 1u);
    const unsigned gen = old / nloc;
    if (old + 1u == (gen + 1u) * nloc) {
      __builtin_amdgcn_fence(__ATOMIC_RELEASE, "agent");
      asm volatile("s_waitcnt vmcnt(0)" ::: "memory");
      const unsigned og = xb_add(&bar[XB_TOP], 1u);
      const unsigned tg = og / nx;
      if (og + 1u == (tg + 1u) * nx) xb_add(&bar[XB_TOPGEN], 1u);
      else XB_SPIN(xb_ld(&bar[XB_TOPGEN]) == tg, bar);
      __builtin_amdgcn_fence(__ATOMIC_ACQUIRE, "agent");
      xb_add(&bar[XB_XGEN(b.x)], 1u);
      asm volatile("s_waitcnt vmcnt(0)" ::: "memory");
    } else {
      XB_SPIN(xb_ld(&bar[XB_XGEN(b.x)]) == gen, bar);
      __builtin_amdgcn_fence(__ATOMIC_ACQUIRE, "agent");
      asm volatile("s_waitcnt vmcnt(0)" ::: "memory");
    }
  }
  __syncthreads();
}

constexpr int NPHASE = 19;
#if !MULTI_LAUNCH
__global__ void __launch_bounds__(256, 2) mega(Params p, int ph_lo, int ph_hi) {
  __shared__ __attribute__((aligned(16))) char lds[65536 + 16];
  cg::grid_group grid = cg::this_grid();
  volatile LAS unsigned* st = (volatile LAS unsigned*)(lds + 65536);
  if (threadIdx.x == 0) { st[0] = 0u; st[1] = 0u; }
  __syncthreads();
  XcdBarrier xb = xcd_barrier_post(p.BAR, st);
  for (int ph = ph_lo; ph < ph_hi; ++ph) {
    if (ph > ph_lo) xcd_barrier(xb);
    run_phase<-1>(p, ph, lds);
  }
  if (ph_hi > NPHASE) grid.sync();
}
#endif
template <int KSEL> __global__ void __launch_bounds__(256, 2) phase_k(Params p, int ph) {
  __shared__ __attribute__((aligned(16))) char lds[65536];
  run_phase<KSEL>(p, ph, lds);
}

extern "C" void kernel_launch(void* const* d_in, const int* in_sizes, int n_in, void* d_out, int out_size, void* d_ws, size_t ws_size, hipStream_t stream) {
  static int grid_blocks = 0;
  if (!grid_blocks) {
    int dev = 0, cus = 0, per_cu = 0;
    (void)hipGetDevice(&dev);
    (void)hipDeviceGetAttribute(&cus, hipDeviceAttributeMultiprocessorCount, dev);
    #if MULTI_LAUNCH
    per_cu = 2;
#else
    (void)hipOccupancyMaxActiveBlocksPerMultiprocessor(&per_cu, mega, 256, 0);
#endif
    if (per_cu > 2) per_cu = 2;
    if (per_cu < 1) per_cu = 1;
    grid_blocks = cus * per_cu;
  }
  Params p{};
  const float** pin = (const float**)&p.x;
  for (int i = 0; i < 32; ++i) pin[i] = (const float*)d_in[i];
  p.out = (float*)d_out;
  char* w = (char*)d_ws;
  size_t off = 0;
  auto take = [&](size_t bytes) { char* r = w + off; off += (bytes + 255) & ~(size_t)255; return r; };
  p.BAR = (unsigned*)take((XCD_BAR_WORDS + 128) * 4);
  p.MOD = (float*)take(2 * 9 * 6144 * 4);
  p.ROPE = (float*)take(64 * 8 * 2 * 4);
  p.RSTD = (float*)take(2 * (size_t)T_TOK * 4);
  p.BON = (float*)take(2 * (size_t)T_TOK * 6 * 4);
  p.XCTX = (float*)take((size_t)8 * NCTX * DM * 4);
  p.Win = (bf16_t*)take((size_t)3328 * 1024 * 2);
  p.Wuq = (bf16_t*)take((size_t)640 * 768 * 2);
  p.WukvK = (bf16_t*)take((size_t)384 * 256 * 2);
  p.WvT = (bf16_t*)take((size_t)384 * 256 * 2);
  p.Wgate = (bf16_t*)take((size_t)384 * 128 * 2);
  p.Wdecay = (bf16_t*)take((size_t)2 * 384 * 64 * 2);
  p.Wicl = (bf16_t*)take((size_t)2 * 384 * 64 * 2);
  p.Wout = (bf16_t*)take((size_t)1024 * 1024 * 2);
  p.HY = (bf16_t*)take((size_t)T_TOK * DM * 2);
  p.TW = (bf16_t*)take((size_t)T_TOK * 64 * 2);
  p.TA = (bf16_t*)take((size_t)T_TOK * 64 * 2);
  p.TG = (bf16_t*)take((size_t)T_TOK * 128 * 2);
  char* qkv = take((size_t)T_TOK * 576 * 2 * 2 + (size_t)384 * T_TOK * 2);
  p.Q = (bf16_t*)qkv;
  p.Kt = (bf16_t*)(qkv + (size_t)T_TOK * 576 * 2);
  p.VT = (bf16_t*)(qkv + (size_t)T_TOK * 576 * 2 * 2);
  p.Wffi = (bf16_t*)take((size_t)5632 * 1024 * 2);
  p.Wffo = (bf16_t*)take((size_t)2816 * 1024 * 2);
  char* pr = take((size_t)T_TOK * (LDPA + LDPBC) * 2);
  p.PA = (bf16_t*)pr;
  p.PBC = (bf16_t*)(pr + (size_t)T_TOK * LDPA * 2);
  p.Y = (float*)p.PBC;
  p.ACT = (bf16_t*)pr;
  if (off > ws_size) { fprintf(stderr, "workspace too small: need %zu have %zu\n", off, ws_size); }
#if MULTI_LAUNCH
  hipLaunchKernelGGL(phase_k<10>, dim3(grid_blocks), dim3(256), 0, stream, p, 0);
  for (int l = 0; l < 2; ++l) {
    const int b0 = 1 + 10 * l;
    hipLaunchKernelGGL(phase_k<0>, dim3(grid_blocks), dim3(256), 0, stream, p, b0 + 0);
    hipLaunchKernelGGL(phase_k<1>, dim3(grid_blocks), dim3(256), 0, stream, p, b0 + 1);
    hipLaunchKernelGGL(phase_k<2>, dim3(grid_blocks), dim3(256), 0, stream, p, b0 + 2);
    hipLaunchKernelGGL(phase_k<3>, dim3(grid_blocks), dim3(256), 0, stream, p, b0 + 3);
    hipLaunchKernelGGL(phase_k<4>, dim3(192), dim3(256), 0, stream, p, b0 + 4);
    hipLaunchKernelGGL(phase_k<11>, dim3(grid_blocks), dim3(256), 0, stream, p, b0 + 4);
    hipLaunchKernelGGL(phase_k<5>, dim3(grid_blocks), dim3(256), 0, stream, p, b0 + 5);
    hipLaunchKernelGGL(phase_k<6>, dim3(grid_blocks), dim3(256), 0, stream, p, b0 + 6);
    hipLaunchKernelGGL(phase_k<7>, dim3(grid_blocks), dim3(256), 0, stream, p, b0 + 7);
    hipLaunchKernelGGL(phase_k<8>, dim3(grid_blocks), dim3(256), 0, stream, p, b0 + 8);
    hipLaunchKernelGGL(phase_k<9>, dim3(grid_blocks), dim3(256), 0, stream, p, b0 + 9);
  }
#else
  int lo = 0, hi = NPHASE;
  void* args[] = {&p, &lo, &hi};
  (void)hipMemsetAsync(p.BAR, 0, (XCD_BAR_WORDS + 128) * 4, stream);
  hipError_t e = hipLaunchCooperativeKernel((void*)mega, dim3(grid_blocks), dim3(256), args, 0, stream);
  if (e != hipSuccess) fprintf(stderr, "cooperative launch failed: %s (grid %d)\n", hipGetErrorString(e), grid_blocks);
#endif
}
```

```cpp
#include <hip/hip_runtime.h>
#include <hip/hip_cooperative_groups.h>
#include <cstdio>
namespace cg = cooperative_groups;

#ifndef MULTI_LAUNCH
#define MULTI_LAUNCH 0
#endif

#define DI __device__ __forceinline__
typedef unsigned short bf16_t;
typedef short bf16x8 __attribute__((ext_vector_type(8)));
typedef short s16x4 __attribute__((ext_vector_type(4)));
typedef float f32x4 __attribute__((ext_vector_type(4)));
typedef float f32x2 __attribute__((ext_vector_type(2)));
typedef float f32x16 __attribute__((ext_vector_type(16)));
typedef unsigned u32x4 __attribute__((ext_vector_type(4)));
typedef unsigned u32x2 __attribute__((ext_vector_type(2)));
#define LAS __attribute__((address_space(3)))

constexpr int T_TOK = 18432, TB = 2304, NCTX = 256, NLAT = 2048, DM = 1024;
constexpr int LDPA = 1408, LDPBC = 1920;
constexpr float EPSF = 1e-6f;
constexpr float LOG_DECAY_SCALE = 0.606531f;
constexpr float GN_EPS = 64e-5f;
constexpr float QSCALE = 0.10206207261596577f * 1.4426950408889634f;

struct Params {
  const float *x, *c, *ctx, *c_ctx, *ada_w, *ada_b, *norm1_g, *norm2_g, *w_in, *tshift_mu, *decay_w0, *decay_up,
      *icl_a0, *icl_up, *gate_up, *k_k, *k_a, *r_k, *lnx_g, *lnx_b, *q_norm_g, *kv_norm_g, *w_uq, *w_ukv, *q_nope_g,
      *k_nope_g, *q_rope_g, *k_rope_g, *conv_w, *w_out, *w_ffn_in, *w_ffn_out;
  float* out;
  float *MOD, *RSTD, *BON, *XCTX, *Y, *ROPE;
  unsigned* BAR;
  bf16_t *Win, *Wuq, *WukvK, *WvT, *Wgate, *Wdecay, *Wicl, *Wout, *Wffi, *Wffo;
  bf16_t *HY, *TW, *TA, *TG, *Q, *Kt, *VT, *PA, *PBC, *ACT;
};

typedef __bf16 bf16v2 __attribute__((ext_vector_type(2)));
DI unsigned pk_bf16(float lo, float hi) { f32x2 v = {lo, hi}; bf16v2 b = __builtin_convertvector(v, bf16v2); return __builtin_bit_cast(unsigned, b); }
DI float bflo(unsigned u) { return __uint_as_float(u << 16); }
DI float bfhi(unsigned u) { return __uint_as_float(u & 0xffff0000u); }
DI int opaque_tid() { int t = threadIdx.x; asm volatile("" : "+v"(t)); return t; }
DI float sigmoidf_(float x) { return __builtin_amdgcn_rcpf(1.f + __expf(-x)); }
template <int CTRL> DI float dppf(float x) { return __builtin_bit_cast(float, __builtin_amdgcn_update_dpp(0, __builtin_bit_cast(int, x), CTRL, 0xf, 0xf, true)); }
DI float red8(float x) { x += dppf<0xB1>(x); x += dppf<0x4E>(x); x += dppf<0x141>(x); return x; }
DI float red16(float x) { x = red8(x); x += dppf<0x140>(x); return x; }
DI float red64(float x) { for (int o = 32; o > 0; o >>= 1) x += __shfl_xor(x, o); return x; }

DI void unpack8(u32x4 v, float* f) {
  f[0] = bflo(v[0]); f[1] = bfhi(v[0]); f[2] = bflo(v[1]); f[3] = bfhi(v[1]);
  f[4] = bflo(v[2]); f[5] = bfhi(v[2]); f[6] = bflo(v[3]); f[7] = bfhi(v[3]);
}
DI void unpack4(u32x2 v, float* f) { f[0] = bflo(v[0]); f[1] = bfhi(v[0]); f[2] = bflo(v[1]); f[3] = bfhi(v[1]); }

DI const float* xsrc_row(const Params& p, bool from_inputs, int b, int s) {
  if (from_inputs) return s < NCTX ? p.ctx + (size_t)(b * NCTX + s) * DM : p.x + (size_t)(b * NLAT + s - NCTX) * DM;
  return s < NCTX ? p.XCTX + (size_t)(b * NCTX + s) * DM : p.out + (size_t)(b * NLAT + s - NCTX) * DM;
}
DI float* xdst_row(const Params& p, int b, int s) {
  return s < NCTX ? p.XCTX + (size_t)(b * NCTX + s) * DM : p.out + (size_t)(b * NLAT + s - NCTX) * DM;
}

DI void adaln_task(const Params& p, int task, char* lds) {
  float* s = (float*)lds;
  float* red = s + 9 * 1024;
  const int l = task / 192, cgi = task % 192, tid = opaque_tid();
  for (int i = tid; i < 9 * 1024; i += 256) {
    int r = i >> 10, k = i & 1023;
    float v = r < 8 ? p.c[r * 1024 + k] : p.c_ctx[k];
    s[i] = v / (1.f + __expf(-v));
  }
  __syncthreads();
  const int kg = tid >> 5, cc = tid & 31, col = cgi * 32 + cc;
  float acc[9];
#pragma unroll
  for (int r = 0; r < 9; ++r) acc[r] = 0.f;
  const float* w = p.ada_w + (size_t)l * 1024 * 6144 + col;
  for (int k0 = kg; k0 < 1024; k0 += 128) {
    float wv[16];
#pragma unroll
    for (int u = 0; u < 16; ++u) wv[u] = w[(size_t)(k0 + 8 * u) * 6144];
#pragma unroll
    for (int u = 0; u < 16; ++u)
#pragma unroll
      for (int r = 0; r < 9; ++r) acc[r] += s[r * 1024 + k0 + 8 * u] * wv[u];
  }
#pragma unroll
  for (int r = 0; r < 9; ++r) red[(kg * 9 + r) * 32 + cc] = acc[r];
  __syncthreads();
  for (int i = tid; i < 9 * 32; i += 256) {
    int r = i >> 5, c2 = i & 31;
    float sum = 0.f;
    for (int g = 0; g < 8; ++g) sum += red[(g * 9 + r) * 32 + c2];
    p.MOD[(size_t)(l * 9 + r) * 6144 + cgi * 32 + c2] = sum + p.ada_b[l * 6144 + cgi * 32 + c2];
  }
  __syncthreads();
}

DI int colmap(int mode, int n, int nvalid) {
  switch (mode) {
    case 0: return n < nvalid ? n : -1;
    case 1: if (n < 384) return (n >> 6) * 96 + (n & 63); if (n < 576) return ((n - 384) >> 5) * 96 + 64 + ((n - 384) & 31); return -1;
    case 2: return (n >> 6) * 128 + (n & 63);
    case 3: return (n >> 6) * 128 + 64 + (n & 63);
    default: { int t64 = n >> 6, w = n & 63; return w < 32 ? t64 * 32 + w : 2816 + t64 * 32 + (w - 32); }
  }
}
DI void conv_tile(const float* src, int ld, int K, int mode, int nvalid, const float* kscale, bf16_t* dst, int tile, int ntn, char* lds) {
  float(*tl)[65] = (float(*)[65])lds;
  const int tk = tile / ntn, tn = tile % ntn, tid = opaque_tid(), k0 = tk * 64;
  {
    const int nn = tid & 63, kk0 = tid >> 6;
    const int sc = colmap(mode, tn * 64 + nn, nvalid);
#pragma unroll 4
    for (int i = 0; i < 16; ++i) {
      const int kk = kk0 + 4 * i;
      float v = 0.f;
      if (sc >= 0) { v = src[(size_t)(k0 + kk) * ld + sc]; if (kscale) v *= kscale[k0 + kk]; }
      tl[kk][nn] = v;
    }
  }
  __syncthreads();
  {
    const int kk2 = (tid & 31) * 2, nn2 = tid >> 5;
#pragma unroll
    for (int i = 0; i < 8; ++i) {
      const int nn = nn2 + 8 * i;
      *(unsigned*)(dst + (size_t)(tn * 64 + nn) * K + k0 + kk2) = pk_bf16(tl[kk2][nn], tl[kk2 + 1][nn]);
    }
  }
  __syncthreads();
}
constexpr int NCONV_W1 = 1292, NCONV_FF = 2112;
DI void conv_w1_task(const Params& p, int l, int t, char* lds) {
  if (t < 832) { conv_tile(p.w_in + (size_t)l * 1024 * 3232, 3232, 1024, 0, 3232, nullptr, p.Win, t, 52, lds); return; } t -= 832;
  if (t < 120) { conv_tile(p.w_uq + (size_t)l * 768 * 576, 576, 768, 1, 0, p.q_norm_g + l * 768, p.Wuq, t, 10, lds); return; } t -= 120;
  if (t < 24) { conv_tile(p.w_ukv + (size_t)l * 256 * 768, 768, 256, 2, 0, p.kv_norm_g + l * 256, p.WukvK, t, 6, lds); return; } t -= 24;
  if (t < 24) { conv_tile(p.w_ukv + (size_t)l * 256 * 768, 768, 256, 3, 0, p.kv_norm_g + l * 256, p.WvT, t, 6, lds); return; } t -= 24;
  if (t < 12) { conv_tile(p.gate_up + (size_t)l * 128 * 384, 384, 128, 0, 384, nullptr, p.Wgate, t, 6, lds); return; } t -= 12;
  if (t < 12) { int d = t / 6; conv_tile(p.decay_up + (size_t)(l * 2 + d) * 64 * 384, 384, 64, 0, 384, nullptr, p.Wdecay + d * 384 * 64, t % 6, 6, lds); return; } t -= 12;
  if (t < 12) { int d = t / 6; conv_tile(p.icl_up + (size_t)(l * 2 + d) * 64 * 384, 384, 64, 0, 384, nullptr, p.Wicl + d * 384 * 64, t % 6, 6, lds); return; } t -= 12;
  conv_tile(p.w_out + (size_t)l * 1024 * 1024, 1024, 1024, 0, 1024, nullptr, p.Wout, t, 16, lds);
}
DI void conv_ff_task(const Params& p, int l, int t, char* lds) {
  if (t < 1408) { conv_tile(p.w_ffn_in + (size_t)l * 1024 * 5632, 5632, 1024, 4, 0, nullptr, p.Wffi, t, 88, lds); return; } t -= 1408;
  conv_tile(p.w_ffn_out + (size_t)l * 2816 * 1024, 1024, 2816, 0, 1024, nullptr, p.Wffo, t, 16, lds);
}

DI void modnorm_rows(const Params& p, int l, int which  , bool from_inputs, bool skip_ctx, int w0, int wstride, int lane) {
  const float* g = (which ? p.norm2_g : p.norm1_g) + l * DM;
  f32x4 gg[4];
#pragma unroll
  for (int i = 0; i < 4; ++i) gg[i] = *(const f32x4*)(g + i * 256 + lane * 4);
  const int nrows = skip_ctx ? 8 * NLAT : T_TOK;
  auto rowof = [&](int i) -> int { return skip_ctx ? (i / NLAT) * TB + NCTX + (i % NLAT) : i; };
  int i = w0;
  if (i >= nrows) return;
  f32x4 vn[4];
  {
    const int row = rowof(i); const float* src = xsrc_row(p, from_inputs, row / TB, row % TB);
#pragma unroll
    for (int q = 0; q < 4; ++q) vn[q] = *(const f32x4*)(src + q * 256 + lane * 4);
  }
  for (; i < nrows; i += wstride) {
    const int row = rowof(i); const int b = row / TB, s = row % TB;
    f32x4 v[4];
#pragma unroll
    for (int q = 0; q < 4; ++q) v[q] = vn[q];
    if (i + wstride < nrows) {
      const int rn = rowof(i + wstride); const float* src = xsrc_row(p, from_inputs, rn / TB, rn % TB);
#pragma unroll
      for (int q = 0; q < 4; ++q) vn[q] = *(const f32x4*)(src + q * 256 + lane * 4);
    }
    const float* mod = p.MOD + (size_t)(l * 9 + (s < NCTX ? 8 : b)) * 6144 + (which ? 3 * 1024 : 0);
    f32x4 sh[4], sc[4];
#pragma unroll
    for (int q = 0; q < 4; ++q) { sh[q] = *(const f32x4*)(mod + q * 256 + lane * 4); sc[q] = *(const f32x4*)(mod + 1024 + q * 256 + lane * 4); }
    float ss = 0.f;
#pragma unroll
    for (int q = 0; q < 4; ++q) ss += v[q][0] * v[q][0] + v[q][1] * v[q][1] + v[q][2] * v[q][2] + v[q][3] * v[q][3];
    ss = red64(ss);
    const float rs = rsqrtf(ss * (1.f / 1024.f) + EPSF);
    bf16_t* dst = p.HY + (size_t)row * DM;
#pragma unroll
    for (int q = 0; q < 4; ++q) {
      float o[4];
#pragma unroll
      for (int j = 0; j < 4; ++j) o[j] = (v[q][j] * rs * gg[q][j]) * (1.f + sc[q][j]) + sh[q][j];
      u32x2 w = {pk_bf16(o[0], o[1]), pk_bf16(o[2], o[3])};
      *(u32x2*)(dst + q * 256 + lane * 4) = w;
    }
  }
}

template <class Epi>
DI void gemm_tile(const bf16_t* __restrict__ A, int lda, const bf16_t* __restrict__ Bt, int ldb, int K, int row0, int col0, char* lds, const Epi& epi) {
  const int tid = opaque_tid(), lane = tid & 63, wid = tid >> 6, wr = wid >> 1, wc = wid & 1, fr = lane & 15, fq = lane >> 4;
  const bf16_t* ag[4];
  const bf16_t* bg[4];
#pragma unroll
  for (int i = 0; i < 4; ++i) {
    const int id = i * 256 + tid, r = id >> 3, cp = id & 7, c = cp ^ ((r >> 1) & 7);
    ag[i] = A + (size_t)(row0 + r) * lda + c * 8;
    bg[i] = Bt + (size_t)(col0 + r) * ldb + c * 8;
  }
  f32x4 acc[4][4];
#pragma unroll
  for (int m = 0; m < 4; ++m)
#pragma unroll
    for (int n = 0; n < 4; ++n) acc[m][n] = (f32x4){0.f, 0.f, 0.f, 0.f};
  const int KT = K >> 6;
  auto stage_a = [&](int kt, int buf) {
    char* sa = lds + buf * 32768;
#pragma unroll
    for (int i = 0; i < 4; ++i)
      __builtin_amdgcn_global_load_lds((const void __attribute__((address_space(1)))*)(ag[i] + kt * 64), (void LAS*)(sa + (i * 256 + tid) * 16), 16, 0, 0);
  };
  auto stage_b = [&](int kt, int buf) {
    char* sb = lds + buf * 32768 + 16384;
#pragma unroll
    for (int i = 0; i < 4; ++i)
      __builtin_amdgcn_global_load_lds((const void __attribute__((address_space(1)))*)(bg[i] + kt * 64), (void LAS*)(sb + (i * 256 + tid) * 16), 16, 0, 0);
  };
  __syncthreads();
  stage_a(0, 0); stage_b(0, 0);
  const int swz = fr >> 1;
  for (int kt = 0; kt < KT; ++kt) {
    asm volatile("s_waitcnt vmcnt(0)" ::: "memory");
    __syncthreads();
    const char* sa = lds + (kt & 1) * 32768 + (wr * 64 + fr) * 128;
    const char* sb = lds + (kt & 1) * 32768 + 16384 + (wc * 64 + fr) * 128;
#pragma unroll
    for (int kk = 0; kk < 2; ++kk) {
      if (kt + 1 < KT) { if (kk == 0) stage_a(kt + 1, (kt + 1) & 1); else stage_b(kt + 1, (kt + 1) & 1); }
      bf16x8 a[4], b[4];
      const int co = ((kk * 4 + fq) ^ swz) * 16;
#pragma unroll
      for (int m = 0; m < 4; ++m) a[m] = *(const bf16x8*)(sa + m * 2048 + co);
#pragma unroll
      for (int n = 0; n < 4; ++n) b[n] = *(const bf16x8*)(sb + n * 2048 + co);
#pragma unroll
      for (int m = 0; m < 4; ++m)
#pragma unroll
        for (int n = 0; n < 4; ++n) acc[m][n] = __builtin_amdgcn_mfma_f32_16x16x32_bf16(b[n], a[m], acc[m][n], 0, 0, 0);
    }
  }
  epi(acc, row0 + wr * 64, col0 + wc * 64, fr, fq);
}

struct EpiP {
  bf16_t *PA, *PBC; float* SSQ;
  DI void operator()(const f32x4 (&acc)[4][4], int r0, int c0, int fr, int fq) const {
    bf16_t* base; int ld, cb;
    if (c0 < LDPA) { base = PA; ld = LDPA; cb = c0; } else { base = PBC; ld = LDPBC; cb = c0 - LDPA; }
    if (c0 >= LDPA && cb < 1024) {
      float* dst = SSQ + (cb < 768 ? 0 : T_TOK);
#pragma unroll
      for (int m = 0; m < 4; ++m) {
        float ss = 0.f;
#pragma unroll
        for (int n = 0; n < 4; ++n)
#pragma unroll
          for (int j = 0; j < 4; ++j) ss += acc[m][n][j] * acc[m][n][j];
        ss += __shfl_xor(ss, 16); ss += __shfl_xor(ss, 32);
        if (fq == 0) atomicAdd(dst + r0 + m * 16 + fr, ss);
      }
    }
#pragma unroll
    for (int m = 0; m < 4; ++m)
#pragma unroll
      for (int n = 0; n < 4; ++n) {
        u32x2 v = {pk_bf16(acc[m][n][0], acc[m][n][1]), pk_bf16(acc[m][n][2], acc[m][n][3])};
        *(u32x2*)(base + (size_t)(r0 + m * 16 + fr) * ld + cb + n * 16 + fq * 4) = v;
      }
  }
};

DI void rope_angle(int pos, int i, float& cs, float& sn) {
  const float invf = __builtin_amdgcn_exp2f(-(float)i * (13.287712379549449f / 8.f));
  float ang = (float)pos * invf;
  float n = rintf(ang * 0.15915494309189535f);
  float r = fmaf(-n, 6.28125f, ang);
  r = fmaf(-n, 1.9353071795864769e-3f, r);
  cs = __cosf(r); sn = __sinf(r);
}

struct EpiQ {
  const float *rstd, *gn, *gr, *rope; bf16_t* Q;
  DI void operator()(const f32x4 (&acc)[4][4], int r0, int c0, int fr, int fq) const {
    if (c0 >= 576) return;
    if (c0 < 384) {
      const int h = c0 >> 6;
#pragma unroll
      for (int m = 0; m < 4; ++m) {
        const int row = r0 + m * 16 + fr; const float rs = rsqrtf(rstd[row] * (1.f / 768.f) + EPSF);
        float ss = 0.f;
#pragma unroll
        for (int n = 0; n < 4; ++n)
#pragma unroll
          for (int j = 0; j < 4; ++j) { float v = acc[m][n][j] * rs; ss += v * v; }
        ss += __shfl_xor(ss, 16); ss += __shfl_xor(ss, 32);
        const float inv = rsqrtf(ss * (1.f / 64.f) + EPSF) * rs * QSCALE;
        const int b = row / TB, s = row % TB;
        bf16_t* dst = Q + ((size_t)(b * 6 + h) * TB + s) * 96;
#pragma unroll
        for (int n = 0; n < 4; ++n) {
          const int d = n * 16 + fq * 4; f32x4 g = *(const f32x4*)(gn + d);
          u32x2 v = {pk_bf16(acc[m][n][0] * inv * g[0], acc[m][n][1] * inv * g[1]), pk_bf16(acc[m][n][2] * inv * g[2], acc[m][n][3] * inv * g[3])};
          *(u32x2*)(dst + d) = v;
        }
      }
    } else {
#pragma unroll
      for (int m = 0; m < 4; ++m) {
        const int row = r0 + m * 16 + fr; const float rs = rsqrtf(rstd[row] * (1.f / 768.f) + EPSF);
        const int b = row / TB, s = row % TB; const bool lat = s >= NCTX; const int sp = s - NCTX;
#pragma unroll
        for (int hh = 0; hh < 2; ++hh) {
          const int h = ((c0 - 384) >> 5) + hh;
          float ss = 0.f;
#pragma unroll
          for (int nn = 0; nn < 2; ++nn)
#pragma unroll
            for (int j = 0; j < 4; ++j) { float v = acc[m][hh * 2 + nn][j] * rs; ss += v * v; }
          ss += __shfl_xor(ss, 16); ss += __shfl_xor(ss, 32);
          const float inv = rsqrtf(ss * (1.f / 32.f) + EPSF) * rs;
          bf16_t* dst = Q + ((size_t)(b * 6 + h) * TB + s) * 96 + 64;
#pragma unroll
          for (int nn = 0; nn < 2; ++nn) {
            const int d = nn * 16 + fq * 4; f32x4 g = *(const f32x4*)(gr + d);
            float o[4];
#pragma unroll
            for (int j = 0; j < 4; ++j) {
              float val = acc[m][hh * 2 + nn][j] * inv * g[j];
              float partner = __shfl_xor(val, 32);
              if (lat) {
                const float* rt = rope + ((nn == 0 ? (sp >> 6) : (sp & 63)) * 8 + ((fq * 4 + j) & 7)) * 2; const float cs = rt[0], sn = rt[1];
                val = fq < 2 ? val * cs - partner * sn : val * cs + partner * sn;
              }
              o[j] = val * QSCALE;
            }
            u32x2 v = {pk_bf16(o[0], o[1]), pk_bf16(o[2], o[3])};
            *(u32x2*)(dst + d) = v;
          }
        }
      }
    }
  }
};

struct EpiK {
  const float *rstd, *gk; bf16_t* Kt;
  DI void operator()(const f32x4 (&acc)[4][4], int r0, int c0, int fr, int fq) const {
    const int h = c0 >> 6;
#pragma unroll
    for (int m = 0; m < 4; ++m) {
      const int row = r0 + m * 16 + fr; const float rs = rsqrtf(rstd[row] * (1.f / 256.f) + EPSF);
      float ss = 0.f;
#pragma unroll
      for (int n = 0; n < 4; ++n)
#pragma unroll
        for (int j = 0; j < 4; ++j) { float v = acc[m][n][j] * rs; ss += v * v; }
      ss += __shfl_xor(ss, 16); ss += __shfl_xor(ss, 32);
      const float inv = rsqrtf(ss * (1.f / 64.f) + EPSF) * rs;
      const int b = row / TB, s = row % TB;
      bf16_t* dst = Kt + ((size_t)(b * 6 + h) * TB + s) * 96;
#pragma unroll
      for (int n = 0; n < 4; ++n) {
        const int d = n * 16 + fq * 4; f32x4 g = *(const f32x4*)(gk + d);
        u32x2 v = {pk_bf16(acc[m][n][0] * inv * g[0], acc[m][n][1] * inv * g[1]), pk_bf16(acc[m][n][2] * inv * g[2], acc[m][n][3] * inv * g[3])};
        *(u32x2*)(dst + d) = v;
      }
    }
  }
};

struct EpiV {
  const float* rstd; bf16_t* VT;
  DI void operator()(const f32x4 (&acc)[4][4], int r0, int c0, int fr, int fq) const {
#pragma unroll
    for (int m = 0; m < 4; ++m)
#pragma unroll
      for (int n = 0; n < 4; ++n) {
        const int row = r0 + m * 16 + fr, col = c0 + n * 16 + fq * 4;
        f32x4 rs = *(const f32x4*)(rstd + col);
#pragma unroll
        for (int j = 0; j < 4; ++j) rs[j] = rsqrtf(rs[j] * (1.f / 256.f) + EPSF);
        u32x2 v = {pk_bf16(acc[m][n][0] * rs[0], acc[m][n][1] * rs[1]), pk_bf16(acc[m][n][2] * rs[2], acc[m][n][3] * rs[3])};
        *(u32x2*)(VT + (size_t)row * T_TOK + col) = v;
      }
  }
};

struct EpiPost {
  const float *Y, *BON, *mu, *lnx_g, *lnx_b; const bf16_t* PA; bf16_t* YC;
  DI void operator()(const f32x4 (&acc)[4][4], int r0, int c0, int fr, int fq) const {
    const int h = c0 >> 6;
#pragma unroll
    for (int m = 0; m < 4; ++m) {
      const int row = r0 + m * 16 + fr; const int s = row % TB;
      const bool hasprev = (s != 0 && s != NCTX), hasnext = (s != NCTX - 1 && s != TB - 1);
      f32x4 y[4];
      float s1 = 0.f;
#pragma unroll
      for (int n = 0; n < 4; ++n) {
        const size_t o = (size_t)row * 384 + c0 + n * 16 + fq * 4;
        y[n] = *(const f32x4*)(Y + o) + *(const f32x4*)(Y + (size_t)T_TOK * 384 + o);
        s1 += y[n][0] + y[n][1] + y[n][2] + y[n][3];
      }
      s1 += __shfl_xor(s1, 16); s1 += __shfl_xor(s1, 32);
      const float mean = s1 * (1.f / 64.f);
      float s2 = 0.f;
#pragma unroll
      for (int n = 0; n < 4; ++n)
#pragma unroll
        for (int j = 0; j < 4; ++j) { float d = y[n][j] - mean; s2 += d * d; }
      s2 += __shfl_xor(s2, 16); s2 += __shfl_xor(s2, 32);
      const float rstdv = rsqrtf(s2 * (1.f / 64.f) + GN_EPS);
      const float bon = BON[(size_t)row * 6 + h] + BON[(size_t)T_TOK * 6 + (size_t)row * 6 + h];
#pragma unroll
      for (int n = 0; n < 4; ++n) {
        const int col = c0 + n * 16 + fq * 4;
        const bf16_t* pv = PA + (size_t)row * LDPA + 768 + col;
        float vc[4], vp[4] = {0.f, 0.f, 0.f, 0.f}, vn[4] = {0.f, 0.f, 0.f, 0.f};
        unpack4(*(const u32x2*)pv, vc);
        if (hasprev) unpack4(*(const u32x2*)(pv - LDPA), vp);
        if (hasnext) unpack4(*(const u32x2*)(pv + LDPA), vn);
        f32x4 m0 = *(const f32x4*)(mu + 768 + col), m1 = *(const f32x4*)(mu + LDPA + 768 + col);
        f32x4 lg = *(const f32x4*)(lnx_g + col), lb = *(const f32x4*)(lnx_b + col);
        float o[4];
#pragma unroll
        for (int j = 0; j < 4; ++j) {
          const float v = vc[j] + m0[j] * (vp[j] - vc[j]) + m1[j] * (vn[j] - vc[j]);
          o[j] = ((y[n][j] - mean) * rstdv * lg[j] + lb[j] + bon * v) * acc[m][n][j];
        }
        u32x2 w = {pk_bf16(o[0], o[1]), pk_bf16(o[2], o[3])};
        *(u32x2*)(YC + (size_t)row * DM + col) = w;
      }
    }
  }
};

struct EpiRes {
  const Params* p; int l; bool from_inputs; int gate_off;
  DI void operator()(const f32x4 (&acc)[4][4], int r0, int c0, int fr, int fq) const {
#pragma unroll
    for (int m = 0; m < 4; ++m) {
      const int row = r0 + m * 16 + fr; const int b = row / TB, s = row % TB;
      const float* src = xsrc_row(*p, from_inputs, b, s);
      float* dst = xdst_row(*p, b, s);
      const float* gate = p->MOD + (size_t)(l * 9 + (s < NCTX ? 8 : b)) * 6144 + gate_off;
#pragma unroll
      for (int n = 0; n < 4; ++n) {
        const int col = c0 + n * 16 + fq * 4;
        f32x4 g = *(const f32x4*)(gate + col), xv = *(const f32x4*)(src + col);
        *(f32x4*)(dst + col) = xv + g * acc[m][n];
      }
    }
  }
};

struct EpiFfnIn {
  bf16_t* ACT;
  DI void operator()(const f32x4 (&acc)[4][4], int r0, int c0, int fr, int fq) const {
    const int cb = (c0 >> 6) * 32;
#pragma unroll
    for (int m = 0; m < 4; ++m)
#pragma unroll
      for (int n = 0; n < 2; ++n) {
        float o[4];
#pragma unroll
        for (int j = 0; j < 4; ++j) { float g = acc[m][n][j]; o[j] = g * __builtin_amdgcn_rcpf(1.f + __expf(-g)) * acc[m][n + 2][j]; }
        u32x2 w = {pk_bf16(o[0], o[1]), pk_bf16(o[2], o[3])};
        *(u32x2*)(ACT + (size_t)(r0 + m * 16 + fr) * 2816 + cb + n * 16 + fq * 4) = w;
      }
  }
};

DI void prep_token(const Params& p, int l, int row, int lane) {
  const int b = row / TB, s = row % TB;
  const bool hasprev = (s != 0 && s != NCTX), hasnext = (s != NCTX - 1 && s != TB - 1);
  const float mp = hasprev ? 1.f : 0.f, mn = hasnext ? 1.f : 0.f;
  const bf16_t* pa = p.PA + (size_t)row * LDPA;
  const bf16_t* pbc = p.PBC + (size_t)row * LDPBC;
  const int opa = hasprev ? -LDPA : 0, ona = hasnext ? LDPA : 0, opb = hasprev ? -LDPBC : 0, onb = hasnext ? LDPBC : 0;
  const int l32 = lane & 31, c8 = l32 * 8, colA = 1152 + c8;
  const u32x4 la_c = *(const u32x4*)(pa + colA), la_p = *(const u32x4*)(pa + opa + colA), la_n = *(const u32x4*)(pa + ona + colA);
  const u32x4 lq0 = *(const u32x4*)(pbc + lane * 8), lq1 = *(const u32x4*)(pbc + 512 + c8), lkv = *(const u32x4*)(pbc + 768 + c8);
  const u32x4 lrp = *(const u32x4*)(pbc + 1024 + (lane & 3) * 8);
  const u32x4 lbg = *(const u32x4*)(pbc + 1056 + c8), lcc = *(const u32x4*)(pbc + 1312 + c8), lhh = *(const u32x4*)(pbc + 1568 + c8);
  const u32x4 lcp = *(const u32x4*)(pbc + opb + 1312 + c8), lhp = *(const u32x4*)(pbc + opb + 1568 + c8);
  const u32x4 lcn = *(const u32x4*)(pbc + onb + 1312 + c8), lhn = *(const u32x4*)(pbc + onb + 1568 + c8);
  const float* mu = p.tshift_mu + (size_t)l * 2 * LDPA;
  {
    float c[8], pv[8], nx[8], o[8];
    unpack8(la_c, c); unpack8(la_p, pv); unpack8(la_n, nx);
    const f32x4 m0a = *(const f32x4*)(mu + colA), m0b = *(const f32x4*)(mu + colA + 4), m1a = *(const f32x4*)(mu + LDPA + colA), m1b = *(const f32x4*)(mu + LDPA + colA + 4);
#pragma unroll
    for (int j = 0; j < 8; ++j) {
      const float m0 = j < 4 ? m0a[j & 3] : m0b[j & 3], m1 = j < 4 ? m1a[j & 3] : m1b[j & 3];
      float t = c[j] + m0 * (pv[j] * mp - c[j]) + m1 * (nx[j] * mn - c[j]);
      if (l32 < 8) { float e = __expf(2.f * t); t = 1.f - 2.f * __builtin_amdgcn_rcpf(1.f + e); }
      else if (l32 >= 16) t = __builtin_amdgcn_rcpf(1.f + __expf(-t));
      o[j] = t;
    }
    u32x4 w = {pk_bf16(o[0], o[1]), pk_bf16(o[2], o[3]), pk_bf16(o[4], o[5]), pk_bf16(o[6], o[7])};
    if (lane < 8) *(u32x4*)(p.TW + (size_t)row * 64 + lane * 8) = w;
    else if (lane < 16) *(u32x4*)(p.TA + (size_t)row * 64 + (lane - 8) * 8) = w;
    else if (lane < 32) *(u32x4*)(p.TG + (size_t)row * 128 + (lane - 16) * 8) = w;
  }
  float f[8], ss = 0.f, s2 = 0.f, s3 = 0.f, fr_[8];
  unpack8(lq0, f);
#pragma unroll
  for (int j = 0; j < 8; ++j) ss += f[j] * f[j];
  unpack8(lq1, f);
  if (lane < 32) {
#pragma unroll
    for (int j = 0; j < 8; ++j) ss += f[j] * f[j];
  }
  unpack8(lkv, f);
  if (lane < 32) {
#pragma unroll
    for (int j = 0; j < 8; ++j) s2 += f[j] * f[j];
  }
  unpack8(lrp, fr_);
  if (lane < 4) {
#pragma unroll
    for (int j = 0; j < 8; ++j) s3 += fr_[j] * fr_[j];
  }
  s3 += __shfl_xor(s3, 1); s3 += __shfl_xor(s3, 2);
  {
    const float inv = rsqrtf(s3 * (1.f / 32.f) + EPSF);
    const float* g = p.k_rope_g + l * 32;
    const bool lat = s >= NCTX; const int sp = lat ? s - NCTX : 0;
    const float* rt = p.ROPE + ((lane & 2) ? (sp & 63) : (sp >> 6)) * 16;
    float o[8];
#pragma unroll
    for (int j = 0; j < 8; ++j) {
      float val = fr_[j] * inv * g[(lane & 3) * 8 + j];
      float partner = __shfl_xor(val, 1);
      if (lat) {
        const float cs = rt[2 * j], sn = rt[2 * j + 1];
        val = (lane & 1) == 0 ? val * cs - partner * sn : val * cs + partner * sn;
      }
      o[j] = val;
    }
    if (lane < 4) {
      u32x4 w = {pk_bf16(o[0], o[1]), pk_bf16(o[2], o[3]), pk_bf16(o[4], o[5]), pk_bf16(o[6], o[7])};
#pragma unroll
      for (int hh = 0; hh < 6; ++hh) *(u32x4*)(p.Kt + ((size_t)(b * 6 + hh) * TB + s) * 96 + 64 + lane * 8) = w;
    }
  }
  {
    float bg[8], cc[8], hh[8], cp[8], hp[8], cn[8], hn[8], o[8];
    unpack8(lbg, bg); unpack8(lcc, cc); unpack8(lhh, hh); unpack8(lcp, cp); unpack8(lhp, hp); unpack8(lcn, cn); unpack8(lhn, hn);
    const float* cw = p.conv_w + (size_t)l * 3 * 256;
#pragma unroll
    for (int j = 0; j < 8; ++j) o[j] = bg[j] * (cw[c8 + j] * cp[j] * hp[j] * mp + cw[256 + c8 + j] * cc[j] * hh[j] + cw[512 + c8 + j] * cn[j] * hn[j] * mn);
    u32x4 w = {pk_bf16(o[0], o[1]), pk_bf16(o[2], o[3]), pk_bf16(o[4], o[5]), pk_bf16(o[6], o[7])};
    if (lane < 32) *(u32x4*)(p.HY + (size_t)row * DM + 768 + c8) = w;
  }
}

#define MFMA32(a, b, c) __builtin_amdgcn_mfma_f32_32x32x16_bf16((a), (b), (c), 0, 0, 0)
DI bf16x8 pack8(const f32x16& x, int s) {
  u32x4 v = {pk_bf16(x[8 * s], x[8 * s + 1]), pk_bf16(x[8 * s + 2], x[8 * s + 3]), pk_bf16(x[8 * s + 4], x[8 * s + 5]), pk_bf16(x[8 * s + 6], x[8 * s + 7])};
  return __builtin_bit_cast(bf16x8, v);
}
constexpr int KROW = 208, VROW = 136, KBUF = 64 * KROW, VBUF = 64 * VROW;
DI void attn_task(const Params& p, int b, int h, int q0, int k0, int nk, char* lds) {
  const int tid = opaque_tid(), lane = tid & 63, wid = tid >> 6, r = lane & 31, hh = lane >> 5;
  const bf16_t* Qp = p.Q + ((size_t)(b * 6 + h) * TB + q0 + wid * 32 + r) * 96;
  const bf16_t* Kp = p.Kt + ((size_t)(b * 6 + h) * TB + k0) * 96;
  const bf16_t* Vp = p.VT + (size_t)(h * 64) * T_TOK + (size_t)b * TB + k0;
  bf16x8 qf[6];
#pragma unroll
  for (int ks = 0; ks < 6; ++ks) qf[ks] = *(const bf16x8*)(Qp + ks * 16 + hh * 8);
  int krow_[3], kch_[3];
#pragma unroll
  for (int i = 0; i < 3; ++i) { int id = tid + i * 256; krow_[i] = id / 12; kch_[i] = id % 12; }
  const int vd0 = tid >> 3, vch = tid & 7;
  u32x4 kreg[3], vreg[2];
  auto load_regs = [&](int kt) {
#pragma unroll
    for (int i = 0; i < 3; ++i) kreg[i] = *(const u32x4*)(Kp + (size_t)(kt * 64 + krow_[i]) * 96 + kch_[i] * 8);
#pragma unroll
    for (int i = 0; i < 2; ++i) vreg[i] = *(const u32x4*)(Vp + (size_t)(vd0 + 32 * i) * T_TOK + kt * 64 + vch * 8);
  };
  auto write_lds = [&](int buf) {
    char* kb = lds + buf * (KBUF + VBUF);
    char* vb = kb + KBUF;
#pragma unroll
    for (int i = 0; i < 3; ++i) *(u32x4*)(kb + krow_[i] * KROW + kch_[i] * 16) = kreg[i];
#pragma unroll
    for (int i = 0; i < 2; ++i) {
      char* d = vb + (vd0 + 32 * i) * VROW + vch * 16;
      *(u32x2*)d = (u32x2){vreg[i][0], vreg[i][1]};
      *(u32x2*)(d + 8) = (u32x2){vreg[i][2], vreg[i][3]};
    }
  };
  f32x16 o[2];
#pragma unroll
  for (int i = 0; i < 16; ++i) { o[0][i] = 0.f; o[1][i] = 0.f; }
  float m_run = -1e30f, l_run = 0.f;
  const int NT = nk >> 6;
  __syncthreads();
  load_regs(0);
  write_lds(0);
  for (int kt = 0; kt < NT; ++kt) {
    if (kt + 1 < NT) load_regs(kt + 1);
    __syncthreads();
    const char* kb = lds + (kt & 1) * (KBUF + VBUF);
    const char* vb = kb + KBUF;
    f32x16 st[2];
#pragma unroll
    for (int kbk = 0; kbk < 2; ++kbk) {
#pragma unroll
      for (int i = 0; i < 16; ++i) st[kbk][i] = 0.f;
#pragma unroll
      for (int ks = 0; ks < 6; ++ks) {
        bf16x8 kf = *(const bf16x8*)(kb + (kbk * 32 + r) * KROW + ks * 32 + hh * 16);
        st[kbk] = MFMA32(kf, qf[ks], st[kbk]);
      }
    }
    float mx = st[0][0];
#pragma unroll
    for (int i = 0; i < 16; ++i) { mx = fmaxf(mx, st[0][i]); mx = fmaxf(mx, st[1][i]); }
    mx = fmaxf(mx, __shfl_xor(mx, 32));
    const float m_new = fmaxf(m_run, mx);
    const float alpha = __builtin_amdgcn_exp2f(m_run - m_new);
    m_run = m_new;
    float psum = 0.f;
#pragma unroll
    for (int kbk = 0; kbk < 2; ++kbk)
#pragma unroll
      for (int i = 0; i < 16; ++i) { float e = __builtin_amdgcn_exp2f(st[kbk][i] - m_new); st[kbk][i] = e; psum += e; }
    psum += __shfl_xor(psum, 32);
    l_run = l_run * alpha + psum;
#pragma unroll
    for (int i = 0; i < 16; ++i) { o[0][i] *= alpha; o[1][i] *= alpha; }
#pragma unroll
    for (int ksv = 0; ksv < 4; ++ksv) {
      const bf16x8 pf = pack8(st[ksv >> 1], ksv & 1);
#pragma unroll
      for (int db = 0; db < 2; ++db) {
        const char* va = vb + (db * 32 + r) * VROW + (ksv * 16 + 4 * hh) * 2;
        s16x4 lo = *(const s16x4*)va, hi = *(const s16x4*)(va + 16);
        bf16x8 vf = __builtin_shufflevector(lo, hi, 0, 1, 2, 3, 4, 5, 6, 7);
        o[db] = MFMA32(vf, pf, o[db]);
      }
    }
    if (kt + 1 < NT) write_lds((kt + 1) & 1);
  }
  const float invl = 1.f / l_run;
  bf16_t* dst = p.HY + (size_t)(b * TB + q0 + wid * 32 + r) * DM + 384 + h * 64;
#pragma unroll
  for (int db = 0; db < 2; ++db)
#pragma unroll
    for (int g = 0; g < 4; ++g) {
      u32x2 w = {pk_bf16(o[db][4 * g] * invl, o[db][4 * g + 1] * invl), pk_bf16(o[db][4 * g + 2] * invl, o[db][4 * g + 3] * invl)};
      *(u32x2*)(dst + db * 32 + 8 * g + 4 * hh) = w;
    }
}

enum { VW = 0, VKK = 1, VB = 2, VKD = 3, VR = 4, VV = 5 };
constexpr int CS = 68, CP = 16 * CS;
DI void scan_task(const Params& p, int l, int b, int h, int dir, int half, char* lds) {
  float* cb = (float*)lds;
  float* tk = cb + 6 * CP;
  float* ybuf = tk + CP;
  const int tid = opaque_tid(), lane = tid & 63, wid = tid >> 6;
  const int st_p = tid >> 4, c4 = tid & 15;
  const int fr = lane & 15, fq = lane >> 4;
  const int rp = lane >> 4, g = lane & 15;
  const int hc = h * 64;
  bf16x8 bw[2], ba[2];
  {
    const bf16_t* wd = p.Wdecay + ((size_t)dir * 384 + hc + wid * 16 + fr) * 64;
    const bf16_t* wi = p.Wicl + ((size_t)dir * 384 + hc + wid * 16 + fr) * 64;
#pragma unroll
    for (int ks = 0; ks < 2; ++ks) { bw[ks] = *(const bf16x8*)(wd + ks * 32 + fq * 8); ba[ks] = *(const bf16x8*)(wi + ks * 32 + fq * 8); }
  }
  f32x4 mu0[3], mu1[3];
  const float* mu = p.tshift_mu + (size_t)l * 2 * LDPA;
#pragma unroll
  for (int sec = 0; sec < 3; ++sec) { mu0[sec] = *(const f32x4*)(mu + sec * 384 + hc + c4 * 4); mu1[sec] = *(const f32x4*)(mu + LDPA + sec * 384 + hc + c4 * 4); }
  const f32x4 kkg = *(const f32x4*)(p.k_k + l * 384 + hc + c4 * 4);
  const f32x4 rkg = *(const f32x4*)(p.r_k + l * 384 + hc + c4 * 4);
  const int colB = wid * 16 + fq * 4;
  const f32x4 w0 = *(const f32x4*)(p.decay_w0 + (size_t)(l * 2 + dir) * 384 + hc + colB);
  const f32x4 a0 = *(const f32x4*)(p.icl_a0 + (size_t)(l * 2 + dir) * 384 + hc + colB);
  const f32x4 kag = *(const f32x4*)(p.k_a + l * 384 + hc + colB);

  u32x2 ld[3][3];
  float mprev = 0.f, mnext = 0.f;
  bf16x8 aw[2], aa[2];
  auto chunk_lo = [&](int c) -> int { return dir == 0 ? 16 * c : (c < 16 ? 240 - 16 * c : 2544 - 16 * c); };
  auto issue_loads = [&](int c) {
    const int slo = chunk_lo(c);
    const int s = slo + st_p;
    const bool hasprev = (s != 0 && s != NCTX), hasnext = (s != NCTX - 1 && s != TB - 1);
    const bf16_t* pa = p.PA + (size_t)(b * TB + s) * LDPA + hc + c4 * 4;
    const int op = hasprev ? -LDPA : 0, on = hasnext ? LDPA : 0;
    mprev = hasprev ? 1.f : 0.f; mnext = hasnext ? 1.f : 0.f;
#pragma unroll
    for (int sec = 0; sec < 3; ++sec) {
      ld[sec][1] = *(const u32x2*)(pa + sec * 384);
      ld[sec][0] = *(const u32x2*)(pa + sec * 384 + op);
      ld[sec][2] = *(const u32x2*)(pa + sec * 384 + on);
    }
    const size_t trow = (size_t)(b * TB + slo + fr) * 64;
#pragma unroll
    for (int ks = 0; ks < 2; ++ks) { aw[ks] = *(const bf16x8*)(p.TW + trow + ks * 32 + fq * 8); aa[ks] = *(const bf16x8*)(p.TA + trow + ks * 32 + fq * 8); }
  };
  auto produce = [&](int c) {
    const int slo = chunk_lo(c);
    float ts[3][4];
#pragma unroll
    for (int sec = 0; sec < 3; ++sec) {
      float pc[4], pp[4], pn[4];
      unpack4(ld[sec][1], pc); unpack4(ld[sec][0], pp); unpack4(ld[sec][2], pn);
#pragma unroll
      for (int j = 0; j < 4; ++j) ts[sec][j] = pc[j] + mu0[sec][j] * (pp[j] * mprev - pc[j]) + mu1[sec][j] * (pn[j] * mnext - pc[j]);
    }
    *(f32x4*)(cb + VR * CP + st_p * CS + c4 * 4) = (f32x4){ts[0][0], ts[0][1], ts[0][2], ts[0][3]};
    *(f32x4*)(cb + VV * CP + st_p * CS + c4 * 4) = (f32x4){ts[2][0], ts[2][1], ts[2][2], ts[2][3]};
    *(f32x4*)(tk + st_p * CS + c4 * 4) = (f32x4){ts[1][0], ts[1][1], ts[1][2], ts[1][3]};
    float kx[4], ss = 0.f;
#pragma unroll
    for (int j = 0; j < 4; ++j) { kx[j] = ts[1][j] * kkg[j]; ss += kx[j] * kx[j]; }
    ss = red16(ss);
    const float inv = rsqrtf(ss + 1e-12f);
    *(f32x4*)(cb + VKK * CP + st_p * CS + c4 * 4) = (f32x4){kx[0] * inv, kx[1] * inv, kx[2] * inv, kx[3] * inv};
    __syncthreads();
    f32x4 dw = {0.f, 0.f, 0.f, 0.f}, da = {0.f, 0.f, 0.f, 0.f};
#pragma unroll
    for (int ks = 0; ks < 2; ++ks) {
      dw = __builtin_amdgcn_mfma_f32_16x16x32_bf16(bw[ks], aw[ks], dw, 0, 0, 0);
      da = __builtin_amdgcn_mfma_f32_16x16x32_bf16(ba[ks], aa[ks], da, 0, 0, 0);
    }
    {
      const f32x4 kv = *(const f32x4*)(tk + fr * CS + colB);
      const f32x4 kkv = *(const f32x4*)(cb + VKK * CP + fr * CS + colB);
      f32x4 wv, kdv, bv;
#pragma unroll
      for (int j = 0; j < 4; ++j) {
        wv[j] = __expf(-LOG_DECAY_SCALE * sigmoidf_(w0[j] + dw[j]));
        const float a = sigmoidf_(a0[j] + da[j]);
        kdv[j] = kv[j] * (1.f + (a - 1.f) * kag[j]);
        bv[j] = kkv[j] * a;
      }
      *(f32x4*)(cb + VW * CP + fr * CS + colB) = wv;
      *(f32x4*)(cb + VKD * CP + fr * CS + colB) = kdv;
      *(f32x4*)(cb + VB * CP + fr * CS + colB) = bv;
    }
    __syncthreads();
    {
      const f32x4 rv = *(const f32x4*)(cb + VR * CP + st_p * CS + c4 * 4);
      const f32x4 kdv = *(const f32x4*)(cb + VKD * CP + st_p * CS + c4 * 4);
      float bs = rv[0] * kdv[0] * rkg[0] + rv[1] * kdv[1] * rkg[1] + rv[2] * kdv[2] * rkg[2] + rv[3] * kdv[3] * rkg[3];
      bs = red16(bs);
      if (c4 == 0 && half == 0) p.BON[(size_t)dir * T_TOK * 6 + (size_t)(b * TB + slo + st_p) * 6 + h] = bs;
    }
  };

  f32x2 S0[2], S1[2];
#pragma unroll
  for (int j = 0; j < 2; ++j) { S0[j] = (f32x2){0.f, 0.f}; S1[j] = (f32x2){0.f, 0.f}; }
  __syncthreads();
  issue_loads(0);
  produce(0);
  __syncthreads();
  const int NCH = TB / 16;
  const int rowl = half * 32 + wid * 8 + rp * 2;
  const int inc = dir ? -CS : CS;
  for (int c = 0; c < NCH; ++c) {
    if (c + 1 < NCH) issue_loads(c + 1);
    {
      const float* ps = cb + (dir ? 15 * CS : 0) + g * 4;
      const float* pv = cb + VV * CP + (dir ? 15 * CS : 0) + rowl;
      float* py = ybuf + (dir ? 15 * 512 : 0) + ((wid * 4 + rp) * 16 + g) * 2;
      f32x4 cw = *(const f32x4*)(ps + VW * CP), ckk = *(const f32x4*)(ps + VKK * CP), cbb = *(const f32x4*)(ps + VB * CP),
            ckd = *(const f32x4*)(ps + VKD * CP), crr = *(const f32x4*)(ps + VR * CP);
      f32x2 cvv = *(const f32x2*)pv;
#pragma unroll
      for (int ii = 0; ii < 16; ++ii) {
        f32x4 nw = cw, nkk = ckk, nbb = cbb, nkd = ckd, nrr = crr; f32x2 nvv = cvv;
        if (ii < 15) {
          ps += inc; pv += inc;
          nw = *(const f32x4*)(ps + VW * CP); nkk = *(const f32x4*)(ps + VKK * CP); nbb = *(const f32x4*)(ps + VB * CP);
          nkd = *(const f32x4*)(ps + VKD * CP); nrr = *(const f32x4*)(ps + VR * CP); nvv = *(const f32x2*)pv;
        }
        __builtin_amdgcn_sched_barrier(0x7);
        const f32x2 kk0 = {ckk[0], ckk[1]}, kk1 = {ckk[2], ckk[3]}, w0 = {cw[0], cw[1]}, w1 = {cw[2], cw[3]};
        const f32x2 b0 = {cbb[0], cbb[1]}, b1 = {cbb[2], cbb[3]}, kd0 = {ckd[0], ckd[1]}, kd1 = {ckd[2], ckd[3]};
        const f32x2 r0 = {crr[0], crr[1]}, r1 = {crr[2], crr[3]};
        const f32x2 p0 = S0[0] * kk0 + S0[1] * kk1, p1 = S1[0] * kk0 + S1[1] * kk1;
        const f32x2 u00 = S0[0] * w0 + kd0 * cvv[0], u01 = S0[1] * w1 + kd1 * cvv[0];
        const f32x2 u10 = S1[0] * w0 + kd0 * cvv[1], u11 = S1[1] * w1 + kd1 * cvv[1];
        const float q0 = red16(p0[0] + p0[1]), q1 = red16(p1[0] + p1[1]);
        S0[0] = u00 - b0 * q0; S0[1] = u01 - b1 * q0;
        S1[0] = u10 - b0 * q1; S1[1] = u11 - b1 * q1;
        const f32x2 y0 = S0[0] * r0 + S0[1] * r1, y1 = S1[0] * r0 + S1[1] * r1;
        *(f32x2*)py = (f32x2){y0[0] + y0[1], y1[0] + y1[1]};
        py += dir ? -512 : 512;
        cw = nw; ckk = nkk; cbb = nbb; ckd = nkd; crr = nrr; cvv = nvv;
      }
    }
    __syncthreads();
    {
      const int slo = chunk_lo(c);
      const float* yp = ybuf + (st_p * 16 + c4) * 32;
      f32x4 a = *(const f32x4*)(yp + 4 * (c4 & 7));
#pragma unroll
      for (int i = 1; i < 8; ++i) a += *(const f32x4*)(yp + 4 * ((i + c4) & 7));
      *(f32x2*)(p.Y + (size_t)dir * T_TOK * 384 + (size_t)(b * TB + slo + st_p) * 384 + hc + half * 32 + c4 * 2) = (f32x2){a[0] + a[2], a[1] + a[3]};
    }
    if (c + 1 < NCH) produce(c + 1);
  }
  __syncthreads();
}

DI int lat_tile(int i) { return (i >> 4) * 18 + 2 + (i & 15); }
DI bool xcd_tile(int bid, int G, int i, int MT, int NT, int& tm, int& tn) {
  if ((G & 7) || (MT & 7)) { const int t = bid + i * G; if (t >= MT * NT) return false; tm = t / NT; tn = t % NT; return true; }
  const int nbx = G >> 3, x = bid & 7, j = bid >> 3, MS = MT >> 3;
  const int q = j + nbx * i;
  if (q >= MS * NT) return false;
  const int full = NT >> 3, wl = NT & 7;
  int nb = q / (MS * 8), m, ni;
  if (nb < full) { const int rem = q - nb * MS * 8; m = rem >> 3; ni = rem & 7; }
  else { const int rem = q - full * MS * 8; nb = full; m = rem / wl; ni = rem % wl; }
  tm = x * MS + m; tn = nb * 8 + ni;
  return true;
}

template <int KSEL> DI void run_phase(const Params& p, int ph, char* lds) {
  const int bid = blockIdx.x, G = gridDim.x, tid = opaque_tid(), lane = tid & 63, wid = tid >> 6;
  if (ph == 0) {
    if (KSEL >= 0 && KSEL != 10) return;
    for (int t = bid; t < 384 + NCONV_W1 + 1; t += G) {
      if (t < 384) adaln_task(p, t, lds);
      else if (t < 384 + NCONV_W1) conv_w1_task(p, 0, t - 384, lds);
      else { for (int e = tid; e < 512; e += 256) { float cs, sn; rope_angle(e >> 3, e & 7, cs, sn); p.ROPE[2 * e] = cs; p.ROPE[2 * e + 1] = sn; } }
    }
    return;
  }
  if (KSEL == 10) return;
  const int l = (ph - 1) / 9, kq = (ph - 1) % 9, k = kq < 2 ? kq : kq + 1;
  const bool last = (l == 1);
  const int lb = ((G & 7) == 0) ? (bid & 7) * (G >> 3) + (bid >> 3) : bid;
  if (KSEL >= 0 && KSEL != 10 && k != (KSEL == 11 ? 4 : KSEL)) return;
  switch (k) {
    case 0:
      for (int i = bid * 256 + tid; i < 2 * T_TOK; i += G * 256) p.RSTD[i] = 0.f;
      modnorm_rows(p, l, 0, l == 0, false, bid * 4 + wid, G * 4, lane);
      break;
    case 1: {
      EpiP e{p.PA, p.PBC, p.RSTD};
      for (int i = 0, tm, tn; xcd_tile(bid, G, i, 144, 26, tm, tn); ++i) gemm_tile(p.HY, DM, p.Win, DM, DM, tm * 128, tn * 128, lds, e);
    } break;
    case 3: {
      const int nq = last ? 128 * 5 : 144 * 5;
      EpiQ eq{p.RSTD, p.q_nope_g + l * 64, p.q_rope_g + l * 32, p.ROPE, p.Q};
      EpiK ek{p.RSTD + T_TOK, p.k_nope_g + l * 64, p.Kt};
      EpiV ev{p.RSTD + T_TOK, p.VT};
      if (KSEL >= 0) {
        for (int t = bid; t < nq + 432 + 432 + T_TOK / 4; t += G) {
          if (t >= nq + 864) { prep_token(p, l, (t - nq - 864) * 4 + wid, lane); continue; }
          if (t < nq) { int i = t / 5; int tm = last ? lat_tile(i) : i; gemm_tile(p.PBC, LDPBC, p.Wuq, 768, 768, tm * 128, (t % 5) * 128, lds, eq); }
          else if (t < nq + 432) { int u = t - nq; gemm_tile(p.PBC + 768, LDPBC, p.WukvK, 256, 256, (u / 3) * 128, (u % 3) * 128, lds, ek); }
          else { int u = t - nq - 432; gemm_tile(p.WvT, 256, p.PBC + 768, LDPBC, 256, (u % 3) * 128, (u / 3) * 128, lds, ev); }
        }
      } else {
        for (int t = bid; t < T_TOK / 4; t += G) prep_token(p, l, t * 4 + wid, lane);
        volatile LAS unsigned* slot = (volatile LAS unsigned*)(lds + 65536 + 8);
        unsigned* qg = p.BAR + 3456   + 64 * l + 16;
        for (;;) {
          __syncthreads();
          if (tid == 0) *slot = __hip_atomic_fetch_add(qg, 1u, __ATOMIC_RELAXED, __HIP_MEMORY_SCOPE_AGENT);
          __syncthreads();
          const int t = (int)*slot;
          if (t >= nq + 864) break;
          if (t < nq) { int i = t / 5; int tm = last ? lat_tile(i) : i; gemm_tile(p.PBC, LDPBC, p.Wuq, 768, 768, tm * 128, (t % 5) * 128, lds, eq); }
          else if (t < nq + 432) { int u = t - nq; gemm_tile(p.PBC + 768, LDPBC, p.WukvK, 256, 256, (u / 3) * 128, (u % 3) * 128, lds, ek); }
          else { int u = t - nq - 432; gemm_tile(p.WvT, 256, p.PBC + 768, LDPBC, 256, (u % 3) * 128, (u / 3) * 128, lds, ev); }
        }
      }
    } break;
    case 4: {
      const int natt = 768 + (last ? 0 : 96);
      if (KSEL != 11) { if (bid < 192) { scan_task(p, l, bid / 24, (bid % 24) >> 2, (bid >> 1) & 1, bid & 1, lds); break; } if (KSEL == 4) break; }
      const int aoff = KSEL == 11 ? 0 : 192;
      if (KSEL == 11) {
        for (int t = bid; t < natt + NCONV_FF; t += G) {
          if (t < 768) { int bh = t >> 4, qb = t & 15; attn_task(p, bh / 6, bh % 6, NCTX + qb * 128, 0, TB, lds); }
          else if (t < natt) { int u = t - 768; int bh = u >> 1, qb = u & 1; attn_task(p, bh / 6, bh % 6, qb * 128, 0, NCTX, lds); }
          else conv_ff_task(p, l, t - natt, lds);
        }
      } else {
        volatile LAS unsigned* slot = (volatile LAS unsigned*)(lds + 65536 + 8);
        for (;;) {
          __syncthreads();
          if (tid == 0) *slot = __hip_atomic_fetch_add(p.BAR + 3456   + 64 * l, 1u, __ATOMIC_RELAXED, __HIP_MEMORY_SCOPE_AGENT);
          __syncthreads();
          const int t = (int)*slot;
          if (t >= natt + NCONV_FF) break;
          if (t < 768) { int bh = t >> 4, qb = t & 15; attn_task(p, bh / 6, bh % 6, NCTX + qb * 128, 0, TB, lds); }
          else if (t < natt) { int u = t - 768; int bh = u >> 1, qb = u & 1; attn_task(p, bh / 6, bh % 6, qb * 128, 0, NCTX, lds); }
          else conv_ff_task(p, l, t - natt, lds);
        }
      }
    } break;
    case 5: {
      EpiPost e{p.Y, p.BON, p.tshift_mu + (size_t)l * 2 * LDPA, p.lnx_g + l * 384, p.lnx_b + l * 384, p.PA, p.HY};
      const int nm = last ? 128 : 144;
      for (int t = bid; t < nm * 3; t += G) { int i = t / 3; int tm = last ? lat_tile(i) : i; gemm_tile(p.TG, 128, p.Wgate, 128, 128, tm * 128, (t % 3) * 128, lds, e); }
    } break;
    case 6: {
      EpiRes e{&p, l, l == 0, 2 * 1024};
      const int nm = last ? 128 : 144;
      for (int i = 0, tm, tn; xcd_tile(bid, G, i, nm, 8, tm, tn); ++i) gemm_tile(p.HY, DM, p.Wout, DM, DM, (last ? lat_tile(tm) : tm) * 128, tn * 128, lds, e);
    } break;
    case 7:
      modnorm_rows(p, l, 1, false, last, bid * 4 + wid, G * 4, lane);
      break;
    case 8: {
      EpiFfnIn e{p.ACT};
      const int nm = last ? 128 : 144;
      const int nconv = last ? 0 : NCONV_W1;
      for (int i = 0, tm, tn; xcd_tile(bid, G, i, nm, 44, tm, tn); ++i) gemm_tile(p.HY, DM, p.Wffi, DM, DM, (last ? lat_tile(tm) : tm) * 128, tn * 128, lds, e);
      for (int t = bid; t < nconv; t += G) conv_w1_task(p, 1, t, lds);
    } break;
    case 9: {
      EpiRes e{&p, l, false, 5 * 1024};
      const int nm = last ? 128 : 144;
      for (int i = 0, tm, tn; xcd_tile(bid, G, i, nm, 8, tm, tn); ++i) gemm_tile(p.ACT, 2816, p.Wffo, 2816, 2816, (last ? lat_tile(tm) : tm) * 128, tn * 128, lds, e);
    } break;
  }
}


#define XB_TMO      128
#define XB_XCNT(j)  (256  + 64 * (j))
#define XB_XSUB(j)  (1280 + 64 * (j))
#define XB_XGEN(j)  (2304 + 64 * (j))
#define XB_TOP      3328
#define XB_TOPGEN   3392
#define XCD_BAR_WORDS 3456
#define XB_SPIN_CAP (1u << 20)
DI unsigned xb_ld(unsigned* p) { return __hip_atomic_load(p, __ATOMIC_RELAXED, __HIP_MEMORY_SCOPE_AGENT); }
DI unsigned xb_add(unsigned* p, unsigned v) { return __hip_atomic_fetch_add(p, v, __ATOMIC_RELAXED, __HIP_MEMORY_SCOPE_AGENT); }
DI unsigned xb_xcc_id() { return (unsigned)__builtin_amdgcn_s_getreg((3 << 11) | 20) & 0xFu; }
#define XB_SPIN(cond, bar) do { unsigned _sp = 0; while (cond) { __builtin_amdgcn_s_sleep(1); \
    if ((++_sp & 255u) == 0u) { if (xb_ld(&(bar)[XB_TMO])) break; if (_sp > XB_SPIN_CAP) { atomicAdd(&(bar)[XB_TMO], 1u); break; } } } } while (0)
struct XcdBarrier { unsigned* bar; unsigned x; volatile LAS unsigned* st; };
DI XcdBarrier xcd_barrier_post(unsigned* bar, volatile LAS unsigned* st) {
  XcdBarrier b; b.bar = bar; b.x = xb_xcc_id(); b.st = st;
  if (threadIdx.x == 0) (void)xb_add(&bar[XB_XCNT(b.x)], 1u);
  return b;
}
DI void xcd_barrier_complete(unsigned* bar, unsigned x, unsigned& nloc, unsigned& nx) {
  const unsigned G = gridDim.x * gridDim.y * gridDim.z;
  unsigned sum, cnt, mine, sp = 0u;
  for (;;) {
    sum = 0u; cnt = 0u; mine = 0u;
#pragma unroll
    for (unsigned j = 0; j < 16; ++j) { const unsigned c = xb_ld(&bar[XB_XCNT(j)]); sum += c; cnt += (c > 0u) ? 1u : 0u; mine = (j == x) ? c : mine; }
    if (sum == G) break;
    __builtin_amdgcn_s_sleep(1);
    if ((++sp & 255u) == 0u) { if (xb_ld(&bar[XB_TMO])) break; if (sp > XB_SPIN_CAP) { atomicAdd(&bar[XB_TMO], 1u); break; } }
  }
  nloc = mine > 0u ? mine : 1u; nx = cnt > 0u ? cnt : 1u;
}
DI void xcd_barrier(const XcdBarrier& b) {
  asm volatile("s_waitcnt vmcnt(0)" ::: "memory");
  __syncthreads();
  if (threadIdx.x == 0) {
    unsigned* bar = b.bar;
    __builtin_amdgcn_s_waitcnt(0);
    unsigned nloc = b.st[0], nx = b.st[1];
    if (nloc == 0u) { xcd_barrier_complete(bar, b.x, nloc, nx); b.st[0] = nloc; b.st[1] = nx; }
    const unsigned old = xb_add(&bar[XB_XSUB(b.x)], 1u);
    const unsigned gen = old / nloc;
    if (old + 1u == (gen + 1u) * nloc) {
      __builtin_amdgcn_fence(__ATOMIC_RELEASE, "agent");
      asm volatile("s_waitcnt vmcnt(0)" ::: "memory");
      const unsigned og = xb_add(&bar[XB_TOP], 1u);
      const unsigned tg = og / nx;
      if (og + 1u == (tg + 1u) * nx) xb_add(&bar[XB_TOPGEN], 1u);
      else XB_SPIN(xb_ld(&bar[XB_TOPGEN]) == tg, bar);
      __builtin_amdgcn_fence(__ATOMIC_ACQUIRE, "agent");
      xb_add(&bar[XB_XGEN(b.x)], 1u);
      asm volatile("s_waitcnt vmcnt(0)" ::: "memory");
    } else {
      XB_SPIN(xb_ld(&bar[XB_XGEN(b.x)]) == gen, bar);
      __builtin_amdgcn_fence(__ATOMIC_ACQUIRE, "agent");
      asm volatile("s_waitcnt vmcnt(0)" ::: "memory");
    }
  }
  __syncthreads();
}

constexpr int NPHASE = 19;
#if !MULTI_LAUNCH
__global__ void __launch_bounds__(256, 2) mega(Params p, int ph_lo, int ph_hi) {
  __shared__ __attribute__((aligned(16))) char lds[65536 + 16];
  cg::grid_group grid = cg::this_grid();
  volatile LAS unsigned* st = (volatile LAS unsigned*)(lds + 65536);
  if (threadIdx.x == 0) { st[0] = 0u; st[1] = 0u; }
  __syncthreads();
  XcdBarrier xb = xcd_barrier_post(p.BAR, st);
  for (int ph = ph_lo; ph < ph_hi; ++ph) {
    if (ph > ph_lo) xcd_barrier(xb);
    run_phase<-1>(p, ph, lds);
  }
  if (ph_hi > NPHASE) grid.sync();
}
#endif
template <int KSEL> __global__ void __launch_bounds__(256, 2) phase_k(Params p, int ph) {
  __shared__ __attribute__((aligned(16))) char lds[65536];
  run_phase<KSEL>(p, ph, lds);
}

extern "C" void kernel_launch(void* const* d_in, const int* in_sizes, int n_in, void* d_out, int out_size, void* d_ws, size_t ws_size, hipStream_t stream) {
  static int grid_blocks = 0;
  if (!grid_blocks) {
    int dev = 0, cus = 0, per_cu = 0;
    (void)hipGetDevice(&dev);
    (void)hipDeviceGetAttribute(&cus, hipDeviceAttributeMultiprocessorCount, dev);
    #if MULTI_LAUNCH
    per_cu = 2;
#else
    (void)hipOccupancyMaxActiveBlocksPerMultiprocessor(&per_cu, mega, 256, 0);
#endif
    if (per_cu > 2) per_cu = 2;
    if (per_cu < 1) per_cu = 1;
    grid_blocks = cus * per_cu;
  }
  Params p{};
  const float** pin = (const float**)&p.x;
  for (int i = 0; i < 32; ++i) pin[i] = (const float*)d_in[i];
  p.out = (float*)d_out;
  char* w = (char*)d_ws;
  size_t off = 0;
  auto take = [&](size_t bytes) { char* r = w + off; off += (bytes + 255) & ~(size_t)255; return r; };
  p.BAR = (unsigned*)take((XCD_BAR_WORDS + 128) * 4);
  p.MOD = (float*)take(2 * 9 * 6144 * 4);
  p.ROPE = (float*)take(64 * 8 * 2 * 4);
  p.RSTD = (float*)take(2 * (size_t)T_TOK * 4);
  p.BON = (float*)take(2 * (size_t)T_TOK * 6 * 4);
  p.XCTX = (float*)take((size_t)8 * NCTX * DM * 4);
  p.Win = (bf16_t*)take((size_t)3328 * 1024 * 2);
  p.Wuq = (bf16_t*)take((size_t)640 * 768 * 2);
  p.WukvK = (bf16_t*)take((size_t)384 * 256 * 2);
  p.WvT = (bf16_t*)take((size_t)384 * 256 * 2);
  p.Wgate = (bf16_t*)take((size_t)384 * 128 * 2);
  p.Wdecay = (bf16_t*)take((size_t)2 * 384 * 64 * 2);
  p.Wicl = (bf16_t*)take((size_t)2 * 384 * 64 * 2);
  p.Wout = (bf16_t*)take((size_t)1024 * 1024 * 2);
  p.HY = (bf16_t*)take((size_t)T_TOK * DM * 2);
  p.TW = (bf16_t*)take((size_t)T_TOK * 64 * 2);
  p.TA = (bf16_t*)take((size_t)T_TOK * 64 * 2);
  p.TG = (bf16_t*)take((size_t)T_TOK * 128 * 2);
  char* qkv = take((size_t)T_TOK * 576 * 2 * 2 + (size_t)384 * T_TOK * 2);
  p.Q = (bf16_t*)qkv;
  p.Kt = (bf16_t*)(qkv + (size_t)T_TOK * 576 * 2);
  p.VT = (bf16_t*)(qkv + (size_t)T_TOK * 576 * 2 * 2);
  p.Wffi = (bf16_t*)take((size_t)5632 * 1024 * 2);
  p.Wffo = (bf16_t*)take((size_t)2816 * 1024 * 2);
  char* pr = take((size_t)T_TOK * (LDPA + LDPBC) * 2);
  p.PA = (bf16_t*)pr;
  p.PBC = (bf16_t*)(pr + (size_t)T_TOK * LDPA * 2);
  p.Y = (float*)p.PBC;
  p.ACT = (bf16_t*)pr;
  if (off > ws_size) { fprintf(stderr, "workspace too small: need %zu have %zu\n", off, ws_size); }
#if MULTI_LAUNCH
  hipLaunchKernelGGL(phase_k<10>, dim3(grid_blocks), dim3(256), 0, stream, p, 0);
  for (int l = 0; l < 2; ++l) {
    const int b0 = 1 + 10 * l;
    hipLaunchKernelGGL(phase_k<0>, dim3(grid_blocks), dim3(256), 0, stream, p, b0 + 0);
    hipLaunchKernelGGL(phase_k<1>, dim3(grid_blocks), dim3(256), 0, stream, p, b0 + 1);
    hipLaunchKernelGGL(phase_k<2>, dim3(grid_blocks), dim3(256), 0, stream, p, b0 + 2);
    hipLaunchKernelGGL(phase_k<3>, dim3(grid_blocks), dim3(256), 0, stream, p, b0 + 3);
    hipLaunchKernelGGL(phase_k<4>, dim3(192), dim3(256), 0, stream, p, b0 + 4);
    hipLaunchKernelGGL(phase_k<11>, dim3(grid_blocks), dim3(256), 0, stream, p, b0 + 4);
    hipLaunchKernelGGL(phase_k<5>, dim3(grid_blocks), dim3(256), 0, stream, p, b0 + 5);
    hipLaunchKernelGGL(phase_k<6>, dim3(grid_blocks), dim3(256), 0, stream, p, b0 + 6);
    hipLaunchKernelGGL(phase_k<7>, dim3(grid_blocks), dim3(256), 0, stream, p, b0 + 7);
    hipLaunchKernelGGL(phase_k<8>, dim3(grid_blocks), dim3(256), 0, stream, p, b0 + 8);
    hipLaunchKernelGGL(phase_k<9>, dim3(grid_blocks), dim3(256), 0, stream, p, b0 + 9);
  }
#else
  int lo = 0, hi = NPHASE;
  void* args[] = {&p, &lo, &hi};
  (void)hipMemsetAsync(p.BAR, 0, (XCD_BAR_WORDS + 128) * 4, stream);
  hipError_t e = hipLaunchCooperativeKernel((void*)mega, dim3(grid_blocks), dim3(256), args, 0, stream);
  if (e != hipSuccess) fprintf(stderr, "cooperative launch failed: %s (grid %d)\n", hipGetErrorString(e), grid_blocks);
#endif
}
```

```cpp
#include <hip/hip_runtime.h>
#include <hip/hip_cooperative_groups.h>
#include <cstdio>
namespace cg = cooperative_groups;

#ifndef MULTI_LAUNCH
#define MULTI_LAUNCH 0
#endif

#define DI __device__ __forceinline__
typedef unsigned short bf16_t;
typedef short bf16x8 __attribute__((ext_vector_type(8)));
typedef short s16x4 __attribute__((ext_vector_type(4)));
typedef float f32x4 __attribute__((ext_vector_type(4)));
typedef float f32x2 __attribute__((ext_vector_type(2)));
typedef float f32x16 __attribute__((ext_vector_type(16)));
typedef unsigned u32x4 __attribute__((ext_vector_type(4)));
typedef unsigned u32x2 __attribute__((ext_vector_type(2)));
#define LAS __attribute__((address_space(3)))

constexpr int T_TOK = 18432, TB = 2304, NCTX = 256, NLAT = 2048, DM = 1024;
constexpr int LDPA = 1408, LDPBC = 1920;
constexpr float EPSF = 1e-6f;
constexpr float LOG_DECAY_SCALE = 0.606531f;
constexpr float GN_EPS = 64e-5f;
constexpr float QSCALE = 0.10206207261596577f * 1.4426950408889634f;

struct Params {
  const float *x, *c, *ctx, *c_ctx, *ada_w, *ada_b, *norm1_g, *norm2_g, *w_in, *tshift_mu, *decay_w0, *decay_up,
      *icl_a0, *icl_up, *gate_up, *k_k, *k_a, *r_k, *lnx_g, *lnx_b, *q_norm_g, *kv_norm_g, *w_uq, *w_ukv, *q_nope_g,
      *k_nope_g, *q_rope_g, *k_rope_g, *conv_w, *w_out, *w_ffn_in, *w_ffn_out;
  float* out;
  float *MOD, *RSTD, *BON, *XCTX, *Y, *ROPE;
  unsigned* BAR;
  bf16_t *Win, *Wuq, *WukvK, *WvT, *Wgate, *Wdecay, *Wicl, *Wout, *Wffi, *Wffo;
  bf16_t *HY, *TW, *TA, *TG, *Q, *Kt, *VT, *PA, *PBC, *ACT;
};

typedef __bf16 bf16v2 __attribute__((ext_vector_type(2)));
DI unsigned pk_bf16(float lo, float hi) { f32x2 v = {lo, hi}; bf16v2 b = __builtin_convertvector(v, bf16v2); return __builtin_bit_cast(unsigned, b); }
DI float bflo(unsigned u) { return __uint_as_float(u << 16); }
DI float bfhi(unsigned u) { return __uint_as_float(u & 0xffff0000u); }
DI int opaque_tid() { int t = threadIdx.x; asm volatile("" : "+v"(t)); return t; }
DI float sigmoidf_(float x) { return __builtin_amdgcn_rcpf(1.f + __expf(-x)); }
template <int CTRL> DI float dppf(float x) { return __builtin_bit_cast(float, __builtin_amdgcn_update_dpp(0, __builtin_bit_cast(int, x), CTRL, 0xf, 0xf, true)); }
DI float red8(float x) { x += dppf<0xB1>(x); x += dppf<0x4E>(x); x += dppf<0x141>(x); return x; }
DI float red16(float x) { x = red8(x); x += dppf<0x140>(x); return x; }
DI float red64(float x) { for (int o = 32; o > 0; o >>= 1) x += __shfl_xor(x, o); return x; }

DI void unpack8(u32x4 v, float* f) {
  f[0] = bflo(v[0]); f[1] = bfhi(v[0]); f[2] = bflo(v[1]); f[3] = bfhi(v[1]);
  f[4] = bflo(v[2]); f[5] = bfhi(v[2]); f[6] = bflo(v[3]); f[7] = bfhi(v[3]);
}
DI void unpack4(u32x2 v, float* f) { f[0] = bflo(v[0]); f[1] = bfhi(v[0]); f[2] = bflo(v[1]); f[3] = bfhi(v[1]); }

DI const float* xsrc_row(const Params& p, bool from_inputs, int b, int s) {
  if (from_inputs) return s < NCTX ? p.ctx + (size_t)(b * NCTX + s) * DM : p.x + (size_t)(b * NLAT + s - NCTX) * DM;
  return s < NCTX ? p.XCTX + (size_t)(b * NCTX + s) * DM : p.out + (size_t)(b * NLAT + s - NCTX) * DM;
}
DI float* xdst_row(const Params& p, int b, int s) {
  return s < NCTX ? p.XCTX + (size_t)(b * NCTX + s) * DM : p.out + (size_t)(b * NLAT + s - NCTX) * DM;
}

DI void adaln_task(const Params& p, int task, char* lds) {
  float* s = (float*)lds;
  float* red = s + 9 * 1024;
  const int l = task / 192, cgi = task % 192, tid = opaque_tid();
  for (int i = tid; i < 9 * 1024; i += 256) {
    int r = i >> 10, k = i & 1023;
    float v = r < 8 ? p.c[r * 1024 + k] : p.c_ctx[k];
    s[i] = v / (1.f + __expf(-v));
  }
  __syncthreads();
  const int kg = tid >> 5, cc = tid & 31, col = cgi * 32 + cc;
  float acc[9];
#pragma unroll
  for (int r = 0; r < 9; ++r) acc[r] = 0.f;
  const float* w = p.ada_w + (size_t)l * 1024 * 6144 + col;
  for (int k0 = kg; k0 < 1024; k0 += 128) {
    float wv[16];
#pragma unroll
    for (int u = 0; u < 16; ++u) wv[u] = w[(size_t)(k0 + 8 * u) * 6144];
#pragma unroll
    for (int u = 0; u < 16; ++u)
#pragma unroll
      for (int r = 0; r < 9; ++r) acc[r] += s[r * 1024 + k0 + 8 * u] * wv[u];
  }
#pragma unroll
  for (int r = 0; r < 9; ++r) red[(kg * 9 + r) * 32 + cc] = acc[r];
  __syncthreads();
  for (int i = tid; i < 9 * 32; i += 256) {
    int r = i >> 5, c2 = i & 31;
    float sum = 0.f;
    for (int g = 0; g < 8; ++g) sum += red[(g * 9 + r) * 32 + c2];
    p.MOD[(size_t)(l * 9 + r) * 6144 + cgi * 32 + c2] = sum + p.ada_b[l * 6144 + cgi * 32 + c2];
  }
  __syncthreads();
}

DI int colmap(int mode, int n, int nvalid) {
  switch (mode) {
    case 0: return n < nvalid ? n : -1;
    case 1: if (n < 384) return (n >> 6) * 96 + (n & 63); if (n < 576) return ((n - 384) >> 5) * 96 + 64 + ((n - 384) & 31); return -1;
    case 2: return (n >> 6) * 128 + (n & 63);
    case 3: return (n >> 6) * 128 + 64 + (n & 63);
    default: { int t64 = n >> 6, w = n & 63; return w < 32 ? t64 * 32 + w : 2816 + t64 * 32 + (w - 32); }
  }
}
DI void conv_tile(const float* src, int ld, int K, int mode, int nvalid, const float* kscale, bf16_t* dst, int tile, int ntn, char* lds) {
  float(*tl)[65] = (float(*)[65])lds;
  const int tk = tile / ntn, tn = tile % ntn, tid = opaque_tid(), k0 = tk * 64;
  {
    const int nn = tid & 63, kk0 = tid >> 6;
    const int sc = colmap(mode, tn * 64 + nn, nvalid);
#pragma unroll 4
    for (int i = 0; i < 16; ++i) {
      const int kk = kk0 + 4 * i;
      float v = 0.f;
      if (sc >= 0) { v = src[(size_t)(k0 + kk) * ld + sc]; if (kscale) v *= kscale[k0 + kk]; }
      tl[kk][nn] = v;
    }
  }
  __syncthreads();
  {
    const int kk2 = (tid & 31) * 2, nn2 = tid >> 5;
#pragma unroll
    for (int i = 0; i < 8; ++i) {
      const int nn = nn2 + 8 * i;
      *(unsigned*)(dst + (size_t)(tn * 64 + nn) * K + k0 + kk2) = pk_bf16(tl[kk2][nn], tl[kk2 + 1][nn]);
    }
  }
  __syncthreads();
}
constexpr int NCONV_W1 = 1292, NCONV_FF = 2112;
DI void conv_w1_task(const Params& p, int l, int t, char* lds) {
  if (t < 832) { conv_tile(p.w_in + (size_t)l * 1024 * 3232, 3232, 1024, 0, 3232, nullptr, p.Win, t, 52, lds); return; } t -= 832;
  if (t < 120) { conv_tile(p.w_uq + (size_t)l * 768 * 576, 576, 768, 1, 0, p.q_norm_g + l * 768, p.Wuq, t, 10, lds); return; } t -= 120;
  if (t < 24) { conv_tile(p.w_ukv + (size_t)l * 256 * 768, 768, 256, 2, 0, p.kv_norm_g + l * 256, p.WukvK, t, 6, lds); return; } t -= 24;
  if (t < 24) { conv_tile(p.w_ukv + (size_t)l * 256 * 768, 768, 256, 3, 0, p.kv_norm_g + l * 256, p.WvT, t, 6, lds); return; } t -= 24;
  if (t < 12) { conv_tile(p.gate_up + (size_t)l * 128 * 384, 384, 128, 0, 384, nullptr, p.Wgate, t, 6, lds); return; } t -= 12;
  if (t < 12) { int d = t / 6; conv_tile(p.decay_up + (size_t)(l * 2 + d) * 64 * 384, 384, 64, 0, 384, nullptr, p.Wdecay + d * 384 * 64, t % 6, 6, lds); return; } t -= 12;
  if (t < 12) { int d = t / 6; conv_tile(p.icl_up + (size_t)(l * 2 + d) * 64 * 384, 384, 64, 0, 384, nullptr, p.Wicl + d * 384 * 64, t % 6, 6, lds); return; } t -= 12;
  conv_tile(p.w_out + (size_t)l * 1024 * 1024, 1024, 1024, 0, 1024, nullptr, p.Wout, t, 16, lds);
}
DI void conv_ff_task(const Params& p, int l, int t, char* lds) {
  if (t < 1408) { conv_tile(p.w_ffn_in + (size_t)l * 1024 * 5632, 5632, 1024, 4, 0, nullptr, p.Wffi, t, 88, lds); return; } t -= 1408;
  conv_tile(p.w_ffn_out + (size_t)l * 2816 * 1024, 1024, 2816, 0, 1024, nullptr, p.Wffo, t, 16, lds);
}

DI void modnorm_rows(const Params& p, int l, int which  , bool from_inputs, bool skip_ctx, int w0, int wstride, int lane) {
  const float* g = (which ? p.norm2_g : p.norm1_g) + l * DM;
  f32x4 gg[4];
#pragma unroll
  for (int i = 0; i < 4; ++i) gg[i] = *(const f32x4*)(g + i * 256 + lane * 4);
  const int nrows = skip_ctx ? 8 * NLAT : T_TOK;
  auto rowof = [&](int i) -> int { return skip_ctx ? (i / NLAT) * TB + NCTX + (i % NLAT) : i; };
  int i = w0;
  if (i >= nrows) return;
  f32x4 vn[4];
  {
    const int row = rowof(i); const float* src = xsrc_row(p, from_inputs, row / TB, row % TB);
#pragma unroll
    for (int q = 0; q < 4; ++q) vn[q] = *(const f32x4*)(src + q * 256 + lane * 4);
  }
  for (; i < nrows; i += wstride) {
    const int row = rowof(i); const int b = row / TB, s = row % TB;
    f32x4 v[4];
#pragma unroll
    for (int q = 0; q < 4; ++q) v[q] = vn[q];
    if (i + wstride < nrows) {
      const int rn = rowof(i + wstride); const float* src = xsrc_row(p, from_inputs, rn / TB, rn % TB);
#pragma unroll
      for (int q = 0; q < 4; ++q) vn[q] = *(const f32x4*)(src + q * 256 + lane * 4);
    }
    const float* mod = p.MOD + (size_t)(l * 9 + (s < NCTX ? 8 : b)) * 6144 + (which ? 3 * 1024 : 0);
    f32x4 sh[4], sc[4];
#pragma unroll
    for (int q = 0; q < 4; ++q) { sh[q] = *(const f32x4*)(mod + q * 256 + lane * 4); sc[q] = *(const f32x4*)(mod + 1024 + q * 256 + lane * 4); }
    float ss = 0.f;
#pragma unroll
    for (int q = 0; q < 4; ++q) ss += v[q][0] * v[q][0] + v[q][1] * v[q][1] + v[q][2] * v[q][2] + v[q][3] * v[q][3];
    ss = red64(ss);
    const float rs = rsqrtf(ss * (1.f / 1024.f) + EPSF);
    bf16_t* dst = p.HY + (size_t)row * DM;
#pragma unroll
    for (int q = 0; q < 4; ++q) {
      float o[4];
#pragma unroll
      for (int j = 0; j < 4; ++j) o[j] = (v[q][j] * rs * gg[q][j]) * (1.f + sc[q][j]) + sh[q][j];
      u32x2 w = {pk_bf16(o[0], o[1]), pk_bf16(o[2], o[3])};
      *(u32x2*)(dst + q * 256 + lane * 4) = w;
    }
  }
}

template <class Epi>
DI void gemm_tile(const bf16_t* __restrict__ A, int lda, const bf16_t* __restrict__ Bt, int ldb, int K, int row0, int col0, char* lds, const Epi& epi) {
  const int tid = opaque_tid(), lane = tid & 63, wid = tid >> 6, wr = wid >> 1, wc = wid & 1, fr = lane & 15, fq = lane >> 4;
  const bf16_t* ag[4];
  const bf16_t* bg[4];
#pragma unroll
  for (int i = 0; i < 4; ++i) {
    const int id = i * 256 + tid, r = id >> 3, cp = id & 7, c = cp ^ ((r >> 1) & 7);
    ag[i] = A + (size_t)(row0 + r) * lda + c * 8;
    bg[i] = Bt + (size_t)(col0 + r) * ldb + c * 8;
  }
  f32x4 acc[4][4];
#pragma unroll
  for (int m = 0; m < 4; ++m)
#pragma unroll
    for (int n = 0; n < 4; ++n) acc[m][n] = (f32x4){0.f, 0.f, 0.f, 0.f};
  const int KT = K >> 6;
  auto stage_a = [&](int kt, int buf) {
    char* sa = lds + buf * 32768;
#pragma unroll
    for (int i = 0; i < 4; ++i)
      __builtin_amdgcn_global_load_lds((const void __attribute__((address_space(1)))*)(ag[i] + kt * 64), (void LAS*)(sa + (i * 256 + tid) * 16), 16, 0, 0);
  };
  auto stage_b = [&](int kt, int buf) {
    char* sb = lds + buf * 32768 + 16384;
#pragma unroll
    for (int i = 0; i < 4; ++i)
      __builtin_amdgcn_global_load_lds((const void __attribute__((address_space(1)))*)(bg[i] + kt * 64), (void LAS*)(sb + (i * 256 + tid) * 16), 16, 0, 0);
  };
  __syncthreads();
  stage_a(0, 0); stage_b(0, 0);
  const int swz = fr >> 1;
  for (int kt = 0; kt < KT; ++kt) {
    asm volatile("s_waitcnt vmcnt(0)" ::: "memory");
    __syncthreads();
    const char* sa = lds + (kt & 1) * 32768 + (wr * 64 + fr) * 128;
    const char* sb = lds + (kt & 1) * 32768 + 16384 + (wc * 64 + fr) * 128;
#pragma unroll
    for (int kk = 0; kk < 2; ++kk) {
      if (kt + 1 < KT) { if (kk == 0) stage_a(kt + 1, (kt + 1) & 1); else stage_b(kt + 1, (kt + 1) & 1); }
      bf16x8 a[4], b[4];
      const int co = ((kk * 4 + fq) ^ swz) * 16;
#pragma unroll
      for (int m = 0; m < 4; ++m) a[m] = *(const bf16x8*)(sa + m * 2048 + co);
#pragma unroll
      for (int n = 0; n < 4; ++n) b[n] = *(const bf16x8*)(sb + n * 2048 + co);
#pragma unroll
      for (int m = 0; m < 4; ++m)
#pragma unroll
        for (int n = 0; n < 4; ++n) acc[m][n] = __builtin_amdgcn_mfma_f32_16x16x32_bf16(b[n], a[m], acc[m][n], 0, 0, 0);
    }
  }
  epi(acc, row0 + wr * 64, col0 + wc * 64, fr, fq);
}

struct EpiP {
  bf16_t *PA, *PBC; float* SSQ;
  DI void operator()(const f32x4 (&acc)[4][4], int r0, int c0, int fr, int fq) const {
    bf16_t* base; int ld, cb;
    if (c0 < LDPA) { base = PA; ld = LDPA; cb = c0; } else { base = PBC; ld = LDPBC; cb = c0 - LDPA; }
    if (c0 >= LDPA && cb < 1024) {
      float* dst = SSQ + (cb < 768 ? 0 : T_TOK);
#pragma unroll
      for (int m = 0; m < 4; ++m) {
        float ss = 0.f;
#pragma unroll
        for (int n = 0; n < 4; ++n)
#pragma unroll
          for (int j = 0; j < 4; ++j) ss += acc[m][n][j] * acc[m][n][j];
        ss += __shfl_xor(ss, 16); ss += __shfl_xor(ss, 32);
        if (fq == 0) atomicAdd(dst + r0 + m * 16 + fr, ss);
      }
    }
#pragma unroll
    for (int m = 0; m < 4; ++m)
#pragma unroll
      for (int n = 0; n < 4; ++n) {
        u32x2 v = {pk_bf16(acc[m][n][0], acc[m][n][1]), pk_bf16(acc[m][n][2], acc[m][n][3])};
        *(u32x2*)(base + (size_t)(r0 + m * 16 + fr) * ld + cb + n * 16 + fq * 4) = v;
      }
  }
};

DI void rope_angle(int pos, int i, float& cs, float& sn) {
  const float invf = __builtin_amdgcn_exp2f(-(float)i * (13.287712379549449f / 8.f));
  float ang = (float)pos * invf;
  float n = rintf(ang * 0.15915494309189535f);
  float r = fmaf(-n, 6.28125f, ang);
  r = fmaf(-n, 1.9353071795864769e-3f, r);
  cs = __cosf(r); sn = __sinf(r);
}

struct EpiQ {
  const float *rstd, *gn, *gr, *rope; bf16_t* Q;
  DI void operator()(const f32x4 (&acc)[4][4], int r0, int c0, int fr, int fq) const {
    if (c0 >= 576) return;
    if (c0 < 384) {
      const int h = c0 >> 6;
#pragma unroll
      for (int m = 0; m < 4; ++m) {
        const int row = r0 + m * 16 + fr; const float rs = rsqrtf(rstd[row] * (1.f / 768.f) + EPSF);
        float ss = 0.f;
#pragma unroll
        for (int n = 0; n < 4; ++n)
#pragma unroll
          for (int j = 0; j < 4; ++j) { float v = acc[m][n][j] * rs; ss += v * v; }
        ss += __shfl_xor(ss, 16); ss += __shfl_xor(ss, 32);
        const float inv = rsqrtf(ss * (1.f / 64.f) + EPSF) * rs * QSCALE;
        const int b = row / TB, s = row % TB;
        bf16_t* dst = Q + ((size_t)(b * 6 + h) * TB + s) * 96;
#pragma unroll
        for (int n = 0; n < 4; ++n) {
          const int d = n * 16 + fq * 4; f32x4 g = *(const f32x4*)(gn + d);
          u32x2 v = {pk_bf16(acc[m][n][0] * inv * g[0], acc[m][n][1] * inv * g[1]), pk_bf16(acc[m][n][2] * inv * g[2], acc[m][n][3] * inv * g[3])};
          *(u32x2*)(dst + d) = v;
        }
      }
    } else {
#pragma unroll
      for (int m = 0; m < 4; ++m) {
        const int row = r0 + m * 16 + fr; const float rs = rsqrtf(rstd[row] * (1.f / 768.f) + EPSF);
        const int b = row / TB, s = row % TB; const bool lat = s >= NCTX; const int sp = s - NCTX;
#pragma unroll
        for (int hh = 0; hh < 2; ++hh) {
          const int h = ((c0 - 384) >> 5) + hh;
          float ss = 0.f;
#pragma unroll
          for (int nn = 0; nn < 2; ++nn)
#pragma unroll
            for (int j = 0; j < 4; ++j) { float v = acc[m][hh * 2 + nn][j] * rs; ss += v * v; }
          ss += __shfl_xor(ss, 16); ss += __shfl_xor(ss, 32);
          const float inv = rsqrtf(ss * (1.f / 32.f) + EPSF) * rs;
          bf16_t* dst = Q + ((size_t)(b * 6 + h) * TB + s) * 96 + 64;
#pragma unroll
          for (int nn = 0; nn < 2; ++nn) {
            const int d = nn * 16 + fq * 4; f32x4 g = *(const f32x4*)(gr + d);
            float o[4];
#pragma unroll
            for (int j = 0; j < 4; ++j) {
              float val = acc[m][hh * 2 + nn][j] * inv * g[j];
              float partner = __shfl_xor(val, 32);
              if (lat) {
                const float* rt = rope + ((nn == 0 ? (sp >> 6) : (sp & 63)) * 8 + ((fq * 4 + j) & 7)) * 2; const float cs = rt[0], sn = rt[1];
                val = fq < 2 ? val * cs - partner * sn : val * cs + partner * sn;
              }
              o[j] = val * QSCALE;
            }
            u32x2 v = {pk_bf16(o[0], o[1]), pk_bf16(o[2], o[3])};
            *(u32x2*)(dst + d) = v;
          }
        }
      }
    }
  }
};

struct EpiK {
  const float *rstd, *gk; bf16_t* Kt;
  DI void operator()(const f32x4 (&acc)[4][4], int r0, int c0, int fr, int fq) const {
    const int h = c0 >> 6;
#pragma unroll
    for (int m = 0; m < 4; ++m) {
      const int row = r0 + m * 16 + fr; const float rs = rsqrtf(rstd[row] * (1.f / 256.f) + EPSF);
      float ss = 0.f;
#pragma unroll
      for (int n = 0; n < 4; ++n)
#pragma unroll
        for (int j = 0; j < 4; ++j) { float v = acc[m][n][j] * rs; ss += v * v; }
      ss += __shfl_xor(ss, 16); ss += __shfl_xor(ss, 32);
      const float inv = rsqrtf(ss * (1.f / 64.f) + EPSF) * rs;
      const int b = row / TB, s = row % TB;
      bf16_t* dst = Kt + ((size_t)(b * 6 + h) * TB + s) * 96;
#pragma unroll
      for (int n = 0; n < 4; ++n) {
        const int d = n * 16 + fq * 4; f32x4 g = *(const f32x4*)(gk + d);
        u32x2 v = {pk_bf16(acc[m][n][0] * inv * g[0], acc[m][n][1] * inv * g[1]), pk_bf16(acc[m][n][2] * inv * g[2], acc[m][n][3] * inv * g[3])};
        *(u32x2*)(dst + d) = v;
      }
    }
  }
};

struct EpiV {
  const float* rstd; bf16_t* VT;
  DI void operator()(const f32x4 (&acc)[4][4], int r0, int c0, int fr, int fq) const {
#pragma unroll
    for (int m = 0; m < 4; ++m)
#pragma unroll
      for (int n = 0; n < 4; ++n) {
        const int row = r0 + m * 16 + fr, col = c0 + n * 16 + fq * 4;
        f32x4 rs = *(const f32x4*)(rstd + col);
#pragma unroll
        for (int j = 0; j < 4; ++j) rs[j] = rsqrtf(rs[j] * (1.f / 256.f) + EPSF);
        u32x2 v = {pk_bf16(acc[m][n][0] * rs[0], acc[m][n][1] * rs[1]), pk_bf16(acc[m][n][2] * rs[2], acc[m][n][3] * rs[3])};
        *(u32x2*)(VT + (size_t)row * T_TOK + col) = v;
      }
  }
};

struct EpiPost {
  const float *Y, *BON, *mu, *lnx_g, *lnx_b; const bf16_t* PA; bf16_t* YC;
  DI void operator()(const f32x4 (&acc)[4][4], int r0, int c0, int fr, int fq) const {
    const int h = c0 >> 6;
#pragma unroll
    for (int m = 0; m < 4; ++m) {
      const int row = r0 + m * 16 + fr; const int s = row % TB;
      const bool hasprev = (s != 0 && s != NCTX), hasnext = (s != NCTX - 1 && s != TB - 1);
      f32x4 y[4];
      float s1 = 0.f;
#pragma unroll
      for (int n = 0; n < 4; ++n) {
        const size_t o = (size_t)row * 384 + c0 + n * 16 + fq * 4;
        y[n] = *(const f32x4*)(Y + o) + *(const f32x4*)(Y + (size_t)T_TOK * 384 + o);
        s1 += y[n][0] + y[n][1] + y[n][2] + y[n][3];
      }
      s1 += __shfl_xor(s1, 16); s1 += __shfl_xor(s1, 32);
      const float mean = s1 * (1.f / 64.f);
      float s2 = 0.f;
#pragma unroll
      for (int n = 0; n < 4; ++n)
#pragma unroll
        for (int j = 0; j < 4; ++j) { float d = y[n][j] - mean; s2 += d * d; }
      s2 += __shfl_xor(s2, 16); s2 += __shfl_xor(s2, 32);
      const float rstdv = rsqrtf(s2 * (1.f / 64.f) + GN_EPS);
      const float bon = BON[(size_t)row * 6 + h] + BON[(size_t)T_TOK * 6 + (size_t)row * 6 + h];
#pragma unroll
      for (int n = 0; n < 4; ++n) {
        const int col = c0 + n * 16 + fq * 4;
        const bf16_t* pv = PA + (size_t)row * LDPA + 768 + col;
        float vc[4], vp[4] = {0.f, 0.f, 0.f, 0.f}, vn[4] = {0.f, 0.f, 0.f, 0.f};
        unpack4(*(const u32x2*)pv, vc);
        if (hasprev) unpack4(*(const u32x2*)(pv - LDPA), vp);
        if (hasnext) unpack4(*(const u32x2*)(pv + LDPA), vn);
        f32x4 m0 = *(const f32x4*)(mu + 768 + col), m1 = *(const f32x4*)(mu + LDPA + 768 + col);
        f32x4 lg = *(const f32x4*)(lnx_g + col), lb = *(const f32x4*)(lnx_b + col);
        float o[4];
#pragma unroll
        for (int j = 0; j < 4; ++j) {
          const float v = vc[j] + m0[j] * (vp[j] - vc[j]) + m1[j] * (vn[j] - vc[j]);
          o[j] = ((y[n][j] - mean) * rstdv * lg[j] + lb[j] + bon * v) * acc[m][n][j];
        }
        u32x2 w = {pk_bf16(o[0], o[1]), pk_bf16(o[2], o[3])};
        *(u32x2*)(YC + (size_t)row * DM + col) = w;
      }
    }
  }
};

struct EpiRes {
  const Params* p; int l; bool from_inputs; int gate_off;
  DI void operator()(const f32x4 (&acc)[4][4], int r0, int c0, int fr, int fq) const {
#pragma unroll
    for (int m = 0; m < 4; ++m) {
      const int row = r0 + m * 16 + fr; const int b = row / TB, s = row % TB;
      const float* src = xsrc_row(*p, from_inputs, b, s);
      float* dst = xdst_row(*p, b, s);
      const float* gate = p->MOD + (size_t)(l * 9 + (s < NCTX ? 8 : b)) * 6144 + gate_off;
#pragma unroll
      for (int n = 0; n < 4; ++n) {
        const int col = c0 + n * 16 + fq * 4;
        f32x4 g = *(const f32x4*)(gate + col), xv = *(const f32x4*)(src + col);
        *(f32x4*)(dst + col) = xv + g * acc[m][n];
      }
    }
  }
};

struct EpiFfnIn {
  bf16_t* ACT;
  DI void operator()(const f32x4 (&acc)[4][4], int r0, int c0, int fr, int fq) const {
    const int cb = (c0 >> 6) * 32;
#pragma unroll
    for (int m = 0; m < 4; ++m)
#pragma unroll
      for (int n = 0; n < 2; ++n) {
        float o[4];
#pragma unroll
        for (int j = 0; j < 4; ++j) { float g = acc[m][n][j]; o[j] = g * __builtin_amdgcn_rcpf(1.f + __expf(-g)) * acc[m][n + 2][j]; }
        u32x2 w = {pk_bf16(o[0], o[1]), pk_bf16(o[2], o[3])};
        *(u32x2*)(ACT + (size_t)(r0 + m * 16 + fr) * 2816 + cb + n * 16 + fq * 4) = w;
      }
  }
};

DI void prep_token(const Params& p, int l, int row, int lane) {
  const int b = row / TB, s = row % TB;
  const bool hasprev = (s != 0 && s != NCTX), hasnext = (s != NCTX - 1 && s != TB - 1);
  const float mp = hasprev ? 1.f : 0.f, mn = hasnext ? 1.f : 0.f;
  const bf16_t* pa = p.PA + (size_t)row * LDPA;
  const bf16_t* pbc = p.PBC + (size_t)row * LDPBC;
  const int opa = hasprev ? -LDPA : 0, ona = hasnext ? LDPA : 0, opb = hasprev ? -LDPBC : 0, onb = hasnext ? LDPBC : 0;
  const int l32 = lane & 31, c8 = l32 * 8, colA = 1152 + c8;
  const u32x4 la_c = *(const u32x4*)(pa + colA), la_p = *(const u32x4*)(pa + opa + colA), la_n = *(const u32x4*)(pa + ona + colA);
  const u32x4 lq0 = *(const u32x4*)(pbc + lane * 8), lq1 = *(const u32x4*)(pbc + 512 + c8), lkv = *(const u32x4*)(pbc + 768 + c8);
  const u32x4 lrp = *(const u32x4*)(pbc + 1024 + (lane & 3) * 8);
  const u32x4 lbg = *(const u32x4*)(pbc + 1056 + c8), lcc = *(const u32x4*)(pbc + 1312 + c8), lhh = *(const u32x4*)(pbc + 1568 + c8);
  const u32x4 lcp = *(const u32x4*)(pbc + opb + 1312 + c8), lhp = *(const u32x4*)(pbc + opb + 1568 + c8);
  const u32x4 lcn = *(const u32x4*)(pbc + onb + 1312 + c8), lhn = *(const u32x4*)(pbc + onb + 1568 + c8);
  const float* mu = p.tshift_mu + (size_t)l * 2 * LDPA;
  {
    float c[8], pv[8], nx[8], o[8];
    unpack8(la_c, c); unpack8(la_p, pv); unpack8(la_n, nx);
    const f32x4 m0a = *(const f32x4*)(mu + colA), m0b = *(const f32x4*)(mu + colA + 4), m1a = *(const f32x4*)(mu + LDPA + colA), m1b = *(const f32x4*)(mu + LDPA + colA + 4);
#pragma unroll
    for (int j = 0; j < 8; ++j) {
      const float m0 = j < 4 ? m0a[j & 3] : m0b[j & 3], m1 = j < 4 ? m1a[j & 3] : m1b[j & 3];
      float t = c[j] + m0 * (pv[j] * mp - c[j]) + m1 * (nx[j] * mn - c[j]);
      if (l32 < 8) { float e = __expf(2.f * t); t = 1.f - 2.f * __builtin_amdgcn_rcpf(1.f + e); }
      else if (l32 >= 16) t = __builtin_amdgcn_rcpf(1.f + __expf(-t));
      o[j] = t;
    }
    u32x4 w = {pk_bf16(o[0], o[1]), pk_bf16(o[2], o[3]), pk_bf16(o[4], o[5]), pk_bf16(o[6], o[7])};
    if (lane < 8) *(u32x4*)(p.TW + (size_t)row * 64 + lane * 8) = w;
    else if (lane < 16) *(u32x4*)(p.TA + (size_t)row * 64 + (lane - 8) * 8) = w;
    else if (lane < 32) *(u32x4*)(p.TG + (size_t)row * 128 + (lane - 16) * 8) = w;
  }
  float f[8], ss = 0.f, s2 = 0.f, s3 = 0.f, fr_[8];
  unpack8(lq0, f);
#pragma unroll
  for (int j = 0; j < 8; ++j) ss += f[j] * f[j];
  unpack8(lq1, f);
  if (lane < 32) {
#pragma unroll
    for (int j = 0; j < 8; ++j) ss += f[j] * f[j];
  }
  unpack8(lkv, f);
  if (lane < 32) {
#pragma unroll
    for (int j = 0; j < 8; ++j) s2 += f[j] * f[j];
  }
  unpack8(lrp, fr_);
  if (lane < 4) {
#pragma unroll
    for (int j = 0; j < 8; ++j) s3 += fr_[j] * fr_[j];
  }
  s3 += __shfl_xor(s3, 1); s3 += __shfl_xor(s3, 2);
  {
    const float inv = rsqrtf(s3 * (1.f / 32.f) + EPSF);
    const float* g = p.k_rope_g + l * 32;
    const bool lat = s >= NCTX; const int sp = lat ? s - NCTX : 0;
    const float* rt = p.ROPE + ((lane & 2) ? (sp & 63) : (sp >> 6)) * 16;
    float o[8];
#pragma unroll
    for (int j = 0; j < 8; ++j) {
      float val = fr_[j] * inv * g[(lane & 3) * 8 + j];
      float partner = __shfl_xor(val, 1);
      if (lat) {
        const float cs = rt[2 * j], sn = rt[2 * j + 1];
        val = (lane & 1) == 0 ? val * cs - partner * sn : val * cs + partner * sn;
      }
      o[j] = val;
    }
    if (lane < 4) {
      u32x4 w = {pk_bf16(o[0], o[1]), pk_bf16(o[2], o[3]), pk_bf16(o[4], o[5]), pk_bf16(o[6], o[7])};
#pragma unroll
      for (int hh = 0; hh < 6; ++hh) *(u32x4*)(p.Kt + ((size_t)(b * 6 + hh) * TB + s) * 96 + 64 + lane * 8) = w;
    }
  }
  {
    float bg[8], cc[8], hh[8], cp[8], hp[8], cn[8], hn[8], o[8];
    unpack8(lbg, bg); unpack8(lcc, cc); unpack8(lhh, hh); unpack8(lcp, cp); unpack8(lhp, hp); unpack8(lcn, cn); unpack8(lhn, hn);
    const float* cw = p.conv_w + (size_t)l * 3 * 256;
#pragma unroll
    for (int j = 0; j < 8; ++j) o[j] = bg[j] * (cw[c8 + j] * cp[j] * hp[j] * mp + cw[256 + c8 + j] * cc[j] * hh[j] + cw[512 + c8 + j] * cn[j] * hn[j] * mn);
    u32x4 w = {pk_bf16(o[0], o[1]), pk_bf16(o[2], o[3]), pk_bf16(o[4], o[5]), pk_bf16(o[6], o[7])};
    if (lane < 32) *(u32x4*)(p.HY + (size_t)row * DM + 768 + c8) = w;
  }
}

#define MFMA32(a, b, c) __builtin_amdgcn_mfma_f32_32x32x16_bf16((a), (b), (c), 0, 0, 0)
DI bf16x8 pack8(const f32x16& x, int s) {
  u32x4 v = {pk_bf16(x[8 * s], x[8 * s + 1]), pk_bf16(x[8 * s + 2], x[8 * s + 3]), pk_bf16(x[8 * s + 4], x[8 * s + 5]), pk_bf16(x[8 * s + 6], x[8 * s + 7])};
  return __builtin_bit_cast(bf16x8, v);
}
constexpr int KROW = 208, VROW = 136, KBUF = 64 * KROW, VBUF = 64 * VROW;
DI void attn_task(const Params& p, int b, int h, int q0, int k0, int nk, char* lds) {
  const int tid = opaque_tid(), lane = tid & 63, wid = tid >> 6, r = lane & 31, hh = lane >> 5;
  const bf16_t* Qp = p.Q + ((size_t)(b * 6 + h) * TB + q0 + wid * 32 + r) * 96;
  const bf16_t* Kp = p.Kt + ((size_t)(b * 6 + h) * TB + k0) * 96;
  const bf16_t* Vp = p.VT + (size_t)(h * 64) * T_TOK + (size_t)b * TB + k0;
  bf16x8 qf[6];
#pragma unroll
  for (int ks = 0; ks < 6; ++ks) qf[ks] = *(const bf16x8*)(Qp + ks * 16 + hh * 8);
  int krow_[3], kch_[3];
#pragma unroll
  for (int i = 0; i < 3; ++i) { int id = tid + i * 256; krow_[i] = id / 12; kch_[i] = id % 12; }
  const int vd0 = tid >> 3, vch = tid & 7;
  u32x4 kreg[3], vreg[2];
  auto load_regs = [&](int kt) {
#pragma unroll
    for (int i = 0; i < 3; ++i) kreg[i] = *(const u32x4*)(Kp + (size_t)(kt * 64 + krow_[i]) * 96 + kch_[i] * 8);
#pragma unroll
    for (int i = 0; i < 2; ++i) vreg[i] = *(const u32x4*)(Vp + (size_t)(vd0 + 32 * i) * T_TOK + kt * 64 + vch * 8);
  };
  auto write_lds = [&](int buf) {
    char* kb = lds + buf * (KBUF + VBUF);
    char* vb = kb + KBUF;
#pragma unroll
    for (int i = 0; i < 3; ++i) *(u32x4*)(kb + krow_[i] * KROW + kch_[i] * 16) = kreg[i];
#pragma unroll
    for (int i = 0; i < 2; ++i) {
      char* d = vb + (vd0 + 32 * i) * VROW + vch * 16;
      *(u32x2*)d = (u32x2){vreg[i][0], vreg[i][1]};
      *(u32x2*)(d + 8) = (u32x2){vreg[i][2], vreg[i][3]};
    }
  };
  f32x16 o[2];
#pragma unroll
  for (int i = 0; i < 16; ++i) { o[0][i] = 0.f; o[1][i] = 0.f; }
  float m_run = -1e30f, l_run = 0.f;
  const int NT = nk >> 6;
  __syncthreads();
  load_regs(0);
  write_lds(0);
  for (int kt = 0; kt < NT; ++kt) {
    if (kt + 1 < NT) load_regs(kt + 1);
    __syncthreads();
    const char* kb = lds + (kt & 1) * (KBUF + VBUF);
    const char* vb = kb + KBUF;
    f32x16 st[2];
#pragma unroll
    for (int kbk = 0; kbk < 2; ++kbk) {
#pragma unroll
      for (int i = 0; i < 16; ++i) st[kbk][i] = 0.f;
#pragma unroll
      for (int ks = 0; ks < 6; ++ks) {
        bf16x8 kf = *(const bf16x8*)(kb + (kbk * 32 + r) * KROW + ks * 32 + hh * 16);
        st[kbk] = MFMA32(kf, qf[ks], st[kbk]);
      }
    }
    float mx = st[0][0];
#pragma unroll
    for (int i = 0; i < 16; ++i) { mx = fmaxf(mx, st[0][i]); mx = fmaxf(mx, st[1][i]); }
    mx = fmaxf(mx, __shfl_xor(mx, 32));
    const float m_new = fmaxf(m_run, mx);
    const float alpha = __builtin_amdgcn_exp2f(m_run - m_new);
    m_run = m_new;
    float psum = 0.f;
#pragma unroll
    for (int kbk = 0; kbk < 2; ++kbk)
#pragma unroll
      for (int i = 0; i < 16; ++i) { float e = __builtin_amdgcn_exp2f(st[kbk][i] - m_new); st[kbk][i] = e; psum += e; }
    psum += __shfl_xor(psum, 32);
    l_run = l_run * alpha + psum;
    if (__builtin_amdgcn_ballot_w64(alpha != 1.f)) {
#pragma unroll
      for (int i = 0; i < 16; ++i) { o[0][i] *= alpha; o[1][i] *= alpha; }
    }
#pragma unroll
    for (int ksv = 0; ksv < 4; ++ksv) {
      const bf16x8 pf = pack8(st[ksv >> 1], ksv & 1);
#pragma unroll
      for (int db = 0; db < 2; ++db) {
        const char* va = vb + (db * 32 + r) * VROW + (ksv * 16 + 4 * hh) * 2;
        s16x4 lo = *(const s16x4*)va, hi = *(const s16x4*)(va + 16);
        bf16x8 vf = __builtin_shufflevector(lo, hi, 0, 1, 2, 3, 4, 5, 6, 7);
        o[db] = MFMA32(vf, pf, o[db]);
      }
    }
    if (kt + 1 < NT) write_lds((kt + 1) & 1);
  }
  const float invl = 1.f / l_run;
  bf16_t* dst = p.HY + (size_t)(b * TB + q0 + wid * 32 + r) * DM + 384 + h * 64;
#pragma unroll
  for (int db = 0; db < 2; ++db)
#pragma unroll
    for (int g = 0; g < 4; ++g) {
      u32x2 w = {pk_bf16(o[db][4 * g] * invl, o[db][4 * g + 1] * invl), pk_bf16(o[db][4 * g + 2] * invl, o[db][4 * g + 3] * invl)};
      *(u32x2*)(dst + db * 32 + 8 * g + 4 * hh) = w;
    }
}

enum { VW = 0, VKK = 1, VB = 2, VKD = 3, VR = 4, VV = 5 };
constexpr int CS = 68, CP = 16 * CS;
DI void scan_task(const Params& p, int l, int b, int h, int dir, int half, char* lds) {
  float* cb = (float*)lds;
  float* tk = cb + 6 * CP;
  float* ybuf = tk + CP;
  const int tid = opaque_tid(), lane = tid & 63, wid = tid >> 6;
  const int st_p = tid >> 4, c4 = tid & 15;
  const int fr = lane & 15, fq = lane >> 4;
  const int rp = lane >> 4, g = lane & 15;
  const int hc = h * 64;
  bf16x8 bw[2], ba[2];
  {
    const bf16_t* wd = p.Wdecay + ((size_t)dir * 384 + hc + wid * 16 + fr) * 64;
    const bf16_t* wi = p.Wicl + ((size_t)dir * 384 + hc + wid * 16 + fr) * 64;
#pragma unroll
    for (int ks = 0; ks < 2; ++ks) { bw[ks] = *(const bf16x8*)(wd + ks * 32 + fq * 8); ba[ks] = *(const bf16x8*)(wi + ks * 32 + fq * 8); }
  }
  f32x4 mu0[3], mu1[3];
  const float* mu = p.tshift_mu + (size_t)l * 2 * LDPA;
#pragma unroll
  for (int sec = 0; sec < 3; ++sec) { mu0[sec] = *(const f32x4*)(mu + sec * 384 + hc + c4 * 4); mu1[sec] = *(const f32x4*)(mu + LDPA + sec * 384 + hc + c4 * 4); }
  const f32x4 kkg = *(const f32x4*)(p.k_k + l * 384 + hc + c4 * 4);
  const f32x4 rkg = *(const f32x4*)(p.r_k + l * 384 + hc + c4 * 4);
  const int colB = wid * 16 + fq * 4;
  const f32x4 w0 = *(const f32x4*)(p.decay_w0 + (size_t)(l * 2 + dir) * 384 + hc + colB);
  const f32x4 a0 = *(const f32x4*)(p.icl_a0 + (size_t)(l * 2 + dir) * 384 + hc + colB);
  const f32x4 kag = *(const f32x4*)(p.k_a + l * 384 + hc + colB);

  u32x2 ld[3][3];
  float mprev = 0.f, mnext = 0.f;
  bf16x8 aw[2], aa[2];
  auto chunk_lo = [&](int c) -> int { return dir == 0 ? 16 * c : (c < 16 ? 240 - 16 * c : 2544 - 16 * c); };
  auto issue_loads = [&](int c) {
    const int slo = chunk_lo(c);
    const int s = slo + st_p;
    const bool hasprev = (s != 0 && s != NCTX), hasnext = (s != NCTX - 1 && s != TB - 1);
    const bf16_t* pa = p.PA + (size_t)(b * TB + s) * LDPA + hc + c4 * 4;
    const int op = hasprev ? -LDPA : 0, on = hasnext ? LDPA : 0;
    mprev = hasprev ? 1.f : 0.f; mnext = hasnext ? 1.f : 0.f;
#pragma unroll
    for (int sec = 0; sec < 3; ++sec) {
      ld[sec][1] = *(const u32x2*)(pa + sec * 384);
      ld[sec][0] = *(const u32x2*)(pa + sec * 384 + op);
      ld[sec][2] = *(const u32x2*)(pa + sec * 384 + on);
    }
    const size_t trow = (size_t)(b * TB + slo + fr) * 64;
#pragma unroll
    for (int ks = 0; ks < 2; ++ks) { aw[ks] = *(const bf16x8*)(p.TW + trow + ks * 32 + fq * 8); aa[ks] = *(const bf16x8*)(p.TA + trow + ks * 32 + fq * 8); }
  };
  auto produce = [&](int c) {
    const int slo = chunk_lo(c);
    float ts[3][4];
#pragma unroll
    for (int sec = 0; sec < 3; ++sec) {
      float pc[4], pp[4], pn[4];
      unpack4(ld[sec][1], pc); unpack4(ld[sec][0], pp); unpack4(ld[sec][2], pn);
#pragma unroll
      for (int j = 0; j < 4; ++j) ts[sec][j] = pc[j] + mu0[sec][j] * (pp[j] * mprev - pc[j]) + mu1[sec][j] * (pn[j] * mnext - pc[j]);
    }
    *(f32x4*)(cb + VR * CP + st_p * CS + c4 * 4) = (f32x4){ts[0][0], ts[0][1], ts[0][2], ts[0][3]};
    *(f32x4*)(cb + VV * CP + st_p * CS + c4 * 4) = (f32x4){ts[2][0], ts[2][1], ts[2][2], ts[2][3]};
    *(f32x4*)(tk + st_p * CS + c4 * 4) = (f32x4){ts[1][0], ts[1][1], ts[1][2], ts[1][3]};
    float kx[4], ss = 0.f;
#pragma unroll
    for (int j = 0; j < 4; ++j) { kx[j] = ts[1][j] * kkg[j]; ss += kx[j] * kx[j]; }
    ss = red16(ss);
    const float inv = rsqrtf(ss + 1e-12f);
    *(f32x4*)(cb + VKK * CP + st_p * CS + c4 * 4) = (f32x4){kx[0] * inv, kx[1] * inv, kx[2] * inv, kx[3] * inv};
    __syncthreads();
    f32x4 dw = {0.f, 0.f, 0.f, 0.f}, da = {0.f, 0.f, 0.f, 0.f};
#pragma unroll
    for (int ks = 0; ks < 2; ++ks) {
      dw = __builtin_amdgcn_mfma_f32_16x16x32_bf16(bw[ks], aw[ks], dw, 0, 0, 0);
      da = __builtin_amdgcn_mfma_f32_16x16x32_bf16(ba[ks], aa[ks], da, 0, 0, 0);
    }
    {
      const f32x4 kv = *(const f32x4*)(tk + fr * CS + colB);
      const f32x4 kkv = *(const f32x4*)(cb + VKK * CP + fr * CS + colB);
      f32x4 wv, kdv, bv;
#pragma unroll
      for (int j = 0; j < 4; ++j) {
        wv[j] = __expf(-LOG_DECAY_SCALE * sigmoidf_(w0[j] + dw[j]));
        const float a = sigmoidf_(a0[j] + da[j]);
        kdv[j] = kv[j] * (1.f + (a - 1.f) * kag[j]);
        bv[j] = kkv[j] * a;
      }
      *(f32x4*)(cb + VW * CP + fr * CS + colB) = wv;
      *(f32x4*)(cb + VKD * CP + fr * CS + colB) = kdv;
      *(f32x4*)(cb + VB * CP + fr * CS + colB) = bv;
    }
    __syncthreads();
    {
      const f32x4 rv = *(const f32x4*)(cb + VR * CP + st_p * CS + c4 * 4);
      const f32x4 kdv = *(const f32x4*)(cb + VKD * CP + st_p * CS + c4 * 4);
      float bs = rv[0] * kdv[0] * rkg[0] + rv[1] * kdv[1] * rkg[1] + rv[2] * kdv[2] * rkg[2] + rv[3] * kdv[3] * rkg[3];
      bs = red16(bs);
      if (c4 == 0 && half == 0) p.BON[(size_t)dir * T_TOK * 6 + (size_t)(b * TB + slo + st_p) * 6 + h] = bs;
    }
  };

  f32x2 S0[2], S1[2];
#pragma unroll
  for (int j = 0; j < 2; ++j) { S0[j] = (f32x2){0.f, 0.f}; S1[j] = (f32x2){0.f, 0.f}; }
  __syncthreads();
  issue_loads(0);
  produce(0);
  __syncthreads();
  const int NCH = TB / 16;
  const int rowl = half * 32 + wid * 8 + rp * 2;
  const int inc = dir ? -CS : CS;
  for (int c = 0; c < NCH; ++c) {
    if (c + 1 < NCH) issue_loads(c + 1);
    {
      const float* ps = cb + (dir ? 15 * CS : 0) + g * 4;
      const float* pv = cb + VV * CP + (dir ? 15 * CS : 0) + rowl;
      float* py = ybuf + (dir ? 15 * 512 : 0) + ((wid * 4 + rp) * 16 + g) * 2;
      f32x4 cw = *(const f32x4*)(ps + VW * CP), ckk = *(const f32x4*)(ps + VKK * CP), cbb = *(const f32x4*)(ps + VB * CP),
            ckd = *(const f32x4*)(ps + VKD * CP), crr = *(const f32x4*)(ps + VR * CP);
      f32x2 cvv = *(const f32x2*)pv;
#pragma unroll
      for (int ii = 0; ii < 16; ++ii) {
        f32x4 nw = cw, nkk = ckk, nbb = cbb, nkd = ckd, nrr = crr; f32x2 nvv = cvv;
        if (ii < 15) {
          ps += inc; pv += inc;
          nw = *(const f32x4*)(ps + VW * CP); nkk = *(const f32x4*)(ps + VKK * CP); nbb = *(const f32x4*)(ps + VB * CP);
          nkd = *(const f32x4*)(ps + VKD * CP); nrr = *(const f32x4*)(ps + VR * CP); nvv = *(const f32x2*)pv;
        }
        __builtin_amdgcn_sched_barrier(0x7);
        const f32x2 kk0 = {ckk[0], ckk[1]}, kk1 = {ckk[2], ckk[3]}, w0 = {cw[0], cw[1]}, w1 = {cw[2], cw[3]};
        const f32x2 b0 = {cbb[0], cbb[1]}, b1 = {cbb[2], cbb[3]}, kd0 = {ckd[0], ckd[1]}, kd1 = {ckd[2], ckd[3]};
        const f32x2 r0 = {crr[0], crr[1]}, r1 = {crr[2], crr[3]};
        const f32x2 p0 = S0[0] * kk0 + S0[1] * kk1, p1 = S1[0] * kk0 + S1[1] * kk1;
        const f32x2 u00 = S0[0] * w0 + kd0 * cvv[0], u01 = S0[1] * w1 + kd1 * cvv[0];
        const f32x2 u10 = S1[0] * w0 + kd0 * cvv[1], u11 = S1[1] * w1 + kd1 * cvv[1];
        const float q0 = red16(p0[0] + p0[1]), q1 = red16(p1[0] + p1[1]);
        S0[0] = u00 - b0 * q0; S0[1] = u01 - b1 * q0;
        S1[0] = u10 - b0 * q1; S1[1] = u11 - b1 * q1;
        const f32x2 y0 = S0[0] * r0 + S0[1] * r1, y1 = S1[0] * r0 + S1[1] * r1;
        *(f32x2*)py = (f32x2){y0[0] + y0[1], y1[0] + y1[1]};
        py += dir ? -512 : 512;
        cw = nw; ckk = nkk; cbb = nbb; ckd = nkd; crr = nrr; cvv = nvv;
      }
    }
    __syncthreads();
    {
      const int slo = chunk_lo(c);
      const float* yp = ybuf + (st_p * 16 + c4) * 32;
      f32x4 a = *(const f32x4*)(yp + 4 * (c4 & 7));
#pragma unroll
      for (int i = 1; i < 8; ++i) a += *(const f32x4*)(yp + 4 * ((i + c4) & 7));
      *(f32x2*)(p.Y + (size_t)dir * T_TOK * 384 + (size_t)(b * TB + slo + st_p) * 384 + hc + half * 32 + c4 * 2) = (f32x2){a[0] + a[2], a[1] + a[3]};
    }
    if (c + 1 < NCH) produce(c + 1);
  }
  __syncthreads();
}

DI int lat_tile(int i) { return (i >> 4) * 18 + 2 + (i & 15); }
DI bool xcd_tile(int bid, int G, int i, int MT, int NT, int& tm, int& tn) {
  if ((G & 7) || (MT & 7)) { const int t = bid + i * G; if (t >= MT * NT) return false; tm = t / NT; tn = t % NT; return true; }
  const int nbx = G >> 3, x = bid & 7, j = bid >> 3, MS = MT >> 3;
  const int q = j + nbx * i;
  if (q >= MS * NT) return false;
  const int full = NT >> 3, wl = NT & 7;
  int nb = q / (MS * 8), m, ni;
  if (nb < full) { const int rem = q - nb * MS * 8; m = rem >> 3; ni = rem & 7; }
  else { const int rem = q - full * MS * 8; nb = full; m = rem / wl; ni = rem % wl; }
  tm = x * MS + m; tn = nb * 8 + ni;
  return true;
}

template <int KSEL> DI void run_phase(const Params& p, int ph, char* lds) {
  const int bid = blockIdx.x, G = gridDim.x, tid = opaque_tid(), lane = tid & 63, wid = tid >> 6;
  if (ph == 0) {
    if (KSEL >= 0 && KSEL != 10) return;
    for (int t = bid; t < 384 + NCONV_W1 + 1; t += G) {
      if (t < 384) adaln_task(p, t, lds);
      else if (t < 384 + NCONV_W1) conv_w1_task(p, 0, t - 384, lds);
      else { for (int e = tid; e < 512; e += 256) { float cs, sn; rope_angle(e >> 3, e & 7, cs, sn); p.ROPE[2 * e] = cs; p.ROPE[2 * e + 1] = sn; } }
    }
    return;
  }
  if (KSEL == 10) return;
  const int l = (ph - 1) / 9, kq = (ph - 1) % 9, k = kq < 2 ? kq : kq + 1;
  const bool last = (l == 1);
  const int lb = ((G & 7) == 0) ? (bid & 7) * (G >> 3) + (bid >> 3) : bid;
  if (KSEL >= 0 && KSEL != 10 && k != (KSEL == 11 ? 4 : KSEL)) return;
  switch (k) {
    case 0:
      for (int i = bid * 256 + tid; i < 2 * T_TOK; i += G * 256) p.RSTD[i] = 0.f;
      modnorm_rows(p, l, 0, l == 0, false, bid * 4 + wid, G * 4, lane);
      break;
    case 1: {
      EpiP e{p.PA, p.PBC, p.RSTD};
      for (int i = 0, tm, tn; xcd_tile(bid, G, i, 144, 26, tm, tn); ++i) gemm_tile(p.HY, DM, p.Win, DM, DM, tm * 128, tn * 128, lds, e);
    } break;
    case 3: {
      const int nq = last ? 128 * 5 : 144 * 5;
      EpiQ eq{p.RSTD, p.q_nope_g + l * 64, p.q_rope_g + l * 32, p.ROPE, p.Q};
      EpiK ek{p.RSTD + T_TOK, p.k_nope_g + l * 64, p.Kt};
      EpiV ev{p.RSTD + T_TOK, p.VT};
      if (KSEL >= 0) {
        for (int t = bid; t < nq + 432 + 432 + T_TOK / 4; t += G) {
          if (t >= nq + 864) { prep_token(p, l, (t - nq - 864) * 4 + wid, lane); continue; }
          if (t < nq) { int i = t / 5; int tm = last ? lat_tile(i) : i; gemm_tile(p.PBC, LDPBC, p.Wuq, 768, 768, tm * 128, (t % 5) * 128, lds, eq); }
          else if (t < nq + 432) { int u = t - nq; gemm_tile(p.PBC + 768, LDPBC, p.WukvK, 256, 256, (u / 3) * 128, (u % 3) * 128, lds, ek); }
          else { int u = t - nq - 432; gemm_tile(p.WvT, 256, p.PBC + 768, LDPBC, 256, (u % 3) * 128, (u / 3) * 128, lds, ev); }
        }
      } else {
        for (int t = bid; t < T_TOK / 4; t += G) prep_token(p, l, t * 4 + wid, lane);
        volatile LAS unsigned* slot = (volatile LAS unsigned*)(lds + 65536 + 8);
        unsigned* qg = p.BAR + 3456   + 64 * l + 16;
        for (;;) {
          __syncthreads();
          if (tid == 0) *slot = __hip_atomic_fetch_add(qg, 1u, __ATOMIC_RELAXED, __HIP_MEMORY_SCOPE_AGENT);
          __syncthreads();
          const int t = (int)*slot;
          if (t >= nq + 864) break;
          if (t < nq) { int i = t / 5; int tm = last ? lat_tile(i) : i; gemm_tile(p.PBC, LDPBC, p.Wuq, 768, 768, tm * 128, (t % 5) * 128, lds, eq); }
          else if (t < nq + 432) { int u = t - nq; gemm_tile(p.PBC + 768, LDPBC, p.WukvK, 256, 256, (u / 3) * 128, (u % 3) * 128, lds, ek); }
          else { int u = t - nq - 432; gemm_tile(p.WvT, 256, p.PBC + 768, LDPBC, 256, (u % 3) * 128, (u / 3) * 128, lds, ev); }
        }
      }
    } break;
    case 4: {
      const int natt = 768 + (last ? 0 : 96);
      if (KSEL != 11) { if (bid < 192) { scan_task(p, l, bid / 24, (bid % 24) >> 2, (bid >> 1) & 1, bid & 1, lds); break; } if (KSEL == 4) break; }
      const int aoff = KSEL == 11 ? 0 : 192;
      if (KSEL == 11) {
        for (int t = bid; t < natt + NCONV_FF; t += G) {
          if (t < 768) { int bh = t >> 4, qb = t & 15; attn_task(p, bh / 6, bh % 6, NCTX + qb * 128, 0, TB, lds); }
          else if (t < natt) { int u = t - 768; int bh = u >> 1, qb = u & 1; attn_task(p, bh / 6, bh % 6, qb * 128, 0, NCTX, lds); }
          else conv_ff_task(p, l, t - natt, lds);
        }
      } else {
        volatile LAS unsigned* slot = (volatile LAS unsigned*)(lds + 65536 + 8);
        for (;;) {
          __syncthreads();
          if (tid == 0) *slot = __hip_atomic_fetch_add(p.BAR + 3456   + 64 * l, 1u, __ATOMIC_RELAXED, __HIP_MEMORY_SCOPE_AGENT);
          __syncthreads();
          const int t = (int)*slot;
          if (t >= natt + NCONV_FF) break;
          if (t < 768) { int bh = t >> 4, qb = t & 15; attn_task(p, bh / 6, bh % 6, NCTX + qb * 128, 0, TB, lds); }
          else if (t < natt) { int u = t - 768; int bh = u >> 1, qb = u & 1; attn_task(p, bh / 6, bh % 6, qb * 128, 0, NCTX, lds); }
          else conv_ff_task(p, l, t - natt, lds);
        }
      }
    } break;
    case 5: {
      EpiPost e{p.Y, p.BON, p.tshift_mu + (size_t)l * 2 * LDPA, p.lnx_g + l * 384, p.lnx_b + l * 384, p.PA, p.HY};
      const int nm = last ? 128 : 144;
      for (int t = bid; t < nm * 3; t += G) { int i = t / 3; int tm = last ? lat_tile(i) : i; gemm_tile(p.TG, 128, p.Wgate, 128, 128, tm * 128, (t % 3) * 128, lds, e); }
    } break;
    case 6: {
      EpiRes e{&p, l, l == 0, 2 * 1024};
      const int nm = last ? 128 : 144;
      for (int i = 0, tm, tn; xcd_tile(bid, G, i, nm, 8, tm, tn); ++i) gemm_tile(p.HY, DM, p.Wout, DM, DM, (last ? lat_tile(tm) : tm) * 128, tn * 128, lds, e);
    } break;
    case 7:
      modnorm_rows(p, l, 1, false, last, bid * 4 + wid, G * 4, lane);
      break;
    case 8: {
      EpiFfnIn e{p.ACT};
      const int nm = last ? 128 : 144;
      const int nconv = last ? 0 : NCONV_W1;
      for (int i = 0, tm, tn; xcd_tile(bid, G, i, nm, 44, tm, tn); ++i) gemm_tile(p.HY, DM, p.Wffi, DM, DM, (last ? lat_tile(tm) : tm) * 128, tn * 128, lds, e);
      for (int t = bid; t < nconv; t += G) conv_w1_task(p, 1, t, lds);
    } break;
    case 9: {
      EpiRes e{&p, l, false, 5 * 1024};
      const int nm = last ? 128 : 144;
      for (int i = 0, tm, tn; xcd_tile(bid, G, i, nm, 8, tm, tn); ++i) gemm_tile(p.ACT, 2816, p.Wffo, 2816, 2816, (last ? lat_tile(tm) : tm) * 128, tn * 128, lds, e);
    } break;
  }
}


#define XB_TMO      128
#define XB_XCNT(j)  (256  + 64 * (j))
#define XB_XSUB(j)  (1280 + 64 * (j))
#define XB_XGEN(j)  (2304 + 64 * (j))
#define XB_TOP      3328
#define XB_TOPGEN   3392
#define XCD_BAR_WORDS 3456
#define XB_SPIN_CAP (1u << 20)
DI unsigned xb_ld(unsigned* p) { return __hip_atomic_load(p, __ATOMIC_RELAXED, __HIP_MEMORY_SCOPE_AGENT); }
DI unsigned xb_add(unsigned* p, unsigned v) { return __hip_atomic_fetch_add(p, v, __ATOMIC_RELAXED, __HIP_MEMORY_SCOPE_AGENT); }
DI unsigned xb_xcc_id() { return (unsigned)__builtin_amdgcn_s_getreg((3 << 11) | 20) & 0xFu; }
#define XB_SPIN(cond, bar) do { unsigned _sp = 0; while (cond) { __builtin_amdgcn_s_sleep(1); \
    if ((++_sp & 255u) == 0u) { if (xb_ld(&(bar)[XB_TMO])) break; if (_sp > XB_SPIN_CAP) { atomicAdd(&(bar)[XB_TMO], 1u); break; } } } } while (0)
struct XcdBarrier { unsigned* bar; unsigned x; volatile LAS unsigned* st; };
DI XcdBarrier xcd_barrier_post(unsigned* bar, volatile LAS unsigned* st) {
  XcdBarrier b; b.bar = bar; b.x = xb_xcc_id(); b.st = st;
  if (threadIdx.x == 0) (void)xb_add(&bar[XB_XCNT(b.x)], 1u);
  return b;
}
DI void xcd_barrier_complete(unsigned* bar, unsigned x, unsigned& nloc, unsigned& nx) {
  const unsigned G = gridDim.x * gridDim.y * gridDim.z;
  unsigned sum, cnt, mine, sp = 0u;
  for (;;) {
    sum = 0u; cnt = 0u; mine = 0u;
#pragma unroll
    for (unsigned j = 0; j < 16; ++j) { const unsigned c = xb_ld(&bar[XB_XCNT(j)]); sum += c; cnt += (c > 0u) ? 1u : 0u; mine = (j == x) ? c : mine; }
    if (sum == G) break;
    __builtin_amdgcn_s_sleep(1);
    if ((++sp & 255u) == 0u) { if (xb_ld(&bar[XB_TMO])) break; if (sp > XB_SPIN_CAP) { atomicAdd(&bar[XB_TMO], 1u); break; } }
  }
  nloc = mine > 0u ? mine : 1u; nx = cnt > 0u ? cnt : 1u;
}
DI void xcd_barrier(const XcdBarrier& b) {
  asm volatile("s_waitcnt vmcnt(0)" ::: "memory");
  __syncthreads();
  if (threadIdx.x == 0) {
    unsigned* bar = b.bar;
    __builtin_amdgcn_s_waitcnt(0);
    unsigned nloc = b.st[0], nx = b.st[1];
    if (nloc == 0u) { xcd_barrier_complete(bar, b.x, nloc, nx); b.st[0] = nloc; b.st[1] = nx; }
    const unsigned old = xb_add(&bar[XB_XSUB(b.x)], 1u);
    const unsigned gen = old / nloc;
    if (old + 1u == (gen + 1u) * nloc) {
      __builtin_amdgcn_fence(__ATOMIC_RELEASE, "agent");
      asm volatile("s_waitcnt vmcnt(0)" ::: "memory");
      const unsigned og = xb_add(&bar[XB_TOP], 1u);
      const unsigned tg = og / nx;
      if (og + 1u == (tg + 1u) * nx) xb_add(&bar[XB_TOPGEN], 1u);
      else XB_SPIN(xb_ld(&bar[XB_TOPGEN]) == tg, bar);
      __builtin_amdgcn_fence(__ATOMIC_ACQUIRE, "agent");
      xb_add(&bar[XB_XGEN(b.x)], 1u);
      asm volatile("s_waitcnt vmcnt(0)" ::: "memory");
    } else {
      XB_SPIN(xb_ld(&bar[XB_XGEN(b.x)]) == gen, bar);
      __builtin_amdgcn_fence(__ATOMIC_ACQUIRE, "agent");
      asm volatile("s_waitcnt vmcnt(0)" ::: "memory");
    }
  }
  __syncthreads();
}

constexpr int NPHASE = 19;
#if !MULTI_LAUNCH
__global__ void __launch_bounds__(256, 2) mega(Params p, int ph_lo, int ph_hi) {
  __shared__ __attribute__((aligned(16))) char lds[65536 + 16];
  cg::grid_group grid = cg::this_grid();
  volatile LAS unsigned* st = (volatile LAS unsigned*)(lds + 65536);
  if (threadIdx.x == 0) { st[0] = 0u; st[1] = 0u; }
  __syncthreads();
  XcdBarrier xb = xcd_barrier_post(p.BAR, st);
  for (int ph = ph_lo; ph < ph_hi; ++ph) {
    if (ph > ph_lo) xcd_barrier(xb);
    run_phase<-1>(p, ph, lds);
  }
  if (ph_hi > NPHASE) grid.sync();
}
#endif
template <int KSEL> __global__ void __launch_bounds__(256, 2) phase_k(Params p, int ph) {
  __shared__ __attribute__((aligned(16))) char lds[65536];
  run_phase<KSEL>(p, ph, lds);
}

extern "C" void kernel_launch(void* const* d_in, const int* in_sizes, int n_in, void* d_out, int out_size, void* d_ws, size_t ws_size, hipStream_t stream) {
  static int grid_blocks = 0;
  if (!grid_blocks) {
    int dev = 0, cus = 0, per_cu = 0;
    (void)hipGetDevice(&dev);
    (void)hipDeviceGetAttribute(&cus, hipDeviceAttributeMultiprocessorCount, dev);
    #if MULTI_LAUNCH
    per_cu = 2;
#else
    (void)hipOccupancyMaxActiveBlocksPerMultiprocessor(&per_cu, mega, 256, 0);
#endif
    if (per_cu > 2) per_cu = 2;
    if (per_cu < 1) per_cu = 1;
    grid_blocks = cus * per_cu;
  }
  Params p{};
  const float** pin = (const float**)&p.x;
  for (int i = 0; i < 32; ++i) pin[i] = (const float*)d_in[i];
  p.out = (float*)d_out;
  char* w = (char*)d_ws;
  size_t off = 0;
  auto take = [&](size_t bytes) { char* r = w + off; off += (bytes + 255) & ~(size_t)255; return r; };
  p.BAR = (unsigned*)take((XCD_BAR_WORDS + 128) * 4);
  p.MOD = (float*)take(2 * 9 * 6144 * 4);
  p.ROPE = (float*)take(64 * 8 * 2 * 4);
  p.RSTD = (float*)take(2 * (size_t)T_TOK * 4);
  p.BON = (float*)take(2 * (size_t)T_TOK * 6 * 4);
  p.XCTX = (float*)take((size_t)8 * NCTX * DM * 4);
  p.Win = (bf16_t*)take((size_t)3328 * 1024 * 2);
  p.Wuq = (bf16_t*)take((size_t)640 * 768 * 2);
  p.WukvK = (bf16_t*)take((size_t)384 * 256 * 2);
  p.WvT = (bf16_t*)take((size_t)384 * 256 * 2);
  p.Wgate = (bf16_t*)take((size_t)384 * 128 * 2);
  p.Wdecay = (bf16_t*)take((size_t)2 * 384 * 64 * 2);
  p.Wicl = (bf16_t*)take((size_t)2 * 384 * 64 * 2);
  p.Wout = (bf16_t*)take((size_t)1024 * 1024 * 2);
  p.HY = (bf16_t*)take((size_t)T_TOK * DM * 2);
  p.TW = (bf16_t*)take((size_t)T_TOK * 64 * 2);
  p.TA = (bf16_t*)take((size_t)T_TOK * 64 * 2);
  p.TG = (bf16_t*)take((size_t)T_TOK * 128 * 2);
  char* qkv = take((size_t)T_TOK * 576 * 2 * 2 + (size_t)384 * T_TOK * 2);
  p.Q = (bf16_t*)qkv;
  p.Kt = (bf16_t*)(qkv + (size_t)T_TOK * 576 * 2);
  p.VT = (bf16_t*)(qkv + (size_t)T_TOK * 576 * 2 * 2);
  p.Wffi = (bf16_t*)take((size_t)5632 * 1024 * 2);
  p.Wffo = (bf16_t*)take((size_t)2816 * 1024 * 2);
  char* pr = take((size_t)T_TOK * (LDPA + LDPBC) * 2);
  p.PA = (bf16_t*)pr;
  p.PBC = (bf16_t*)(pr + (size_t)T_TOK * LDPA * 2);
  p.Y = (float*)p.PBC;
  p.ACT = (bf16_t*)pr;
  if (off > ws_size) { fprintf(stderr, "workspace too small: need %zu have %zu\n", off, ws_size); }
#if MULTI_LAUNCH
  hipLaunchKernelGGL(phase_k<10>, dim3(grid_blocks), dim3(256), 0, stream, p, 0);
  for (int l = 0; l < 2; ++l) {
    const int b0 = 1 + 10 * l;
    hipLaunchKernelGGL(phase_k<0>, dim3(grid_blocks), dim3(256), 0, stream, p, b0 + 0);
    hipLaunchKernelGGL(phase_k<1>, dim3(grid_blocks), dim3(256), 0, stream, p, b0 + 1);
    hipLaunchKernelGGL(phase_k<2>, dim3(grid_blocks), dim3(256), 0, stream, p, b0 + 2);
    hipLaunchKernelGGL(phase_k<3>, dim3(grid_blocks), dim3(256), 0, stream, p, b0 + 3);
    hipLaunchKernelGGL(phase_k<4>, dim3(192), dim3(256), 0, stream, p, b0 + 4);
    hipLaunchKernelGGL(phase_k<11>, dim3(grid_blocks), dim3(256), 0, stream, p, b0 + 4);
    hipLaunchKernelGGL(phase_k<5>, dim3(grid_blocks), dim3(256), 0, stream, p, b0 + 5);
    hipLaunchKernelGGL(phase_k<6>, dim3(grid_blocks), dim3(256), 0, stream, p, b0 + 6);
    hipLaunchKernelGGL(phase_k<7>, dim3(grid_blocks), dim3(256), 0, stream, p, b0 + 7);
    hipLaunchKernelGGL(phase_k<8>, dim3(grid_blocks), dim3(256), 0, stream, p, b0 + 8);
    hipLaunchKernelGGL(phase_k<9>, dim3(grid_blocks), dim3(256), 0, stream, p, b0 + 9);
  }
#else
  int lo = 0, hi = NPHASE;
  void* args[] = {&p, &lo, &hi};
  (void)hipMemsetAsync(p.BAR, 0, (XCD_BAR_WORDS + 128) * 4, stream);
  hipError_t e = hipLaunchCooperativeKernel((void*)mega, dim3(grid_blocks), dim3(256), args, 0, stream);
  if (e != hipSuccess) fprintf(stderr, "cooperative launch failed: %s (grid %d)\n", hipGetErrorString(e), grid_blocks);
#endif
}
```
